# Optimizing an MI355X kernel written in HIP

```python
import math
import jax, jax.numpy as jnp
from jax import lax
import numpy as np

D_MODEL = 1024
BATCH = 4
SEQ = 4096
DEPTH = 1
DEC_BATCH = 8
DEC_SEQ = 4096
PAST_LEN = 128

HEAD_DIM = 64
N_HEADS = 8
N_KV = 2
GROUP = N_HEADS // N_KV
ATT_WIDTH = N_HEADS * HEAD_DIM
KV_WIDTH = N_KV * HEAD_DIM
GM_HEADS = 8
GM_HD = 64
GM_WIDTH = GM_HEADS * GM_HD
MIX_WIDTH = ATT_WIDTH + GM_WIDTH
IN_WIDTH = ATT_WIDTH + 2 * KV_WIDTH + 2 * GM_WIDTH
BLK = 128
WINDOW = 128
CHUNK = 128
N_BUCKETS = 32
MAX_DIST = 128
D_FF = int(math.ceil(8 * D_MODEL / 3 / 256) * 256)
EPS = 1e-6
NEG = -1e30

kernel_name = "hymba_style_window_gqa_gmlp_encoder"


def rms_norm(x, g):
    xf = x.astype(jnp.float32)
    y = xf * lax.rsqrt(jnp.mean(xf * xf, axis=-1, keepdims=True) + EPS)
    return (y * g.astype(jnp.float32)).astype(x.dtype)


def t5_buckets(rel):
    half = N_BUCKETS // 2
    max_exact = half // 2
    ret = (rel > 0).astype(np.int32) * half
    n = np.abs(rel)
    large = max_exact + (np.log(np.maximum(n, 1).astype(np.float32) / max_exact)
                         / np.log(MAX_DIST / max_exact) * (half - max_exact)).astype(np.int32)
    large = np.minimum(large, half - 1)
    return (ret + np.where(n < max_exact, n, large)).astype(np.int32)


def windowed_gqa(q, k, v, q_gain, k_gain, sink, rel_table):
    B, S, _ = q.shape
    nb = S // BLK
    q = rms_norm(q.reshape(B, S, N_KV, GROUP, HEAD_DIM), q_gain)
    k = rms_norm(k.reshape(B, S, N_KV, HEAD_DIM), k_gain)
    v = v.reshape(B, S, N_KV, HEAD_DIM)
    pad = ((0, 0), (BLK, BLK), (0, 0), (0, 0))
    kp = jnp.pad(k, pad).reshape(B, nb + 2, BLK, N_KV, HEAD_DIM)
    vp = jnp.pad(v, pad).reshape(B, nb + 2, BLK, N_KV, HEAD_DIM)
    kband = jnp.concatenate([kp[:, :-2], kp[:, 1:-1], kp[:, 2:]], axis=2)
    vband = jnp.concatenate([vp[:, :-2], vp[:, 1:-1], vp[:, 2:]], axis=2)
    qb = q.reshape(B, nb, BLK, N_KV, GROUP, HEAD_DIM)
    scores = jnp.einsum("bnqkgd,bnskd->bnkgqs", qb, kband).astype(jnp.float32)
    scores = scores * (1.0 / math.sqrt(HEAD_DIM))
    rel = (np.arange(3 * BLK) - BLK)[None, :] - np.arange(BLK)[:, None]
    bias = rel_table.astype(jnp.float32)[t5_buckets(rel)]
    bias = jnp.transpose(bias, (2, 0, 1)).reshape(N_KV, GROUP, BLK, 3 * BLK)
    band = np.abs(rel) <= WINDOW
    key_pos = np.arange(nb)[:, None] * BLK - BLK + np.arange(3 * BLK)[None, :]
    valid = (key_pos >= 0) & (key_pos < S)
    mask = band[None] & valid[:, None, :]
    scores = jnp.where(mask[None, :, None, None], scores + bias[None, None], NEG)
    s_sink = sink.astype(jnp.float32).reshape(N_KV, GROUP)[None, None, :, :, None, None]
    m = jnp.maximum(jnp.max(scores, axis=-1, keepdims=True), s_sink)
    e = jnp.exp(scores - m)
    probs = e / (jnp.sum(e, axis=-1, keepdims=True) + jnp.exp(s_sink - m))
    out = jnp.einsum("bnkgqs,bnskd->bnqkgd", probs.astype(v.dtype), vband)
    return out.reshape(B, S, ATT_WIDTH)


def chunked_spatial_gating(u, v, v_gain, w_s, b_s):
    B, S, _ = u.shape
    nc = S // CHUNK
    u = jax.nn.gelu(u)
    v = rms_norm(jax.nn.gelu(v), v_gain)
    vh = v.reshape(B, nc, CHUNK, GM_HEADS, GM_HD)
    s = jnp.einsum("hpq,bcqhd->bcphd", w_s, vh) + jnp.transpose(b_s)[None, None, :, :, None]
    return (u.reshape(B, nc, CHUNK, GM_HEADS, GM_HD) * s).reshape(B, S, GM_WIDTH)


def encoder_layer(x, rel_table, norm1, w_in, q_gain, k_gain, sink, v_gain, w_s, b_s,
                  attn_out_gain, gmlp_out_gain, w_o, norm2, w_gate, w_up, w_down):
    h = rms_norm(x, norm1)
    proj = h @ w_in
    o1 = ATT_WIDTH
    o2 = o1 + KV_WIDTH
    o3 = o2 + KV_WIDTH
    o4 = o3 + GM_WIDTH
    q, k, v = proj[..., :o1], proj[..., o1:o2], proj[..., o2:o3]
    gu, gv = proj[..., o3:o4], proj[..., o4:]
    a = rms_norm(windowed_gqa(q, k, v, q_gain, k_gain, sink, rel_table), attn_out_gain)
    g = rms_norm(chunked_spatial_gating(gu, gv, v_gain, w_s, b_s), gmlp_out_gain)
    x = x + jnp.concatenate([a, g], axis=-1) @ w_o
    h2 = rms_norm(x, norm2)
    x = x + (jax.nn.silu(h2 @ w_gate) * (h2 @ w_up)) @ w_down
    return x


def setup_inputs(seed: int = 0) -> dict:
    key = jax.random.key(seed)
    ks = jax.random.split(key, 20)
    f = jnp.float32
    nrm = lambda k, shape, s: jax.random.normal(k, shape, f) * s
    L = DEPTH
    return {
        "x_prompt": nrm(ks[0], (BATCH, SEQ, D_MODEL), 1.0),
        "x_sample": nrm(ks[1], (DEC_BATCH, DEC_SEQ, D_MODEL), 1.0),
        "rel_bias_table": nrm(ks[2], (N_BUCKETS, N_HEADS), 0.5),
        "norm1": 1.0 + nrm(ks[3], (L, D_MODEL), 0.05),
        "w_in": nrm(ks[4], (L, D_MODEL, IN_WIDTH), D_MODEL ** -0.5),
        "q_gain": 1.0 + nrm(ks[5], (L, HEAD_DIM), 0.05),
        "k_gain": 1.0 + nrm(ks[6], (L, HEAD_DIM), 0.05),
        "sink": nrm(ks[7], (L, N_HEADS), 0.5),
        "v_gain": 1.0 + nrm(ks[8], (L, GM_WIDTH), 0.05),
        "w_s": nrm(ks[9], (L, GM_HEADS, CHUNK, CHUNK), CHUNK ** -0.5),
        "b_s": 1.0 + nrm(ks[10], (L, GM_HEADS, CHUNK), 0.1),
        "attn_out_gain": 1.0 + nrm(ks[11], (L, ATT_WIDTH), 0.05),
        "gmlp_out_gain": 1.0 + nrm(ks[12], (L, GM_WIDTH), 0.05),
        "w_o": nrm(ks[13], (L, MIX_WIDTH, D_MODEL), MIX_WIDTH ** -0.5),
        "norm2": 1.0 + nrm(ks[14], (L, D_MODEL), 0.05),
        "w_gate": nrm(ks[15], (L, D_MODEL, D_FF), D_MODEL ** -0.5),
        "w_up": nrm(ks[16], (L, D_MODEL, D_FF), D_MODEL ** -0.5),
        "w_down": nrm(ks[17], (L, D_FF, D_MODEL), D_FF ** -0.5),
    }


def reference(x_prompt, x_sample, rel_bias_table, norm1, w_in, q_gain, k_gain, sink, v_gain,
              w_s, b_s, attn_out_gain, gmlp_out_gain, w_o, norm2, w_gate, w_up, w_down):
    y_prompt = x_prompt
    y_sample = x_sample
    for l in range(DEPTH):
        params = (rel_bias_table, norm1[l], w_in[l], q_gain[l], k_gain[l], sink[l], v_gain[l],
                  w_s[l], b_s[l], attn_out_gain[l], gmlp_out_gain[l], w_o[l], norm2[l],
                  w_gate[l], w_up[l], w_down[l])
        y_prompt = encoder_layer(y_prompt, *params)
        y_sample = encoder_layer(y_sample, *params)
    return (y_prompt, y_sample)
```

```cpp
#include <hip/hip_runtime.h>
#include <cstdio>
#include <cstdint>

typedef unsigned short bf16_t;
constexpr int D = 1024, SEQ = 4096, NSEQ = 12, M = NSEQ * SEQ, MP = 4 * SEQ;
constexpr int INW = 1792, DFF = 2816, NGU = 2 * DFF;
constexpr float EPS = 1e-6f, LOG2E = 1.4426950408889634f, QSCALE = 0.125f * LOG2E;

constexpr size_t MiB = 1u << 20;
constexpr size_t WS_CTL = 0;
constexpr size_t WS_WIN = 1 * MiB;
constexpr size_t WS_WO = 5 * MiB;
constexpr size_t WS_WGU = 7 * MiB;
constexpr size_t WS_WDN = 18 * MiB;
constexpr size_t WS_WS = 24 * MiB;
constexpr size_t WS_VSSQ = 25 * MiB;
constexpr size_t WS_SSQ2 = 27 * MiB;
constexpr size_t WS_XN = 32 * MiB;
constexpr size_t WS_PROJ = 128 * MiB;
constexpr size_t WS_H = 32 * MiB;
constexpr size_t WS_MIX = 296 * MiB;
constexpr size_t WS_X1B = 392 * MiB;
constexpr size_t WS_END = 488 * MiB;

__device__ __forceinline__ unsigned f2bf(float f) { unsigned u = __builtin_bit_cast(unsigned, f); return (u + 0x7fffu + ((u >> 16) & 1u)) >> 16; }
__device__ __forceinline__ float bf2f(bf16_t b) { return __builtin_bit_cast(float, (unsigned)b << 16); }
__device__ __forceinline__ float gelu_tanh(float x) { const float u = 0.7978845608028654f * (x + 0.044715f * x * x * x); return x / (1.0f + __expf(-2.0f * u)); }
__device__ __forceinline__ float silu(float x) { return x / (1.0f + __expf(-x)); }
__device__ __forceinline__ int t5_bucket(int rel) { const int n = rel < 0 ? -rel : rel; int b = n < 8 ? n : (2 + (31 - __builtin_clz(n * n))); b = b > 15 ? 15 : b; return b + (rel > 0 ? 16 : 0); }

__global__ void __launch_bounds__(256) k_prep_w(const float* w_in, const float* w_o, const float* w_gate, const float* w_up, const float* w_down, const float* w_s, const float* norm2, unsigned char* ws) {
    const size_t N0 = (size_t)INW * D, N1 = (size_t)D * D, N2 = (size_t)NGU * D, N3 = (size_t)D * DFF, N4 = 8 * 128 * 128;
    size_t i = (size_t)blockIdx.x * 256 + threadIdx.x;
    if (i < N0) { const int n = i / D, k = i % D; ((bf16_t*)(ws + WS_WIN))[i] = f2bf(w_in[(size_t)k * INW + n]); return; } i -= N0;
    if (i < N1) { const int n = i / D, k = i % D; ((bf16_t*)(ws + WS_WO))[i] = f2bf(w_o[(size_t)k * D + n]); return; } i -= N1;
    if (i < N2) { const int r = i / D, k = i % D; const int pn = r >> 8, bj = (r >> 7) & 1, c = r & 127, col = 128 * pn + c;
        ((bf16_t*)(ws + WS_WGU))[i] = f2bf(norm2[k] * (bj ? w_up : w_gate)[(size_t)k * DFF + col]); return; } i -= N2;
    if (i < N3) { const int n = i / DFF, k = i % DFF; ((bf16_t*)(ws + WS_WDN))[i] = f2bf(w_down[(size_t)k * D + n]); return; } i -= N3;
    if (i < N4) { ((bf16_t*)(ws + WS_WS))[i] = f2bf(w_s[i]); }
}
__global__ void __launch_bounds__(256) k_xn(const float* xp, const float* xs, const float* norm1, bf16_t* XN) {
    const int m = blockIdx.x * 4 + (threadIdx.x >> 6), lane = threadIdx.x & 63;
    const float* x = m < MP ? xp + (size_t)m * D : xs + (size_t)(m - MP) * D;
    float v[16]; float ss = 0.f;
#pragma unroll
    for (int j = 0; j < 16; ++j) { v[j] = x[lane + 64 * j]; ss += v[j] * v[j]; }
#pragma unroll
    for (int o = 1; o < 64; o <<= 1) ss += __shfl_xor(ss, o);
    const float r = rsqrtf(ss * (1.0f / D) + EPS);
#pragma unroll
    for (int j = 0; j < 16; ++j) XN[(size_t)m * D + lane + 64 * j] = f2bf(v[j] * r * norm1[lane + 64 * j]);
}

template <class Epi, bool DUAL>
__global__ void __launch_bounds__(256) k_gemm_naive(const bf16_t* A, const bf16_t* Bt, int K, Epi epi) {
    __shared__ float As[32][68], Bs[32][68], B2s[DUAL ? 32 : 1][68], Ct[64][65], C2t[DUAL ? 64 : 1][65];
    const int tid = threadIdx.x, ty = tid >> 4, tx = tid & 15, lr = tid >> 2, kc = (tid & 3) * 8;
    const int m0 = blockIdx.y * 64, n0 = blockIdx.x * 64;
    const bf16_t* ap = A + (size_t)(m0 + lr) * K + kc;
    const int br = epi.brow(n0 + lr);
    const bf16_t* bp = Bt + (size_t)br * K + kc;
    const bf16_t* bp2 = Bt + (size_t)(br + 128) * K + kc;
    float acc[4][4] = {}, acc2[4][4] = {};
    for (int k0 = 0; k0 < K; k0 += 32) {
        const uint4 av = *(const uint4*)(ap + k0), bv = *(const uint4*)(bp + k0);
        const unsigned aw[4] = {av.x, av.y, av.z, av.w}, bw[4] = {bv.x, bv.y, bv.z, bv.w};
#pragma unroll
        for (int j = 0; j < 4; ++j) { As[kc + 2 * j][lr] = __builtin_bit_cast(float, aw[j] << 16); As[kc + 2 * j + 1][lr] = __builtin_bit_cast(float, aw[j] & 0xffff0000u);
                                      Bs[kc + 2 * j][lr] = __builtin_bit_cast(float, bw[j] << 16); Bs[kc + 2 * j + 1][lr] = __builtin_bit_cast(float, bw[j] & 0xffff0000u); }
        if (DUAL) { const uint4 cv = *(const uint4*)(bp2 + k0); const unsigned cw[4] = {cv.x, cv.y, cv.z, cv.w};
#pragma unroll
            for (int j = 0; j < 4; ++j) { B2s[kc + 2 * j][lr] = __builtin_bit_cast(float, cw[j] << 16); B2s[kc + 2 * j + 1][lr] = __builtin_bit_cast(float, cw[j] & 0xffff0000u); } }
        __syncthreads();
#pragma unroll 8
        for (int k = 0; k < 32; ++k) {
            float a[4], b[4], b2[4];
#pragma unroll
            for (int i = 0; i < 4; ++i) { a[i] = As[k][4 * ty + i]; b[i] = Bs[k][4 * tx + i]; b2[i] = DUAL ? B2s[k][4 * tx + i] : 0.f; }
#pragma unroll
            for (int i = 0; i < 4; ++i)
#pragma unroll
                for (int j = 0; j < 4; ++j) { acc[i][j] += a[i] * b[j]; if (DUAL) acc2[i][j] += a[i] * b2[j]; }
        }
        __syncthreads();
    }
#pragma unroll
    for (int i = 0; i < 4; ++i)
#pragma unroll
        for (int j = 0; j < 4; ++j) { Ct[4 * ty + i][4 * tx + j] = acc[i][j]; if (DUAL) C2t[4 * ty + i][4 * tx + j] = acc2[i][j]; }
    __syncthreads();
    const int r = tid >> 2, part = tid & 3;
    epi(m0 + r, n0, part, &Ct[r][part * 16], DUAL ? &C2t[r][part * 16] : nullptr);
}
__device__ __forceinline__ float red4(float v) { v += __shfl_xor(v, 1); v += __shfl_xor(v, 2); return v; }
struct NEpiIn {
    bf16_t* PROJ; float* VSSQ; const float* qg; const float* kg;
    __device__ int brow(int n) const { return n; }
    __device__ void operator()(int row, int n0, int part, const float* c, const float*) const {
        const int ct = n0 >> 6; float v[16];
#pragma unroll
        for (int j = 0; j < 16; ++j) v[j] = c[j];
        if (ct < 10) { float ss = 0.f;
#pragma unroll
            for (int j = 0; j < 16; ++j) ss += v[j] * v[j];
            ss = red4(ss); const float r = rsqrtf(ss * (1.0f / 64.0f) + EPS); const float* g = ct < 8 ? qg : kg; const float sc = ct < 8 ? QSCALE : 1.0f;
#pragma unroll
            for (int j = 0; j < 16; ++j) v[j] = v[j] * r * g[part * 16 + j] * sc;
        } else if (ct >= 12) { float ss = 0.f;
#pragma unroll
            for (int j = 0; j < 16; ++j) { v[j] = gelu_tanh(v[j]); ss += v[j] * v[j]; }
            if (ct >= 20) { ss = red4(ss); if (part == 0) VSSQ[(size_t)row * 8 + (ct - 20)] = ss; }
        }
#pragma unroll
        for (int j = 0; j < 16; ++j) PROJ[(size_t)row * INW + n0 + part * 16 + j] = f2bf(v[j]);
    }
};
struct NEpiOut {
    const float* xp; const float* xs; float* out; bf16_t* X1B; float* SSQ2;
    __device__ int brow(int n) const { return n; }
    __device__ void operator()(int row, int n0, int part, const float* c, const float*) const {
        const float* x = row < MP ? xp + (size_t)row * D : xs + (size_t)(row - MP) * D; float ss = 0.f;
#pragma unroll
        for (int j = 0; j < 16; ++j) { const int col = n0 + part * 16 + j; const float v = x[col] + c[j]; out[(size_t)row * D + col] = v; X1B[(size_t)row * D + col] = f2bf(v); ss += v * v; }
        ss = red4(ss); if (part == 0) SSQ2[(size_t)row * 16 + (n0 >> 6)] = ss;
    }
};
struct NEpiUp {
    bf16_t* H; const float* SSQ2;
    __device__ int brow(int n) const { return 256 * (n >> 7) + (n & 127); }
    __device__ void operator()(int row, int n0, int part, const float* c, const float* c2) const {
        float ss = 0.f;
#pragma unroll
        for (int j = 0; j < 16; ++j) ss += SSQ2[(size_t)row * 16 + j];
        const float r = rsqrtf(ss * (1.0f / D) + EPS);
#pragma unroll
        for (int j = 0; j < 16; ++j) H[(size_t)row * DFF + n0 + part * 16 + j] = f2bf(silu(c[j] * r) * (c2[j] * r));
    }
};
struct NEpiDown {
    float* out;
    __device__ int brow(int n) const { return n; }
    __device__ void operator()(int row, int n0, int part, const float* c, const float*) const {
#pragma unroll
        for (int j = 0; j < 16; ++j) { const size_t o = (size_t)row * D + n0 + part * 16 + j; out[o] = out[o] + c[j]; }
    }
};

__global__ void __launch_bounds__(256) k_mix_naive(const bf16_t* PROJ, const float* VSSQ, const bf16_t* WSB, const float* rel_table, const float* sink, const float* v_gain,
                                                  const float* b_s, const float* ag, const float* gg, bf16_t* MIX) {
    __shared__ float ps[4][320], qs[4][64], arow[512], grow[512], rv[128], red[4];
    const int m = blockIdx.x, s = m / SEQ, t = m % SEQ, tid = threadIdx.x, w = tid >> 6, lane = tid & 63;
    const bf16_t* prow = PROJ + (size_t)m * INW;
    const int jlo = t - 128 < 0 ? 0 : t - 128, jhi = t + 128 > SEQ - 1 ? SEQ - 1 : t + 128, nk = jhi - jlo + 1;
    for (int hh = 0; hh < 2; ++hh) {
        const int h = w * 2 + hh, g = h >> 2;
        qs[w][lane] = bf2f(prow[64 * h + lane]);
        __syncthreads();
        const float sink2 = sink[h] * LOG2E; float sc[5]; float mx = sink2;
#pragma unroll
        for (int i = 0; i < 5; ++i) { const int j = jlo + lane + 64 * i; sc[i] = -1e30f;
            if (j <= jhi) { const bf16_t* kr = PROJ + (size_t)(s * SEQ + j) * INW + 512 + 64 * g; float dot = 0.f;
                for (int d = 0; d < 64; ++d) dot += qs[w][d] * bf2f(kr[d]);
                dot += rel_table[t5_bucket(j - t) * 8 + h] * LOG2E; sc[i] = dot; mx = fmaxf(mx, dot); } }
#pragma unroll
        for (int o = 1; o < 64; o <<= 1) mx = fmaxf(mx, __shfl_xor(mx, o));
        float l = 0.f;
#pragma unroll
        for (int i = 0; i < 5; ++i) { const int j = jlo + lane + 64 * i; const float p = j <= jhi ? exp2f(sc[i] - mx) : 0.f; l += p; ps[w][lane + 64 * i] = p; }
#pragma unroll
        for (int o = 1; o < 64; o <<= 1) l += __shfl_xor(l, o);
        l += exp2f(sink2 - mx);
        __syncthreads();
        float o = 0.f;
        for (int jj = 0; jj < nk; ++jj) o += ps[w][jj] * bf2f(PROJ[(size_t)(s * SEQ + jlo + jj) * INW + 640 + 64 * g + lane]);
        arow[64 * h + lane] = o / l;
        __syncthreads();
    }
    const int mc = m - (t & 127), p = t & 127;
    if (tid < 128) { float ss = 0.f; for (int i = 0; i < 8; ++i) ss += VSSQ[(size_t)(mc + tid) * 8 + i]; rv[tid] = rsqrtf(ss * (1.0f / 512.0f) + EPS); }
    __syncthreads();
    for (int c = tid; c < 512; c += 256) { const int h = c >> 6; float a = 0.f; const float vg = v_gain[c];
        for (int q = 0; q < 128; ++q) a += bf2f(WSB[(h * 128 + p) * 128 + q]) * (bf2f(PROJ[(size_t)(mc + q) * INW + 1280 + c]) * rv[q] * vg);
        grow[c] = bf2f(prow[768 + c]) * (a + b_s[h * 128 + p]); }
    __syncthreads();
    float sa = arow[tid] * arow[tid] + arow[tid + 256] * arow[tid + 256], sg = grow[tid] * grow[tid] + grow[tid + 256] * grow[tid + 256];
#pragma unroll
    for (int o = 1; o < 64; o <<= 1) { sa += __shfl_xor(sa, o); sg += __shfl_xor(sg, o); }
    if (lane == 0) { red[w] = sa; } __syncthreads(); sa = red[0] + red[1] + red[2] + red[3]; __syncthreads();
    if (lane == 0) { red[w] = sg; } __syncthreads(); sg = red[0] + red[1] + red[2] + red[3];
    const float ra = rsqrtf(sa * (1.0f / 512.0f) + EPS), rg = rsqrtf(sg * (1.0f / 512.0f) + EPS);
    for (int c = tid; c < 512; c += 256) { MIX[(size_t)m * D + c] = f2bf(arow[c] * ra * ag[c]); MIX[(size_t)m * D + 512 + c] = f2bf(grow[c] * rg * gg[c]); }
}

extern "C" void kernel_launch(void* const* d_in, const int* in_sizes, int n_in, void* d_out, int out_size, void* d_ws, size_t ws_size, hipStream_t stream) {
    if (n_in != 18 || in_sizes[0] != MP * D || in_sizes[1] != (M - MP) * D || out_size != M * D || ws_size < WS_END) {
        fprintf(stderr, "kernel_launch: unexpected shapes (n_in %d, in0 %d, in1 %d, out %d, ws %zu)\n", n_in, n_in > 0 ? in_sizes[0] : -1, n_in > 1 ? in_sizes[1] : -1, out_size, ws_size); return; }
    const float* xp = (const float*)d_in[0]; const float* xs = (const float*)d_in[1]; const float* rel = (const float*)d_in[2]; const float* norm1 = (const float*)d_in[3];
    const float* w_in = (const float*)d_in[4]; const float* qg = (const float*)d_in[5]; const float* kg = (const float*)d_in[6]; const float* sink = (const float*)d_in[7];
    const float* vg = (const float*)d_in[8]; const float* w_s = (const float*)d_in[9]; const float* b_s = (const float*)d_in[10]; const float* ag = (const float*)d_in[11];
    const float* gg = (const float*)d_in[12]; const float* w_o = (const float*)d_in[13]; const float* norm2 = (const float*)d_in[14]; const float* w_gate = (const float*)d_in[15];
    const float* w_up = (const float*)d_in[16]; const float* w_down = (const float*)d_in[17];
    unsigned char* ws = (unsigned char*)d_ws; float* out = (float*)d_out;
    bf16_t* WIN = (bf16_t*)(ws + WS_WIN); bf16_t* WO = (bf16_t*)(ws + WS_WO); bf16_t* WGU = (bf16_t*)(ws + WS_WGU); bf16_t* WDN = (bf16_t*)(ws + WS_WDN); bf16_t* WSB = (bf16_t*)(ws + WS_WS);
    float* VSSQ = (float*)(ws + WS_VSSQ); float* SSQ2 = (float*)(ws + WS_SSQ2);
    bf16_t* XN = (bf16_t*)(ws + WS_XN); bf16_t* PROJ = (bf16_t*)(ws + WS_PROJ); bf16_t* H = (bf16_t*)(ws + WS_H); bf16_t* MIX = (bf16_t*)(ws + WS_MIX); bf16_t* X1B = (bf16_t*)(ws + WS_X1B);
    const size_t nprep = (size_t)INW * D + (size_t)D * D + (size_t)NGU * D + (size_t)D * DFF + 8 * 128 * 128;
    k_prep_w<<<(unsigned)((nprep + 255) / 256), 256, 0, stream>>>(w_in, w_o, w_gate, w_up, w_down, w_s, norm2, ws);
    k_xn<<<M / 4, 256, 0, stream>>>(xp, xs, norm1, XN);
    k_gemm_naive<NEpiIn, false><<<dim3(INW / 64, M / 64), 256, 0, stream>>>(XN, WIN, D, NEpiIn{PROJ, VSSQ, qg, kg});
    k_mix_naive<<<M, 256, 0, stream>>>(PROJ, VSSQ, WSB, rel, sink, vg, b_s, ag, gg, MIX);
    k_gemm_naive<NEpiOut, false><<<dim3(D / 64, M / 64), 256, 0, stream>>>(MIX, WO, D, NEpiOut{xp, xs, out, X1B, SSQ2});
    k_gemm_naive<NEpiUp, true><<<dim3(DFF / 64, M / 64), 256, 0, stream>>>(X1B, WGU, D, NEpiUp{H, SSQ2});
    k_gemm_naive<NEpiDown, false><<<dim3(D / 64, M / 64), 256, 0, stream>>>(H, WDN, DFF, NEpiDown{out});
}
```

```cpp
#include <hip/hip_runtime.h>
#include <cstdio>
#include <cstdint>

typedef unsigned short bf16_t;
constexpr int D = 1024, SEQ = 4096, NSEQ = 12, M = NSEQ * SEQ, MP = 4 * SEQ;
constexpr int INW = 1792, DFF = 2816, NGU = 2 * DFF;
constexpr float EPS = 1e-6f, LOG2E = 1.4426950408889634f, QSCALE = 0.125f * LOG2E;

constexpr size_t MiB = 1u << 20;
constexpr size_t WS_CTL = 0;
constexpr size_t WS_WIN = 1 * MiB;
constexpr size_t WS_WO = 5 * MiB;
constexpr size_t WS_WGU = 7 * MiB;
constexpr size_t WS_WDN = 18 * MiB;
constexpr size_t WS_WS = 24 * MiB;
constexpr size_t WS_VSSQ = 25 * MiB;
constexpr size_t WS_SSQ2 = 27 * MiB;
constexpr size_t WS_XN = 32 * MiB;
constexpr size_t WS_PROJ = 128 * MiB;
constexpr size_t WS_H = 32 * MiB;
constexpr size_t WS_MIX = 296 * MiB;
constexpr size_t WS_X1B = 392 * MiB;
constexpr size_t WS_END = 488 * MiB;

__device__ __forceinline__ unsigned f2bf(float f) { unsigned u = __builtin_bit_cast(unsigned, f); return (u + 0x7fffu + ((u >> 16) & 1u)) >> 16; }
__device__ __forceinline__ float bf2f(bf16_t b) { return __builtin_bit_cast(float, (unsigned)b << 16); }
__device__ __forceinline__ float gelu_tanh(float x) { const float u = 0.7978845608028654f * (x + 0.044715f * x * x * x); return x / (1.0f + __expf(-2.0f * u)); }
__device__ __forceinline__ float silu(float x) { return x / (1.0f + __expf(-x)); }
__device__ __forceinline__ int t5_bucket(int rel) { const int n = rel < 0 ? -rel : rel; int b = n < 8 ? n : (2 + (31 - __builtin_clz(n * n))); b = b > 15 ? 15 : b; return b + (rel > 0 ? 16 : 0); }

__device__ __forceinline__ void prep_w_elem(size_t i, const float* w_in, const float* w_o, const float* w_gate, const float* w_up, const float* w_down, const float* w_s, const float* norm2, unsigned char* ws) {
    const size_t N0 = (size_t)INW * D, N1 = (size_t)D * D, N2 = (size_t)NGU * D, N3 = (size_t)D * DFF, N4 = 8 * 128 * 128;
    if (i < N0) { const int n = i / D, k = i % D; ((bf16_t*)(ws + WS_WIN))[i] = f2bf(w_in[(size_t)k * INW + n]); return; } i -= N0;
    if (i < N1) { const int n = i / D, k = i % D; ((bf16_t*)(ws + WS_WO))[i] = f2bf(w_o[(size_t)k * D + n]); return; } i -= N1;
    if (i < N2) { const int r = i / D, k = i % D; const int pn = r >> 8, bj = (r >> 7) & 1, c = r & 127, col = 128 * pn + c;
        ((bf16_t*)(ws + WS_WGU))[i] = f2bf(norm2[k] * (bj ? w_up : w_gate)[(size_t)k * DFF + col]); return; } i -= N2;
    if (i < N3) { const int n = i / DFF, k = i % DFF; ((bf16_t*)(ws + WS_WDN))[i] = f2bf(w_down[(size_t)k * D + n]); return; } i -= N3;
    if (i < N4) { ((bf16_t*)(ws + WS_WS))[i] = f2bf(w_s[i]); }
}
constexpr size_t NPREP = (size_t)INW * D + (size_t)D * D + (size_t)NGU * D + (size_t)D * DFF + 8 * 128 * 128;
__global__ void __launch_bounds__(256) k_prep_w(const float* w_in, const float* w_o, const float* w_gate, const float* w_up, const float* w_down, const float* w_s, const float* norm2, unsigned char* ws) {
    prep_w_elem((size_t)blockIdx.x * 256 + threadIdx.x, w_in, w_o, w_gate, w_up, w_down, w_s, norm2, ws);
}
__device__ __forceinline__ void xn_row(int m, int lane, const float* xp, const float* xs, const float* norm1, bf16_t* XN) {
    const float* x = m < MP ? xp + (size_t)m * D : xs + (size_t)(m - MP) * D;
    float v[16]; float ss = 0.f;
#pragma unroll
    for (int j = 0; j < 16; ++j) { v[j] = x[lane + 64 * j]; ss += v[j] * v[j]; }
#pragma unroll
    for (int o = 1; o < 64; o <<= 1) ss += __shfl_xor(ss, o);
    const float r = rsqrtf(ss * (1.0f / D) + EPS);
#pragma unroll
    for (int j = 0; j < 16; ++j) XN[(size_t)m * D + lane + 64 * j] = f2bf(v[j] * r * norm1[lane + 64 * j]);
}
__global__ void __launch_bounds__(256) k_xn(const float* xp, const float* xs, const float* norm1, bf16_t* XN) { xn_row(blockIdx.x * 4 + (threadIdx.x >> 6), threadIdx.x & 63, xp, xs, norm1, XN); }

template <class Epi, bool DUAL>
__global__ void __launch_bounds__(256) k_gemm_naive(const bf16_t* A, const bf16_t* Bt, int K, Epi epi) {
    __shared__ float As[32][68], Bs[32][68], B2s[DUAL ? 32 : 1][68], Ct[64][65], C2t[DUAL ? 64 : 1][65];
    const int tid = threadIdx.x, ty = tid >> 4, tx = tid & 15, lr = tid >> 2, kc = (tid & 3) * 8;
    const int m0 = blockIdx.y * 64, n0 = blockIdx.x * 64;
    const bf16_t* ap = A + (size_t)(m0 + lr) * K + kc;
    const int br = epi.brow(n0 + lr);
    const bf16_t* bp = Bt + (size_t)br * K + kc;
    const bf16_t* bp2 = Bt + (size_t)(br + 128) * K + kc;
    float acc[4][4] = {}, acc2[4][4] = {};
    for (int k0 = 0; k0 < K; k0 += 32) {
        const uint4 av = *(const uint4*)(ap + k0), bv = *(const uint4*)(bp + k0);
        const unsigned aw[4] = {av.x, av.y, av.z, av.w}, bw[4] = {bv.x, bv.y, bv.z, bv.w};
#pragma unroll
        for (int j = 0; j < 4; ++j) { As[kc + 2 * j][lr] = __builtin_bit_cast(float, aw[j] << 16); As[kc + 2 * j + 1][lr] = __builtin_bit_cast(float, aw[j] & 0xffff0000u);
                                      Bs[kc + 2 * j][lr] = __builtin_bit_cast(float, bw[j] << 16); Bs[kc + 2 * j + 1][lr] = __builtin_bit_cast(float, bw[j] & 0xffff0000u); }
        if (DUAL) { const uint4 cv = *(const uint4*)(bp2 + k0); const unsigned cw[4] = {cv.x, cv.y, cv.z, cv.w};
#pragma unroll
            for (int j = 0; j < 4; ++j) { B2s[kc + 2 * j][lr] = __builtin_bit_cast(float, cw[j] << 16); B2s[kc + 2 * j + 1][lr] = __builtin_bit_cast(float, cw[j] & 0xffff0000u); } }
        __syncthreads();
#pragma unroll 8
        for (int k = 0; k < 32; ++k) {
            float a[4], b[4], b2[4];
#pragma unroll
            for (int i = 0; i < 4; ++i) { a[i] = As[k][4 * ty + i]; b[i] = Bs[k][4 * tx + i]; b2[i] = DUAL ? B2s[k][4 * tx + i] : 0.f; }
#pragma unroll
            for (int i = 0; i < 4; ++i)
#pragma unroll
                for (int j = 0; j < 4; ++j) { acc[i][j] += a[i] * b[j]; if (DUAL) acc2[i][j] += a[i] * b2[j]; }
        }
        __syncthreads();
    }
#pragma unroll
    for (int i = 0; i < 4; ++i)
#pragma unroll
        for (int j = 0; j < 4; ++j) { Ct[4 * ty + i][4 * tx + j] = acc[i][j]; if (DUAL) C2t[4 * ty + i][4 * tx + j] = acc2[i][j]; }
    __syncthreads();
    const int r = tid >> 2, part = tid & 3;
    epi(m0 + r, n0, part, &Ct[r][part * 16], DUAL ? &C2t[r][part * 16] : nullptr);
}
__device__ __forceinline__ float red4(float v) { v += __shfl_xor(v, 1); v += __shfl_xor(v, 2); return v; }
struct NEpiIn {
    bf16_t* PROJ; float* VSSQ; const float* qg; const float* kg;
    __device__ int brow(int n) const { return n; }
    __device__ void operator()(int row, int n0, int part, const float* c, const float*) const {
        const int ct = n0 >> 6; float v[16];
#pragma unroll
        for (int j = 0; j < 16; ++j) v[j] = c[j];
        if (ct < 10) { float ss = 0.f;
#pragma unroll
            for (int j = 0; j < 16; ++j) ss += v[j] * v[j];
            ss = red4(ss); const float r = rsqrtf(ss * (1.0f / 64.0f) + EPS); const float* g = ct < 8 ? qg : kg; const float sc = ct < 8 ? QSCALE : 1.0f;
#pragma unroll
            for (int j = 0; j < 16; ++j) v[j] = v[j] * r * g[part * 16 + j] * sc;
        } else if (ct >= 12) { float ss = 0.f;
#pragma unroll
            for (int j = 0; j < 16; ++j) { v[j] = gelu_tanh(v[j]); ss += v[j] * v[j]; }
            if (ct >= 20) { ss = red4(ss); if (part == 0) VSSQ[(size_t)row * 8 + (ct - 20)] = ss; }
        }
#pragma unroll
        for (int j = 0; j < 16; ++j) PROJ[(size_t)row * INW + n0 + part * 16 + j] = f2bf(v[j]);
    }
};
struct NEpiOut {
    const float* xp; const float* xs; float* out; bf16_t* X1B; float* SSQ2;
    __device__ int brow(int n) const { return n; }
    __device__ void operator()(int row, int n0, int part, const float* c, const float*) const {
        const float* x = row < MP ? xp + (size_t)row * D : xs + (size_t)(row - MP) * D; float ss = 0.f;
#pragma unroll
        for (int j = 0; j < 16; ++j) { const int col = n0 + part * 16 + j; const float v = x[col] + c[j]; out[(size_t)row * D + col] = v; X1B[(size_t)row * D + col] = f2bf(v); ss += v * v; }
        ss = red4(ss); if (part == 0) SSQ2[(size_t)row * 16 + (n0 >> 6)] = ss;
    }
};
struct NEpiUp {
    bf16_t* H; const float* SSQ2;
    __device__ int brow(int n) const { return 256 * (n >> 7) + (n & 127); }
    __device__ void operator()(int row, int n0, int part, const float* c, const float* c2) const {
        float ss = 0.f;
#pragma unroll
        for (int j = 0; j < 16; ++j) ss += SSQ2[(size_t)row * 16 + j];
        const float r = rsqrtf(ss * (1.0f / D) + EPS);
#pragma unroll
        for (int j = 0; j < 16; ++j) H[(size_t)row * DFF + n0 + part * 16 + j] = f2bf(silu(c[j] * r) * (c2[j] * r));
    }
};
struct NEpiDown {
    float* out;
    __device__ int brow(int n) const { return n; }
    __device__ void operator()(int row, int n0, int part, const float* c, const float*) const {
#pragma unroll
        for (int j = 0; j < 16; ++j) { const size_t o = (size_t)row * D + n0 + part * 16 + j; out[o] = out[o] + c[j]; }
    }
};

struct MixNaiveLds { float ps[4][320], qs[4][64], arow[512], grow[512], rv[128], red[4]; };
__device__ __forceinline__ void mix_naive_token(int m, int tid, MixNaiveLds& L, const bf16_t* PROJ, const float* VSSQ, const bf16_t* WSB, const float* rel_table, const float* sink, const float* v_gain,
                                                const float* b_s, const float* ag, const float* gg, bf16_t* MIX) {
    const int s = m / SEQ, t = m % SEQ, w = tid >> 6, lane = tid & 63;
    const bf16_t* prow = PROJ + (size_t)m * INW;
    const int jlo = t - 128 < 0 ? 0 : t - 128, jhi = t + 128 > SEQ - 1 ? SEQ - 1 : t + 128, nk = jhi - jlo + 1;
    for (int hh = 0; hh < 2; ++hh) {
        const int h = w * 2 + hh, g = h >> 2;
        L.qs[w][lane] = bf2f(prow[64 * h + lane]);
        __syncthreads();
        const float sink2 = sink[h] * LOG2E; float sc[5]; float mx = sink2;
#pragma unroll
        for (int i = 0; i < 5; ++i) { const int j = jlo + lane + 64 * i; sc[i] = -1e30f;
            if (j <= jhi) { const bf16_t* kr = PROJ + (size_t)(s * SEQ + j) * INW + 512 + 64 * g; float dot = 0.f;
                for (int d = 0; d < 64; ++d) dot += L.qs[w][d] * bf2f(kr[d]);
                dot += rel_table[t5_bucket(j - t) * 8 + h] * LOG2E; sc[i] = dot; mx = fmaxf(mx, dot); } }
#pragma unroll
        for (int o = 1; o < 64; o <<= 1) mx = fmaxf(mx, __shfl_xor(mx, o));
        float l = 0.f;
#pragma unroll
        for (int i = 0; i < 5; ++i) { const int j = jlo + lane + 64 * i; const float p = j <= jhi ? exp2f(sc[i] - mx) : 0.f; l += p; L.ps[w][lane + 64 * i] = p; }
#pragma unroll
        for (int o = 1; o < 64; o <<= 1) l += __shfl_xor(l, o);
        l += exp2f(sink2 - mx);
        __syncthreads();
        float o = 0.f;
        for (int jj = 0; jj < nk; ++jj) o += L.ps[w][jj] * bf2f(PROJ[(size_t)(s * SEQ + jlo + jj) * INW + 640 + 64 * g + lane]);
        L.arow[64 * h + lane] = o / l;
        __syncthreads();
    }
    const int mc = m - (t & 127), p = t & 127;
    if (tid < 128) { float ss = 0.f; for (int i = 0; i < 8; ++i) ss += VSSQ[(size_t)(mc + tid) * 8 + i]; L.rv[tid] = rsqrtf(ss * (1.0f / 512.0f) + EPS); }
    __syncthreads();
    for (int c = tid; c < 512; c += 256) { const int h = c >> 6; float a = 0.f; const float vg = v_gain[c];
        for (int q = 0; q < 128; ++q) a += bf2f(WSB[(h * 128 + p) * 128 + q]) * (bf2f(PROJ[(size_t)(mc + q) * INW + 1280 + c]) * L.rv[q] * vg);
        L.grow[c] = bf2f(prow[768 + c]) * (a + b_s[h * 128 + p]); }
    __syncthreads();
    float sa = L.arow[tid] * L.arow[tid] + L.arow[tid + 256] * L.arow[tid + 256], sg = L.grow[tid] * L.grow[tid] + L.grow[tid + 256] * L.grow[tid + 256];
#pragma unroll
    for (int o = 1; o < 64; o <<= 1) { sa += __shfl_xor(sa, o); sg += __shfl_xor(sg, o); }
    if (lane == 0) { L.red[w] = sa; } __syncthreads(); sa = L.red[0] + L.red[1] + L.red[2] + L.red[3]; __syncthreads();
    if (lane == 0) { L.red[w] = sg; } __syncthreads(); sg = L.red[0] + L.red[1] + L.red[2] + L.red[3];
    const float ra = rsqrtf(sa * (1.0f / 512.0f) + EPS), rg = rsqrtf(sg * (1.0f / 512.0f) + EPS);
    for (int c = tid; c < 512; c += 256) { MIX[(size_t)m * D + c] = f2bf(L.arow[c] * ra * ag[c]); MIX[(size_t)m * D + 512 + c] = f2bf(L.grow[c] * rg * gg[c]); }
    __syncthreads();
}
__global__ void __launch_bounds__(256) k_mix_naive(const bf16_t* PROJ, const float* VSSQ, const bf16_t* WSB, const float* rel_table, const float* sink, const float* v_gain,
                                                  const float* b_s, const float* ag, const float* gg, bf16_t* MIX) {
    __shared__ MixNaiveLds L;
    mix_naive_token(blockIdx.x, threadIdx.x, L, PROJ, VSSQ, WSB, rel_table, sink, v_gain, b_s, ag, gg, MIX);
}

#define MK_ONE_LAUNCH 1
#define MK_PHASE_MASK 0x3F
#define MK_MIXER_NAIVE 1

namespace pg8 {
#define PG8_LAS __attribute__((address_space(3)))
typedef short bf16x8 __attribute__((ext_vector_type(8)));
typedef float f32x4 __attribute__((ext_vector_type(4)));
typedef unsigned u32x4 __attribute__((ext_vector_type(4)));
typedef unsigned u32x2 __attribute__((ext_vector_type(2)));
constexpr int BM = 256, BK = 64, HALF = 128, HTB = HALF * BK * 2  , STAGE_BYTES = 8 * HTB, NXCD = 8, WGM = 8;

__host__ __device__ __forceinline__ int lds_byte(int r, int c) { const int st = (r >> 4) * 2 + (c >> 5), rr = r & 15, cc = c & 31, ob = rr * 64 + cc * 2; return st * 1024 + (ob ^ (((ob >> 9) & 1) << 5)); }
__host__ __device__ __forceinline__ void stage_rc(int b, int& R, int& C) { const int st = b / 1024, sb = b % 1024, swz = sb ^ (((sb >> 9) & 1) << 5); R = (st >> 1) * 16 + swz / 64; C = (st & 1) * 32 + (swz % 64) / 2; }
__host__ __device__ __forceinline__ int perm32(int rho) { const int n = rho >> 4, i = rho & 15; return 8 * (i >> 2) + 4 * n + (i & 3); }

struct Unit { int pm, pn; };
struct Gemm { const bf16_t* A; const bf16_t* Bt; int M, N, K; };

struct StaticOrder {
    int nM, nN, nwg, G, c;
    __host__ __device__ void init(int M_, int N_, int G_, int c_) { nM = M_ / BM; nN = N_ / BM; nwg = nM * nN; G = G_; c = c_; }
    __host__ __device__ bool next(int i, Unit& u) const {
        const long L = (long)i * G + c; if (L >= nwg) return false;
        int wgid = (int)L; { const int q = nwg / NXCD, r = nwg % NXCD, xcd = wgid % NXCD, off = wgid / NXCD; wgid = (xcd < r ? xcd * (q + 1) : r * (q + 1) + (xcd - r) * q) + off; }
        const int nig = WGM * nN, gid = wgid / nig, fm = gid * WGM, gsz = (nM - fm) < WGM ? (nM - fm) : WGM;
        u.pm = fm + ((wgid % nig) % gsz); u.pn = (wgid % nig) / gsz; return true;
    }
};

__device__ __forceinline__ unsigned cvt_pk_bf16(float lo, float hi) { unsigned r; asm volatile("v_cvt_pk_bf16_f32 %0, %1, %2" : "=v"(r) : "v"(lo), "v"(hi)); return r; }
__device__ __forceinline__ float rsum_fq(float s) { s += __shfl_xor(s, 16); s += __shfl_xor(s, 32); return s; }

struct EpiIn {
    static constexpr int BMAP = 2;
    bf16_t* PROJ; float* VSSQ; const float* qg; const float* kg;
    __device__ __forceinline__ void operator()(const f32x4 (&acc)[2][2][4][2], const Unit& u, int wr, int wc, int fr, int fq) const {
        const int ct = 4 * u.pn + wc;
        const int row0 = u.pm * BM + wr * 64 + fr, col0 = u.pn * BM + wc * 64 + 8 * fq;
        if (ct < 10) {
            const float* g = (ct < 8 ? qg : kg) + 8 * fq; const float sc = ct < 8 ? QSCALE : 1.0f;
            f32x4 gv[2][2];
#pragma unroll
            for (int bj = 0; bj < 2; ++bj)
#pragma unroll
                for (int n = 0; n < 2; ++n) gv[bj][n] = *(const f32x4*)(g + 32 * bj + 4 * n) * sc;
#pragma unroll
            for (int ai = 0; ai < 2; ++ai)
#pragma unroll
                for (int m = 0; m < 4; ++m) {
                    float ss = 0.f;
#pragma unroll
                    for (int bj = 0; bj < 2; ++bj)
#pragma unroll
                        for (int n = 0; n < 2; ++n) { const f32x4 x = acc[ai][bj][m][n]; ss += (x[0] * x[0] + x[1] * x[1]) + (x[2] * x[2] + x[3] * x[3]); }
                    ss = rsum_fq(ss); const float r = rsqrtf(ss * (1.0f / 64.0f) + EPS);
                    bf16_t* rowp = PROJ + (size_t)(row0 + ai * HALF + m * 16) * INW + col0;
#pragma unroll
                    for (int bj = 0; bj < 2; ++bj) { const f32x4 v0 = acc[ai][bj][m][0] * r * gv[bj][0], v1 = acc[ai][bj][m][1] * r * gv[bj][1];
                        u32x4 w; w.x = cvt_pk_bf16(v0[0], v0[1]); w.y = cvt_pk_bf16(v0[2], v0[3]); w.z = cvt_pk_bf16(v1[0], v1[1]); w.w = cvt_pk_bf16(v1[2], v1[3]);
                        *(u32x4*)(rowp + 32 * bj) = w; }
                }
        } else if (ct < 12) {
#pragma unroll
            for (int ai = 0; ai < 2; ++ai)
#pragma unroll
                for (int m = 0; m < 4; ++m) { bf16_t* rowp = PROJ + (size_t)(row0 + ai * HALF + m * 16) * INW + col0;
#pragma unroll
                    for (int bj = 0; bj < 2; ++bj) { const f32x4 v0 = acc[ai][bj][m][0], v1 = acc[ai][bj][m][1];
                        u32x4 w; w.x = cvt_pk_bf16(v0[0], v0[1]); w.y = cvt_pk_bf16(v0[2], v0[3]); w.z = cvt_pk_bf16(v1[0], v1[1]); w.w = cvt_pk_bf16(v1[2], v1[3]);
                        *(u32x4*)(rowp + 32 * bj) = w; } }
        } else {
#pragma unroll
            for (int ai = 0; ai < 2; ++ai)
#pragma unroll
                for (int m = 0; m < 4; ++m) { const int row = row0 + ai * HALF + m * 16; bf16_t* rowp = PROJ + (size_t)row * INW + col0; float ss = 0.f;
#pragma unroll
                    for (int bj = 0; bj < 2; ++bj) { f32x4 v0 = acc[ai][bj][m][0], v1 = acc[ai][bj][m][1];
#pragma unroll
                        for (int e = 0; e < 4; ++e) { v0[e] = gelu_tanh(v0[e]); v1[e] = gelu_tanh(v1[e]); ss += v0[e] * v0[e] + v1[e] * v1[e]; }
                        u32x4 w; w.x = cvt_pk_bf16(v0[0], v0[1]); w.y = cvt_pk_bf16(v0[2], v0[3]); w.z = cvt_pk_bf16(v1[0], v1[1]); w.w = cvt_pk_bf16(v1[2], v1[3]);
                        *(u32x4*)(rowp + 32 * bj) = w; }
                    if (ct >= 20) { ss = rsum_fq(ss); if (fq == 0) VSSQ[(size_t)row * 8 + (ct - 20)] = ss; }
                }
        }
    }
};
struct EpiOut {
    static constexpr int BMAP = 0;
    const float* xp; const float* xs; float* out; bf16_t* X1B; float* SSQ2;
    __device__ __forceinline__ void operator()(const f32x4 (&acc)[2][2][4][2], const Unit& u, int wr, int wc, int fr, int fq) const {
        const int row0 = u.pm * BM + wr * 64 + fr, col0 = u.pn * BM + wc * 32 + 4 * fq;
#pragma unroll
        for (int ai = 0; ai < 2; ++ai)
#pragma unroll
            for (int m = 0; m < 4; ++m) { const int row = row0 + ai * HALF + m * 16; const size_t off = (size_t)row * D + col0;
                const float* xr = (row < MP ? xp + (size_t)row * D : xs + (size_t)(row - MP) * D) + col0; float ss = 0.f;
#pragma unroll
                for (int bj = 0; bj < 2; ++bj)
#pragma unroll
                    for (int n = 0; n < 2; ++n) { const f32x4 v = *(const f32x4*)(xr + bj * HALF + n * 16) + acc[ai][bj][m][n];
                        *(f32x4*)(out + off + bj * HALF + n * 16) = v; u32x2 w; w.x = cvt_pk_bf16(v[0], v[1]); w.y = cvt_pk_bf16(v[2], v[3]); *(u32x2*)(X1B + off + bj * HALF + n * 16) = w;
                        ss += (v[0] * v[0] + v[1] * v[1]) + (v[2] * v[2] + v[3] * v[3]); }
                ss = rsum_fq(ss); if (fq == 0) SSQ2[(size_t)row * 16 + 4 * u.pn + wc] = ss; }
    }
};
struct EpiUp {
    static constexpr int BMAP = 1;
    bf16_t* H; const float* SSQ2;
    __device__ __forceinline__ void operator()(const f32x4 (&acc)[2][2][4][2], const Unit& u, int wr, int wc, int fr, int fq) const {
        const int row0 = u.pm * BM + wr * 64 + fr, col0 = u.pn * HALF + wc * 32 + 8 * fq;
#pragma unroll
        for (int ai = 0; ai < 2; ++ai)
#pragma unroll
            for (int m = 0; m < 4; ++m) { const int row = row0 + ai * HALF + m * 16; const f32x4* sp = (const f32x4*)(SSQ2 + (size_t)row * 16);
                const f32x4 s = (sp[0] + sp[1]) + (sp[2] + sp[3]); const float r = rsqrtf(((s[0] + s[1]) + (s[2] + s[3])) * (1.0f / D) + EPS);
                f32x4 h0, h1;
#pragma unroll
                for (int e = 0; e < 4; ++e) { h0[e] = silu(acc[ai][0][m][0][e] * r) * (acc[ai][1][m][0][e] * r); h1[e] = silu(acc[ai][0][m][1][e] * r) * (acc[ai][1][m][1][e] * r); }
                u32x4 w; w.x = cvt_pk_bf16(h0[0], h0[1]); w.y = cvt_pk_bf16(h0[2], h0[3]); w.z = cvt_pk_bf16(h1[0], h1[1]); w.w = cvt_pk_bf16(h1[2], h1[3]);
                *(u32x4*)(H + (size_t)row * DFF + col0) = w; }
    }
};
struct EpiDown {
    static constexpr int BMAP = 0;
    float* out;
    __device__ __forceinline__ void operator()(const f32x4 (&acc)[2][2][4][2], const Unit& u, int wr, int wc, int fr, int fq) const {
        const int row0 = u.pm * BM + wr * 64 + fr, col0 = u.pn * BM + wc * 32 + 4 * fq;
#pragma unroll
        for (int ai = 0; ai < 2; ++ai)
#pragma unroll
            for (int m = 0; m < 4; ++m) { float* rowp = out + (size_t)(row0 + ai * HALF + m * 16) * D + col0;
#pragma unroll
                for (int bj = 0; bj < 2; ++bj)
#pragma unroll
                    for (int n = 0; n < 2; ++n) { float* p = rowp + bj * HALF + n * 16; *(f32x4*)p = *(const f32x4*)p + acc[ai][bj][m][n]; } }
    }
};

template <class Epi, class Sched, bool ALIGN_EPI>
__device__ __forceinline__ void gemm_phase(PG8_LAS unsigned char* lds, const Gemm g, const Sched& S, const Epi& E) {
    const int tid = threadIdx.x, wid = __builtin_amdgcn_readfirstlane(tid >> 6), lane = tid & 63, wr = wid >> 2, wc = wid & 3, fr = lane & 15, fq = lane >> 4;
    const int K = g.K, nt = K / BK;
    unsigned voffA[2], voffB[2];
#pragma unroll
    for (int i = 0; i < 2; ++i) { int R, C; stage_rc(tid * 16 + i * 8192, R, C);
        const int Rb = Epi::BMAP == 0 ? R : Epi::BMAP == 1 ? ((R & ~31) + perm32(R & 31)) : (64 * (R >> 5) + perm32(R & 31));
        voffA[i] = (unsigned)(R * K + C) * 2u; voffB[i] = (unsigned)(Rb * K + C) * 2u; }
    const size_t kstep = (size_t)(BK * 2);
    const size_t hstep = (size_t)HALF * K * 2;
    const size_t hstepB = Epi::BMAP == 2 ? (size_t)32 * K * 2 : hstep;
    const size_t tstep = 2 * hstep;
    const unsigned ldsw = (unsigned)wid * 1024u;
    const int aoff = lds_byte(wr * 64 + fr, fq * 8), boff = lds_byte(wc * 32 + fr, fq * 8);
#define PG8_SA(b, h) (((b) * 2 + (h)) * HTB)
#define PG8_SB(b, h) ((4 + (b) * 2 + (h)) * HTB)
#define PG8_STAGE(bufoff, gbase, voff) do { _Pragma("unroll") for (int _i = 0; _i < 2; ++_i) \
        __builtin_amdgcn_global_load_lds((const unsigned*)((const char*)(gbase) + (voff)[_i]), (PG8_LAS unsigned*)(lds + (bufoff) + ldsw + _i * 8192), 16, 0, 0); } while (0)
#define PG8_LDA(dst, b, h) do { _Pragma("unroll") for (int m = 0; m < 4; ++m) _Pragma("unroll") for (int k = 0; k < 2; ++k) dst[m][k] = *(const PG8_LAS bf16x8*)(lds + PG8_SA(b, h) + aoff + m * 2048 + k * 1024); } while (0)
#define PG8_LDB(dst, b, h) do { _Pragma("unroll") for (int n = 0; n < 2; ++n) _Pragma("unroll") for (int k = 0; k < 2; ++k) dst[n][k] = *(const PG8_LAS bf16x8*)(lds + PG8_SB(b, h) + boff + n * 2048 + k * 1024); } while (0)
#define PG8_MMA(ai, bj, At, Bt) do { __builtin_amdgcn_s_setprio(1); _Pragma("unroll") for (int m = 0; m < 4; ++m) _Pragma("unroll") for (int n = 0; n < 2; ++n) _Pragma("unroll") for (int k = 0; k < 2; ++k) \
        acc[ai][bj][m][n] = __builtin_amdgcn_mfma_f32_16x16x32_bf16(Bt[n][k], At[m][k], acc[ai][bj][m][n], 0, 0, 0); __builtin_amdgcn_s_setprio(0); } while (0)
#define PG8_WAIT_V(n) asm volatile("s_waitcnt vmcnt(" #n ")" ::: "memory")
#define PG8_WAIT_L(n) asm volatile("s_waitcnt lgkmcnt(" #n ")" ::: "memory")
#define PG8_BAR __builtin_amdgcn_s_barrier()
#define PG8_SCHED __builtin_amdgcn_sched_barrier(0)
    Unit cur, nxt; int ui = 0;
    if (!S.next(0, cur)) return;
    f32x4 acc[2][2][4][2];
#pragma unroll
    for (int a = 0; a < 2; ++a)
#pragma unroll
        for (int b = 0; b < 2; ++b)
#pragma unroll
            for (int m = 0; m < 4; ++m)
#pragma unroll
                for (int n = 0; n < 2; ++n) acc[a][b][m][n] = (f32x4){0.f, 0.f, 0.f, 0.f};
    bf16x8 At[4][2], B0[2][2], B1[2][2];
    const char* cA = (const char*)g.A + (size_t)cur.pm * tstep; const char* cB = (const char*)g.Bt + (size_t)cur.pn * tstep;
    PG8_STAGE(PG8_SB(0, 0), cB, voffB); PG8_STAGE(PG8_SB(0, 1), cB + hstepB, voffB); PG8_STAGE(PG8_SA(0, 0), cA, voffA); PG8_STAGE(PG8_SA(0, 1), cA + hstep, voffA);
    if (wr == 1) PG8_BAR;
    PG8_WAIT_V(2); PG8_BAR;
    PG8_STAGE(PG8_SB(1, 0), cB + kstep, voffB); PG8_STAGE(PG8_SA(1, 0), cA + kstep, voffA); PG8_STAGE(PG8_SB(1, 1), cB + hstepB + kstep, voffB);
    PG8_WAIT_V(6); PG8_BAR;
    for (;;) {
        const bool has_next = S.next(ui + 1, nxt);
        const char* nA = has_next ? (const char*)g.A + (size_t)nxt.pm * tstep : cA; const char* nB = has_next ? (const char*)g.Bt + (size_t)nxt.pn * tstep : cB;
        for (int t = 0; t < nt; t += 2) {
            const bool last = (t == nt - 2);
            const char* a1 = cA + (size_t)(t + 1) * kstep;
            const char* a2 = last ? nA : cA + (size_t)(t + 2) * kstep; const char* b2 = last ? nB : cB + (size_t)(t + 2) * kstep;
            const char* a3 = a2 + kstep; const char* b3 = b2 + kstep;
            PG8_LDB(B0, 0, 0); PG8_LDB(B1, 0, 1); PG8_SCHED; PG8_LDA(At, 0, 0); PG8_STAGE(PG8_SA(1, 1), a1 + hstep, voffA);
            PG8_WAIT_V(8); PG8_WAIT_L(0); PG8_BAR; PG8_MMA(0, 0, At, B0); PG8_MMA(0, 1, At, B1); PG8_BAR; PG8_SCHED;
            PG8_LDA(At, 0, 1); PG8_STAGE(PG8_SB(0, 0), b2, voffB); PG8_STAGE(PG8_SB(0, 1), b2 + hstepB, voffB); PG8_STAGE(PG8_SA(0, 0), a2, voffA);
            PG8_WAIT_V(8); PG8_WAIT_L(0); PG8_BAR; PG8_MMA(1, 0, At, B0); PG8_MMA(1, 1, At, B1); PG8_BAR; PG8_SCHED;
            PG8_LDB(B0, 1, 0); PG8_LDB(B1, 1, 1); PG8_SCHED; PG8_LDA(At, 1, 0); PG8_STAGE(PG8_SA(0, 1), a2 + hstep, voffA);
            PG8_WAIT_V(8); PG8_WAIT_L(0); PG8_BAR; PG8_MMA(0, 0, At, B0); PG8_MMA(0, 1, At, B1); PG8_BAR; PG8_SCHED;
            PG8_LDA(At, 1, 1); PG8_STAGE(PG8_SB(1, 0), b3, voffB); PG8_STAGE(PG8_SB(1, 1), b3 + hstepB, voffB); PG8_STAGE(PG8_SA(1, 0), a3, voffA);
            PG8_WAIT_V(8); PG8_WAIT_L(0); PG8_BAR; PG8_MMA(1, 0, At, B0); PG8_MMA(1, 1, At, B1); PG8_BAR; PG8_SCHED;
        }
        if constexpr (ALIGN_EPI) { if (wr == 0) PG8_BAR; }
        E(acc, cur, wr, wc, fr, fq);
        if (!has_next) break;
#pragma unroll
        for (int a = 0; a < 2; ++a)
#pragma unroll
            for (int b = 0; b < 2; ++b)
#pragma unroll
                for (int m = 0; m < 4; ++m)
#pragma unroll
                    for (int n = 0; n < 2; ++n) acc[a][b][m][n] = (f32x4){0.f, 0.f, 0.f, 0.f};
        cur = nxt; cA = nA; cB = nB; ++ui;
        if constexpr (ALIGN_EPI) { if (wr == 1) PG8_BAR; }
    }
    PG8_WAIT_V(0);
    if constexpr (!ALIGN_EPI) { if (wr == 0) PG8_BAR; }
    PG8_BAR;
#undef PG8_SA
#undef PG8_SB
#undef PG8_STAGE
#undef PG8_LDA
#undef PG8_LDB
#undef PG8_MMA
#undef PG8_WAIT_V
#undef PG8_WAIT_L
#undef PG8_BAR
#undef PG8_SCHED
}
}
#define LAS __attribute__((address_space(3)))

struct Args;
__device__ __forceinline__ void p0_prologue_naive(const float* const* in, unsigned char* ws, int G) {
    const size_t gt = (size_t)blockIdx.x * 512 + threadIdx.x, GT = (size_t)G * 512;
    for (size_t i = gt; i < NPREP; i += GT) prep_w_elem(i, in[4], in[13], in[15], in[16], in[17], in[9], in[14], ws);
    const int wave = threadIdx.x >> 6, lane = threadIdx.x & 63;
    for (int m = blockIdx.x * 8 + wave; m < M; m += G * 8) xn_row(m, lane, in[0], in[1], in[3], (bf16_t*)(ws + WS_XN));
}

__device__ __forceinline__ void p2_mixer_naive(const float* const* in, unsigned char* ws, unsigned char* lds_generic, int G) {
    MixNaiveLds* L = (MixNaiveLds*)lds_generic + (threadIdx.x >> 8);
    for (int pr = blockIdx.x; pr < M / 2; pr += G)
        mix_naive_token(2 * pr + (threadIdx.x >> 8), threadIdx.x & 255, *L, (const bf16_t*)(ws + WS_PROJ), (const float*)(ws + WS_VSSQ), (const bf16_t*)(ws + WS_WS), in[2], in[7], in[8], in[10], in[11], in[12], (bf16_t*)(ws + WS_MIX));
}

static void launch_naive_phase(int p, void* const* d_in, float* out, unsigned char* ws, hipStream_t stream) {
    const float* xp = (const float*)d_in[0]; const float* xs = (const float*)d_in[1]; const float* rel = (const float*)d_in[2]; const float* norm1 = (const float*)d_in[3];
    const float* w_in = (const float*)d_in[4]; const float* qg = (const float*)d_in[5]; const float* kg = (const float*)d_in[6]; const float* sink = (const float*)d_in[7];
    const float* vg = (const float*)d_in[8]; const float* w_s = (const float*)d_in[9]; const float* b_s = (const float*)d_in[10]; const float* ag = (const float*)d_in[11];
    const float* gg = (const float*)d_in[12]; const float* w_o = (const float*)d_in[13]; const float* norm2 = (const float*)d_in[14]; const float* w_gate = (const float*)d_in[15];
    const float* w_up = (const float*)d_in[16]; const float* w_down = (const float*)d_in[17];
    bf16_t* WIN = (bf16_t*)(ws + WS_WIN); bf16_t* WO = (bf16_t*)(ws + WS_WO); bf16_t* WGU = (bf16_t*)(ws + WS_WGU); bf16_t* WDN = (bf16_t*)(ws + WS_WDN); bf16_t* WSB = (bf16_t*)(ws + WS_WS);
    float* VSSQ = (float*)(ws + WS_VSSQ); float* SSQ2 = (float*)(ws + WS_SSQ2);
    bf16_t* XN = (bf16_t*)(ws + WS_XN); bf16_t* PROJ = (bf16_t*)(ws + WS_PROJ); bf16_t* H = (bf16_t*)(ws + WS_H); bf16_t* MIX = (bf16_t*)(ws + WS_MIX); bf16_t* X1B = (bf16_t*)(ws + WS_X1B);
    switch (p) {
    case 0: k_prep_w<<<(unsigned)((NPREP + 255) / 256), 256, 0, stream>>>(w_in, w_o, w_gate, w_up, w_down, w_s, norm2, ws);
            k_xn<<<M / 4, 256, 0, stream>>>(xp, xs, norm1, XN); break;
    case 1: k_gemm_naive<NEpiIn, false><<<dim3(INW / 64, M / 64), 256, 0, stream>>>(XN, WIN, D, NEpiIn{PROJ, VSSQ, qg, kg}); break;
    case 2: k_mix_naive<<<M, 256, 0, stream>>>(PROJ, VSSQ, WSB, rel, sink, vg, b_s, ag, gg, MIX); break;
    case 3: k_gemm_naive<NEpiOut, false><<<dim3(D / 64, M / 64), 256, 0, stream>>>(MIX, WO, D, NEpiOut{xp, xs, out, X1B, SSQ2}); break;
    case 4: k_gemm_naive<NEpiUp, true><<<dim3(DFF / 64, M / 64), 256, 0, stream>>>(X1B, WGU, D, NEpiUp{H, SSQ2}); break;
    case 5: k_gemm_naive<NEpiDown, false><<<dim3(D / 64, M / 64), 256, 0, stream>>>(H, WDN, DFF, NEpiDown{out}); break;
    }
}

__device__ __forceinline__ void p2_mixer(const float* const* in, unsigned char* ws, LAS unsigned char* lds, int G) {}

constexpr int NWAVES = 8;
constexpr int N_PHASES = 6;
constexpr int RING_BYTES = 131072;
constexpr int LDSCTL_OFF = RING_BYTES + 24576, MISC_OFF = LDSCTL_OFF + 320;
constexpr int LDS_BYTES = 157696;
static_assert(MISC_OFF + 128 <= LDS_BYTES, "LDS map");
constexpr int CW_BAR = 4096;

#define GAS __attribute__((address_space(1)))

typedef GAS unsigned gu32;
#define RLX_AGENT __ATOMIC_RELAXED, __HIP_MEMORY_SCOPE_AGENT

#define XB_TMO      128
#define XB_XCNT(j)  (256  + 64 * (j))
#define XB_XSUB(j)  (1280 + 64 * (j))
#define XB_XGEN(j)  (2304 + 64 * (j))
#define XB_TOP      3328
#define XB_TOPGEN   3392
#define XCD_BAR_WORDS 3456
#define XB_SPIN_CAP (1u << 18)

__device__ __forceinline__ unsigned xb_ld(unsigned* p)              { return __hip_atomic_load(p, __ATOMIC_RELAXED, __HIP_MEMORY_SCOPE_AGENT); }
__device__ __forceinline__ unsigned xb_add(unsigned* p, unsigned v) { return __hip_atomic_fetch_add(p, v, __ATOMIC_RELAXED, __HIP_MEMORY_SCOPE_AGENT); }
__device__ __forceinline__ unsigned xb_xcc_id() { return (unsigned)__builtin_amdgcn_s_getreg((3 << 11) | 20) & 0xFu; }
#define XB_SPIN(cond, bar) do { unsigned _sp = 0; while (cond) { __builtin_amdgcn_s_sleep(1); \
    if ((++_sp & 255u) == 0u) { if (xb_ld(&(bar)[XB_TMO])) break; if (_sp > XB_SPIN_CAP) { atomicAdd(&(bar)[XB_TMO], 1u); break; } } } } while (0)

struct XcdBarrier { unsigned* bar; unsigned x; volatile LAS unsigned* st; };
__device__ __forceinline__ XcdBarrier xcd_barrier_post(unsigned* bar, volatile LAS unsigned* st) {
    XcdBarrier b; b.bar = bar; b.x = xb_xcc_id(); b.st = st;
    if (threadIdx.x == 0) (void)xb_add(&bar[XB_XCNT(b.x)], 1u);
    return b;
}
__device__ __forceinline__ void xcd_barrier_complete(unsigned* bar, unsigned x, unsigned& nloc, unsigned& nx) {
    const unsigned G = gridDim.x * gridDim.y * gridDim.z;
    unsigned sum, cnt, mine, sp = 0u;
    for (;;) {
        sum = 0u; cnt = 0u; mine = 0u;
#pragma unroll
        for (unsigned j = 0; j < 16; ++j) { const unsigned c = xb_ld(&bar[XB_XCNT(j)]); sum += c; cnt += (c > 0u) ? 1u : 0u; mine = (j == x) ? c : mine; }
        if (sum == G) break;
        __builtin_amdgcn_s_sleep(1);
        if ((++sp & 255u) == 0u) { if (xb_ld(&bar[XB_TMO])) break; if (sp > XB_SPIN_CAP) { atomicAdd(&bar[XB_TMO], 1u); break; } }
    }
    nloc = mine > 0u ? mine : 1u; nx = cnt > 0u ? cnt : 1u;
}
__device__ __forceinline__ void xcd_barrier(const XcdBarrier& b) {
    asm volatile("s_waitcnt vmcnt(0)" ::: "memory");
    __syncthreads();
    if (threadIdx.x == 0) {
        unsigned* bar = b.bar;
        __builtin_amdgcn_s_waitcnt(0);
        unsigned nloc = b.st[0], nx = b.st[1];
        if (nloc == 0u) { xcd_barrier_complete(bar, b.x, nloc, nx); b.st[0] = nloc; b.st[1] = nx; }
        const unsigned old = xb_add(&bar[XB_XSUB(b.x)], 1u);
        const unsigned gen = old / nloc;
        if (old + 1u == (gen + 1u) * nloc) {
            __builtin_amdgcn_fence(__ATOMIC_RELEASE, "agent");
            asm volatile("s_waitcnt vmcnt(0)" ::: "memory");
            const unsigned og = xb_add(&bar[XB_TOP], 1u);
            const unsigned tg = og / nx;
            if (og + 1u == (tg + 1u) * nx) xb_add(&bar[XB_TOPGEN], 1u);
            else XB_SPIN(xb_ld(&bar[XB_TOPGEN]) == tg, bar);
            __builtin_amdgcn_fence(__ATOMIC_ACQUIRE, "agent");
            xb_add(&bar[XB_XGEN(b.x)], 1u);
            asm volatile("s_waitcnt vmcnt(0)" ::: "memory");
        } else {
            XB_SPIN(xb_ld(&bar[XB_XGEN(b.x)]) == gen, bar);
            __builtin_amdgcn_fence(__ATOMIC_ACQUIRE, "agent");
            asm volatile("s_waitcnt vmcnt(0)" ::: "memory");
        }
    }
    __syncthreads();
}

struct Args { const float* in[18]; float* out; unsigned char* ws; int ph_lo, ph_hi; };

__global__ void __launch_bounds__(NWAVES * 64, 2) mk_fwd(Args args) {
    extern __shared__ __attribute__((aligned(16))) unsigned char lds_raw[];
    LAS unsigned char* lds = (LAS unsigned char*)lds_raw;
    volatile LAS unsigned* MISC = (volatile LAS unsigned*)(lds + MISC_OFF);
    const int tid = threadIdx.x, G = gridDim.x;
    unsigned char* ws = args.ws;
    gu32* ctl = (gu32*)(ws + WS_CTL);
    for (int u = tid; u < (LDS_BYTES - LDSCTL_OFF) / 4; u += NWAVES * 64) ((LAS unsigned*)(lds + LDSCTL_OFF))[u] = 0u;
    __syncthreads();
    const int lo = args.ph_lo, hi = args.ph_hi;
    const bool multi = hi - lo > 1;
    XcdBarrier bar; bar.bar = (unsigned*)(ctl + CW_BAR); bar.x = 0; bar.st = nullptr;
    if (multi) bar = xcd_barrier_post((unsigned*)(ctl + CW_BAR), MISC + 8);
#define IN(k) (lo <= (k) && (k) < hi)
#define BOTH(k) (IN(k) && IN((k) + 1))
    const float* xp = args.in[0]; const float* xs = args.in[1];
    bf16_t* WIN = (bf16_t*)(ws + WS_WIN); bf16_t* WO = (bf16_t*)(ws + WS_WO); bf16_t* WGU = (bf16_t*)(ws + WS_WGU); bf16_t* WDN = (bf16_t*)(ws + WS_WDN);
    float* VSSQ = (float*)(ws + WS_VSSQ); float* SSQ2 = (float*)(ws + WS_SSQ2);
    bf16_t* XN = (bf16_t*)(ws + WS_XN); bf16_t* PROJ = (bf16_t*)(ws + WS_PROJ); bf16_t* H = (bf16_t*)(ws + WS_H); bf16_t* MIX = (bf16_t*)(ws + WS_MIX); bf16_t* X1B = (bf16_t*)(ws + WS_X1B);

    if (IN(0)) { p0_prologue_naive(args.in, ws, G); if (BOTH(0)) xcd_barrier(bar); }
    if (IN(1)) {
        pg8::Gemm g{XN, WIN, M, INW, D}; pg8::StaticOrder S; S.init(M, INW, G, (int)blockIdx.x);
        pg8::EpiIn E{PROJ, VSSQ, args.in[5], args.in[6]};
        pg8::gemm_phase<pg8::EpiIn, pg8::StaticOrder, true>(lds, g, S, E);
        if (BOTH(1)) xcd_barrier(bar);
    }
    if (IN(2)) {
#if MK_MIXER_NAIVE
        p2_mixer_naive(args.in, ws, lds_raw, G);
#else
        p2_mixer(args.in, ws, lds, G);
#endif
        if (BOTH(2)) xcd_barrier(bar); }
    if (IN(3)) {
        pg8::Gemm g{MIX, WO, M, D, D}; pg8::StaticOrder S; S.init(M, D, G, (int)blockIdx.x);
        pg8::EpiOut E{xp, xs, args.out, X1B, SSQ2};
        pg8::gemm_phase<pg8::EpiOut, pg8::StaticOrder, true>(lds, g, S, E);
        if (BOTH(3)) xcd_barrier(bar);
    }
    if (IN(4)) {
        pg8::Gemm g{X1B, WGU, M, NGU, D}; pg8::StaticOrder S; S.init(M, NGU, G, (int)blockIdx.x);
        pg8::EpiUp E{H, SSQ2};
        pg8::gemm_phase<pg8::EpiUp, pg8::StaticOrder, true>(lds, g, S, E);
        if (BOTH(4)) xcd_barrier(bar);
    }
    if (IN(5)) {
        pg8::Gemm g{H, WDN, M, D, DFF}; pg8::StaticOrder S; S.init(M, D, G, (int)blockIdx.x);
        pg8::EpiDown E{args.out};
        pg8::gemm_phase<pg8::EpiDown, pg8::StaticOrder, true>(lds, g, S, E);
    }
#undef IN
#undef BOTH
}

extern "C" void kernel_launch(void* const* d_in, const int* in_sizes, int n_in, void* d_out, int out_size, void* d_ws, size_t ws_size, hipStream_t stream) {
    static int grid = 0;
    if (grid == 0) {
        if (n_in != 18 || in_sizes[0] != MP * D || in_sizes[1] != (M - MP) * D || out_size != M * D || ws_size < WS_END) {
            fprintf(stderr, "kernel_launch: unexpected shapes (n_in %d, in0 %d, in1 %d, out %d, ws %zu)\n", n_in, n_in > 0 ? in_sizes[0] : -1, n_in > 1 ? in_sizes[1] : -1, out_size, ws_size); grid = -1; return; }
        int dev = 0, cus = 0, per_cu = 0;
        if (hipGetDevice(&dev) != hipSuccess || hipDeviceGetAttribute(&cus, hipDeviceAttributeMultiprocessorCount, dev) != hipSuccess) { grid = -1; return; }
        if (hipFuncSetAttribute((const void*)mk_fwd, hipFuncAttributeMaxDynamicSharedMemorySize, LDS_BYTES) != hipSuccess) { fprintf(stderr, "kernel_launch: hipFuncSetAttribute failed\n"); grid = -1; return; }
        if (hipOccupancyMaxActiveBlocksPerMultiprocessor(&per_cu, (const void*)mk_fwd, NWAVES * 64, LDS_BYTES) != hipSuccess || per_cu < 1) { fprintf(stderr, "kernel_launch: occupancy query says %d blocks per CU\n", per_cu); grid = -1; return; }
        (void)hipGetLastError();
        grid = cus;
    }
    if (grid < 0) return;
    Args a{};
    for (int i = 0; i < 18; ++i) a.in[i] = (const float*)d_in[i];
    a.out = (float*)d_out; a.ws = (unsigned char*)d_ws;
    unsigned char* ws = (unsigned char*)d_ws;
    (void)hipMemsetAsync(ws + WS_CTL, 0, 1 * MiB, stream);
#if MK_ONE_LAUNCH
    a.ph_lo = 0; a.ph_hi = N_PHASES;
    { void* kargs[] = {&a}; hipError_t e = hipLaunchCooperativeKernel((const void*)mk_fwd, dim3(grid), dim3(NWAVES * 64), kargs, LDS_BYTES, stream);
      if (e != hipSuccess) fprintf(stderr, "kernel_launch: cooperative launch failed: %s (grid %d)\n", hipGetErrorString(e), grid); }
#else
    for (int p = 0; p < N_PHASES; ++p) {
        if (!(MK_PHASE_MASK & (1 << p))) { launch_naive_phase(p, d_in, (float*)d_out, ws, stream); continue; }
        a.ph_lo = p; a.ph_hi = p + 1;
        hipLaunchKernelGGL(mk_fwd, dim3(grid), dim3(NWAVES * 64), LDS_BYTES, stream, a);
    }
#endif
}
```

```cpp
#include <hip/hip_runtime.h>
#include <cstdio>
#include <cstdint>

typedef unsigned short bf16_t;
constexpr int D = 1024, SEQ = 4096, NSEQ = 12, M = NSEQ * SEQ, MP = 4 * SEQ;
constexpr int INW = 1792, DFF = 2816, NGU = 2 * DFF;
constexpr float EPS = 1e-6f, LOG2E = 1.4426950408889634f, QSCALE = 0.125f * LOG2E;

constexpr size_t MiB = 1u << 20;
constexpr size_t WS_CTL = 0;
constexpr size_t WS_WIN = 1 * MiB;
constexpr size_t WS_WO = 5 * MiB;
constexpr size_t WS_WGU = 7 * MiB;
constexpr size_t WS_WDN = 18 * MiB;
constexpr size_t WS_WS = 24 * MiB;
constexpr size_t WS_VSSQ = 25 * MiB;
constexpr size_t WS_SSQ2 = 27 * MiB;
constexpr size_t WS_XN = 32 * MiB;
constexpr size_t WS_PROJ = 128 * MiB;
constexpr size_t WS_H = 32 * MiB;
constexpr size_t WS_MIX = 296 * MiB;
constexpr size_t WS_X1B = 392 * MiB;
constexpr size_t WS_END = 488 * MiB;

__device__ __forceinline__ unsigned f2bf(float f) { unsigned u = __builtin_bit_cast(unsigned, f); return (u + 0x7fffu + ((u >> 16) & 1u)) >> 16; }
__device__ __forceinline__ float bf2f(bf16_t b) { return __builtin_bit_cast(float, (unsigned)b << 16); }
__device__ __forceinline__ float gelu_tanh(float x) { const float u = 0.7978845608028654f * (x + 0.044715f * x * x * x); return x / (1.0f + __expf(-2.0f * u)); }
__device__ __forceinline__ float silu(float x) { return x / (1.0f + __expf(-x)); }
__device__ __forceinline__ int t5_bucket(int rel) { const int n = rel < 0 ? -rel : rel; int b = n < 8 ? n : (2 + (31 - __builtin_clz(n * n))); b = b > 15 ? 15 : b; return b + (rel > 0 ? 16 : 0); }

__device__ __forceinline__ void prep_w_elem(size_t i, const float* w_in, const float* w_o, const float* w_gate, const float* w_up, const float* w_down, const float* w_s, const float* norm2, unsigned char* ws) {
    const size_t N0 = (size_t)INW * D, N1 = (size_t)D * D, N2 = (size_t)NGU * D, N3 = (size_t)D * DFF, N4 = 8 * 128 * 128;
    if (i < N0) { const int n = i / D, k = i % D; ((bf16_t*)(ws + WS_WIN))[i] = f2bf(w_in[(size_t)k * INW + n]); return; } i -= N0;
    if (i < N1) { const int n = i / D, k = i % D; ((bf16_t*)(ws + WS_WO))[i] = f2bf(w_o[(size_t)k * D + n]); return; } i -= N1;
    if (i < N2) { const int r = i / D, k = i % D; const int pn = r >> 8, bj = (r >> 7) & 1, c = r & 127, col = 128 * pn + c;
        ((bf16_t*)(ws + WS_WGU))[i] = f2bf(norm2[k] * (bj ? w_up : w_gate)[(size_t)k * DFF + col]); return; } i -= N2;
    if (i < N3) { const int n = i / DFF, k = i % DFF; ((bf16_t*)(ws + WS_WDN))[i] = f2bf(w_down[(size_t)k * D + n]); return; } i -= N3;
    if (i < N4) { ((bf16_t*)(ws + WS_WS))[i] = f2bf(w_s[i]); }
}
constexpr size_t NPREP = (size_t)INW * D + (size_t)D * D + (size_t)NGU * D + (size_t)D * DFF + 8 * 128 * 128;
__global__ void __launch_bounds__(256) k_prep_w(const float* w_in, const float* w_o, const float* w_gate, const float* w_up, const float* w_down, const float* w_s, const float* norm2, unsigned char* ws) {
    prep_w_elem((size_t)blockIdx.x * 256 + threadIdx.x, w_in, w_o, w_gate, w_up, w_down, w_s, norm2, ws);
}
__device__ __forceinline__ void xn_row(int m, int lane, const float* xp, const float* xs, const float* norm1, bf16_t* XN) {
    const float* x = m < MP ? xp + (size_t)m * D : xs + (size_t)(m - MP) * D;
    float v[16]; float ss = 0.f;
#pragma unroll
    for (int j = 0; j < 16; ++j) { v[j] = x[lane + 64 * j]; ss += v[j] * v[j]; }
#pragma unroll
    for (int o = 1; o < 64; o <<= 1) ss += __shfl_xor(ss, o);
    const float r = rsqrtf(ss * (1.0f / D) + EPS);
#pragma unroll
    for (int j = 0; j < 16; ++j) XN[(size_t)m * D + lane + 64 * j] = f2bf(v[j] * r * norm1[lane + 64 * j]);
}
__global__ void __launch_bounds__(256) k_xn(const float* xp, const float* xs, const float* norm1, bf16_t* XN) { xn_row(blockIdx.x * 4 + (threadIdx.x >> 6), threadIdx.x & 63, xp, xs, norm1, XN); }

template <class Epi, bool DUAL>
__global__ void __launch_bounds__(256) k_gemm_naive(const bf16_t* A, const bf16_t* Bt, int K, Epi epi) {
    __shared__ float As[32][68], Bs[32][68], B2s[DUAL ? 32 : 1][68], Ct[64][65], C2t[DUAL ? 64 : 1][65];
    const int tid = threadIdx.x, ty = tid >> 4, tx = tid & 15, lr = tid >> 2, kc = (tid & 3) * 8;
    const int m0 = blockIdx.y * 64, n0 = blockIdx.x * 64;
    const bf16_t* ap = A + (size_t)(m0 + lr) * K + kc;
    const int br = epi.brow(n0 + lr);
    const bf16_t* bp = Bt + (size_t)br * K + kc;
    const bf16_t* bp2 = Bt + (size_t)(br + 128) * K + kc;
    float acc[4][4] = {}, acc2[4][4] = {};
    for (int k0 = 0; k0 < K; k0 += 32) {
        const uint4 av = *(const uint4*)(ap + k0), bv = *(const uint4*)(bp + k0);
        const unsigned aw[4] = {av.x, av.y, av.z, av.w}, bw[4] = {bv.x, bv.y, bv.z, bv.w};
#pragma unroll
        for (int j = 0; j < 4; ++j) { As[kc + 2 * j][lr] = __builtin_bit_cast(float, aw[j] << 16); As[kc + 2 * j + 1][lr] = __builtin_bit_cast(float, aw[j] & 0xffff0000u);
                                      Bs[kc + 2 * j][lr] = __builtin_bit_cast(float, bw[j] << 16); Bs[kc + 2 * j + 1][lr] = __builtin_bit_cast(float, bw[j] & 0xffff0000u); }
        if (DUAL) { const uint4 cv = *(const uint4*)(bp2 + k0); const unsigned cw[4] = {cv.x, cv.y, cv.z, cv.w};
#pragma unroll
            for (int j = 0; j < 4; ++j) { B2s[kc + 2 * j][lr] = __builtin_bit_cast(float, cw[j] << 16); B2s[kc + 2 * j + 1][lr] = __builtin_bit_cast(float, cw[j] & 0xffff0000u); } }
        __syncthreads();
#pragma unroll 8
        for (int k = 0; k < 32; ++k) {
            float a[4], b[4], b2[4];
#pragma unroll
            for (int i = 0; i < 4; ++i) { a[i] = As[k][4 * ty + i]; b[i] = Bs[k][4 * tx + i]; b2[i] = DUAL ? B2s[k][4 * tx + i] : 0.f; }
#pragma unroll
            for (int i = 0; i < 4; ++i)
#pragma unroll
                for (int j = 0; j < 4; ++j) { acc[i][j] += a[i] * b[j]; if (DUAL) acc2[i][j] += a[i] * b2[j]; }
        }
        __syncthreads();
    }
#pragma unroll
    for (int i = 0; i < 4; ++i)
#pragma unroll
        for (int j = 0; j < 4; ++j) { Ct[4 * ty + i][4 * tx + j] = acc[i][j]; if (DUAL) C2t[4 * ty + i][4 * tx + j] = acc2[i][j]; }
    __syncthreads();
    const int r = tid >> 2, part = tid & 3;
    epi(m0 + r, n0, part, &Ct[r][part * 16], DUAL ? &C2t[r][part * 16] : nullptr);
}
__device__ __forceinline__ float red4(float v) { v += __shfl_xor(v, 1); v += __shfl_xor(v, 2); return v; }
struct NEpiIn {
    bf16_t* PROJ; float* VSSQ; const float* qg; const float* kg;
    __device__ int brow(int n) const { return n; }
    __device__ void operator()(int row, int n0, int part, const float* c, const float*) const {
        const int ct = n0 >> 6; float v[16];
#pragma unroll
        for (int j = 0; j < 16; ++j) v[j] = c[j];
        if (ct < 10) { float ss = 0.f;
#pragma unroll
            for (int j = 0; j < 16; ++j) ss += v[j] * v[j];
            ss = red4(ss); const float r = rsqrtf(ss * (1.0f / 64.0f) + EPS); const float* g = ct < 8 ? qg : kg; const float sc = ct < 8 ? QSCALE : 1.0f;
#pragma unroll
            for (int j = 0; j < 16; ++j) v[j] = v[j] * r * g[part * 16 + j] * sc;
        } else if (ct >= 12) { float ss = 0.f;
#pragma unroll
            for (int j = 0; j < 16; ++j) { v[j] = gelu_tanh(v[j]); ss += v[j] * v[j]; }
            if (ct >= 20) { ss = red4(ss); if (part == 0) VSSQ[(size_t)row * 8 + (ct - 20)] = ss; }
        }
#pragma unroll
        for (int j = 0; j < 16; ++j) PROJ[(size_t)row * INW + n0 + part * 16 + j] = f2bf(v[j]);
    }
};
struct NEpiOut {
    const float* xp; const float* xs; float* out; bf16_t* X1B; float* SSQ2;
    __device__ int brow(int n) const { return n; }
    __device__ void operator()(int row, int n0, int part, const float* c, const float*) const {
        const float* x = row < MP ? xp + (size_t)row * D : xs + (size_t)(row - MP) * D; float ss = 0.f;
#pragma unroll
        for (int j = 0; j < 16; ++j) { const int col = n0 + part * 16 + j; const float v = x[col] + c[j]; out[(size_t)row * D + col] = v; X1B[(size_t)row * D + col] = f2bf(v); ss += v * v; }
        ss = red4(ss); if (part == 0) SSQ2[(size_t)row * 16 + (n0 >> 6)] = ss;
    }
};
struct NEpiUp {
    bf16_t* H; const float* SSQ2;
    __device__ int brow(int n) const { return 256 * (n >> 7) + (n & 127); }
    __device__ void operator()(int row, int n0, int part, const float* c, const float* c2) const {
        float ss = 0.f;
#pragma unroll
        for (int j = 0; j < 16; ++j) ss += SSQ2[(size_t)row * 16 + j];
        const float r = rsqrtf(ss * (1.0f / D) + EPS);
#pragma unroll
        for (int j = 0; j < 16; ++j) H[(size_t)row * DFF + n0 + part * 16 + j] = f2bf(silu(c[j] * r) * (c2[j] * r));
    }
};
struct NEpiDown {
    float* out;
    __device__ int brow(int n) const { return n; }
    __device__ void operator()(int row, int n0, int part, const float* c, const float*) const {
#pragma unroll
        for (int j = 0; j < 16; ++j) { const size_t o = (size_t)row * D + n0 + part * 16 + j; out[o] = out[o] + c[j]; }
    }
};

struct MixNaiveLds { float ps[4][320], qs[4][64], arow[512], grow[512], rv[128], red[4]; };
__device__ __forceinline__ void mix_naive_token(int m, int tid, MixNaiveLds& L, const bf16_t* PROJ, const float* VSSQ, const bf16_t* WSB, const float* rel_table, const float* sink, const float* v_gain,
                                                const float* b_s, const float* ag, const float* gg, bf16_t* MIX) {
    const int s = m / SEQ, t = m % SEQ, w = tid >> 6, lane = tid & 63;
    const bf16_t* prow = PROJ + (size_t)m * INW;
    const int jlo = t - 128 < 0 ? 0 : t - 128, jhi = t + 128 > SEQ - 1 ? SEQ - 1 : t + 128, nk = jhi - jlo + 1;
    for (int hh = 0; hh < 2; ++hh) {
        const int h = w * 2 + hh, g = h >> 2;
        L.qs[w][lane] = bf2f(prow[64 * h + lane]);
        __syncthreads();
        const float sink2 = sink[h] * LOG2E; float sc[5]; float mx = sink2;
#pragma unroll
        for (int i = 0; i < 5; ++i) { const int j = jlo + lane + 64 * i; sc[i] = -1e30f;
            if (j <= jhi) { const bf16_t* kr = PROJ + (size_t)(s * SEQ + j) * INW + 512 + 64 * g; float dot = 0.f;
                for (int d = 0; d < 64; ++d) dot += L.qs[w][d] * bf2f(kr[d]);
                dot += rel_table[t5_bucket(j - t) * 8 + h] * LOG2E; sc[i] = dot; mx = fmaxf(mx, dot); } }
#pragma unroll
        for (int o = 1; o < 64; o <<= 1) mx = fmaxf(mx, __shfl_xor(mx, o));
        float l = 0.f;
#pragma unroll
        for (int i = 0; i < 5; ++i) { const int j = jlo + lane + 64 * i; const float p = j <= jhi ? exp2f(sc[i] - mx) : 0.f; l += p; L.ps[w][lane + 64 * i] = p; }
#pragma unroll
        for (int o = 1; o < 64; o <<= 1) l += __shfl_xor(l, o);
        l += exp2f(sink2 - mx);
        __syncthreads();
        float o = 0.f;
        for (int jj = 0; jj < nk; ++jj) o += L.ps[w][jj] * bf2f(PROJ[(size_t)(s * SEQ + jlo + jj) * INW + 640 + 64 * g + lane]);
        L.arow[64 * h + lane] = o / l;
        __syncthreads();
    }
    const int mc = m - (t & 127), p = t & 127;
    if (tid < 128) { float ss = 0.f; for (int i = 0; i < 8; ++i) ss += VSSQ[(size_t)(mc + tid) * 8 + i]; L.rv[tid] = rsqrtf(ss * (1.0f / 512.0f) + EPS); }
    __syncthreads();
    for (int c = tid; c < 512; c += 256) { const int h = c >> 6; float a = 0.f; const float vg = v_gain[c];
        for (int q = 0; q < 128; ++q) a += bf2f(WSB[(h * 128 + p) * 128 + q]) * (bf2f(PROJ[(size_t)(mc + q) * INW + 1280 + c]) * L.rv[q] * vg);
        L.grow[c] = bf2f(prow[768 + c]) * (a + b_s[h * 128 + p]); }
    __syncthreads();
    float sa = L.arow[tid] * L.arow[tid] + L.arow[tid + 256] * L.arow[tid + 256], sg = L.grow[tid] * L.grow[tid] + L.grow[tid + 256] * L.grow[tid + 256];
#pragma unroll
    for (int o = 1; o < 64; o <<= 1) { sa += __shfl_xor(sa, o); sg += __shfl_xor(sg, o); }
    if (lane == 0) { L.red[w] = sa; } __syncthreads(); sa = L.red[0] + L.red[1] + L.red[2] + L.red[3]; __syncthreads();
    if (lane == 0) { L.red[w] = sg; } __syncthreads(); sg = L.red[0] + L.red[1] + L.red[2] + L.red[3];
    const float ra = rsqrtf(sa * (1.0f / 512.0f) + EPS), rg = rsqrtf(sg * (1.0f / 512.0f) + EPS);
    for (int c = tid; c < 512; c += 256) { MIX[(size_t)m * D + c] = f2bf(L.arow[c] * ra * ag[c]); MIX[(size_t)m * D + 512 + c] = f2bf(L.grow[c] * rg * gg[c]); }
    __syncthreads();
}
__global__ void __launch_bounds__(256) k_mix_naive(const bf16_t* PROJ, const float* VSSQ, const bf16_t* WSB, const float* rel_table, const float* sink, const float* v_gain,
                                                  const float* b_s, const float* ag, const float* gg, bf16_t* MIX) {
    __shared__ MixNaiveLds L;
    mix_naive_token(blockIdx.x, threadIdx.x, L, PROJ, VSSQ, WSB, rel_table, sink, v_gain, b_s, ag, gg, MIX);
}

#define MK_ONE_LAUNCH 1
#define MK_PHASE_MASK 0x3F
#define MK_MIXER_NAIVE 0

namespace pg8 {
#define PG8_LAS __attribute__((address_space(3)))
typedef short bf16x8 __attribute__((ext_vector_type(8)));
typedef float f32x4 __attribute__((ext_vector_type(4)));
typedef unsigned u32x4 __attribute__((ext_vector_type(4)));
typedef unsigned u32x2 __attribute__((ext_vector_type(2)));
constexpr int BM = 256, BK = 64, HALF = 128, HTB = HALF * BK * 2  , STAGE_BYTES = 8 * HTB, NXCD = 8, WGM = 8;

__host__ __device__ __forceinline__ int lds_byte(int r, int c) { const int st = (r >> 4) * 2 + (c >> 5), rr = r & 15, cc = c & 31, ob = rr * 64 + cc * 2; return st * 1024 + (ob ^ (((ob >> 9) & 1) << 5)); }
__host__ __device__ __forceinline__ void stage_rc(int b, int& R, int& C) { const int st = b / 1024, sb = b % 1024, swz = sb ^ (((sb >> 9) & 1) << 5); R = (st >> 1) * 16 + swz / 64; C = (st & 1) * 32 + (swz % 64) / 2; }
__host__ __device__ __forceinline__ int perm32(int rho) { const int n = rho >> 4, i = rho & 15; return 8 * (i >> 2) + 4 * n + (i & 3); }

struct Unit { int pm, pn; };
struct Gemm { const bf16_t* A; const bf16_t* Bt; int M, N, K; };

struct StaticOrder {
    int nM, nN, nwg, G, c;
    __host__ __device__ void init(int M_, int N_, int G_, int c_) { nM = M_ / BM; nN = N_ / BM; nwg = nM * nN; G = G_; c = c_; }
    __host__ __device__ bool next(int i, Unit& u) const {
        const long L = (long)i * G + c; if (L >= nwg) return false;
        int wgid = (int)L; { const int q = nwg / NXCD, r = nwg % NXCD, xcd = wgid % NXCD, off = wgid / NXCD; wgid = (xcd < r ? xcd * (q + 1) : r * (q + 1) + (xcd - r) * q) + off; }
        const int nig = WGM * nN, gid = wgid / nig, fm = gid * WGM, gsz = (nM - fm) < WGM ? (nM - fm) : WGM;
        u.pm = fm + ((wgid % nig) % gsz); u.pn = (wgid % nig) / gsz; return true;
    }
};

__device__ __forceinline__ unsigned cvt_pk_bf16(float lo, float hi) { unsigned r; asm volatile("v_cvt_pk_bf16_f32 %0, %1, %2" : "=v"(r) : "v"(lo), "v"(hi)); return r; }
__device__ __forceinline__ float rsum_fq(float s) { s += __shfl_xor(s, 16); s += __shfl_xor(s, 32); return s; }

struct EpiIn {
    static constexpr int BMAP = 2;
    bf16_t* PROJ; float* VSSQ; const float* qg; const float* kg;
    __device__ __forceinline__ void operator()(const f32x4 (&acc)[2][2][4][2], const Unit& u, int wr, int wc, int fr, int fq) const {
        const int ct = 4 * u.pn + wc;
        const int row0 = u.pm * BM + wr * 64 + fr, col0 = u.pn * BM + wc * 64 + 8 * fq;
        if (ct < 10) {
            const float* g = (ct < 8 ? qg : kg) + 8 * fq; const float sc = ct < 8 ? QSCALE : 1.0f;
            f32x4 gv[2][2];
#pragma unroll
            for (int bj = 0; bj < 2; ++bj)
#pragma unroll
                for (int n = 0; n < 2; ++n) gv[bj][n] = *(const f32x4*)(g + 32 * bj + 4 * n) * sc;
#pragma unroll
            for (int ai = 0; ai < 2; ++ai)
#pragma unroll
                for (int m = 0; m < 4; ++m) {
                    float ss = 0.f;
#pragma unroll
                    for (int bj = 0; bj < 2; ++bj)
#pragma unroll
                        for (int n = 0; n < 2; ++n) { const f32x4 x = acc[ai][bj][m][n]; ss += (x[0] * x[0] + x[1] * x[1]) + (x[2] * x[2] + x[3] * x[3]); }
                    ss = rsum_fq(ss); const float r = rsqrtf(ss * (1.0f / 64.0f) + EPS);
                    bf16_t* rowp = PROJ + (size_t)(row0 + ai * HALF + m * 16) * INW + col0;
#pragma unroll
                    for (int bj = 0; bj < 2; ++bj) { const f32x4 v0 = acc[ai][bj][m][0] * r * gv[bj][0], v1 = acc[ai][bj][m][1] * r * gv[bj][1];
                        u32x4 w; w.x = cvt_pk_bf16(v0[0], v0[1]); w.y = cvt_pk_bf16(v0[2], v0[3]); w.z = cvt_pk_bf16(v1[0], v1[1]); w.w = cvt_pk_bf16(v1[2], v1[3]);
                        *(u32x4*)(rowp + 32 * bj) = w; }
                }
        } else if (ct < 12) {
#pragma unroll
            for (int ai = 0; ai < 2; ++ai)
#pragma unroll
                for (int m = 0; m < 4; ++m) { bf16_t* rowp = PROJ + (size_t)(row0 + ai * HALF + m * 16) * INW + col0;
#pragma unroll
                    for (int bj = 0; bj < 2; ++bj) { const f32x4 v0 = acc[ai][bj][m][0], v1 = acc[ai][bj][m][1];
                        u32x4 w; w.x = cvt_pk_bf16(v0[0], v0[1]); w.y = cvt_pk_bf16(v0[2], v0[3]); w.z = cvt_pk_bf16(v1[0], v1[1]); w.w = cvt_pk_bf16(v1[2], v1[3]);
                        *(u32x4*)(rowp + 32 * bj) = w; } }
        } else {
#pragma unroll
            for (int ai = 0; ai < 2; ++ai)
#pragma unroll
                for (int m = 0; m < 4; ++m) { const int row = row0 + ai * HALF + m * 16; bf16_t* rowp = PROJ + (size_t)row * INW + col0; float ss = 0.f;
#pragma unroll
                    for (int bj = 0; bj < 2; ++bj) { f32x4 v0 = acc[ai][bj][m][0], v1 = acc[ai][bj][m][1];
#pragma unroll
                        for (int e = 0; e < 4; ++e) { v0[e] = gelu_tanh(v0[e]); v1[e] = gelu_tanh(v1[e]); ss += v0[e] * v0[e] + v1[e] * v1[e]; }
                        u32x4 w; w.x = cvt_pk_bf16(v0[0], v0[1]); w.y = cvt_pk_bf16(v0[2], v0[3]); w.z = cvt_pk_bf16(v1[0], v1[1]); w.w = cvt_pk_bf16(v1[2], v1[3]);
                        *(u32x4*)(rowp + 32 * bj) = w; }
                    if (ct >= 20) { ss = rsum_fq(ss); if (fq == 0) VSSQ[(size_t)row * 8 + (ct - 20)] = ss; }
                }
        }
    }
};
struct EpiOut {
    static constexpr int BMAP = 0;
    const float* xp; const float* xs; float* out; bf16_t* X1B; float* SSQ2;
    __device__ __forceinline__ void operator()(const f32x4 (&acc)[2][2][4][2], const Unit& u, int wr, int wc, int fr, int fq) const {
        const int row0 = u.pm * BM + wr * 64 + fr, col0 = u.pn * BM + wc * 32 + 4 * fq;
#pragma unroll
        for (int ai = 0; ai < 2; ++ai)
#pragma unroll
            for (int m = 0; m < 4; ++m) { const int row = row0 + ai * HALF + m * 16; const size_t off = (size_t)row * D + col0;
                const float* xr = (row < MP ? xp + (size_t)row * D : xs + (size_t)(row - MP) * D) + col0; float ss = 0.f;
#pragma unroll
                for (int bj = 0; bj < 2; ++bj)
#pragma unroll
                    for (int n = 0; n < 2; ++n) { const f32x4 v = *(const f32x4*)(xr + bj * HALF + n * 16) + acc[ai][bj][m][n];
                        *(f32x4*)(out + off + bj * HALF + n * 16) = v; u32x2 w; w.x = cvt_pk_bf16(v[0], v[1]); w.y = cvt_pk_bf16(v[2], v[3]); *(u32x2*)(X1B + off + bj * HALF + n * 16) = w;
                        ss += (v[0] * v[0] + v[1] * v[1]) + (v[2] * v[2] + v[3] * v[3]); }
                ss = rsum_fq(ss); if (fq == 0) SSQ2[(size_t)row * 16 + 4 * u.pn + wc] = ss; }
    }
};
struct EpiUp {
    static constexpr int BMAP = 1;
    bf16_t* H; const float* SSQ2;
    __device__ __forceinline__ void operator()(const f32x4 (&acc)[2][2][4][2], const Unit& u, int wr, int wc, int fr, int fq) const {
        const int row0 = u.pm * BM + wr * 64 + fr, col0 = u.pn * HALF + wc * 32 + 8 * fq;
#pragma unroll
        for (int ai = 0; ai < 2; ++ai)
#pragma unroll
            for (int m = 0; m < 4; ++m) { const int row = row0 + ai * HALF + m * 16; const f32x4* sp = (const f32x4*)(SSQ2 + (size_t)row * 16);
                const f32x4 s = (sp[0] + sp[1]) + (sp[2] + sp[3]); const float r = rsqrtf(((s[0] + s[1]) + (s[2] + s[3])) * (1.0f / D) + EPS);
                f32x4 h0, h1;
#pragma unroll
                for (int e = 0; e < 4; ++e) { h0[e] = silu(acc[ai][0][m][0][e] * r) * (acc[ai][1][m][0][e] * r); h1[e] = silu(acc[ai][0][m][1][e] * r) * (acc[ai][1][m][1][e] * r); }
                u32x4 w; w.x = cvt_pk_bf16(h0[0], h0[1]); w.y = cvt_pk_bf16(h0[2], h0[3]); w.z = cvt_pk_bf16(h1[0], h1[1]); w.w = cvt_pk_bf16(h1[2], h1[3]);
                *(u32x4*)(H + (size_t)row * DFF + col0) = w; }
    }
};
struct EpiDown {
    static constexpr int BMAP = 0;
    float* out;
    __device__ __forceinline__ void operator()(const f32x4 (&acc)[2][2][4][2], const Unit& u, int wr, int wc, int fr, int fq) const {
        const int row0 = u.pm * BM + wr * 64 + fr, col0 = u.pn * BM + wc * 32 + 4 * fq;
#pragma unroll
        for (int ai = 0; ai < 2; ++ai)
#pragma unroll
            for (int m = 0; m < 4; ++m) { float* rowp = out + (size_t)(row0 + ai * HALF + m * 16) * D + col0;
#pragma unroll
                for (int bj = 0; bj < 2; ++bj)
#pragma unroll
                    for (int n = 0; n < 2; ++n) { float* p = rowp + bj * HALF + n * 16; *(f32x4*)p = *(const f32x4*)p + acc[ai][bj][m][n]; } }
    }
};

template <class Epi, class Sched, bool ALIGN_EPI>
__device__ __forceinline__ void gemm_phase(PG8_LAS unsigned char* lds, const Gemm g, const Sched& S, const Epi& E) {
    const int tid = threadIdx.x, wid = __builtin_amdgcn_readfirstlane(tid >> 6), lane = tid & 63, wr = wid >> 2, wc = wid & 3, fr = lane & 15, fq = lane >> 4;
    const int K = g.K, nt = K / BK;
    unsigned voffA[2], voffB[2];
#pragma unroll
    for (int i = 0; i < 2; ++i) { int R, C; stage_rc(tid * 16 + i * 8192, R, C);
        const int Rb = Epi::BMAP == 0 ? R : Epi::BMAP == 1 ? ((R & ~31) + perm32(R & 31)) : (64 * (R >> 5) + perm32(R & 31));
        voffA[i] = (unsigned)(R * K + C) * 2u; voffB[i] = (unsigned)(Rb * K + C) * 2u; }
    const size_t kstep = (size_t)(BK * 2);
    const size_t hstep = (size_t)HALF * K * 2;
    const size_t hstepB = Epi::BMAP == 2 ? (size_t)32 * K * 2 : hstep;
    const size_t tstep = 2 * hstep;
    const unsigned ldsw = (unsigned)wid * 1024u;
    const int aoff = lds_byte(wr * 64 + fr, fq * 8), boff = lds_byte(wc * 32 + fr, fq * 8);
#define PG8_SA(b, h) (((b) * 2 + (h)) * HTB)
#define PG8_SB(b, h) ((4 + (b) * 2 + (h)) * HTB)
#define PG8_STAGE(bufoff, gbase, voff) do { _Pragma("unroll") for (int _i = 0; _i < 2; ++_i) \
        __builtin_amdgcn_global_load_lds((const unsigned*)((const char*)(gbase) + (voff)[_i]), (PG8_LAS unsigned*)(lds + (bufoff) + ldsw + _i * 8192), 16, 0, 0); } while (0)
#define PG8_LDA(dst, b, h) do { _Pragma("unroll") for (int m = 0; m < 4; ++m) _Pragma("unroll") for (int k = 0; k < 2; ++k) dst[m][k] = *(const PG8_LAS bf16x8*)(lds + PG8_SA(b, h) + aoff + m * 2048 + k * 1024); } while (0)
#define PG8_LDB(dst, b, h) do { _Pragma("unroll") for (int n = 0; n < 2; ++n) _Pragma("unroll") for (int k = 0; k < 2; ++k) dst[n][k] = *(const PG8_LAS bf16x8*)(lds + PG8_SB(b, h) + boff + n * 2048 + k * 1024); } while (0)
#define PG8_MMA(ai, bj, At, Bt) do { __builtin_amdgcn_s_setprio(1); _Pragma("unroll") for (int m = 0; m < 4; ++m) _Pragma("unroll") for (int n = 0; n < 2; ++n) _Pragma("unroll") for (int k = 0; k < 2; ++k) \
        acc[ai][bj][m][n] = __builtin_amdgcn_mfma_f32_16x16x32_bf16(Bt[n][k], At[m][k], acc[ai][bj][m][n], 0, 0, 0); __builtin_amdgcn_s_setprio(0); } while (0)
#define PG8_WAIT_V(n) asm volatile("s_waitcnt vmcnt(" #n ")" ::: "memory")
#define PG8_WAIT_L(n) asm volatile("s_waitcnt lgkmcnt(" #n ")" ::: "memory")
#define PG8_BAR __builtin_amdgcn_s_barrier()
#define PG8_SCHED __builtin_amdgcn_sched_barrier(0)
    Unit cur, nxt; int ui = 0;
    if (!S.next(0, cur)) return;
    f32x4 acc[2][2][4][2];
#pragma unroll
    for (int a = 0; a < 2; ++a)
#pragma unroll
        for (int b = 0; b < 2; ++b)
#pragma unroll
            for (int m = 0; m < 4; ++m)
#pragma unroll
                for (int n = 0; n < 2; ++n) acc[a][b][m][n] = (f32x4){0.f, 0.f, 0.f, 0.f};
    bf16x8 At[4][2], B0[2][2], B1[2][2];
    const char* cA = (const char*)g.A + (size_t)cur.pm * tstep; const char* cB = (const char*)g.Bt + (size_t)cur.pn * tstep;
    PG8_STAGE(PG8_SB(0, 0), cB, voffB); PG8_STAGE(PG8_SB(0, 1), cB + hstepB, voffB); PG8_STAGE(PG8_SA(0, 0), cA, voffA); PG8_STAGE(PG8_SA(0, 1), cA + hstep, voffA);
    if (wr == 1) PG8_BAR;
    PG8_WAIT_V(2); PG8_BAR;
    PG8_STAGE(PG8_SB(1, 0), cB + kstep, voffB); PG8_STAGE(PG8_SA(1, 0), cA + kstep, voffA); PG8_STAGE(PG8_SB(1, 1), cB + hstepB + kstep, voffB);
    PG8_WAIT_V(6); PG8_BAR;
    for (;;) {
        const bool has_next = S.next(ui + 1, nxt);
        const char* nA = has_next ? (const char*)g.A + (size_t)nxt.pm * tstep : cA; const char* nB = has_next ? (const char*)g.Bt + (size_t)nxt.pn * tstep : cB;
        for (int t = 0; t < nt; t += 2) {
            const bool last = (t == nt - 2);
            const char* a1 = cA + (size_t)(t + 1) * kstep;
            const char* a2 = last ? nA : cA + (size_t)(t + 2) * kstep; const char* b2 = last ? nB : cB + (size_t)(t + 2) * kstep;
            const char* a3 = a2 + kstep; const char* b3 = b2 + kstep;
            PG8_LDB(B0, 0, 0); PG8_LDB(B1, 0, 1); PG8_SCHED; PG8_LDA(At, 0, 0); PG8_STAGE(PG8_SA(1, 1), a1 + hstep, voffA);
            PG8_WAIT_V(8); PG8_WAIT_L(0); PG8_BAR; PG8_MMA(0, 0, At, B0); PG8_MMA(0, 1, At, B1); PG8_BAR; PG8_SCHED;
            PG8_LDA(At, 0, 1); PG8_STAGE(PG8_SB(0, 0), b2, voffB); PG8_STAGE(PG8_SB(0, 1), b2 + hstepB, voffB); PG8_STAGE(PG8_SA(0, 0), a2, voffA);
            PG8_WAIT_V(8); PG8_WAIT_L(0); PG8_BAR; PG8_MMA(1, 0, At, B0); PG8_MMA(1, 1, At, B1); PG8_BAR; PG8_SCHED;
            PG8_LDB(B0, 1, 0); PG8_LDB(B1, 1, 1); PG8_SCHED; PG8_LDA(At, 1, 0); PG8_STAGE(PG8_SA(0, 1), a2 + hstep, voffA);
            PG8_WAIT_V(8); PG8_WAIT_L(0); PG8_BAR; PG8_MMA(0, 0, At, B0); PG8_MMA(0, 1, At, B1); PG8_BAR; PG8_SCHED;
            PG8_LDA(At, 1, 1); PG8_STAGE(PG8_SB(1, 0), b3, voffB); PG8_STAGE(PG8_SB(1, 1), b3 + hstepB, voffB); PG8_STAGE(PG8_SA(1, 0), a3, voffA);
            PG8_WAIT_V(8); PG8_WAIT_L(0); PG8_BAR; PG8_MMA(1, 0, At, B0); PG8_MMA(1, 1, At, B1); PG8_BAR; PG8_SCHED;
        }
        if constexpr (ALIGN_EPI) { if (wr == 0) PG8_BAR; }
        E(acc, cur, wr, wc, fr, fq);
        if (!has_next) break;
#pragma unroll
        for (int a = 0; a < 2; ++a)
#pragma unroll
            for (int b = 0; b < 2; ++b)
#pragma unroll
                for (int m = 0; m < 4; ++m)
#pragma unroll
                    for (int n = 0; n < 2; ++n) acc[a][b][m][n] = (f32x4){0.f, 0.f, 0.f, 0.f};
        cur = nxt; cA = nA; cB = nB; ++ui;
        if constexpr (ALIGN_EPI) { if (wr == 1) PG8_BAR; }
    }
    PG8_WAIT_V(0);
    if constexpr (!ALIGN_EPI) { if (wr == 0) PG8_BAR; }
    PG8_BAR;
#undef PG8_SA
#undef PG8_SB
#undef PG8_STAGE
#undef PG8_LDA
#undef PG8_LDB
#undef PG8_MMA
#undef PG8_WAIT_V
#undef PG8_WAIT_L
#undef PG8_BAR
#undef PG8_SCHED
}
}
#define LAS __attribute__((address_space(3)))

struct Args;
__device__ __forceinline__ void p0_prologue_naive(const float* const* in, unsigned char* ws, int G) {
    const size_t gt = (size_t)blockIdx.x * 512 + threadIdx.x, GT = (size_t)G * 512;
    for (size_t i = gt; i < NPREP; i += GT) prep_w_elem(i, in[4], in[13], in[15], in[16], in[17], in[9], in[14], ws);
    const int wave = threadIdx.x >> 6, lane = threadIdx.x & 63;
    for (int m = blockIdx.x * 8 + wave; m < M; m += G * 8) xn_row(m, lane, in[0], in[1], in[3], (bf16_t*)(ws + WS_XN));
}

__device__ __forceinline__ void p2_mixer_naive(const float* const* in, unsigned char* ws, unsigned char* lds_generic, int G) {
    MixNaiveLds* L = (MixNaiveLds*)lds_generic + (threadIdx.x >> 8);
    for (int pr = blockIdx.x; pr < M / 2; pr += G)
        mix_naive_token(2 * pr + (threadIdx.x >> 8), threadIdx.x & 255, *L, (const bf16_t*)(ws + WS_PROJ), (const float*)(ws + WS_VSSQ), (const bf16_t*)(ws + WS_WS), in[2], in[7], in[8], in[10], in[11], in[12], (bf16_t*)(ws + WS_MIX));
}

static void launch_naive_phase(int p, void* const* d_in, float* out, unsigned char* ws, hipStream_t stream) {
    const float* xp = (const float*)d_in[0]; const float* xs = (const float*)d_in[1]; const float* rel = (const float*)d_in[2]; const float* norm1 = (const float*)d_in[3];
    const float* w_in = (const float*)d_in[4]; const float* qg = (const float*)d_in[5]; const float* kg = (const float*)d_in[6]; const float* sink = (const float*)d_in[7];
    const float* vg = (const float*)d_in[8]; const float* w_s = (const float*)d_in[9]; const float* b_s = (const float*)d_in[10]; const float* ag = (const float*)d_in[11];
    const float* gg = (const float*)d_in[12]; const float* w_o = (const float*)d_in[13]; const float* norm2 = (const float*)d_in[14]; const float* w_gate = (const float*)d_in[15];
    const float* w_up = (const float*)d_in[16]; const float* w_down = (const float*)d_in[17];
    bf16_t* WIN = (bf16_t*)(ws + WS_WIN); bf16_t* WO = (bf16_t*)(ws + WS_WO); bf16_t* WGU = (bf16_t*)(ws + WS_WGU); bf16_t* WDN = (bf16_t*)(ws + WS_WDN); bf16_t* WSB = (bf16_t*)(ws + WS_WS);
    float* VSSQ = (float*)(ws + WS_VSSQ); float* SSQ2 = (float*)(ws + WS_SSQ2);
    bf16_t* XN = (bf16_t*)(ws + WS_XN); bf16_t* PROJ = (bf16_t*)(ws + WS_PROJ); bf16_t* H = (bf16_t*)(ws + WS_H); bf16_t* MIX = (bf16_t*)(ws + WS_MIX); bf16_t* X1B = (bf16_t*)(ws + WS_X1B);
    switch (p) {
    case 0: k_prep_w<<<(unsigned)((NPREP + 255) / 256), 256, 0, stream>>>(w_in, w_o, w_gate, w_up, w_down, w_s, norm2, ws);
            k_xn<<<M / 4, 256, 0, stream>>>(xp, xs, norm1, XN); break;
    case 1: k_gemm_naive<NEpiIn, false><<<dim3(INW / 64, M / 64), 256, 0, stream>>>(XN, WIN, D, NEpiIn{PROJ, VSSQ, qg, kg}); break;
    case 2: k_mix_naive<<<M, 256, 0, stream>>>(PROJ, VSSQ, WSB, rel, sink, vg, b_s, ag, gg, MIX); break;
    case 3: k_gemm_naive<NEpiOut, false><<<dim3(D / 64, M / 64), 256, 0, stream>>>(MIX, WO, D, NEpiOut{xp, xs, out, X1B, SSQ2}); break;
    case 4: k_gemm_naive<NEpiUp, true><<<dim3(DFF / 64, M / 64), 256, 0, stream>>>(X1B, WGU, D, NEpiUp{H, SSQ2}); break;
    case 5: k_gemm_naive<NEpiDown, false><<<dim3(D / 64, M / 64), 256, 0, stream>>>(H, WDN, DFF, NEpiDown{out}); break;
    }
}

namespace mix {
typedef short bf16x8 __attribute__((ext_vector_type(8)));
typedef short s16x4 __attribute__((ext_vector_type(4)));
typedef float f32x16 __attribute__((ext_vector_type(16)));
typedef float f32x4 __attribute__((ext_vector_type(4)));
typedef unsigned u32x2 __attribute__((ext_vector_type(2)));
typedef unsigned u32x4 __attribute__((ext_vector_type(4)));
typedef float f32x2_t __attribute__((ext_vector_type(2))); typedef __bf16 bf16x2_t __attribute__((ext_vector_type(2)));
constexpr int L_K = 0, L_V = 40960, L_TAB = 81920, TABN = 392, L_RV = L_TAB + 8 * 4 * TABN * 4, L_SS = L_RV + 512, L_END = L_SS + 2048;
constexpr int NUNITS = NSEQ * (SEQ / 64);
__device__ __forceinline__ unsigned cvtpk(float lo, float hi) { f32x2_t v = {lo, hi}; bf16x2_t b = __builtin_convertvector(v, bf16x2_t); return __builtin_bit_cast(unsigned, b); }
__device__ __forceinline__ s16x4 trrd(const LAS unsigned char* p) { typedef short v4i16_t __attribute__((ext_vector_type(4))); return __builtin_bit_cast(s16x4, __builtin_amdgcn_ds_read_tr16_b64_v4i16((LAS v4i16_t*)p)); }
__device__ __forceinline__ float xhalf_sum(float v) { auto rr = __builtin_amdgcn_permlane32_swap(__float_as_uint(v), __float_as_uint(v), false, false); return __uint_as_float(rr[0]) + __uint_as_float(rr[1]); }
__device__ __forceinline__ float xhalf_max(float v) { auto rr = __builtin_amdgcn_permlane32_swap(__float_as_uint(v), __float_as_uint(v), false, false); return fmaxf(__uint_as_float(rr[0]), __uint_as_float(rr[1])); }

template <int MODE> __device__ __forceinline__ void stage_rows(LAS unsigned char* img, const bf16_t* src, int row_lo, int row_hi, int wave, int lane) {
    for (int r8 = (row_lo >> 3) + wave; r8 < (row_hi >> 3); r8 += 8) {
        const int row = 8 * r8 + (lane >> 3), pc = lane & 7, c = MODE == 0 ? (pc ^ ((row >> 1) & 7)) : (pc ^ (((row >> 1) & 1) << 2));
        __builtin_amdgcn_global_load_lds((const unsigned*)(src + (size_t)row * INW + 8 * c), (LAS unsigned*)(img + r8 * 1024), 16, 0, 0);
    }
}

__device__ __forceinline__ void p2_mixer(const float* const* in, unsigned char* ws, LAS unsigned char* lds, int G) {
    const int tid = threadIdx.x, wave = __builtin_amdgcn_readfirstlane(tid >> 6), lane = tid & 63, r32 = lane & 31, hi = lane >> 5, hq = wave >> 1, tb = wave & 1;
    const bf16_t* PROJ = (const bf16_t*)(ws + WS_PROJ); const float* VSSQ = (const float*)(ws + WS_VSSQ); const bf16_t* WSB = (const bf16_t*)(ws + WS_WS); bf16_t* MIX = (bf16_t*)(ws + WS_MIX);
    const float* rel_table = in[2]; const float* sink = in[7]; const float* v_gain = in[8]; const float* b_s = in[10]; const float* ag = in[11]; const float* gg = in[12];
    LAS float* TAB = (LAS float*)(lds + L_TAB); LAS float* RV = (LAS float*)(lds + L_RV); LAS float* SS = (LAS float*)(lds + L_SS);
    for (int i = tid; i < 8 * 4 * TABN; i += 512) { const int h = i / (4 * TABN), rem = i % (4 * TABN), sh = rem / TABN, e = rem % TABN, bi = e + sh - 64;
        TAB[i] = (bi >= 0 && bi <= 256) ? rel_table[t5_bucket(bi - 128) * 8 + h] * LOG2E : -1e30f; }
    int koff[4], voff[2], gvoff[2];
    { const int q = (lane & 15) >> 2, sw = (q >> 1) & 1;
#pragma unroll
      for (int d0 = 0; d0 < 4; ++d0) koff[d0] = r32 * 128 + (((2 * d0 + hi) ^ ((r32 >> 1) & 7)) << 4);
#pragma unroll
      for (int dh = 0; dh < 2; ++dh) { const int ch = 4 * (dh ^ sw) + 2 * ((lane >> 4) & 1) + ((lane & 3) >> 1);
          voff[dh] = (4 * hi + q) * 128 + ch * 16 + (lane & 1) * 8; gvoff[dh] = (8 * hi + q) * 128 + ch * 16 + (lane & 1) * 8; } }
    const int e0 = 64 - 32 * tb - r32 + 4 * hi, sh = e0 & 3;
    const int vcu = (G % 8 == 0) ? ((int)blockIdx.x % 8) * (G / 8) + (int)blockIdx.x / 8 : (int)blockIdx.x;

    for (int u = vcu; u < NUNITS; u += G) {
        const int s = u >> 6, t0 = (u & 63) * 64, m0 = s * SEQ + t0;
        const int kt_lo = t0 < 128 ? (128 - t0) >> 6 : 0, kt_hi = t0 + 192 > SEQ ? (SEQ + 128 - t0) >> 6 : 5;
        const int mc = m0 - (t0 & 127), pbase = (t0 & 127) + 32 * tb + r32;
        const size_t mrow = (size_t)(m0 + 32 * tb + r32);
        f32x16 oa[2][2];
        __syncthreads();
        if (tid < 128) { const f32x4* vp = (const f32x4*)(VSSQ + (size_t)(mc + tid) * 8); const f32x4 a = vp[0] + vp[1]; RV[tid] = rsqrtf(((a[0] + a[1]) + (a[2] + a[3])) * (1.0f / 512.0f) + EPS); }
#pragma unroll
        for (int g = 0; g < 2; ++g) {
            const int h = 4 * g + hq;
            if (g == 1) __syncthreads();
            { const bf16_t* krow0 = PROJ + (long)(m0 - 128) * INW + 512 + 64 * g;
              stage_rows<0>(lds + L_K, krow0, 64 * kt_lo, 64 * kt_hi, wave, lane);
              stage_rows<1>(lds + L_V, krow0 + 128, 64 * kt_lo, 64 * kt_hi, wave, lane); }
            bf16x8 qf[4];
#pragma unroll
            for (int d0 = 0; d0 < 4; ++d0) qf[d0] = *(const bf16x8*)(PROJ + mrow * INW + 64 * h + 16 * d0 + 8 * hi);
            const float sink2 = sink[h] * LOG2E;
            __syncthreads();
            float m = sink2, l = hi == 0 ? 1.0f : 0.0f;
            f32x16 o0 = {}, o1 = {};
            const LAS float* tbp = TAB + (h * 4 + sh) * TABN + (e0 - sh);
            for (int kt = kt_lo; kt < kt_hi; ++kt) {
                f32x16 p0, p1;
                { const LAS float* tp = tbp + 64 * kt;
#pragma unroll
                  for (int gq = 0; gq < 4; ++gq) { const f32x4 a = *(const LAS f32x4*)(tp + 8 * gq), b = *(const LAS f32x4*)(tp + 32 + 8 * gq);
#pragma unroll
                      for (int e = 0; e < 4; ++e) { p0[4 * gq + e] = a[e]; p1[4 * gq + e] = b[e]; } } }
                const LAS unsigned char* kb = lds + L_K + kt * 8192;
#pragma unroll
                for (int d0 = 0; d0 < 4; ++d0) { const bf16x8 k0 = *(const LAS bf16x8*)(kb + koff[d0]), k1 = *(const LAS bf16x8*)(kb + 4096 + koff[d0]);
                    p0 = __builtin_amdgcn_mfma_f32_32x32x16_bf16(k0, qf[d0], p0, 0, 0, 0); p1 = __builtin_amdgcn_mfma_f32_32x32x16_bf16(k1, qf[d0], p1, 0, 0, 0); }
                float rm = fmaxf(p0[0], p1[0]);
#pragma unroll
                for (int r = 1; r < 16; ++r) rm = fmaxf(rm, fmaxf(p0[r], p1[r]));
                rm = xhalf_max(rm);
                const float mn = fmaxf(m, rm), alpha = __builtin_amdgcn_exp2f(m - mn); m = mn;
                float ls = 0.f;
#pragma unroll
                for (int r = 0; r < 16; ++r) { p0[r] = __builtin_amdgcn_exp2f(p0[r] - m); p1[r] = __builtin_amdgcn_exp2f(p1[r] - m); ls += p0[r] + p1[r]; }
                l = l * alpha + ls;
#pragma unroll
                for (int r = 0; r < 16; ++r) { o0[r] *= alpha; o1[r] *= alpha; }
                u32x4 pw[2][2];
#pragma unroll
                for (int sI = 0; sI < 2; ++sI) { pw[0][sI] = (u32x4){cvtpk(p0[8 * sI], p0[8 * sI + 1]), cvtpk(p0[8 * sI + 2], p0[8 * sI + 3]), cvtpk(p0[8 * sI + 4], p0[8 * sI + 5]), cvtpk(p0[8 * sI + 6], p0[8 * sI + 7])};
                                                 pw[1][sI] = (u32x4){cvtpk(p1[8 * sI], p1[8 * sI + 1]), cvtpk(p1[8 * sI + 2], p1[8 * sI + 3]), cvtpk(p1[8 * sI + 4], p1[8 * sI + 5]), cvtpk(p1[8 * sI + 6], p1[8 * sI + 7])}; }
                const LAS unsigned char* vb = lds + L_V + kt * 8192;
#pragma unroll
                for (int sub = 0; sub < 2; ++sub)
#pragma unroll
                    for (int sI = 0; sI < 2; ++sI) { const bf16x8 pf = __builtin_bit_cast(bf16x8, pw[sub][sI]);
#pragma unroll
                        for (int dh = 0; dh < 2; ++dh) { const LAS unsigned char* vp = vb + (32 * sub + 16 * sI) * 128 + voff[dh];
                            const s16x4 lo = trrd(vp), hi4 = trrd(vp + 8 * 128); const bf16x8 vf = {lo[0], lo[1], lo[2], lo[3], hi4[0], hi4[1], hi4[2], hi4[3]};
                            if (dh == 0) o0 = __builtin_amdgcn_mfma_f32_32x32x16_bf16(vf, pf, o0, 0, 0, 0); else o1 = __builtin_amdgcn_mfma_f32_32x32x16_bf16(vf, pf, o1, 0, 0, 0); } }
            }
            const float inv = 1.0f / xhalf_sum(l);
#pragma unroll
            for (int r = 0; r < 16; ++r) { o0[r] *= inv; o1[r] *= inv; }
            oa[g][0] = o0; oa[g][1] = o1;
        }
        { float ss = 0.f;
#pragma unroll
          for (int g = 0; g < 2; ++g)
#pragma unroll
              for (int dh = 0; dh < 2; ++dh)
#pragma unroll
                  for (int r = 0; r < 16; ++r) ss += oa[g][dh][r] * oa[g][dh][r];
          ss = xhalf_sum(ss); if (hi == 0) SS[wave * 32 + r32] = ss; }
        __syncthreads();
        { const bf16_t* vrow0 = PROJ + (size_t)mc * INW + 1280;
#pragma unroll
          for (int hh = 0; hh < 4; ++hh) stage_rows<1>(lds + hh * 16384, vrow0 + 64 * hh, 0, 128, wave, lane); }
        { const float tot = (SS[tb * 32 + r32] + SS[(2 + tb) * 32 + r32]) + (SS[(4 + tb) * 32 + r32] + SS[(6 + tb) * 32 + r32]);
          const float ra = rsqrtf(tot * (1.0f / 512.0f) + EPS);
#pragma unroll
          for (int g = 0; g < 2; ++g)
#pragma unroll
              for (int dh = 0; dh < 2; ++dh)
#pragma unroll
                  for (int gq = 0; gq < 4; ++gq) { const int col = 64 * (4 * g + hq) + 32 * dh + 8 * gq + 4 * hi; const f32x4 gn = *(const f32x4*)(ag + col);
                      u32x2 w; w.x = cvtpk(oa[g][dh][4 * gq] * ra * gn[0], oa[g][dh][4 * gq + 1] * ra * gn[1]); w.y = cvtpk(oa[g][dh][4 * gq + 2] * ra * gn[2], oa[g][dh][4 * gq + 3] * ra * gn[3]);
                      *(u32x2*)(MIX + mrow * D + col) = w; } }
        f32x16 og[2][2];
#pragma unroll
        for (int rd = 0; rd < 2; ++rd) {
            const int hh = 4 * rd + hq;
            if (rd == 1) { __syncthreads();
                const bf16_t* vrow0 = PROJ + (size_t)mc * INW + 1280 + 256;
#pragma unroll
                for (int h4 = 0; h4 < 4; ++h4) stage_rows<1>(lds + h4 * 16384, vrow0 + 64 * h4, 0, 128, wave, lane); }
            bf16x8 wf[8];
            { const bf16_t* wrow = WSB + ((size_t)hh * 128 + pbase) * 128 + 8 * hi;
#pragma unroll
              for (int sI = 0; sI < 8; ++sI) wf[sI] = *(const bf16x8*)(wrow + 16 * sI); }
            __syncthreads();
            f32x16 a0 = {}, a1 = {};
            const LAS unsigned char* gb = lds + hq * 16384;
#pragma unroll
            for (int sI = 0; sI < 8; ++sI) {
                const f32x4 ra = *(const LAS f32x4*)(RV + 16 * sI + 8 * hi), rb = *(const LAS f32x4*)(RV + 16 * sI + 8 * hi + 4);
                const u32x4 wu = __builtin_bit_cast(u32x4, wf[sI]); u32x4 ws4;
                ws4.x = cvtpk(__uint_as_float(wu.x << 16) * ra[0], __uint_as_float(wu.x & 0xffff0000u) * ra[1]); ws4.y = cvtpk(__uint_as_float(wu.y << 16) * ra[2], __uint_as_float(wu.y & 0xffff0000u) * ra[3]);
                ws4.z = cvtpk(__uint_as_float(wu.z << 16) * rb[0], __uint_as_float(wu.z & 0xffff0000u) * rb[1]); ws4.w = cvtpk(__uint_as_float(wu.w << 16) * rb[2], __uint_as_float(wu.w & 0xffff0000u) * rb[3]);
                const bf16x8 bfr = __builtin_bit_cast(bf16x8, ws4);
#pragma unroll
                for (int dh = 0; dh < 2; ++dh) { const LAS unsigned char* vp = gb + (16 * sI) * 128 + gvoff[dh];
                    const s16x4 lo = trrd(vp), hi4 = trrd(vp + 4 * 128); const bf16x8 vf = {lo[0], lo[1], lo[2], lo[3], hi4[0], hi4[1], hi4[2], hi4[3]};
                    if (dh == 0) a0 = __builtin_amdgcn_mfma_f32_32x32x16_bf16(vf, bfr, a0, 0, 0, 0); else a1 = __builtin_amdgcn_mfma_f32_32x32x16_bf16(vf, bfr, a1, 0, 0, 0); }
            }
            const float bsv = b_s[hh * 128 + pbase];
#pragma unroll
            for (int dh = 0; dh < 2; ++dh)
#pragma unroll
                for (int gq = 0; gq < 4; ++gq) { const int col = 64 * hh + 32 * dh + 8 * gq + 4 * hi; const f32x4 vg = *(const f32x4*)(v_gain + col);
                    const u32x2 uu = *(const u32x2*)(PROJ + mrow * INW + 768 + col);
                    const float u0 = __uint_as_float(uu.x << 16), u1 = __uint_as_float(uu.x & 0xffff0000u), u2 = __uint_as_float(uu.y << 16), u3 = __uint_as_float(uu.y & 0xffff0000u);
                    f32x16& acc = dh == 0 ? a0 : a1;
                    acc[4 * gq] = u0 * (vg[0] * acc[4 * gq] + bsv); acc[4 * gq + 1] = u1 * (vg[1] * acc[4 * gq + 1] + bsv);
                    acc[4 * gq + 2] = u2 * (vg[2] * acc[4 * gq + 2] + bsv); acc[4 * gq + 3] = u3 * (vg[3] * acc[4 * gq + 3] + bsv); }
            og[rd][0] = a0; og[rd][1] = a1;
        }
        { float ss = 0.f;
#pragma unroll
          for (int rd = 0; rd < 2; ++rd)
#pragma unroll
              for (int dh = 0; dh < 2; ++dh)
#pragma unroll
                  for (int r = 0; r < 16; ++r) ss += og[rd][dh][r] * og[rd][dh][r];
          ss = xhalf_sum(ss); if (hi == 0) SS[256 + wave * 32 + r32] = ss; }
        __syncthreads();
        { const float tot = (SS[256 + tb * 32 + r32] + SS[256 + (2 + tb) * 32 + r32]) + (SS[256 + (4 + tb) * 32 + r32] + SS[256 + (6 + tb) * 32 + r32]);
          const float rg = rsqrtf(tot * (1.0f / 512.0f) + EPS);
#pragma unroll
          for (int rd = 0; rd < 2; ++rd)
#pragma unroll
              for (int dh = 0; dh < 2; ++dh)
#pragma unroll
                  for (int gq = 0; gq < 4; ++gq) { const int col = 64 * (4 * rd + hq) + 32 * dh + 8 * gq + 4 * hi; const f32x4 gn = *(const f32x4*)(gg + col);
                      u32x2 w; w.x = cvtpk(og[rd][dh][4 * gq] * rg * gn[0], og[rd][dh][4 * gq + 1] * rg * gn[1]); w.y = cvtpk(og[rd][dh][4 * gq + 2] * rg * gn[2], og[rd][dh][4 * gq + 3] * rg * gn[3]);
                      *(u32x2*)(MIX + mrow * D + 512 + col) = w; } }
    }
    __syncthreads();
}
}

constexpr int NWAVES = 8;
constexpr int N_PHASES = 6;
constexpr int RING_BYTES = 131072;
constexpr int LDSCTL_OFF = RING_BYTES + 24576, MISC_OFF = LDSCTL_OFF + 320;
constexpr int LDS_BYTES = 157696;
static_assert(MISC_OFF + 128 <= LDS_BYTES && mix::L_END <= LDSCTL_OFF, "LDS map");
constexpr int CW_BAR = 4096;

#define GAS __attribute__((address_space(1)))

typedef GAS unsigned gu32;
#define RLX_AGENT __ATOMIC_RELAXED, __HIP_MEMORY_SCOPE_AGENT

#define XB_TMO      128
#define XB_XCNT(j)  (256  + 64 * (j))
#define XB_XSUB(j)  (1280 + 64 * (j))
#define XB_XGEN(j)  (2304 + 64 * (j))
#define XB_TOP      3328
#define XB_TOPGEN   3392
#define XCD_BAR_WORDS 3456
#define XB_SPIN_CAP (1u << 18)

__device__ __forceinline__ unsigned xb_ld(unsigned* p)              { return __hip_atomic_load(p, __ATOMIC_RELAXED, __HIP_MEMORY_SCOPE_AGENT); }
__device__ __forceinline__ unsigned xb_add(unsigned* p, unsigned v) { return __hip_atomic_fetch_add(p, v, __ATOMIC_RELAXED, __HIP_MEMORY_SCOPE_AGENT); }
__device__ __forceinline__ unsigned xb_xcc_id() { return (unsigned)__builtin_amdgcn_s_getreg((3 << 11) | 20) & 0xFu; }
#define XB_SPIN(cond, bar) do { unsigned _sp = 0; while (cond) { __builtin_amdgcn_s_sleep(1); \
    if ((++_sp & 255u) == 0u) { if (xb_ld(&(bar)[XB_TMO])) break; if (_sp > XB_SPIN_CAP) { atomicAdd(&(bar)[XB_TMO], 1u); break; } } } } while (0)

struct XcdBarrier { unsigned* bar; unsigned x; volatile LAS unsigned* st; };
__device__ __forceinline__ XcdBarrier xcd_barrier_post(unsigned* bar, volatile LAS unsigned* st) {
    XcdBarrier b; b.bar = bar; b.x = xb_xcc_id(); b.st = st;
    if (threadIdx.x == 0) (void)xb_add(&bar[XB_XCNT(b.x)], 1u);
    return b;
}
__device__ __forceinline__ void xcd_barrier_complete(unsigned* bar, unsigned x, unsigned& nloc, unsigned& nx) {
    const unsigned G = gridDim.x * gridDim.y * gridDim.z;
    unsigned sum, cnt, mine, sp = 0u;
    for (;;) {
        sum = 0u; cnt = 0u; mine = 0u;
#pragma unroll
        for (unsigned j = 0; j < 16; ++j) { const unsigned c = xb_ld(&bar[XB_XCNT(j)]); sum += c; cnt += (c > 0u) ? 1u : 0u; mine = (j == x) ? c : mine; }
        if (sum == G) break;
        __builtin_amdgcn_s_sleep(1);
        if ((++sp & 255u) == 0u) { if (xb_ld(&bar[XB_TMO])) break; if (sp > XB_SPIN_CAP) { atomicAdd(&bar[XB_TMO], 1u); break; } }
    }
    nloc = mine > 0u ? mine : 1u; nx = cnt > 0u ? cnt : 1u;
}
__device__ __forceinline__ void xcd_barrier(const XcdBarrier& b) {
    asm volatile("s_waitcnt vmcnt(0)" ::: "memory");
    __syncthreads();
    if (threadIdx.x == 0) {
        unsigned* bar = b.bar;
        __builtin_amdgcn_s_waitcnt(0);
        unsigned nloc = b.st[0], nx = b.st[1];
        if (nloc == 0u) { xcd_barrier_complete(bar, b.x, nloc, nx); b.st[0] = nloc; b.st[1] = nx; }
        const unsigned old = xb_add(&bar[XB_XSUB(b.x)], 1u);
        const unsigned gen = old / nloc;
        if (old + 1u == (gen + 1u) * nloc) {
            __builtin_amdgcn_fence(__ATOMIC_RELEASE, "agent");
            asm volatile("s_waitcnt vmcnt(0)" ::: "memory");
            const unsigned og = xb_add(&bar[XB_TOP], 1u);
            const unsigned tg = og / nx;
            if (og + 1u == (tg + 1u) * nx) xb_add(&bar[XB_TOPGEN], 1u);
            else XB_SPIN(xb_ld(&bar[XB_TOPGEN]) == tg, bar);
            __builtin_amdgcn_fence(__ATOMIC_ACQUIRE, "agent");
            xb_add(&bar[XB_XGEN(b.x)], 1u);
            asm volatile("s_waitcnt vmcnt(0)" ::: "memory");
        } else {
            XB_SPIN(xb_ld(&bar[XB_XGEN(b.x)]) == gen, bar);
            __builtin_amdgcn_fence(__ATOMIC_ACQUIRE, "agent");
            asm volatile("s_waitcnt vmcnt(0)" ::: "memory");
        }
    }
    __syncthreads();
}

struct Args { const float* in[18]; float* out; unsigned char* ws; int ph_lo, ph_hi; };

__global__ void __launch_bounds__(NWAVES * 64, 2) mk_fwd(Args args) {
    extern __shared__ __attribute__((aligned(16))) unsigned char lds_raw[];
    LAS unsigned char* lds = (LAS unsigned char*)lds_raw;
    volatile LAS unsigned* MISC = (volatile LAS unsigned*)(lds + MISC_OFF);
    const int tid = threadIdx.x, G = gridDim.x;
    unsigned char* ws = args.ws;
    gu32* ctl = (gu32*)(ws + WS_CTL);
    for (int u = tid; u < (LDS_BYTES - LDSCTL_OFF) / 4; u += NWAVES * 64) ((LAS unsigned*)(lds + LDSCTL_OFF))[u] = 0u;
    __syncthreads();
    const int lo = args.ph_lo, hi = args.ph_hi;
    const bool multi = hi - lo > 1;
    XcdBarrier bar; bar.bar = (unsigned*)(ctl + CW_BAR); bar.x = 0; bar.st = nullptr;
    if (multi) bar = xcd_barrier_post((unsigned*)(ctl + CW_BAR), MISC + 8);
#define IN(k) (lo <= (k) && (k) < hi)
#define BOTH(k) (IN(k) && IN((k) + 1))
    const float* xp = args.in[0]; const float* xs = args.in[1];
    bf16_t* WIN = (bf16_t*)(ws + WS_WIN); bf16_t* WO = (bf16_t*)(ws + WS_WO); bf16_t* WGU = (bf16_t*)(ws + WS_WGU); bf16_t* WDN = (bf16_t*)(ws + WS_WDN);
    float* VSSQ = (float*)(ws + WS_VSSQ); float* SSQ2 = (float*)(ws + WS_SSQ2);
    bf16_t* XN = (bf16_t*)(ws + WS_XN); bf16_t* PROJ = (bf16_t*)(ws + WS_PROJ); bf16_t* H = (bf16_t*)(ws + WS_H); bf16_t* MIX = (bf16_t*)(ws + WS_MIX); bf16_t* X1B = (bf16_t*)(ws + WS_X1B);

    if (IN(0)) { p0_prologue_naive(args.in, ws, G); if (BOTH(0)) xcd_barrier(bar); }
    if (IN(1)) {
        pg8::Gemm g{XN, WIN, M, INW, D}; pg8::StaticOrder S; S.init(M, INW, G, (int)blockIdx.x);
        pg8::EpiIn E{PROJ, VSSQ, args.in[5], args.in[6]};
        pg8::gemm_phase<pg8::EpiIn, pg8::StaticOrder, true>(lds, g, S, E);
        if (BOTH(1)) xcd_barrier(bar);
    }
    if (IN(2)) {
#if MK_MIXER_NAIVE
        p2_mixer_naive(args.in, ws, lds_raw, G);
#else
        mix::p2_mixer(args.in, ws, lds, G);
#endif
        if (BOTH(2)) xcd_barrier(bar); }
    if (IN(3)) {
        pg8::Gemm g{MIX, WO, M, D, D}; pg8::StaticOrder S; S.init(M, D, G, (int)blockIdx.x);
        pg8::EpiOut E{xp, xs, args.out, X1B, SSQ2};
        pg8::gemm_phase<pg8::EpiOut, pg8::StaticOrder, true>(lds, g, S, E);
        if (BOTH(3)) xcd_barrier(bar);
    }
    if (IN(4)) {
        pg8::Gemm g{X1B, WGU, M, NGU, D}; pg8::StaticOrder S; S.init(M, NGU, G, (int)blockIdx.x);
        pg8::EpiUp E{H, SSQ2};
        pg8::gemm_phase<pg8::EpiUp, pg8::StaticOrder, true>(lds, g, S, E);
        if (BOTH(4)) xcd_barrier(bar);
    }
    if (IN(5)) {
        pg8::Gemm g{H, WDN, M, D, DFF}; pg8::StaticOrder S; S.init(M, D, G, (int)blockIdx.x);
        pg8::EpiDown E{args.out};
        pg8::gemm_phase<pg8::EpiDown, pg8::StaticOrder, true>(lds, g, S, E);
    }
#undef IN
#undef BOTH
}

extern "C" void kernel_launch(void* const* d_in, const int* in_sizes, int n_in, void* d_out, int out_size, void* d_ws, size_t ws_size, hipStream_t stream) {
    static int grid = 0;
    if (grid == 0) {
        if (n_in != 18 || in_sizes[0] != MP * D || in_sizes[1] != (M - MP) * D || out_size != M * D || ws_size < WS_END) {
            fprintf(stderr, "kernel_launch: unexpected shapes (n_in %d, in0 %d, in1 %d, out %d, ws %zu)\n", n_in, n_in > 0 ? in_sizes[0] : -1, n_in > 1 ? in_sizes[1] : -1, out_size, ws_size); grid = -1; return; }
        int dev = 0, cus = 0, per_cu = 0;
        if (hipGetDevice(&dev) != hipSuccess || hipDeviceGetAttribute(&cus, hipDeviceAttributeMultiprocessorCount, dev) != hipSuccess) { grid = -1; return; }
        if (hipFuncSetAttribute((const void*)mk_fwd, hipFuncAttributeMaxDynamicSharedMemorySize, LDS_BYTES) != hipSuccess) { fprintf(stderr, "kernel_launch: hipFuncSetAttribute failed\n"); grid = -1; return; }
        if (hipOccupancyMaxActiveBlocksPerMultiprocessor(&per_cu, (const void*)mk_fwd, NWAVES * 64, LDS_BYTES) != hipSuccess || per_cu < 1) { fprintf(stderr, "kernel_launch: occupancy query says %d blocks per CU\n", per_cu); grid = -1; return; }
        (void)hipGetLastError();
        grid = cus;
    }
    if (grid < 0) return;
    Args a{};
    for (int i = 0; i < 18; ++i) a.in[i] = (const float*)d_in[i];
    a.out = (float*)d_out; a.ws = (unsigned char*)d_ws;
    unsigned char* ws = (unsigned char*)d_ws;
    (void)hipMemsetAsync(ws + WS_CTL, 0, 1 * MiB, stream);
#if MK_ONE_LAUNCH
    a.ph_lo = 0; a.ph_hi = N_PHASES;
    { void* kargs[] = {&a}; hipError_t e = hipLaunchCooperativeKernel((const void*)mk_fwd, dim3(grid), dim3(NWAVES * 64), kargs, LDS_BYTES, stream);
      if (e != hipSuccess) fprintf(stderr, "kernel_launch: cooperative launch failed: %s (grid %d)\n", hipGetErrorString(e), grid); }
#else
    for (int p = 0; p < N_PHASES; ++p) {
        if (!(MK_PHASE_MASK & (1 << p))) { launch_naive_phase(p, d_in, (float*)d_out, ws, stream); continue; }
        a.ph_lo = p; a.ph_hi = p + 1;
        hipLaunchKernelGGL(mk_fwd, dim3(grid), dim3(NWAVES * 64), LDS_BYTES, stream, a);
    }
#endif
}
```

```cpp
#include <hip/hip_runtime.h>
#include <cstdio>
#include <cstdint>

typedef unsigned short bf16_t;
constexpr int D = 1024, SEQ = 4096, NSEQ = 12, M = NSEQ * SEQ, MP = 4 * SEQ;
constexpr int INW = 1792, DFF = 2816, NGU = 2 * DFF;
constexpr float EPS = 1e-6f, LOG2E = 1.4426950408889634f, QSCALE = 0.125f * LOG2E;

constexpr size_t MiB = 1u << 20;
constexpr size_t WS_CTL = 0;
constexpr size_t WS_WIN = 1 * MiB;
constexpr size_t WS_WO = 5 * MiB;
constexpr size_t WS_WGU = 7 * MiB;
constexpr size_t WS_WDN = 18 * MiB;
constexpr size_t WS_WS = 24 * MiB;
constexpr size_t WS_VSSQ = 25 * MiB;
constexpr size_t WS_SSQ2 = 27 * MiB;
constexpr size_t WS_XN = 32 * MiB;
constexpr size_t WS_PROJ = 128 * MiB;
constexpr size_t WS_H = 32 * MiB;
constexpr size_t WS_MIX = 296 * MiB;
constexpr size_t WS_X1B = 392 * MiB;
constexpr size_t WS_END = 488 * MiB;

__device__ __forceinline__ unsigned f2bf(float f) { unsigned u = __builtin_bit_cast(unsigned, f); return (u + 0x7fffu + ((u >> 16) & 1u)) >> 16; }
__device__ __forceinline__ float bf2f(bf16_t b) { return __builtin_bit_cast(float, (unsigned)b << 16); }
__device__ __forceinline__ float gelu_tanh(float x) { const float u = x * (-2.302208198f - 0.1029432397f * x * x); return x * __builtin_amdgcn_rcpf(1.0f + __builtin_amdgcn_exp2f(u)); }
__device__ __forceinline__ float silu(float x) { return x * __builtin_amdgcn_rcpf(1.0f + __builtin_amdgcn_exp2f(-LOG2E * x)); }
__device__ __forceinline__ int t5_bucket(int rel) { const int n = rel < 0 ? -rel : rel; int b = n < 8 ? n : (2 + (31 - __builtin_clz(n * n))); b = b > 15 ? 15 : b; return b + (rel > 0 ? 16 : 0); }

__device__ __forceinline__ void prep_w_elem(size_t i, const float* w_in, const float* w_o, const float* w_gate, const float* w_up, const float* w_down, const float* w_s, const float* norm2, unsigned char* ws) {
    const size_t N0 = (size_t)INW * D, N1 = (size_t)D * D, N2 = (size_t)NGU * D, N3 = (size_t)D * DFF, N4 = 8 * 128 * 128;
    if (i < N0) { const int n = i / D, k = i % D; ((bf16_t*)(ws + WS_WIN))[i] = f2bf(w_in[(size_t)k * INW + n]); return; } i -= N0;
    if (i < N1) { const int n = i / D, k = i % D; ((bf16_t*)(ws + WS_WO))[i] = f2bf(w_o[(size_t)k * D + n]); return; } i -= N1;
    if (i < N2) { const int r = i / D, k = i % D; const int pn = r >> 8, bj = (r >> 7) & 1, c = r & 127, col = 128 * pn + c;
        ((bf16_t*)(ws + WS_WGU))[i] = f2bf(norm2[k] * (bj ? w_up : w_gate)[(size_t)k * DFF + col]); return; } i -= N2;
    if (i < N3) { const int n = i / DFF, k = i % DFF; ((bf16_t*)(ws + WS_WDN))[i] = f2bf(w_down[(size_t)k * D + n]); return; } i -= N3;
    if (i < N4) { ((bf16_t*)(ws + WS_WS))[i] = f2bf(w_s[i]); }
}
constexpr size_t NPREP = (size_t)INW * D + (size_t)D * D + (size_t)NGU * D + (size_t)D * DFF + 8 * 128 * 128;
__global__ void __launch_bounds__(256) k_prep_w(const float* w_in, const float* w_o, const float* w_gate, const float* w_up, const float* w_down, const float* w_s, const float* norm2, unsigned char* ws) {
    prep_w_elem((size_t)blockIdx.x * 256 + threadIdx.x, w_in, w_o, w_gate, w_up, w_down, w_s, norm2, ws);
}
__device__ __forceinline__ void xn_row(int m, int lane, const float* xp, const float* xs, const float* norm1, bf16_t* XN) {
    const float* x = m < MP ? xp + (size_t)m * D : xs + (size_t)(m - MP) * D;
    float v[16]; float ss = 0.f;
#pragma unroll
    for (int j = 0; j < 16; ++j) { v[j] = x[lane + 64 * j]; ss += v[j] * v[j]; }
#pragma unroll
    for (int o = 1; o < 64; o <<= 1) ss += __shfl_xor(ss, o);
    const float r = rsqrtf(ss * (1.0f / D) + EPS);
#pragma unroll
    for (int j = 0; j < 16; ++j) XN[(size_t)m * D + lane + 64 * j] = f2bf(v[j] * r * norm1[lane + 64 * j]);
}
__global__ void __launch_bounds__(256) k_xn(const float* xp, const float* xs, const float* norm1, bf16_t* XN) { xn_row(blockIdx.x * 4 + (threadIdx.x >> 6), threadIdx.x & 63, xp, xs, norm1, XN); }

template <class Epi, bool DUAL>
__global__ void __launch_bounds__(256) k_gemm_naive(const bf16_t* A, const bf16_t* Bt, int K, Epi epi) {
    __shared__ float As[32][68], Bs[32][68], B2s[DUAL ? 32 : 1][68], Ct[64][65], C2t[DUAL ? 64 : 1][65];
    const int tid = threadIdx.x, ty = tid >> 4, tx = tid & 15, lr = tid >> 2, kc = (tid & 3) * 8;
    const int m0 = blockIdx.y * 64, n0 = blockIdx.x * 64;
    const bf16_t* ap = A + (size_t)(m0 + lr) * K + kc;
    const int br = epi.brow(n0 + lr);
    const bf16_t* bp = Bt + (size_t)br * K + kc;
    const bf16_t* bp2 = Bt + (size_t)(br + 128) * K + kc;
    float acc[4][4] = {}, acc2[4][4] = {};
    for (int k0 = 0; k0 < K; k0 += 32) {
        const uint4 av = *(const uint4*)(ap + k0), bv = *(const uint4*)(bp + k0);
        const unsigned aw[4] = {av.x, av.y, av.z, av.w}, bw[4] = {bv.x, bv.y, bv.z, bv.w};
#pragma unroll
        for (int j = 0; j < 4; ++j) { As[kc + 2 * j][lr] = __builtin_bit_cast(float, aw[j] << 16); As[kc + 2 * j + 1][lr] = __builtin_bit_cast(float, aw[j] & 0xffff0000u);
                                      Bs[kc + 2 * j][lr] = __builtin_bit_cast(float, bw[j] << 16); Bs[kc + 2 * j + 1][lr] = __builtin_bit_cast(float, bw[j] & 0xffff0000u); }
        if (DUAL) { const uint4 cv = *(const uint4*)(bp2 + k0); const unsigned cw[4] = {cv.x, cv.y, cv.z, cv.w};
#pragma unroll
            for (int j = 0; j < 4; ++j) { B2s[kc + 2 * j][lr] = __builtin_bit_cast(float, cw[j] << 16); B2s[kc + 2 * j + 1][lr] = __builtin_bit_cast(float, cw[j] & 0xffff0000u); } }
        __syncthreads();
#pragma unroll 8
        for (int k = 0; k < 32; ++k) {
            float a[4], b[4], b2[4];
#pragma unroll
            for (int i = 0; i < 4; ++i) { a[i] = As[k][4 * ty + i]; b[i] = Bs[k][4 * tx + i]; b2[i] = DUAL ? B2s[k][4 * tx + i] : 0.f; }
#pragma unroll
            for (int i = 0; i < 4; ++i)
#pragma unroll
                for (int j = 0; j < 4; ++j) { acc[i][j] += a[i] * b[j]; if (DUAL) acc2[i][j] += a[i] * b2[j]; }
        }
        __syncthreads();
    }
#pragma unroll
    for (int i = 0; i < 4; ++i)
#pragma unroll
        for (int j = 0; j < 4; ++j) { Ct[4 * ty + i][4 * tx + j] = acc[i][j]; if (DUAL) C2t[4 * ty + i][4 * tx + j] = acc2[i][j]; }
    __syncthreads();
    const int r = tid >> 2, part = tid & 3;
    epi(m0 + r, n0, part, &Ct[r][part * 16], DUAL ? &C2t[r][part * 16] : nullptr);
}
__device__ __forceinline__ float red4(float v) { v += __shfl_xor(v, 1); v += __shfl_xor(v, 2); return v; }
struct NEpiIn {
    bf16_t* PROJ; float* VSSQ; const float* qg; const float* kg;
    __device__ int brow(int n) const { return n; }
    __device__ void operator()(int row, int n0, int part, const float* c, const float*) const {
        const int ct = n0 >> 6; float v[16];
#pragma unroll
        for (int j = 0; j < 16; ++j) v[j] = c[j];
        if (ct < 10) { float ss = 0.f;
#pragma unroll
            for (int j = 0; j < 16; ++j) ss += v[j] * v[j];
            ss = red4(ss); const float r = rsqrtf(ss * (1.0f / 64.0f) + EPS); const float* g = ct < 8 ? qg : kg; const float sc = ct < 8 ? QSCALE : 1.0f;
#pragma unroll
            for (int j = 0; j < 16; ++j) v[j] = v[j] * r * g[part * 16 + j] * sc;
        } else if (ct >= 12) { float ss = 0.f;
#pragma unroll
            for (int j = 0; j < 16; ++j) { v[j] = gelu_tanh(v[j]); ss += v[j] * v[j]; }
            if (ct >= 20) { ss = red4(ss); if (part == 0) VSSQ[(size_t)row * 8 + (ct - 20)] = ss; }
        }
#pragma unroll
        for (int j = 0; j < 16; ++j) PROJ[(size_t)row * INW + n0 + part * 16 + j] = f2bf(v[j]);
    }
};
struct NEpiOut {
    const float* xp; const float* xs; float* out; bf16_t* X1B; float* SSQ2;
    __device__ int brow(int n) const { return n; }
    __device__ void operator()(int row, int n0, int part, const float* c, const float*) const {
        const float* x = row < MP ? xp + (size_t)row * D : xs + (size_t)(row - MP) * D; float ss = 0.f;
#pragma unroll
        for (int j = 0; j < 16; ++j) { const int col = n0 + part * 16 + j; const float v = x[col] + c[j]; out[(size_t)row * D + col] = v; X1B[(size_t)row * D + col] = f2bf(v); ss += v * v; }
        ss = red4(ss); if (part == 0) SSQ2[(size_t)row * 16 + (n0 >> 6)] = ss;
    }
};
struct NEpiUp {
    bf16_t* H; const float* SSQ2;
    __device__ int brow(int n) const { return 256 * (n >> 7) + (n & 127); }
    __device__ void operator()(int row, int n0, int part, const float* c, const float* c2) const {
        float ss = 0.f;
#pragma unroll
        for (int j = 0; j < 16; ++j) ss += SSQ2[(size_t)row * 16 + j];
        const float r = rsqrtf(ss * (1.0f / D) + EPS);
#pragma unroll
        for (int j = 0; j < 16; ++j) H[(size_t)row * DFF + n0 + part * 16 + j] = f2bf(silu(c[j] * r) * (c2[j] * r));
    }
};
struct NEpiDown {
    float* out;
    __device__ int brow(int n) const { return n; }
    __device__ void operator()(int row, int n0, int part, const float* c, const float*) const {
#pragma unroll
        for (int j = 0; j < 16; ++j) { const size_t o = (size_t)row * D + n0 + part * 16 + j; out[o] = out[o] + c[j]; }
    }
};

struct MixNaiveLds { float ps[4][320], qs[4][64], arow[512], grow[512], rv[128], red[4]; };
__device__ __forceinline__ void mix_naive_token(int m, int tid, MixNaiveLds& L, const bf16_t* PROJ, const float* VSSQ, const bf16_t* WSB, const float* rel_table, const float* sink, const float* v_gain,
                                                const float* b_s, const float* ag, const float* gg, bf16_t* MIX) {
    const int s = m / SEQ, t = m % SEQ, w = tid >> 6, lane = tid & 63;
    const bf16_t* prow = PROJ + (size_t)m * INW;
    const int jlo = t - 128 < 0 ? 0 : t - 128, jhi = t + 128 > SEQ - 1 ? SEQ - 1 : t + 128, nk = jhi - jlo + 1;
    for (int hh = 0; hh < 2; ++hh) {
        const int h = w * 2 + hh, g = h >> 2;
        L.qs[w][lane] = bf2f(prow[64 * h + lane]);
        __syncthreads();
        const float sink2 = sink[h] * LOG2E; float sc[5]; float mx = sink2;
#pragma unroll
        for (int i = 0; i < 5; ++i) { const int j = jlo + lane + 64 * i; sc[i] = -1e30f;
            if (j <= jhi) { const bf16_t* kr = PROJ + (size_t)(s * SEQ + j) * INW + 512 + 64 * g; float dot = 0.f;
                for (int d = 0; d < 64; ++d) dot += L.qs[w][d] * bf2f(kr[d]);
                dot += rel_table[t5_bucket(j - t) * 8 + h] * LOG2E; sc[i] = dot; mx = fmaxf(mx, dot); } }
#pragma unroll
        for (int o = 1; o < 64; o <<= 1) mx = fmaxf(mx, __shfl_xor(mx, o));
        float l = 0.f;
#pragma unroll
        for (int i = 0; i < 5; ++i) { const int j = jlo + lane + 64 * i; const float p = j <= jhi ? exp2f(sc[i] - mx) : 0.f; l += p; L.ps[w][lane + 64 * i] = p; }
#pragma unroll
        for (int o = 1; o < 64; o <<= 1) l += __shfl_xor(l, o);
        l += exp2f(sink2 - mx);
        __syncthreads();
        float o = 0.f;
        for (int jj = 0; jj < nk; ++jj) o += L.ps[w][jj] * bf2f(PROJ[(size_t)(s * SEQ + jlo + jj) * INW + 640 + 64 * g + lane]);
        L.arow[64 * h + lane] = o / l;
        __syncthreads();
    }
    const int mc = m - (t & 127), p = t & 127;
    if (tid < 128) { float ss = 0.f; for (int i = 0; i < 8; ++i) ss += VSSQ[(size_t)(mc + tid) * 8 + i]; L.rv[tid] = rsqrtf(ss * (1.0f / 512.0f) + EPS); }
    __syncthreads();
    for (int c = tid; c < 512; c += 256) { const int h = c >> 6; float a = 0.f; const float vg = v_gain[c];
        for (int q = 0; q < 128; ++q) a += bf2f(WSB[(h * 128 + p) * 128 + q]) * (bf2f(PROJ[(size_t)(mc + q) * INW + 1280 + c]) * L.rv[q] * vg);
        L.grow[c] = bf2f(prow[768 + c]) * (a + b_s[h * 128 + p]); }
    __syncthreads();
    float sa = L.arow[tid] * L.arow[tid] + L.arow[tid + 256] * L.arow[tid + 256], sg = L.grow[tid] * L.grow[tid] + L.grow[tid + 256] * L.grow[tid + 256];
#pragma unroll
    for (int o = 1; o < 64; o <<= 1) { sa += __shfl_xor(sa, o); sg += __shfl_xor(sg, o); }
    if (lane == 0) { L.red[w] = sa; } __syncthreads(); sa = L.red[0] + L.red[1] + L.red[2] + L.red[3]; __syncthreads();
    if (lane == 0) { L.red[w] = sg; } __syncthreads(); sg = L.red[0] + L.red[1] + L.red[2] + L.red[3];
    const float ra = rsqrtf(sa * (1.0f / 512.0f) + EPS), rg = rsqrtf(sg * (1.0f / 512.0f) + EPS);
    for (int c = tid; c < 512; c += 256) { MIX[(size_t)m * D + c] = f2bf(L.arow[c] * ra * ag[c]); MIX[(size_t)m * D + 512 + c] = f2bf(L.grow[c] * rg * gg[c]); }
    __syncthreads();
}
__global__ void __launch_bounds__(256) k_mix_naive(const bf16_t* PROJ, const float* VSSQ, const bf16_t* WSB, const float* rel_table, const float* sink, const float* v_gain,
                                                  const float* b_s, const float* ag, const float* gg, bf16_t* MIX) {
    __shared__ MixNaiveLds L;
    mix_naive_token(blockIdx.x, threadIdx.x, L, PROJ, VSSQ, WSB, rel_table, sink, v_gain, b_s, ag, gg, MIX);
}

#define MK_ONE_LAUNCH 1
#define MK_PHASE_MASK 0x3F
#define MK_MIXER_NAIVE 0
#define MK_PROLOGUE_NAIVE 0
#define MK_REPEAT_MASK 0
#define MK_EXTRA_PHASE -1

namespace pg8 {
#define PG8_LAS __attribute__((address_space(3)))
typedef short bf16x8 __attribute__((ext_vector_type(8)));
typedef float f32x4 __attribute__((ext_vector_type(4)));
typedef unsigned u32x4 __attribute__((ext_vector_type(4)));
typedef unsigned u32x2 __attribute__((ext_vector_type(2)));
constexpr int BM = 256, BK = 64, HALF = 128, HTB = HALF * BK * 2  , STAGE_BYTES = 8 * HTB, NXCD = 8, WGM = 8;

__host__ __device__ __forceinline__ int lds_byte(int r, int c) { const int st = (r >> 4) * 2 + (c >> 5), rr = r & 15, cc = c & 31, ob = rr * 64 + cc * 2; return st * 1024 + (ob ^ (((ob >> 9) & 1) << 5)); }
__host__ __device__ __forceinline__ void stage_rc(int b, int& R, int& C) { const int st = b / 1024, sb = b % 1024, swz = sb ^ (((sb >> 9) & 1) << 5); R = (st >> 1) * 16 + swz / 64; C = (st & 1) * 32 + (swz % 64) / 2; }
__host__ __device__ __forceinline__ int perm32(int rho) { const int n = rho >> 4, i = rho & 15; return 8 * (i >> 2) + 4 * n + (i & 3); }

struct Unit { int pm, pn; };
struct Gemm { const bf16_t* A; const bf16_t* Bt; int M, N, K; };

struct StaticOrder {
    int nM, nN, nwg, G, c;
    __host__ __device__ void init(int M_, int N_, int G_, int c_) { nM = M_ / BM; nN = N_ / BM; nwg = nM * nN; G = G_; c = c_; }
    __host__ __device__ bool next(int i, Unit& u) const {
        const long L = (long)i * G + c; if (L >= nwg) return false;
        int wgid = (int)L; { const int q = nwg / NXCD, r = nwg % NXCD, xcd = wgid % NXCD, off = wgid / NXCD; wgid = (xcd < r ? xcd * (q + 1) : r * (q + 1) + (xcd - r) * q) + off; }
        const int nig = WGM * nN, gid = wgid / nig, fm = gid * WGM, gsz = (nM - fm) < WGM ? (nM - fm) : WGM;
        u.pm = fm + ((wgid % nig) % gsz); u.pn = (wgid % nig) / gsz; return true;
    }
};

__device__ __forceinline__ unsigned cvt_pk_bf16(float lo, float hi) { unsigned r; asm volatile("v_cvt_pk_bf16_f32 %0, %1, %2" : "=v"(r) : "v"(lo), "v"(hi)); return r; }
__device__ __forceinline__ float rsum_fq(float s) { s += __shfl_xor(s, 16); s += __shfl_xor(s, 32); return s; }

struct EpiIn {
    static constexpr int BMAP = 2;
    bf16_t* PROJ; float* VSSQ; const float* qg; const float* kg;
    __device__ __forceinline__ void operator()(const f32x4 (&acc)[2][2][4][2], const Unit& u, int wr, int wc, int fr, int fq) const {
        const int ct = 4 * u.pn + wc;
        const int row0 = u.pm * BM + wr * 64 + fr, col0 = u.pn * BM + wc * 64 + 8 * fq;
        if (ct < 10) {
            const float* g = (ct < 8 ? qg : kg) + 8 * fq; const float sc = ct < 8 ? QSCALE : 1.0f;
            f32x4 gv[2][2];
#pragma unroll
            for (int bj = 0; bj < 2; ++bj)
#pragma unroll
                for (int n = 0; n < 2; ++n) gv[bj][n] = *(const f32x4*)(g + 32 * bj + 4 * n) * sc;
#pragma unroll
            for (int ai = 0; ai < 2; ++ai)
#pragma unroll
                for (int m = 0; m < 4; ++m) {
                    float ss = 0.f;
#pragma unroll
                    for (int bj = 0; bj < 2; ++bj)
#pragma unroll
                        for (int n = 0; n < 2; ++n) { const f32x4 x = acc[ai][bj][m][n]; ss += (x[0] * x[0] + x[1] * x[1]) + (x[2] * x[2] + x[3] * x[3]); }
                    ss = rsum_fq(ss); const float r = rsqrtf(ss * (1.0f / 64.0f) + EPS);
                    bf16_t* rowp = PROJ + (size_t)(row0 + ai * HALF + m * 16) * INW + col0;
#pragma unroll
                    for (int bj = 0; bj < 2; ++bj) { const f32x4 v0 = acc[ai][bj][m][0] * r * gv[bj][0], v1 = acc[ai][bj][m][1] * r * gv[bj][1];
                        u32x4 w; w.x = cvt_pk_bf16(v0[0], v0[1]); w.y = cvt_pk_bf16(v0[2], v0[3]); w.z = cvt_pk_bf16(v1[0], v1[1]); w.w = cvt_pk_bf16(v1[2], v1[3]);
                        *(u32x4*)(rowp + 32 * bj) = w; }
                }
        } else if (ct < 12) {
#pragma unroll
            for (int ai = 0; ai < 2; ++ai)
#pragma unroll
                for (int m = 0; m < 4; ++m) { bf16_t* rowp = PROJ + (size_t)(row0 + ai * HALF + m * 16) * INW + col0;
#pragma unroll
                    for (int bj = 0; bj < 2; ++bj) { const f32x4 v0 = acc[ai][bj][m][0], v1 = acc[ai][bj][m][1];
                        u32x4 w; w.x = cvt_pk_bf16(v0[0], v0[1]); w.y = cvt_pk_bf16(v0[2], v0[3]); w.z = cvt_pk_bf16(v1[0], v1[1]); w.w = cvt_pk_bf16(v1[2], v1[3]);
                        *(u32x4*)(rowp + 32 * bj) = w; } }
        } else {
#pragma unroll
            for (int ai = 0; ai < 2; ++ai)
#pragma unroll
                for (int m = 0; m < 4; ++m) { const int row = row0 + ai * HALF + m * 16; bf16_t* rowp = PROJ + (size_t)row * INW + col0; float ss = 0.f;
#pragma unroll
                    for (int bj = 0; bj < 2; ++bj) { f32x4 v0 = acc[ai][bj][m][0], v1 = acc[ai][bj][m][1];
#pragma unroll
                        for (int e = 0; e < 4; ++e) { v0[e] = gelu_tanh(v0[e]); v1[e] = gelu_tanh(v1[e]); ss += v0[e] * v0[e] + v1[e] * v1[e]; }
                        u32x4 w; w.x = cvt_pk_bf16(v0[0], v0[1]); w.y = cvt_pk_bf16(v0[2], v0[3]); w.z = cvt_pk_bf16(v1[0], v1[1]); w.w = cvt_pk_bf16(v1[2], v1[3]);
                        *(u32x4*)(rowp + 32 * bj) = w; }
                    if (ct >= 20) { ss = rsum_fq(ss); if (fq == 0) VSSQ[(size_t)row * 8 + (ct - 20)] = ss; }
                }
        }
    }
};
struct EpiOut {
    static constexpr int BMAP = 0;
    const float* xp; const float* xs; bf16_t* X1B; float* SSQ2;
    __device__ __forceinline__ void operator()(const f32x4 (&acc)[2][2][4][2], const Unit& u, int wr, int wc, int fr, int fq) const {
        const int row0 = u.pm * BM + wr * 64 + fr, col0 = u.pn * BM + wc * 32 + 4 * fq;
        const float* xb = u.pm * BM < MP ? xp : xs - (size_t)MP * D;
#pragma unroll
        for (int ai = 0; ai < 2; ++ai) {
            f32x4 xv[4][2][2];
#pragma unroll
            for (int m = 0; m < 4; ++m)
#pragma unroll
                for (int bj = 0; bj < 2; ++bj)
#pragma unroll
                    for (int n = 0; n < 2; ++n) xv[m][bj][n] = *(const f32x4*)(xb + (size_t)(row0 + ai * HALF + m * 16) * D + col0 + bj * HALF + n * 16);
#pragma unroll
            for (int m = 0; m < 4; ++m) { const int row = row0 + ai * HALF + m * 16; const size_t off = (size_t)row * D + col0; float ss = 0.f;
#pragma unroll
                for (int bj = 0; bj < 2; ++bj)
#pragma unroll
                    for (int n = 0; n < 2; ++n) { const f32x4 v = xv[m][bj][n] + acc[ai][bj][m][n];
                        u32x2 w; w.x = cvt_pk_bf16(v[0], v[1]); w.y = cvt_pk_bf16(v[2], v[3]); *(u32x2*)(X1B + off + bj * HALF + n * 16) = w;
                        ss += (v[0] * v[0] + v[1] * v[1]) + (v[2] * v[2] + v[3] * v[3]); }
                ss = rsum_fq(ss); if (fq == 0) SSQ2[(size_t)row * 16 + 4 * u.pn + wc] = ss; }
        }
    }
};
struct EpiUp {
    static constexpr int BMAP = 1;
    bf16_t* H; const float* SSQ2;
    __device__ __forceinline__ void operator()(const f32x4 (&acc)[2][2][4][2], const Unit& u, int wr, int wc, int fr, int fq) const {
        const int row0 = u.pm * BM + wr * 64 + fr, col0 = u.pn * HALF + wc * 32 + 8 * fq;
        f32x4 pl[2][4]; float rs[2][4];
#pragma unroll
        for (int ai = 0; ai < 2; ++ai)
#pragma unroll
            for (int m = 0; m < 4; ++m) pl[ai][m] = *(const f32x4*)(SSQ2 + (size_t)(row0 + ai * HALF + m * 16) * 16 + 4 * fq);
#pragma unroll
        for (int ai = 0; ai < 2; ++ai)
#pragma unroll
            for (int m = 0; m < 4; ++m) { const float s = rsum_fq((pl[ai][m][0] + pl[ai][m][1]) + (pl[ai][m][2] + pl[ai][m][3])); rs[ai][m] = rsqrtf(s * (1.0f / D) + EPS); }
#pragma unroll
        for (int ai = 0; ai < 2; ++ai)
#pragma unroll
            for (int m = 0; m < 4; ++m) { const int row = row0 + ai * HALF + m * 16; const float r = rs[ai][m];
                f32x4 h0, h1;
#pragma unroll
                for (int e = 0; e < 4; ++e) { h0[e] = silu(acc[ai][0][m][0][e] * r) * (acc[ai][1][m][0][e] * r); h1[e] = silu(acc[ai][0][m][1][e] * r) * (acc[ai][1][m][1][e] * r); }
                u32x4 w; w.x = cvt_pk_bf16(h0[0], h0[1]); w.y = cvt_pk_bf16(h0[2], h0[3]); w.z = cvt_pk_bf16(h1[0], h1[1]); w.w = cvt_pk_bf16(h1[2], h1[3]);
                *(u32x4*)(H + (size_t)row * DFF + col0) = w; }
    }
};
struct EpiDown {
    static constexpr int BMAP = 0;
    const bf16_t* X1B; float* out;
    __device__ __forceinline__ void operator()(const f32x4 (&acc)[2][2][4][2], const Unit& u, int wr, int wc, int fr, int fq) const {
        const int row0 = u.pm * BM + wr * 64 + fr, col0 = u.pn * BM + wc * 32 + 4 * fq;
        u32x2 xv[2][4][2][2];
#pragma unroll
        for (int ai = 0; ai < 2; ++ai)
#pragma unroll
            for (int m = 0; m < 4; ++m)
#pragma unroll
                for (int bj = 0; bj < 2; ++bj)
#pragma unroll
                    for (int n = 0; n < 2; ++n) xv[ai][m][bj][n] = *(const u32x2*)(X1B + (size_t)(row0 + ai * HALF + m * 16) * D + col0 + bj * HALF + n * 16);
#pragma unroll
        for (int ai = 0; ai < 2; ++ai)
#pragma unroll
            for (int m = 0; m < 4; ++m) { float* rowp = out + (size_t)(row0 + ai * HALF + m * 16) * D + col0;
#pragma unroll
                for (int bj = 0; bj < 2; ++bj)
#pragma unroll
                    for (int n = 0; n < 2; ++n) { const u32x2 x = xv[ai][m][bj][n];
                        const f32x4 r = {__uint_as_float(x.x << 16), __uint_as_float(x.x & 0xffff0000u), __uint_as_float(x.y << 16), __uint_as_float(x.y & 0xffff0000u)};
                        *(f32x4*)(rowp + bj * HALF + n * 16) = r + acc[ai][bj][m][n]; } }
    }
};
struct EpiNone {
    static constexpr int BMAP = 1;
    __device__ __forceinline__ void operator()(const f32x4 (&acc)[2][2][4][2], const Unit& u, int wr, int wc, int fr, int fq) const {
#pragma unroll
        for (int ai = 0; ai < 2; ++ai)
#pragma unroll
            for (int bj = 0; bj < 2; ++bj)
#pragma unroll
                for (int m = 0; m < 4; ++m)
#pragma unroll
                    for (int n = 0; n < 2; ++n) asm volatile("" :: "v"(acc[ai][bj][m][n]));
    }
};

template <class Epi, class Sched, bool ALIGN_EPI>
__device__ __forceinline__ void gemm_phase(PG8_LAS unsigned char* lds, const Gemm g, const Sched& S, const Epi& E) {
    const int tid = threadIdx.x, wid = __builtin_amdgcn_readfirstlane(tid >> 6), lane = tid & 63, wr = wid >> 2, wc = wid & 3, fr = lane & 15, fq = lane >> 4;
    const int K = g.K, nt = K / BK;
    unsigned voffA[2], voffB[2];
#pragma unroll
    for (int i = 0; i < 2; ++i) { int R, C; stage_rc(tid * 16 + i * 8192, R, C);
        const int Rb = Epi::BMAP == 0 ? R : Epi::BMAP == 1 ? ((R & ~31) + perm32(R & 31)) : (64 * (R >> 5) + perm32(R & 31));
        voffA[i] = (unsigned)(R * K + C) * 2u; voffB[i] = (unsigned)(Rb * K + C) * 2u; }
    const size_t kstep = (size_t)(BK * 2);
    const size_t hstep = (size_t)HALF * K * 2;
    const size_t hstepB = Epi::BMAP == 2 ? (size_t)32 * K * 2 : hstep;
    const size_t tstep = 2 * hstep;
    const unsigned ldsw = (unsigned)wid * 1024u;
    const int aoff = lds_byte(wr * 64 + fr, fq * 8), boff = lds_byte(wc * 32 + fr, fq * 8);
#define PG8_SA(b, h) (((b) * 2 + (h)) * HTB)
#define PG8_SB(b, h) ((4 + (b) * 2 + (h)) * HTB)
#define PG8_STAGE(bufoff, gbase, voff) do { _Pragma("unroll") for (int _i = 0; _i < 2; ++_i) \
        __builtin_amdgcn_global_load_lds((const unsigned*)((const char*)(gbase) + (voff)[_i]), (PG8_LAS unsigned*)(lds + (bufoff) + ldsw + _i * 8192), 16, 0, 0); } while (0)
#define PG8_LDA(dst, b, h) do { _Pragma("unroll") for (int m = 0; m < 4; ++m) _Pragma("unroll") for (int k = 0; k < 2; ++k) dst[m][k] = *(const PG8_LAS bf16x8*)(lds + PG8_SA(b, h) + aoff + m * 2048 + k * 1024); } while (0)
#define PG8_LDB(dst, b, h) do { _Pragma("unroll") for (int n = 0; n < 2; ++n) _Pragma("unroll") for (int k = 0; k < 2; ++k) dst[n][k] = *(const PG8_LAS bf16x8*)(lds + PG8_SB(b, h) + boff + n * 2048 + k * 1024); } while (0)
#define PG8_MMA(ai, bj, At, Bt) do { __builtin_amdgcn_s_setprio(1); _Pragma("unroll") for (int m = 0; m < 4; ++m) _Pragma("unroll") for (int n = 0; n < 2; ++n) _Pragma("unroll") for (int k = 0; k < 2; ++k) \
        acc[ai][bj][m][n] = __builtin_amdgcn_mfma_f32_16x16x32_bf16(Bt[n][k], At[m][k], acc[ai][bj][m][n], 0, 0, 0); __builtin_amdgcn_s_setprio(0); } while (0)
#define PG8_WAIT_V(n) asm volatile("s_waitcnt vmcnt(" #n ")" ::: "memory")
#define PG8_WAIT_L(n) asm volatile("s_waitcnt lgkmcnt(" #n ")" ::: "memory")
#define PG8_BAR __builtin_amdgcn_s_barrier()
#define PG8_SCHED __builtin_amdgcn_sched_barrier(0)
    Unit cur, nxt; int ui = 0;
    if (!S.next(0, cur)) return;
    f32x4 acc[2][2][4][2];
#pragma unroll
    for (int a = 0; a < 2; ++a)
#pragma unroll
        for (int b = 0; b < 2; ++b)
#pragma unroll
            for (int m = 0; m < 4; ++m)
#pragma unroll
                for (int n = 0; n < 2; ++n) acc[a][b][m][n] = (f32x4){0.f, 0.f, 0.f, 0.f};
    bf16x8 At[4][2], B0[2][2], B1[2][2];
    const char* cA = (const char*)g.A + (size_t)cur.pm * tstep; const char* cB = (const char*)g.Bt + (size_t)cur.pn * tstep;
    PG8_STAGE(PG8_SB(0, 0), cB, voffB); PG8_STAGE(PG8_SB(0, 1), cB + hstepB, voffB); PG8_STAGE(PG8_SA(0, 0), cA, voffA); PG8_STAGE(PG8_SA(0, 1), cA + hstep, voffA);
    if (wr == 1) PG8_BAR;
    PG8_WAIT_V(2); PG8_BAR;
    PG8_STAGE(PG8_SB(1, 0), cB + kstep, voffB); PG8_STAGE(PG8_SA(1, 0), cA + kstep, voffA); PG8_STAGE(PG8_SB(1, 1), cB + hstepB + kstep, voffB);
    PG8_WAIT_V(6); PG8_BAR;
    for (;;) {
        const bool has_next = S.next(ui + 1, nxt);
        const char* nA = has_next ? (const char*)g.A + (size_t)nxt.pm * tstep : cA; const char* nB = has_next ? (const char*)g.Bt + (size_t)nxt.pn * tstep : cB;
        for (int t = 0; t < nt; t += 2) {
            const bool last = (t == nt - 2);
            const char* a1 = cA + (size_t)(t + 1) * kstep;
            const char* a2 = last ? nA : cA + (size_t)(t + 2) * kstep; const char* b2 = last ? nB : cB + (size_t)(t + 2) * kstep;
            const char* a3 = a2 + kstep; const char* b3 = b2 + kstep;
            PG8_LDB(B0, 0, 0); PG8_LDB(B1, 0, 1); PG8_SCHED; PG8_LDA(At, 0, 0); PG8_STAGE(PG8_SA(1, 1), a1 + hstep, voffA);
            PG8_WAIT_V(8); PG8_WAIT_L(0); PG8_BAR; PG8_MMA(0, 0, At, B0); PG8_MMA(0, 1, At, B1); PG8_BAR; PG8_SCHED;
            PG8_LDA(At, 0, 1); PG8_STAGE(PG8_SB(0, 0), b2, voffB); PG8_STAGE(PG8_SB(0, 1), b2 + hstepB, voffB); PG8_STAGE(PG8_SA(0, 0), a2, voffA);
            PG8_WAIT_V(8); PG8_WAIT_L(0); PG8_BAR; PG8_MMA(1, 0, At, B0); PG8_MMA(1, 1, At, B1); PG8_BAR; PG8_SCHED;
            PG8_LDB(B0, 1, 0); PG8_LDB(B1, 1, 1); PG8_SCHED; PG8_LDA(At, 1, 0); PG8_STAGE(PG8_SA(0, 1), a2 + hstep, voffA);
            PG8_WAIT_V(8); PG8_WAIT_L(0); PG8_BAR; PG8_MMA(0, 0, At, B0); PG8_MMA(0, 1, At, B1); PG8_BAR; PG8_SCHED;
            PG8_LDA(At, 1, 1); PG8_STAGE(PG8_SB(1, 0), b3, voffB); PG8_STAGE(PG8_SB(1, 1), b3 + hstepB, voffB); PG8_STAGE(PG8_SA(1, 0), a3, voffA);
            PG8_WAIT_V(8); PG8_WAIT_L(0); PG8_BAR; PG8_MMA(1, 0, At, B0); PG8_MMA(1, 1, At, B1); PG8_BAR; PG8_SCHED;
        }
        if constexpr (ALIGN_EPI) { if (wr == 0) PG8_BAR; }
        E(acc, cur, wr, wc, fr, fq);
        if (!has_next) break;
#pragma unroll
        for (int a = 0; a < 2; ++a)
#pragma unroll
            for (int b = 0; b < 2; ++b)
#pragma unroll
                for (int m = 0; m < 4; ++m)
#pragma unroll
                    for (int n = 0; n < 2; ++n) acc[a][b][m][n] = (f32x4){0.f, 0.f, 0.f, 0.f};
        cur = nxt; cA = nA; cB = nB; ++ui;
        if constexpr (ALIGN_EPI) { if (wr == 1) PG8_BAR; }
    }
    PG8_WAIT_V(0);
    if constexpr (!ALIGN_EPI) { if (wr == 0) PG8_BAR; }
    PG8_BAR;
#undef PG8_SA
#undef PG8_SB
#undef PG8_STAGE
#undef PG8_LDA
#undef PG8_LDB
#undef PG8_MMA
#undef PG8_WAIT_V
#undef PG8_WAIT_L
#undef PG8_BAR
#undef PG8_SCHED
}
}
#define LAS __attribute__((address_space(3)))

struct Args;
__device__ __forceinline__ void p0_prologue_naive(const float* const* in, unsigned char* ws, int G) {
    const size_t gt = (size_t)blockIdx.x * 512 + threadIdx.x, GT = (size_t)G * 512;
    for (size_t i = gt; i < NPREP; i += GT) prep_w_elem(i, in[4], in[13], in[15], in[16], in[17], in[9], in[14], ws);
    const int wave = threadIdx.x >> 6, lane = threadIdx.x & 63;
    for (int m = blockIdx.x * 8 + wave; m < M; m += G * 8) xn_row(m, lane, in[0], in[1], in[3], (bf16_t*)(ws + WS_XN));
}


__device__ __forceinline__ unsigned pk2(float lo, float hi) { return f2bf(lo) | (f2bf(hi) << 16); }
__device__ __forceinline__ void p0_item(const float* W, int K, int N, bf16_t* WT, int orow0, const float* kscale, LAS float* scr, int k0, int n0, int lane) {
    typedef unsigned v4u __attribute__((ext_vector_type(4)));
#pragma unroll 8
    for (int i = 0; i < 32; ++i) { const int kk = 2 * i + (lane >> 5); float v = W[(size_t)(k0 + kk) * N + n0 + (lane & 31)]; if (kscale) v *= kscale[k0 + kk]; scr[kk * 33 + (lane & 31)] = v; }
    asm volatile("s_waitcnt lgkmcnt(0)" ::: "memory");
    const int c = lane & 7;
#pragma unroll
    for (int j = 0; j < 4; ++j) { const int n = (lane >> 3) + 8 * j; const LAS float* s = scr + (8 * c) * 33 + n;
        v4u o; o.x = pk2(s[0 * 33], s[1 * 33]); o.y = pk2(s[2 * 33], s[3 * 33]); o.z = pk2(s[4 * 33], s[5 * 33]); o.w = pk2(s[6 * 33], s[7 * 33]);
        *(v4u*)(WT + (size_t)(orow0 + n) * K + k0 + 8 * c) = o; }
    asm volatile("s_waitcnt lgkmcnt(0)" ::: "memory");
}
__device__ __forceinline__ void p0_prologue(const float* const* in, unsigned char* ws, LAS unsigned char* lds, int G) {
    const int wave = __builtin_amdgcn_readfirstlane(threadIdx.x >> 6), lane = threadIdx.x & 63;
    LAS float* scr = (LAS float*)(lds + wave * 16384);
    const int gw = (int)blockIdx.x * 8 + wave, NGW = G * 8;
    constexpr int I_IN = (D / 64) * (INW / 32), I_O = (D / 64) * (D / 32), I_G = (D / 64) * (DFF / 32), I_D = (DFF / 64) * (D / 32), NITEMS = I_IN + I_O + 2 * I_G + I_D;
    bf16_t* WIN = (bf16_t*)(ws + WS_WIN); bf16_t* WO = (bf16_t*)(ws + WS_WO); bf16_t* WGU = (bf16_t*)(ws + WS_WGU); bf16_t* WDN = (bf16_t*)(ws + WS_WDN);
    for (int it = gw; it < NITEMS; it += NGW) {
        int r = it;
        if (r < I_IN) { const int nb = r % (INW / 32), kb = r / (INW / 32); p0_item(in[4], D, INW, WIN, 32 * nb, nullptr, scr, 64 * kb, 32 * nb, lane); continue; } r -= I_IN;
        if (r < I_O) { const int nb = r % (D / 32), kb = r / (D / 32); p0_item(in[13], D, D, WO, 32 * nb, nullptr, scr, 64 * kb, 32 * nb, lane); continue; } r -= I_O;
        if (r < 2 * I_G) { const int up = r >= I_G; if (up) r -= I_G; const int nb = r % (DFF / 32), kb = r / (DFF / 32), n0 = 32 * nb;
            p0_item(in[up ? 16 : 15], D, DFF, WGU, 256 * (n0 >> 7) + (n0 & 127) + 128 * up, in[14], scr, 64 * kb, n0, lane); continue; } r -= 2 * I_G;
        { const int nb = r % (D / 32), kb = r / (D / 32); p0_item(in[17], DFF, D, WDN, 32 * nb, nullptr, scr, 64 * kb, 32 * nb, lane); }
    }
    { const size_t gt = (size_t)blockIdx.x * 512 + threadIdx.x; bf16_t* WSB = (bf16_t*)(ws + WS_WS); for (size_t i = gt; i < 8 * 128 * 128; i += (size_t)G * 512) WSB[i] = f2bf(in[9][i]); }
    typedef float f32x4 __attribute__((ext_vector_type(4)));
    bf16_t* XN = (bf16_t*)(ws + WS_XN);
    for (int m = gw; m < M; m += NGW) {
        const f32x4* xr = (const f32x4*)(m < MP ? in[0] + (size_t)m * D : in[1] + (size_t)(m - MP) * D) + lane; const f32x4* gr = (const f32x4*)in[3] + lane;
        f32x4 v[4]; float ss = 0.f;
#pragma unroll
        for (int j = 0; j < 4; ++j) { v[j] = xr[64 * j]; ss += (v[j][0] * v[j][0] + v[j][1] * v[j][1]) + (v[j][2] * v[j][2] + v[j][3] * v[j][3]); }
#pragma unroll
        for (int o = 1; o < 64; o <<= 1) ss += __shfl_xor(ss, o);
        const float rs = rsqrtf(ss * (1.0f / D) + EPS);
        unsigned long long* o8 = (unsigned long long*)(XN + (size_t)m * D) + lane;
#pragma unroll
        for (int j = 0; j < 4; ++j) { const f32x4 gn = gr[64 * j]; o8[64 * j] = (unsigned long long)pk2(v[j][0] * rs * gn[0], v[j][1] * rs * gn[1]) | ((unsigned long long)pk2(v[j][2] * rs * gn[2], v[j][3] * rs * gn[3]) << 32); }
    }
}

__device__ __forceinline__ void p2_mixer_naive(const float* const* in, unsigned char* ws, unsigned char* lds_generic, int G) {
    MixNaiveLds* L = (MixNaiveLds*)lds_generic + (threadIdx.x >> 8);
    for (int pr = blockIdx.x; pr < M / 2; pr += G)
        mix_naive_token(2 * pr + (threadIdx.x >> 8), threadIdx.x & 255, *L, (const bf16_t*)(ws + WS_PROJ), (const float*)(ws + WS_VSSQ), (const bf16_t*)(ws + WS_WS), in[2], in[7], in[8], in[10], in[11], in[12], (bf16_t*)(ws + WS_MIX));
}

static void launch_naive_phase(int p, void* const* d_in, float* out, unsigned char* ws, hipStream_t stream) {
    const float* xp = (const float*)d_in[0]; const float* xs = (const float*)d_in[1]; const float* rel = (const float*)d_in[2]; const float* norm1 = (const float*)d_in[3];
    const float* w_in = (const float*)d_in[4]; const float* qg = (const float*)d_in[5]; const float* kg = (const float*)d_in[6]; const float* sink = (const float*)d_in[7];
    const float* vg = (const float*)d_in[8]; const float* w_s = (const float*)d_in[9]; const float* b_s = (const float*)d_in[10]; const float* ag = (const float*)d_in[11];
    const float* gg = (const float*)d_in[12]; const float* w_o = (const float*)d_in[13]; const float* norm2 = (const float*)d_in[14]; const float* w_gate = (const float*)d_in[15];
    const float* w_up = (const float*)d_in[16]; const float* w_down = (const float*)d_in[17];
    bf16_t* WIN = (bf16_t*)(ws + WS_WIN); bf16_t* WO = (bf16_t*)(ws + WS_WO); bf16_t* WGU = (bf16_t*)(ws + WS_WGU); bf16_t* WDN = (bf16_t*)(ws + WS_WDN); bf16_t* WSB = (bf16_t*)(ws + WS_WS);
    float* VSSQ = (float*)(ws + WS_VSSQ); float* SSQ2 = (float*)(ws + WS_SSQ2);
    bf16_t* XN = (bf16_t*)(ws + WS_XN); bf16_t* PROJ = (bf16_t*)(ws + WS_PROJ); bf16_t* H = (bf16_t*)(ws + WS_H); bf16_t* MIX = (bf16_t*)(ws + WS_MIX); bf16_t* X1B = (bf16_t*)(ws + WS_X1B);
    switch (p) {
    case 0: k_prep_w<<<(unsigned)((NPREP + 255) / 256), 256, 0, stream>>>(w_in, w_o, w_gate, w_up, w_down, w_s, norm2, ws);
            k_xn<<<M / 4, 256, 0, stream>>>(xp, xs, norm1, XN); break;
    case 1: k_gemm_naive<NEpiIn, false><<<dim3(INW / 64, M / 64), 256, 0, stream>>>(XN, WIN, D, NEpiIn{PROJ, VSSQ, qg, kg}); break;
    case 2: k_mix_naive<<<M, 256, 0, stream>>>(PROJ, VSSQ, WSB, rel, sink, vg, b_s, ag, gg, MIX); break;
    case 3: k_gemm_naive<NEpiOut, false><<<dim3(D / 64, M / 64), 256, 0, stream>>>(MIX, WO, D, NEpiOut{xp, xs, out, X1B, SSQ2}); break;
    case 4: k_gemm_naive<NEpiUp, true><<<dim3(DFF / 64, M / 64), 256, 0, stream>>>(X1B, WGU, D, NEpiUp{H, SSQ2}); break;
    case 5: k_gemm_naive<NEpiDown, false><<<dim3(D / 64, M / 64), 256, 0, stream>>>(H, WDN, DFF, NEpiDown{out}); break;
    }
}

namespace mix {
typedef short bf16x8 __attribute__((ext_vector_type(8)));
typedef short s16x4 __attribute__((ext_vector_type(4)));
typedef float f32x16 __attribute__((ext_vector_type(16)));
typedef float f32x4 __attribute__((ext_vector_type(4)));
typedef unsigned u32x2 __attribute__((ext_vector_type(2)));
typedef unsigned u32x4 __attribute__((ext_vector_type(4)));
typedef float f32x2_t __attribute__((ext_vector_type(2))); typedef __bf16 bf16x2_t __attribute__((ext_vector_type(2)));
constexpr int L_K = 0, L_V = 40960, L_TAB = 81920, TABN = 392, L_RV = L_TAB + 8 * 4 * TABN * 4, L_SS = L_RV + 512, L_END = L_SS + 2048;
constexpr int NUNITS = NSEQ * (SEQ / 64);
__device__ __forceinline__ unsigned cvtpk(float lo, float hi) { f32x2_t v = {lo, hi}; bf16x2_t b = __builtin_convertvector(v, bf16x2_t); return __builtin_bit_cast(unsigned, b); }
__device__ __forceinline__ s16x4 trrd(const LAS unsigned char* p) { typedef short v4i16_t __attribute__((ext_vector_type(4))); return __builtin_bit_cast(s16x4, __builtin_amdgcn_ds_read_tr16_b64_v4i16((LAS v4i16_t*)p)); }
__device__ __forceinline__ float xhalf_sum(float v) { auto rr = __builtin_amdgcn_permlane32_swap(__float_as_uint(v), __float_as_uint(v), false, false); return __uint_as_float(rr[0]) + __uint_as_float(rr[1]); }
__device__ __forceinline__ float xhalf_max(float v) { auto rr = __builtin_amdgcn_permlane32_swap(__float_as_uint(v), __float_as_uint(v), false, false); return fmaxf(__uint_as_float(rr[0]), __uint_as_float(rr[1])); }

template <int MODE> __device__ __forceinline__ void stage_rows(LAS unsigned char* img, const bf16_t* src, int row_lo, int row_hi, int wave, int lane) {
    for (int r8 = (row_lo >> 3) + wave; r8 < (row_hi >> 3); r8 += 8) {
        const int row = 8 * r8 + (lane >> 3), pc = lane & 7, c = MODE == 0 ? (pc ^ ((row >> 1) & 7)) : (pc ^ (((row >> 1) & 1) << 2));
        __builtin_amdgcn_global_load_lds((const unsigned*)(src + (size_t)row * INW + 8 * c), (LAS unsigned*)(img + r8 * 1024), 16, 0, 0);
    }
}

__device__ __forceinline__ void p2_mixer(const float* const* in, unsigned char* ws, LAS unsigned char* lds, int G) {
    const int tid = threadIdx.x, wave = __builtin_amdgcn_readfirstlane(tid >> 6), lane = tid & 63, r32 = lane & 31, hi = lane >> 5, hq = wave >> 1, tb = wave & 1;
    const bf16_t* PROJ = (const bf16_t*)(ws + WS_PROJ); const float* VSSQ = (const float*)(ws + WS_VSSQ); const bf16_t* WSB = (const bf16_t*)(ws + WS_WS); bf16_t* MIX = (bf16_t*)(ws + WS_MIX);
    const float* rel_table = in[2]; const float* sink = in[7]; const float* v_gain = in[8]; const float* b_s = in[10]; const float* ag = in[11]; const float* gg = in[12];
    LAS float* TAB = (LAS float*)(lds + L_TAB); LAS float* RV = (LAS float*)(lds + L_RV); LAS float* SS = (LAS float*)(lds + L_SS);
    for (int i = tid; i < 8 * 4 * TABN; i += 512) { const int h = i / (4 * TABN), rem = i % (4 * TABN), sh = rem / TABN, e = rem % TABN, bi = e + sh - 64;
        TAB[i] = (bi >= 0 && bi <= 256) ? rel_table[t5_bucket(bi - 128) * 8 + h] * LOG2E : -1e30f; }
    int koff[4], voff[2], gvoff[2];
    { const int q = (lane & 15) >> 2, sw = (q >> 1) & 1;
#pragma unroll
      for (int d0 = 0; d0 < 4; ++d0) koff[d0] = r32 * 128 + (((2 * d0 + hi) ^ ((r32 >> 1) & 7)) << 4);
#pragma unroll
      for (int dh = 0; dh < 2; ++dh) { const int ch = 4 * (dh ^ sw) + 2 * ((lane >> 4) & 1) + ((lane & 3) >> 1);
          voff[dh] = (4 * hi + q) * 128 + ch * 16 + (lane & 1) * 8; gvoff[dh] = (8 * hi + q) * 128 + ch * 16 + (lane & 1) * 8; } }
    const int e0 = 64 - 32 * tb - r32 + 4 * hi, sh = e0 & 3;
    const int vcu = (G % 8 == 0) ? ((int)blockIdx.x % 8) * (G / 8) + (int)blockIdx.x / 8 : (int)blockIdx.x;

    for (int u = vcu; u < NUNITS; u += G) {
        const int s = u >> 6, t0 = (u & 63) * 64, m0 = s * SEQ + t0;
        const int kt_lo = t0 < 128 ? (128 - t0) >> 6 : 0, kt_hi = t0 + 192 > SEQ ? (SEQ + 128 - t0) >> 6 : 5;
        const int mc = m0 - (t0 & 127), pbase = (t0 & 127) + 32 * tb + r32;
        const size_t mrow = (size_t)(m0 + 32 * tb + r32);
        f32x16 oa[2][2];
        __syncthreads();
        if (tid < 128) { const f32x4* vp = (const f32x4*)(VSSQ + (size_t)(mc + tid) * 8); const f32x4 a = vp[0] + vp[1]; RV[tid] = rsqrtf(((a[0] + a[1]) + (a[2] + a[3])) * (1.0f / 512.0f) + EPS); }
#pragma unroll
        for (int g = 0; g < 2; ++g) {
            const int h = 4 * g + hq;
            if (g == 1) __syncthreads();
            { const bf16_t* krow0 = PROJ + (long)(m0 - 128) * INW + 512 + 64 * g;
              stage_rows<0>(lds + L_K, krow0, 64 * kt_lo, 64 * kt_hi, wave, lane);
              stage_rows<1>(lds + L_V, krow0 + 128, 64 * kt_lo, 64 * kt_hi, wave, lane); }
            bf16x8 qf[4];
#pragma unroll
            for (int d0 = 0; d0 < 4; ++d0) qf[d0] = *(const bf16x8*)(PROJ + mrow * INW + 64 * h + 16 * d0 + 8 * hi);
            const float sink2 = sink[h] * LOG2E;
            __syncthreads();
            float m = sink2, l = hi == 0 ? 1.0f : 0.0f;
            f32x16 o0 = {}, o1 = {};
            const LAS float* tbp = TAB + (h * 4 + sh) * TABN + (e0 - sh);
            for (int kt = kt_lo; kt < kt_hi; ++kt) {
                f32x16 p0, p1;
                { const LAS float* tp = tbp + 64 * kt;
#pragma unroll
                  for (int gq = 0; gq < 4; ++gq) { const f32x4 a = *(const LAS f32x4*)(tp + 8 * gq), b = *(const LAS f32x4*)(tp + 32 + 8 * gq);
#pragma unroll
                      for (int e = 0; e < 4; ++e) { p0[4 * gq + e] = a[e]; p1[4 * gq + e] = b[e]; } } }
                const LAS unsigned char* kb = lds + L_K + kt * 8192;
#pragma unroll
                for (int d0 = 0; d0 < 4; ++d0) { const bf16x8 k0 = *(const LAS bf16x8*)(kb + koff[d0]), k1 = *(const LAS bf16x8*)(kb + 4096 + koff[d0]);
                    p0 = __builtin_amdgcn_mfma_f32_32x32x16_bf16(k0, qf[d0], p0, 0, 0, 0); p1 = __builtin_amdgcn_mfma_f32_32x32x16_bf16(k1, qf[d0], p1, 0, 0, 0); }
                float rm = fmaxf(p0[0], p1[0]);
#pragma unroll
                for (int r = 1; r < 16; ++r) rm = fmaxf(rm, fmaxf(p0[r], p1[r]));
                rm = xhalf_max(rm);
                const float mn = fmaxf(m, rm), alpha = __builtin_amdgcn_exp2f(m - mn); m = mn;
                float ls = 0.f;
#pragma unroll
                for (int r = 0; r < 16; ++r) { p0[r] = __builtin_amdgcn_exp2f(p0[r] - m); p1[r] = __builtin_amdgcn_exp2f(p1[r] - m); ls += p0[r] + p1[r]; }
                l = l * alpha + ls;
#pragma unroll
                for (int r = 0; r < 16; ++r) { o0[r] *= alpha; o1[r] *= alpha; }
                u32x4 pw[2][2];
#pragma unroll
                for (int sI = 0; sI < 2; ++sI) { pw[0][sI] = (u32x4){cvtpk(p0[8 * sI], p0[8 * sI + 1]), cvtpk(p0[8 * sI + 2], p0[8 * sI + 3]), cvtpk(p0[8 * sI + 4], p0[8 * sI + 5]), cvtpk(p0[8 * sI + 6], p0[8 * sI + 7])};
                                                 pw[1][sI] = (u32x4){cvtpk(p1[8 * sI], p1[8 * sI + 1]), cvtpk(p1[8 * sI + 2], p1[8 * sI + 3]), cvtpk(p1[8 * sI + 4], p1[8 * sI + 5]), cvtpk(p1[8 * sI + 6], p1[8 * sI + 7])}; }
                const LAS unsigned char* vb = lds + L_V + kt * 8192;
#pragma unroll
                for (int sub = 0; sub < 2; ++sub)
#pragma unroll
                    for (int sI = 0; sI < 2; ++sI) { const bf16x8 pf = __builtin_bit_cast(bf16x8, pw[sub][sI]);
#pragma unroll
                        for (int dh = 0; dh < 2; ++dh) { const LAS unsigned char* vp = vb + (32 * sub + 16 * sI) * 128 + voff[dh];
                            const s16x4 lo = trrd(vp), hi4 = trrd(vp + 8 * 128); const bf16x8 vf = {lo[0], lo[1], lo[2], lo[3], hi4[0], hi4[1], hi4[2], hi4[3]};
                            if (dh == 0) o0 = __builtin_amdgcn_mfma_f32_32x32x16_bf16(vf, pf, o0, 0, 0, 0); else o1 = __builtin_amdgcn_mfma_f32_32x32x16_bf16(vf, pf, o1, 0, 0, 0); } }
            }
            const float inv = 1.0f / xhalf_sum(l);
#pragma unroll
            for (int r = 0; r < 16; ++r) { o0[r] *= inv; o1[r] *= inv; }
            oa[g][0] = o0; oa[g][1] = o1;
        }
        { float ss = 0.f;
#pragma unroll
          for (int g = 0; g < 2; ++g)
#pragma unroll
              for (int dh = 0; dh < 2; ++dh)
#pragma unroll
                  for (int r = 0; r < 16; ++r) ss += oa[g][dh][r] * oa[g][dh][r];
          ss = xhalf_sum(ss); if (hi == 0) SS[wave * 32 + r32] = ss; }
        __syncthreads();
        { const bf16_t* vrow0 = PROJ + (size_t)mc * INW + 1280;
#pragma unroll
          for (int hh = 0; hh < 4; ++hh) stage_rows<1>(lds + hh * 16384, vrow0 + 64 * hh, 0, 128, wave, lane); }
        { const float tot = (SS[tb * 32 + r32] + SS[(2 + tb) * 32 + r32]) + (SS[(4 + tb) * 32 + r32] + SS[(6 + tb) * 32 + r32]);
          const float ra = rsqrtf(tot * (1.0f / 512.0f) + EPS);
#pragma unroll
          for (int g = 0; g < 2; ++g)
#pragma unroll
              for (int dh = 0; dh < 2; ++dh)
#pragma unroll
                  for (int gq = 0; gq < 4; ++gq) { const int col = 64 * (4 * g + hq) + 32 * dh + 8 * gq + 4 * hi; const f32x4 gn = *(const f32x4*)(ag + col);
                      u32x2 w; w.x = cvtpk(oa[g][dh][4 * gq] * ra * gn[0], oa[g][dh][4 * gq + 1] * ra * gn[1]); w.y = cvtpk(oa[g][dh][4 * gq + 2] * ra * gn[2], oa[g][dh][4 * gq + 3] * ra * gn[3]);
                      *(u32x2*)(MIX + mrow * D + col) = w; } }
        f32x16 og[2][2];
#pragma unroll
        for (int rd = 0; rd < 2; ++rd) {
            const int hh = 4 * rd + hq;
            if (rd == 1) { __syncthreads();
                const bf16_t* vrow0 = PROJ + (size_t)mc * INW + 1280 + 256;
#pragma unroll
                for (int h4 = 0; h4 < 4; ++h4) stage_rows<1>(lds + h4 * 16384, vrow0 + 64 * h4, 0, 128, wave, lane); }
            bf16x8 wf[8];
            { const bf16_t* wrow = WSB + ((size_t)hh * 128 + pbase) * 128 + 8 * hi;
#pragma unroll
              for (int sI = 0; sI < 8; ++sI) wf[sI] = *(const bf16x8*)(wrow + 16 * sI); }
            __syncthreads();
            f32x16 a0 = {}, a1 = {};
            const LAS unsigned char* gb = lds + hq * 16384;
#pragma unroll
            for (int sI = 0; sI < 8; ++sI) {
                const f32x4 ra = *(const LAS f32x4*)(RV + 16 * sI + 8 * hi), rb = *(const LAS f32x4*)(RV + 16 * sI + 8 * hi + 4);
                const u32x4 wu = __builtin_bit_cast(u32x4, wf[sI]); u32x4 ws4;
                ws4.x = cvtpk(__uint_as_float(wu.x << 16) * ra[0], __uint_as_float(wu.x & 0xffff0000u) * ra[1]); ws4.y = cvtpk(__uint_as_float(wu.y << 16) * ra[2], __uint_as_float(wu.y & 0xffff0000u) * ra[3]);
                ws4.z = cvtpk(__uint_as_float(wu.z << 16) * rb[0], __uint_as_float(wu.z & 0xffff0000u) * rb[1]); ws4.w = cvtpk(__uint_as_float(wu.w << 16) * rb[2], __uint_as_float(wu.w & 0xffff0000u) * rb[3]);
                const bf16x8 bfr = __builtin_bit_cast(bf16x8, ws4);
#pragma unroll
                for (int dh = 0; dh < 2; ++dh) { const LAS unsigned char* vp = gb + (16 * sI) * 128 + gvoff[dh];
                    const s16x4 lo = trrd(vp), hi4 = trrd(vp + 4 * 128); const bf16x8 vf = {lo[0], lo[1], lo[2], lo[3], hi4[0], hi4[1], hi4[2], hi4[3]};
                    if (dh == 0) a0 = __builtin_amdgcn_mfma_f32_32x32x16_bf16(vf, bfr, a0, 0, 0, 0); else a1 = __builtin_amdgcn_mfma_f32_32x32x16_bf16(vf, bfr, a1, 0, 0, 0); }
            }
            const float bsv = b_s[hh * 128 + pbase];
#pragma unroll
            for (int dh = 0; dh < 2; ++dh)
#pragma unroll
                for (int gq = 0; gq < 4; ++gq) { const int col = 64 * hh + 32 * dh + 8 * gq + 4 * hi; const f32x4 vg = *(const f32x4*)(v_gain + col);
                    const u32x2 uu = *(const u32x2*)(PROJ + mrow * INW + 768 + col);
                    const float u0 = __uint_as_float(uu.x << 16), u1 = __uint_as_float(uu.x & 0xffff0000u), u2 = __uint_as_float(uu.y << 16), u3 = __uint_as_float(uu.y & 0xffff0000u);
                    f32x16& acc = dh == 0 ? a0 : a1;
                    acc[4 * gq] = u0 * (vg[0] * acc[4 * gq] + bsv); acc[4 * gq + 1] = u1 * (vg[1] * acc[4 * gq + 1] + bsv);
                    acc[4 * gq + 2] = u2 * (vg[2] * acc[4 * gq + 2] + bsv); acc[4 * gq + 3] = u3 * (vg[3] * acc[4 * gq + 3] + bsv); }
            og[rd][0] = a0; og[rd][1] = a1;
        }
        { float ss = 0.f;
#pragma unroll
          for (int rd = 0; rd < 2; ++rd)
#pragma unroll
              for (int dh = 0; dh < 2; ++dh)
#pragma unroll
                  for (int r = 0; r < 16; ++r) ss += og[rd][dh][r] * og[rd][dh][r];
          ss = xhalf_sum(ss); if (hi == 0) SS[256 + wave * 32 + r32] = ss; }
        __syncthreads();
        { const float tot = (SS[256 + tb * 32 + r32] + SS[256 + (2 + tb) * 32 + r32]) + (SS[256 + (4 + tb) * 32 + r32] + SS[256 + (6 + tb) * 32 + r32]);
          const float rg = rsqrtf(tot * (1.0f / 512.0f) + EPS);
#pragma unroll
          for (int rd = 0; rd < 2; ++rd)
#pragma unroll
              for (int dh = 0; dh < 2; ++dh)
#pragma unroll
                  for (int gq = 0; gq < 4; ++gq) { const int col = 64 * (4 * rd + hq) + 32 * dh + 8 * gq + 4 * hi; const f32x4 gn = *(const f32x4*)(gg + col);
                      u32x2 w; w.x = cvtpk(og[rd][dh][4 * gq] * rg * gn[0], og[rd][dh][4 * gq + 1] * rg * gn[1]); w.y = cvtpk(og[rd][dh][4 * gq + 2] * rg * gn[2], og[rd][dh][4 * gq + 3] * rg * gn[3]);
                      *(u32x2*)(MIX + mrow * D + 512 + col) = w; } }
    }
    __syncthreads();
}
}

constexpr int NWAVES = 8;
constexpr int N_PHASES = 6;
constexpr int RING_BYTES = 131072;
constexpr int LDSCTL_OFF = RING_BYTES + 24576, MISC_OFF = LDSCTL_OFF + 320;
constexpr int LDS_BYTES = 157696;
static_assert(MISC_OFF + 128 <= LDS_BYTES && mix::L_END <= LDSCTL_OFF, "LDS map");
constexpr int CW_BAR = 4096;

#define GAS __attribute__((address_space(1)))

typedef GAS unsigned gu32;
#define RLX_AGENT __ATOMIC_RELAXED, __HIP_MEMORY_SCOPE_AGENT

#define XB_TMO      128
#define XB_XCNT(j)  (256  + 64 * (j))
#define XB_XSUB(j)  (1280 + 64 * (j))
#define XB_XGEN(j)  (2304 + 64 * (j))
#define XB_TOP      3328
#define XB_TOPGEN   3392
#define XCD_BAR_WORDS 3456
#define XB_SPIN_CAP (1u << 18)

__device__ __forceinline__ unsigned xb_ld(unsigned* p)              { return __hip_atomic_load(p, __ATOMIC_RELAXED, __HIP_MEMORY_SCOPE_AGENT); }
__device__ __forceinline__ unsigned xb_add(unsigned* p, unsigned v) { return __hip_atomic_fetch_add(p, v, __ATOMIC_RELAXED, __HIP_MEMORY_SCOPE_AGENT); }
__device__ __forceinline__ unsigned xb_xcc_id() { return (unsigned)__builtin_amdgcn_s_getreg((3 << 11) | 20) & 0xFu; }
#define XB_SPIN(cond, bar) do { unsigned _sp = 0; while (cond) { __builtin_amdgcn_s_sleep(1); \
    if ((++_sp & 255u) == 0u) { if (xb_ld(&(bar)[XB_TMO])) break; if (_sp > XB_SPIN_CAP) { atomicAdd(&(bar)[XB_TMO], 1u); break; } } } } while (0)

struct XcdBarrier { unsigned* bar; unsigned x; volatile LAS unsigned* st; };
__device__ __forceinline__ XcdBarrier xcd_barrier_post(unsigned* bar, volatile LAS unsigned* st) {
    XcdBarrier b; b.bar = bar; b.x = xb_xcc_id(); b.st = st;
    if (threadIdx.x == 0) (void)xb_add(&bar[XB_XCNT(b.x)], 1u);
    return b;
}
__device__ __forceinline__ void xcd_barrier_complete(unsigned* bar, unsigned x, unsigned& nloc, unsigned& nx) {
    const unsigned G = gridDim.x * gridDim.y * gridDim.z;
    unsigned sum, cnt, mine, sp = 0u;
    for (;;) {
        sum = 0u; cnt = 0u; mine = 0u;
#pragma unroll
        for (unsigned j = 0; j < 16; ++j) { const unsigned c = xb_ld(&bar[XB_XCNT(j)]); sum += c; cnt += (c > 0u) ? 1u : 0u; mine = (j == x) ? c : mine; }
        if (sum == G) break;
        __builtin_amdgcn_s_sleep(1);
        if ((++sp & 255u) == 0u) { if (xb_ld(&bar[XB_TMO])) break; if (sp > XB_SPIN_CAP) { atomicAdd(&bar[XB_TMO], 1u); break; } }
    }
    nloc = mine > 0u ? mine : 1u; nx = cnt > 0u ? cnt : 1u;
}
__device__ __forceinline__ void xcd_barrier(const XcdBarrier& b) {
    asm volatile("s_waitcnt vmcnt(0)" ::: "memory");
    __syncthreads();
    if (threadIdx.x == 0) {
        unsigned* bar = b.bar;
        __builtin_amdgcn_s_waitcnt(0);
        unsigned nloc = b.st[0], nx = b.st[1];
        if (nloc == 0u) { xcd_barrier_complete(bar, b.x, nloc, nx); b.st[0] = nloc; b.st[1] = nx; }
        const unsigned old = xb_add(&bar[XB_XSUB(b.x)], 1u);
        const unsigned gen = old / nloc;
        if (old + 1u == (gen + 1u) * nloc) {
            __builtin_amdgcn_fence(__ATOMIC_RELEASE, "agent");
            asm volatile("s_waitcnt vmcnt(0)" ::: "memory");
            const unsigned og = xb_add(&bar[XB_TOP], 1u);
            const unsigned tg = og / nx;
            if (og + 1u == (tg + 1u) * nx) xb_add(&bar[XB_TOPGEN], 1u);
            else XB_SPIN(xb_ld(&bar[XB_TOPGEN]) == tg, bar);
            __builtin_amdgcn_fence(__ATOMIC_ACQUIRE, "agent");
            xb_add(&bar[XB_XGEN(b.x)], 1u);
            asm volatile("s_waitcnt vmcnt(0)" ::: "memory");
        } else {
            XB_SPIN(xb_ld(&bar[XB_XGEN(b.x)]) == gen, bar);
            __builtin_amdgcn_fence(__ATOMIC_ACQUIRE, "agent");
            asm volatile("s_waitcnt vmcnt(0)" ::: "memory");
        }
    }
    __syncthreads();
}

struct Args { const float* in[18]; float* out; unsigned char* ws; int ph_lo, ph_hi; };

__global__ void __launch_bounds__(NWAVES * 64, 2) mk_fwd(Args args) {
    extern __shared__ __attribute__((aligned(16))) unsigned char lds_raw[];
    LAS unsigned char* lds = (LAS unsigned char*)lds_raw;
    volatile LAS unsigned* MISC = (volatile LAS unsigned*)(lds + MISC_OFF);
    const int tid = threadIdx.x, G = gridDim.x;
    unsigned char* ws = args.ws;
    gu32* ctl = (gu32*)(ws + WS_CTL);
    for (int u = tid; u < (LDS_BYTES - LDSCTL_OFF) / 4; u += NWAVES * 64) ((LAS unsigned*)(lds + LDSCTL_OFF))[u] = 0u;
    __syncthreads();
    const int lo = args.ph_lo, hi = args.ph_hi;
    const bool multi = hi - lo > 1;
    XcdBarrier bar; bar.bar = (unsigned*)(ctl + CW_BAR); bar.x = 0; bar.st = nullptr;
    if (multi) bar = xcd_barrier_post((unsigned*)(ctl + CW_BAR), MISC + 8);
#define STAMP(k) do {} while (0)
#define IN(k) (lo <= (k) && (k) < hi)
#define BOTH(k) (IN(k) && IN((k) + 1))
    const float* xp = args.in[0]; const float* xs = args.in[1];
    bf16_t* WIN = (bf16_t*)(ws + WS_WIN); bf16_t* WO = (bf16_t*)(ws + WS_WO); bf16_t* WGU = (bf16_t*)(ws + WS_WGU); bf16_t* WDN = (bf16_t*)(ws + WS_WDN);
    float* VSSQ = (float*)(ws + WS_VSSQ); float* SSQ2 = (float*)(ws + WS_SSQ2);
    bf16_t* XN = (bf16_t*)(ws + WS_XN); bf16_t* PROJ = (bf16_t*)(ws + WS_PROJ); bf16_t* H = (bf16_t*)(ws + WS_H); bf16_t* MIX = (bf16_t*)(ws + WS_MIX); bf16_t* X1B = (bf16_t*)(ws + WS_X1B);

    for (int rep = 0; rep < 1 + ((MK_REPEAT_MASK >> 0) & 1); ++rep) if (IN(0)) {
#if MK_PROLOGUE_NAIVE
        p0_prologue_naive(args.in, ws, G);
#else
        p0_prologue(args.in, ws, lds, G);
#endif
        if (BOTH(0)) xcd_barrier(bar); STAMP(0); }
    for (int rep = 0; rep < 1 + ((MK_REPEAT_MASK >> 1) & 1); ++rep) if (IN(1)) {
        pg8::Gemm g{XN, WIN, M, INW, D}; pg8::StaticOrder S; S.init(M, INW, G, (int)blockIdx.x);
        pg8::EpiIn E{PROJ, VSSQ, args.in[5], args.in[6]};
        pg8::gemm_phase<pg8::EpiIn, pg8::StaticOrder, true>(lds, g, S, E);
        if (BOTH(1)) xcd_barrier(bar); STAMP(1);
    }
    for (int rep = 0; rep < 1 + ((MK_REPEAT_MASK >> 2) & 1); ++rep) if (IN(2)) {
#if MK_MIXER_NAIVE
        p2_mixer_naive(args.in, ws, lds_raw, G);
#else
        mix::p2_mixer(args.in, ws, lds, G);
#endif
        if (BOTH(2)) xcd_barrier(bar); STAMP(2); }
    for (int rep = 0; rep < 1 + ((MK_REPEAT_MASK >> 3) & 1); ++rep) if (IN(3)) {
        pg8::Gemm g{MIX, WO, M, D, D}; pg8::StaticOrder S; S.init(M, D, G, (int)blockIdx.x);
        pg8::EpiOut E{xp, xs, X1B, SSQ2};
        pg8::gemm_phase<pg8::EpiOut, pg8::StaticOrder, true>(lds, g, S, E);
        if (BOTH(3)) xcd_barrier(bar); STAMP(3);
    }
    for (int rep = 0; rep < 1 + ((MK_REPEAT_MASK >> 4) & 1); ++rep) if (IN(4)) {
        pg8::Gemm g{X1B, WGU, M, NGU, D}; pg8::StaticOrder S; S.init(M, NGU, G, (int)blockIdx.x);
        pg8::EpiUp E{H, SSQ2};
        pg8::gemm_phase<pg8::EpiUp, pg8::StaticOrder, true>(lds, g, S, E);
        if (BOTH(4)) xcd_barrier(bar); STAMP(4);
    }
    if (IN(5)) {
        pg8::Gemm g{H, WDN, M, D, DFF}; pg8::StaticOrder S; S.init(M, D, G, (int)blockIdx.x);
        pg8::EpiDown E{X1B, args.out};
        pg8::gemm_phase<pg8::EpiDown, pg8::StaticOrder, true>(lds, g, S, E);
        STAMP(5);
    }

#if MK_EXTRA_PHASE >= 6
    if (lo == 6) { pg8::Gemm g{X1B, WGU, M, NGU, D}; pg8::StaticOrder S; S.init(M, NGU, G, (int)blockIdx.x); pg8::EpiNone E; pg8::gemm_phase<pg8::EpiNone, pg8::StaticOrder, true>(lds, g, S, E); }
    if (lo == 7) { pg8::Gemm g{H, WDN, M, D, DFF}; pg8::StaticOrder S; S.init(M, D, G, (int)blockIdx.x); pg8::EpiNone E; pg8::gemm_phase<pg8::EpiNone, pg8::StaticOrder, true>(lds, g, S, E); }
    if (lo == 8) { pg8::Gemm g{X1B, WGU, M, INW, D}; pg8::StaticOrder S; S.init(M, INW, G, (int)blockIdx.x); pg8::EpiNone E; pg8::gemm_phase<pg8::EpiNone, pg8::StaticOrder, true>(lds, g, S, E); }
#endif
#undef IN
#undef BOTH
}

extern "C" void kernel_launch(void* const* d_in, const int* in_sizes, int n_in, void* d_out, int out_size, void* d_ws, size_t ws_size, hipStream_t stream) {
    static int grid = 0;
    if (grid == 0) {
        if (n_in != 18 || in_sizes[0] != MP * D || in_sizes[1] != (M - MP) * D || out_size != M * D || ws_size < WS_END) {
            fprintf(stderr, "kernel_launch: unexpected shapes (n_in %d, in0 %d, in1 %d, out %d, ws %zu)\n", n_in, n_in > 0 ? in_sizes[0] : -1, n_in > 1 ? in_sizes[1] : -1, out_size, ws_size); grid = -1; return; }
        int dev = 0, cus = 0, per_cu = 0;
        if (hipGetDevice(&dev) != hipSuccess || hipDeviceGetAttribute(&cus, hipDeviceAttributeMultiprocessorCount, dev) != hipSuccess) { grid = -1; return; }
        if (hipFuncSetAttribute((const void*)mk_fwd, hipFuncAttributeMaxDynamicSharedMemorySize, LDS_BYTES) != hipSuccess) { fprintf(stderr, "kernel_launch: hipFuncSetAttribute failed\n"); grid = -1; return; }
        if (hipOccupancyMaxActiveBlocksPerMultiprocessor(&per_cu, (const void*)mk_fwd, NWAVES * 64, LDS_BYTES) != hipSuccess || per_cu < 1) { fprintf(stderr, "kernel_launch: occupancy query says %d blocks per CU\n", per_cu); grid = -1; return; }
        (void)hipGetLastError();
        grid = cus;
    }
    if (grid < 0) return;
    Args a{};
    for (int i = 0; i < 18; ++i) a.in[i] = (const float*)d_in[i];
    a.out = (float*)d_out; a.ws = (unsigned char*)d_ws;
    unsigned char* ws = (unsigned char*)d_ws;
    (void)hipMemsetAsync(ws + WS_CTL, 0, 1 * MiB, stream);
#if MK_ONE_LAUNCH
#if MK_EXTRA_PHASE == 3
    a.ph_lo = 0; a.ph_hi = 4; hipLaunchKernelGGL(mk_fwd, dim3(grid), dim3(NWAVES * 64), LDS_BYTES, stream, a);
    (void)hipMemsetAsync(ws + WS_CTL, 0, 1 * MiB, stream);
    a.ph_lo = 3; a.ph_hi = 6; hipLaunchKernelGGL(mk_fwd, dim3(grid), dim3(NWAVES * 64), LDS_BYTES, stream, a);
#else
    a.ph_lo = 0; a.ph_hi = N_PHASES;
    { void* kargs[] = {&a}; hipError_t e = hipLaunchCooperativeKernel((const void*)mk_fwd, dim3(grid), dim3(NWAVES * 64), kargs, LDS_BYTES, stream);
      if (e != hipSuccess) fprintf(stderr, "kernel_launch: cooperative launch failed: %s (grid %d)\n", hipGetErrorString(e), grid); }
#if MK_EXTRA_PHASE >= 0
    a.ph_lo = MK_EXTRA_PHASE; a.ph_hi = MK_EXTRA_PHASE + 1; hipLaunchKernelGGL(mk_fwd, dim3(grid), dim3(NWAVES * 64), LDS_BYTES, stream, a);
#endif
#endif
#else
    for (int p = 0; p < N_PHASES; ++p) {
        if (!(MK_PHASE_MASK & (1 << p))) { launch_naive_phase(p, d_in, (float*)d_out, ws, stream); continue; }
        a.ph_lo = p; a.ph_hi = p + 1;
        hipLaunchKernelGGL(mk_fwd, dim3(grid), dim3(NWAVES * 64), LDS_BYTES, stream, a);
    }
#endif
}
```

```cpp
#include <hip/hip_runtime.h>
#include <cstdio>
#include <cstdint>

typedef unsigned short bf16_t;
constexpr int D = 1024, SEQ = 4096, NSEQ = 12, M = NSEQ * SEQ, MP = 4 * SEQ;
constexpr int INW = 1792, DFF = 2816, NGU = 2 * DFF;
constexpr float EPS = 1e-6f, LOG2E = 1.4426950408889634f, QSCALE = 0.125f * LOG2E;

constexpr size_t MiB = 1u << 20;
constexpr size_t WS_CTL = 0;
constexpr size_t WS_WIN = 1 * MiB;
constexpr size_t WS_WO = 5 * MiB;
constexpr size_t WS_WGU = 7 * MiB;
constexpr size_t WS_WDN = 18 * MiB;
constexpr size_t WS_WS = 24 * MiB;
constexpr size_t WS_VSSQ = 25 * MiB;
constexpr size_t WS_SSQ2 = 27 * MiB;
constexpr size_t WS_RS1 = 30 * MiB;
constexpr size_t WS_XN = 32 * MiB;
constexpr size_t WS_PROJ = 128 * MiB;
constexpr size_t WS_H = 32 * MiB;
constexpr size_t WS_MIX = 296 * MiB;
constexpr size_t WS_X1B = 392 * MiB;
constexpr size_t WS_END = 488 * MiB;

__device__ __forceinline__ unsigned f2bf(float f) { unsigned u = __builtin_bit_cast(unsigned, f); return (u + 0x7fffu + ((u >> 16) & 1u)) >> 16; }
__device__ __forceinline__ float bf2f(bf16_t b) { return __builtin_bit_cast(float, (unsigned)b << 16); }
__device__ __forceinline__ float gelu_tanh(float x) { const float u = x * (-2.302208198f - 0.1029432397f * x * x); return x * __builtin_amdgcn_rcpf(1.0f + __builtin_amdgcn_exp2f(u)); }
__device__ __forceinline__ float silu(float x) { return x * __builtin_amdgcn_rcpf(1.0f + __builtin_amdgcn_exp2f(-LOG2E * x)); }
__device__ __forceinline__ int t5_bucket(int rel) { const int n = rel < 0 ? -rel : rel; int b = n < 8 ? n : (2 + (31 - __builtin_clz(n * n))); b = b > 15 ? 15 : b; return b + (rel > 0 ? 16 : 0); }

__device__ __forceinline__ void prep_w_elem(size_t i, const float* w_in, const float* w_o, const float* w_gate, const float* w_up, const float* w_down, const float* w_s, const float* norm2, unsigned char* ws) {
    const size_t N0 = (size_t)INW * D, N1 = (size_t)D * D, N2 = (size_t)NGU * D, N3 = (size_t)D * DFF, N4 = 8 * 128 * 128;
    if (i < N0) { const int n = i / D, k = i % D; ((bf16_t*)(ws + WS_WIN))[i] = f2bf(w_in[(size_t)k * INW + n]); return; } i -= N0;
    if (i < N1) { const int n = i / D, k = i % D; ((bf16_t*)(ws + WS_WO))[i] = f2bf(w_o[(size_t)k * D + n]); return; } i -= N1;
    if (i < N2) { const int r = i / D, k = i % D; const int pn = r >> 8, bj = (r >> 7) & 1, c = r & 127, col = 128 * pn + c;
        ((bf16_t*)(ws + WS_WGU))[i] = f2bf(norm2[k] * (bj ? w_up : w_gate)[(size_t)k * DFF + col]); return; } i -= N2;
    if (i < N3) { const int n = i / DFF, k = i % DFF; ((bf16_t*)(ws + WS_WDN))[i] = f2bf(w_down[(size_t)k * D + n]); return; } i -= N3;
    if (i < N4) { ((bf16_t*)(ws + WS_WS))[i] = f2bf(w_s[i]); }
}
constexpr size_t NPREP = (size_t)INW * D + (size_t)D * D + (size_t)NGU * D + (size_t)D * DFF + 8 * 128 * 128;
__global__ void __launch_bounds__(256) k_prep_w(const float* w_in, const float* w_o, const float* w_gate, const float* w_up, const float* w_down, const float* w_s, const float* norm2, unsigned char* ws) {
    prep_w_elem((size_t)blockIdx.x * 256 + threadIdx.x, w_in, w_o, w_gate, w_up, w_down, w_s, norm2, ws);
}
__device__ __forceinline__ void xn_row(int m, int lane, const float* xp, const float* xs, const float* norm1, bf16_t* XN) {
    const float* x = m < MP ? xp + (size_t)m * D : xs + (size_t)(m - MP) * D;
    float v[16]; float ss = 0.f;
#pragma unroll
    for (int j = 0; j < 16; ++j) { v[j] = x[lane + 64 * j]; ss += v[j] * v[j]; }
#pragma unroll
    for (int o = 1; o < 64; o <<= 1) ss += __shfl_xor(ss, o);
    const float r = rsqrtf(ss * (1.0f / D) + EPS);
#pragma unroll
    for (int j = 0; j < 16; ++j) XN[(size_t)m * D + lane + 64 * j] = f2bf(v[j] * r * norm1[lane + 64 * j]);
}
__global__ void __launch_bounds__(256) k_xn(const float* xp, const float* xs, const float* norm1, bf16_t* XN) { xn_row(blockIdx.x * 4 + (threadIdx.x >> 6), threadIdx.x & 63, xp, xs, norm1, XN); }

template <class Epi, bool DUAL>
__global__ void __launch_bounds__(256) k_gemm_naive(const bf16_t* A, const bf16_t* Bt, int K, Epi epi) {
    __shared__ float As[32][68], Bs[32][68], B2s[DUAL ? 32 : 1][68], Ct[64][65], C2t[DUAL ? 64 : 1][65];
    const int tid = threadIdx.x, ty = tid >> 4, tx = tid & 15, lr = tid >> 2, kc = (tid & 3) * 8;
    const int m0 = blockIdx.y * 64, n0 = blockIdx.x * 64;
    const bf16_t* ap = A + (size_t)(m0 + lr) * K + kc;
    const int br = epi.brow(n0 + lr);
    const bf16_t* bp = Bt + (size_t)br * K + kc;
    const bf16_t* bp2 = Bt + (size_t)(br + 128) * K + kc;
    float acc[4][4] = {}, acc2[4][4] = {};
    for (int k0 = 0; k0 < K; k0 += 32) {
        const uint4 av = *(const uint4*)(ap + k0), bv = *(const uint4*)(bp + k0);
        const unsigned aw[4] = {av.x, av.y, av.z, av.w}, bw[4] = {bv.x, bv.y, bv.z, bv.w};
#pragma unroll
        for (int j = 0; j < 4; ++j) { As[kc + 2 * j][lr] = __builtin_bit_cast(float, aw[j] << 16); As[kc + 2 * j + 1][lr] = __builtin_bit_cast(float, aw[j] & 0xffff0000u);
                                      Bs[kc + 2 * j][lr] = __builtin_bit_cast(float, bw[j] << 16); Bs[kc + 2 * j + 1][lr] = __builtin_bit_cast(float, bw[j] & 0xffff0000u); }
        if (DUAL) { const uint4 cv = *(const uint4*)(bp2 + k0); const unsigned cw[4] = {cv.x, cv.y, cv.z, cv.w};
#pragma unroll
            for (int j = 0; j < 4; ++j) { B2s[kc + 2 * j][lr] = __builtin_bit_cast(float, cw[j] << 16); B2s[kc + 2 * j + 1][lr] = __builtin_bit_cast(float, cw[j] & 0xffff0000u); } }
        __syncthreads();
#pragma unroll 8
        for (int k = 0; k < 32; ++k) {
            float a[4], b[4], b2[4];
#pragma unroll
            for (int i = 0; i < 4; ++i) { a[i] = As[k][4 * ty + i]; b[i] = Bs[k][4 * tx + i]; b2[i] = DUAL ? B2s[k][4 * tx + i] : 0.f; }
#pragma unroll
            for (int i = 0; i < 4; ++i)
#pragma unroll
                for (int j = 0; j < 4; ++j) { acc[i][j] += a[i] * b[j]; if (DUAL) acc2[i][j] += a[i] * b2[j]; }
        }
        __syncthreads();
    }
#pragma unroll
    for (int i = 0; i < 4; ++i)
#pragma unroll
        for (int j = 0; j < 4; ++j) { Ct[4 * ty + i][4 * tx + j] = acc[i][j]; if (DUAL) C2t[4 * ty + i][4 * tx + j] = acc2[i][j]; }
    __syncthreads();
    const int r = tid >> 2, part = tid & 3;
    epi(m0 + r, n0, part, &Ct[r][part * 16], DUAL ? &C2t[r][part * 16] : nullptr);
}
__device__ __forceinline__ float red4(float v) { v += __shfl_xor(v, 1); v += __shfl_xor(v, 2); return v; }
struct NEpiIn {
    bf16_t* PROJ; float* VSSQ; const float* qg; const float* kg;
    __device__ int brow(int n) const { return n; }
    __device__ void operator()(int row, int n0, int part, const float* c, const float*) const {
        const int ct = n0 >> 6; float v[16];
#pragma unroll
        for (int j = 0; j < 16; ++j) v[j] = c[j];
        if (ct < 10) { float ss = 0.f;
#pragma unroll
            for (int j = 0; j < 16; ++j) ss += v[j] * v[j];
            ss = red4(ss); const float r = rsqrtf(ss * (1.0f / 64.0f) + EPS); const float* g = ct < 8 ? qg : kg; const float sc = ct < 8 ? QSCALE : 1.0f;
#pragma unroll
            for (int j = 0; j < 16; ++j) v[j] = v[j] * r * g[part * 16 + j] * sc;
        } else if (ct >= 12) { float ss = 0.f;
#pragma unroll
            for (int j = 0; j < 16; ++j) { v[j] = gelu_tanh(v[j]); ss += v[j] * v[j]; }
            if (ct >= 20) { ss = red4(ss); if (part == 0) VSSQ[(size_t)row * 8 + (ct - 20)] = ss; }
        }
#pragma unroll
        for (int j = 0; j < 16; ++j) PROJ[(size_t)row * INW + n0 + part * 16 + j] = f2bf(v[j]);
    }
};
struct NEpiOut {
    const float* xp; const float* xs; float* out; bf16_t* X1B; float* SSQ2;
    __device__ int brow(int n) const { return n; }
    __device__ void operator()(int row, int n0, int part, const float* c, const float*) const {
        const float* x = row < MP ? xp + (size_t)row * D : xs + (size_t)(row - MP) * D; float ss = 0.f;
#pragma unroll
        for (int j = 0; j < 16; ++j) { const int col = n0 + part * 16 + j; const float v = x[col] + c[j]; out[(size_t)row * D + col] = v; X1B[(size_t)row * D + col] = f2bf(v); ss += v * v; }
        ss = red4(ss); if (part == 0) SSQ2[(size_t)row * 16 + (n0 >> 6)] = ss;
    }
};
struct NEpiUp {
    bf16_t* H; const float* SSQ2;
    __device__ int brow(int n) const { return 256 * (n >> 7) + (n & 127); }
    __device__ void operator()(int row, int n0, int part, const float* c, const float* c2) const {
        float ss = 0.f;
#pragma unroll
        for (int j = 0; j < 16; ++j) ss += SSQ2[(size_t)row * 16 + j];
        const float r = rsqrtf(ss * (1.0f / D) + EPS);
#pragma unroll
        for (int j = 0; j < 16; ++j) H[(size_t)row * DFF + n0 + part * 16 + j] = f2bf(silu(c[j] * r) * (c2[j] * r));
    }
};
struct NEpiDown {
    float* out;
    __device__ int brow(int n) const { return n; }
    __device__ void operator()(int row, int n0, int part, const float* c, const float*) const {
#pragma unroll
        for (int j = 0; j < 16; ++j) { const size_t o = (size_t)row * D + n0 + part * 16 + j; out[o] = out[o] + c[j]; }
    }
};

struct MixNaiveLds { float ps[4][320], qs[4][64], arow[512], grow[512], rv[128], red[4]; };
__device__ __forceinline__ void mix_naive_token(int m, int tid, MixNaiveLds& L, const bf16_t* PROJ, const float* VSSQ, const bf16_t* WSB, const float* rel_table, const float* sink, const float* v_gain,
                                                const float* b_s, const float* ag, const float* gg, bf16_t* MIX) {
    const int s = m / SEQ, t = m % SEQ, w = tid >> 6, lane = tid & 63;
    const bf16_t* prow = PROJ + (size_t)m * INW;
    const int jlo = t - 128 < 0 ? 0 : t - 128, jhi = t + 128 > SEQ - 1 ? SEQ - 1 : t + 128, nk = jhi - jlo + 1;
    for (int hh = 0; hh < 2; ++hh) {
        const int h = w * 2 + hh, g = h >> 2;
        L.qs[w][lane] = bf2f(prow[64 * h + lane]);
        __syncthreads();
        const float sink2 = sink[h] * LOG2E; float sc[5]; float mx = sink2;
#pragma unroll
        for (int i = 0; i < 5; ++i) { const int j = jlo + lane + 64 * i; sc[i] = -1e30f;
            if (j <= jhi) { const bf16_t* kr = PROJ + (size_t)(s * SEQ + j) * INW + 512 + 64 * g; float dot = 0.f;
                for (int d = 0; d < 64; ++d) dot += L.qs[w][d] * bf2f(kr[d]);
                dot += rel_table[t5_bucket(j - t) * 8 + h] * LOG2E; sc[i] = dot; mx = fmaxf(mx, dot); } }
#pragma unroll
        for (int o = 1; o < 64; o <<= 1) mx = fmaxf(mx, __shfl_xor(mx, o));
        float l = 0.f;
#pragma unroll
        for (int i = 0; i < 5; ++i) { const int j = jlo + lane + 64 * i; const float p = j <= jhi ? exp2f(sc[i] - mx) : 0.f; l += p; L.ps[w][lane + 64 * i] = p; }
#pragma unroll
        for (int o = 1; o < 64; o <<= 1) l += __shfl_xor(l, o);
        l += exp2f(sink2 - mx);
        __syncthreads();
        float o = 0.f;
        for (int jj = 0; jj < nk; ++jj) o += L.ps[w][jj] * bf2f(PROJ[(size_t)(s * SEQ + jlo + jj) * INW + 640 + 64 * g + lane]);
        L.arow[64 * h + lane] = o / l;
        __syncthreads();
    }
    const int mc = m - (t & 127), p = t & 127;
    if (tid < 128) { float ss = 0.f; for (int i = 0; i < 8; ++i) ss += VSSQ[(size_t)(mc + tid) * 8 + i]; L.rv[tid] = rsqrtf(ss * (1.0f / 512.0f) + EPS); }
    __syncthreads();
    for (int c = tid; c < 512; c += 256) { const int h = c >> 6; float a = 0.f; const float vg = v_gain[c];
        for (int q = 0; q < 128; ++q) a += bf2f(WSB[(h * 128 + p) * 128 + q]) * (bf2f(PROJ[(size_t)(mc + q) * INW + 1280 + c]) * L.rv[q] * vg);
        L.grow[c] = bf2f(prow[768 + c]) * (a + b_s[h * 128 + p]); }
    __syncthreads();
    float sa = L.arow[tid] * L.arow[tid] + L.arow[tid + 256] * L.arow[tid + 256], sg = L.grow[tid] * L.grow[tid] + L.grow[tid + 256] * L.grow[tid + 256];
#pragma unroll
    for (int o = 1; o < 64; o <<= 1) { sa += __shfl_xor(sa, o); sg += __shfl_xor(sg, o); }
    if (lane == 0) { L.red[w] = sa; } __syncthreads(); sa = L.red[0] + L.red[1] + L.red[2] + L.red[3]; __syncthreads();
    if (lane == 0) { L.red[w] = sg; } __syncthreads(); sg = L.red[0] + L.red[1] + L.red[2] + L.red[3];
    const float ra = rsqrtf(sa * (1.0f / 512.0f) + EPS), rg = rsqrtf(sg * (1.0f / 512.0f) + EPS);
    for (int c = tid; c < 512; c += 256) { MIX[(size_t)m * D + c] = f2bf(L.arow[c] * ra * ag[c]); MIX[(size_t)m * D + 512 + c] = f2bf(L.grow[c] * rg * gg[c]); }
    __syncthreads();
}
__global__ void __launch_bounds__(256) k_mix_naive(const bf16_t* PROJ, const float* VSSQ, const bf16_t* WSB, const float* rel_table, const float* sink, const float* v_gain,
                                                  const float* b_s, const float* ag, const float* gg, bf16_t* MIX) {
    __shared__ MixNaiveLds L;
    mix_naive_token(blockIdx.x, threadIdx.x, L, PROJ, VSSQ, WSB, rel_table, sink, v_gain, b_s, ag, gg, MIX);
}

#define MK_ONE_LAUNCH 1
#define MK_PHASE_MASK 0x3F
#define MK_MIXER_NAIVE 0
#define MK_PROLOGUE_NAIVE 0
#define MK_REPEAT_MASK 0
#define MK_EXTRA_PHASE -1
#define MK_STAGGER_TICKS 0
#define MK_PFLAGS 0
#define MK_MIXER_RING 0
#define MK_NST 0
#define MK_PLAIN_LAUNCH 0
#define MK_ALIGN35 true
#define MK_ALIGN4 true
#define MK_LATE_WEIGHTS 1

namespace pg8 {
#define PG8_LAS __attribute__((address_space(3)))
typedef short bf16x8 __attribute__((ext_vector_type(8)));
typedef float f32x4 __attribute__((ext_vector_type(4)));
typedef unsigned u32x4 __attribute__((ext_vector_type(4)));
typedef unsigned u32x2 __attribute__((ext_vector_type(2)));
constexpr int BM = 256, BK = 64, HALF = 128, HTB = HALF * BK * 2  , STAGE_BYTES = 8 * HTB, NXCD = 8, WGM = 8;

__host__ __device__ __forceinline__ int lds_byte(int r, int c) { const int st = (r >> 4) * 2 + (c >> 5), rr = r & 15, cc = c & 31, ob = rr * 64 + cc * 2; return st * 1024 + (ob ^ (((ob >> 9) & 1) << 5)); }
__host__ __device__ __forceinline__ void stage_rc(int b, int& R, int& C) { const int st = b / 1024, sb = b % 1024, swz = sb ^ (((sb >> 9) & 1) << 5); R = (st >> 1) * 16 + swz / 64; C = (st & 1) * 32 + (swz % 64) / 2; }
__host__ __device__ __forceinline__ int perm32(int rho) { const int n = rho >> 4, i = rho & 15; return 8 * (i >> 2) + 4 * n + (i & 3); }

struct Unit { int pm, pn, ui; };
struct Gemm { const bf16_t* A; const bf16_t* Bt; int M, N, K; };

struct StaticOrder {
    int nM, nN, nwg, G, c, wgm;
    __host__ __device__ __forceinline__ void init(int M_, int N_, int G_, int c_) { nM = M_ / BM; nN = N_ / BM; nwg = nM * nN; G = G_; c = c_; wgm = WGM; }
    __host__ __device__ __forceinline__ bool next(int i, Unit& u) const {
        const long L = (long)i * G + c; if (L >= nwg) return false;
        int wgid = (int)L; { const int q = nwg / NXCD, r = nwg % NXCD, xcd = wgid % NXCD, off = wgid / NXCD; wgid = (xcd < r ? xcd * (q + 1) : r * (q + 1) + (xcd - r) * q) + off; }
        const int nig = wgm * nN, gid = wgid / nig, fm = gid * wgm, gsz = (nM - fm) < wgm ? (nM - fm) : wgm;
        u.pm = fm + ((wgid % nig) % gsz); u.pn = (wgid % nig) / gsz; u.ui = i; return true;
    }
};

__device__ __forceinline__ unsigned cvt_pk_bf16(float lo, float hi) { unsigned r; asm volatile("v_cvt_pk_bf16_f32 %0, %1, %2" : "=v"(r) : "v"(lo), "v"(hi)); return r; }
__device__ __forceinline__ float rsum_fq(float s) { s += __shfl_xor(s, 16); s += __shfl_xor(s, 32); return s; }

struct EpiIn {
    static constexpr int BMAP = 2, NS1 = 8;
    bf16_t* PROJ; float* VSSQ; const float* qg; const float* kg; const PG8_LAS float* RSL; const float* RS1;
    __device__ __forceinline__ void operator()(const f32x4 (&acc)[2][2][4][2], const Unit& u, int wr, int wc, int fr, int fq) const {
        const int ct = 4 * u.pn + wc;
        const int row0 = u.pm * BM + wr * 64 + fr, col0 = u.pn * BM + wc * 64 + 8 * fq;
        float r1[2][4];
        if (u.ui < NS1) { const PG8_LAS float* rp = RSL + u.ui * 256 + wr * 64 + fr;
#pragma unroll
            for (int ai = 0; ai < 2; ++ai)
#pragma unroll
                for (int m = 0; m < 4; ++m) r1[ai][m] = rp[ai * HALF + m * 16];
        } else {
#pragma unroll
            for (int ai = 0; ai < 2; ++ai)
#pragma unroll
                for (int m = 0; m < 4; ++m) r1[ai][m] = RS1[row0 + ai * HALF + m * 16];
        }
        if (ct < 10) {
            const float* g = (ct < 8 ? qg : kg) + 8 * fq; const float sc = ct < 8 ? QSCALE : 1.0f;
            f32x4 gv[2][2];
#pragma unroll
            for (int bj = 0; bj < 2; ++bj)
#pragma unroll
                for (int n = 0; n < 2; ++n) gv[bj][n] = *(const f32x4*)(g + 32 * bj + 4 * n) * sc;
#pragma unroll
            for (int ai = 0; ai < 2; ++ai)
#pragma unroll
                for (int m = 0; m < 4; ++m) {
                    float ss = 0.f;
#pragma unroll
                    for (int bj = 0; bj < 2; ++bj)
#pragma unroll
                        for (int n = 0; n < 2; ++n) { const f32x4 x = acc[ai][bj][m][n]; ss += (x[0] * x[0] + x[1] * x[1]) + (x[2] * x[2] + x[3] * x[3]); }
                    const float rr = r1[ai][m];
                    ss = rsum_fq(ss) * (rr * rr); const float r = rsqrtf(ss * (1.0f / 64.0f) + EPS) * rr;
                    bf16_t* rowp = PROJ + (size_t)(row0 + ai * HALF + m * 16) * INW + col0;
#pragma unroll
                    for (int bj = 0; bj < 2; ++bj) { const f32x4 v0 = acc[ai][bj][m][0] * r * gv[bj][0], v1 = acc[ai][bj][m][1] * r * gv[bj][1];
                        u32x4 w; w.x = cvt_pk_bf16(v0[0], v0[1]); w.y = cvt_pk_bf16(v0[2], v0[3]); w.z = cvt_pk_bf16(v1[0], v1[1]); w.w = cvt_pk_bf16(v1[2], v1[3]);
                        *(u32x4*)(rowp + 32 * bj) = w; }
                }
        } else if (ct < 12) {
#pragma unroll
            for (int ai = 0; ai < 2; ++ai)
#pragma unroll
                for (int m = 0; m < 4; ++m) { bf16_t* rowp = PROJ + (size_t)(row0 + ai * HALF + m * 16) * INW + col0; const float rr = r1[ai][m];
#pragma unroll
                    for (int bj = 0; bj < 2; ++bj) { const f32x4 v0 = acc[ai][bj][m][0] * rr, v1 = acc[ai][bj][m][1] * rr;
                        u32x4 w; w.x = cvt_pk_bf16(v0[0], v0[1]); w.y = cvt_pk_bf16(v0[2], v0[3]); w.z = cvt_pk_bf16(v1[0], v1[1]); w.w = cvt_pk_bf16(v1[2], v1[3]);
                        *(u32x4*)(rowp + 32 * bj) = w; } }
        } else {
#pragma unroll
            for (int ai = 0; ai < 2; ++ai)
#pragma unroll
                for (int m = 0; m < 4; ++m) { const int row = row0 + ai * HALF + m * 16; bf16_t* rowp = PROJ + (size_t)row * INW + col0; float ss = 0.f; const float rr = r1[ai][m];
#pragma unroll
                    for (int bj = 0; bj < 2; ++bj) { f32x4 v0 = acc[ai][bj][m][0] * rr, v1 = acc[ai][bj][m][1] * rr;
#pragma unroll
                        for (int e = 0; e < 4; e += 2) { typedef float f32x2v __attribute__((ext_vector_type(2)));
                            f32x2v x0 = {v0[e], v0[e + 1]}, x1 = {v1[e], v1[e + 1]};
                            const f32x2v u0 = x0 * ((x0 * x0) * (-0.1029432397f) + (-2.302208198f)), u1 = x1 * ((x1 * x1) * (-0.1029432397f) + (-2.302208198f));
                            f32x2v e0, e1; e0.x = __builtin_amdgcn_exp2f(u0.x); e0.y = __builtin_amdgcn_exp2f(u0.y); e1.x = __builtin_amdgcn_exp2f(u1.x); e1.y = __builtin_amdgcn_exp2f(u1.y);
                            const f32x2v d0 = e0 + 1.0f, d1 = e1 + 1.0f; f32x2v s0, s1; s0.x = __builtin_amdgcn_rcpf(d0.x); s0.y = __builtin_amdgcn_rcpf(d0.y); s1.x = __builtin_amdgcn_rcpf(d1.x); s1.y = __builtin_amdgcn_rcpf(d1.y);
                            x0 = x0 * s0; x1 = x1 * s1; v0[e] = x0.x; v0[e + 1] = x0.y; v1[e] = x1.x; v1[e + 1] = x1.y;
                            const f32x2v q = x0 * x0 + x1 * x1; ss += q.x + q.y; }
                        u32x4 w; w.x = cvt_pk_bf16(v0[0], v0[1]); w.y = cvt_pk_bf16(v0[2], v0[3]); w.z = cvt_pk_bf16(v1[0], v1[1]); w.w = cvt_pk_bf16(v1[2], v1[3]);
                        *(u32x4*)(rowp + 32 * bj) = w; }
                    if (ct >= 20) { ss = rsum_fq(ss); if (fq == 0) VSSQ[(size_t)row * 8 + (ct - 20)] = ss; }
                }
        }
    }
};
struct EpiOut {
    static constexpr int BMAP = 1;
    const bf16_t* XB; bf16_t* X1B; float* SSQ2;
    __device__ __forceinline__ void operator()(const f32x4 (&acc)[2][2][4][2], const Unit& u, int wr, int wc, int fr, int fq) const {
        const int row0 = u.pm * BM + wr * 64 + fr, col0 = u.pn * BM + wc * 32 + 8 * fq;
        u32x4 xv[2][4][2];
#pragma unroll
        for (int ai = 0; ai < 2; ++ai)
#pragma unroll
            for (int m = 0; m < 4; ++m)
#pragma unroll
                for (int bj = 0; bj < 2; ++bj) xv[ai][m][bj] = *(const u32x4*)(XB + (size_t)(row0 + ai * HALF + m * 16) * D + col0 + bj * HALF);
#pragma unroll
        for (int ai = 0; ai < 2; ++ai)
#pragma unroll
            for (int m = 0; m < 4; ++m) { const int row = row0 + ai * HALF + m * 16; bf16_t* rowp = X1B + (size_t)row * D + col0; float ss = 0.f;
#pragma unroll
                for (int bj = 0; bj < 2; ++bj) { const u32x4 x = xv[ai][m][bj];
                    const f32x4 r0 = {__uint_as_float(x.x << 16), __uint_as_float(x.x & 0xffff0000u), __uint_as_float(x.y << 16), __uint_as_float(x.y & 0xffff0000u)};
                    const f32x4 r1 = {__uint_as_float(x.z << 16), __uint_as_float(x.z & 0xffff0000u), __uint_as_float(x.w << 16), __uint_as_float(x.w & 0xffff0000u)};
                    const f32x4 v0 = r0 + acc[ai][bj][m][0], v1 = r1 + acc[ai][bj][m][1];
                    u32x4 w; w.x = cvt_pk_bf16(v0[0], v0[1]); w.y = cvt_pk_bf16(v0[2], v0[3]); w.z = cvt_pk_bf16(v1[0], v1[1]); w.w = cvt_pk_bf16(v1[2], v1[3]);
                    *(u32x4*)(rowp + bj * HALF) = w;
                    ss += ((v0[0] * v0[0] + v0[1] * v0[1]) + (v0[2] * v0[2] + v0[3] * v0[3])) + ((v1[0] * v1[0] + v1[1] * v1[1]) + (v1[2] * v1[2] + v1[3] * v1[3])); }
                ss = rsum_fq(ss); if (fq == 0) SSQ2[(size_t)row * 16 + 4 * u.pn + wc] = ss; }
    }
};
struct EpiUp {
    static constexpr int BMAP = 1;
    bf16_t* H; const PG8_LAS float* RS; const float* SSQ2;
    __device__ __forceinline__ void operator()(const f32x4 (&acc)[2][2][4][2], const Unit& u, int wr, int wc, int fr, int fq) const {
        const int row0 = u.pm * BM + wr * 64 + fr, col0 = u.pn * HALF + wc * 32 + 8 * fq;
        const int slot = (u.pm >> 3) % 3;
        float rs[2][4];
        if (((const PG8_LAS int*)(RS + 768))[slot] == u.pm) {
            const PG8_LAS float* rsp = RS + slot * 256 + wr * 64 + fr;
#pragma unroll
            for (int ai = 0; ai < 2; ++ai)
#pragma unroll
                for (int m = 0; m < 4; ++m) rs[ai][m] = rsp[ai * HALF + m * 16];
        } else {
#pragma unroll
            for (int ai = 0; ai < 2; ++ai)
#pragma unroll
                for (int m = 0; m < 4; ++m) { const f32x4 pl = *(const f32x4*)(SSQ2 + (size_t)(row0 + ai * HALF + m * 16) * 16 + 4 * fq);
                    rs[ai][m] = rsqrtf(rsum_fq((pl[0] + pl[1]) + (pl[2] + pl[3])) * (1.0f / D) + EPS); }
        }
#pragma unroll
        for (int ai = 0; ai < 2; ++ai)
#pragma unroll
            for (int m = 0; m < 4; ++m) { const int row = row0 + ai * HALF + m * 16; const float r = rs[ai][m], r2 = r * r, c1 = -LOG2E * r;
                f32x4 h0, h1;
#pragma unroll
                for (int n = 0; n < 2; ++n)
#pragma unroll
                    for (int e = 0; e < 4; e += 2) { typedef float f32x2v __attribute__((ext_vector_type(2)));
                        const f32x2v gg2 = {acc[ai][0][m][n][e], acc[ai][0][m][n][e + 1]}, uu2 = {acc[ai][1][m][n][e], acc[ai][1][m][n][e + 1]};
                        const f32x2v cc = gg2 * c1; f32x2v ee; ee.x = __builtin_amdgcn_exp2f(cc.x); ee.y = __builtin_amdgcn_exp2f(cc.y);
                        const f32x2v dd = ee + 1.0f; f32x2v ss; ss.x = __builtin_amdgcn_rcpf(dd.x); ss.y = __builtin_amdgcn_rcpf(dd.y);
                        const f32x2v hh = ((gg2 * uu2) * r2) * ss;
                        if (n == 0) { h0[e] = hh.x; h0[e + 1] = hh.y; } else { h1[e] = hh.x; h1[e + 1] = hh.y; } }
                u32x4 w; w.x = cvt_pk_bf16(h0[0], h0[1]); w.y = cvt_pk_bf16(h0[2], h0[3]); w.z = cvt_pk_bf16(h1[0], h1[1]); w.w = cvt_pk_bf16(h1[2], h1[3]);
                *(u32x4*)(H + (size_t)row * DFF + col0) = w; }
    }
};
struct EpiUpFullLine {
    static constexpr int BMAP = 1;
    bf16_t* H; const PG8_LAS float* RS; const float* SSQ2;
    __device__ __forceinline__ void operator()(const f32x4 (&acc)[2][2][4][2], const Unit& u, int wr, int wc, int fr, int fq) const {
        const int row0 = u.pm * BM + wr * 64 + fr, col0 = u.pn * HALF + wc * 32 + 8 * fq;
        const int slot = (u.pm >> 3) % 3;
        float rs[2][4];
        if (((const PG8_LAS int*)(RS + 768))[slot] == u.pm) {
            const PG8_LAS float* rsp = RS + slot * 256 + wr * 64 + fr;
#pragma unroll
            for (int ai = 0; ai < 2; ++ai)
#pragma unroll
                for (int m = 0; m < 4; ++m) rs[ai][m] = rsp[ai * HALF + m * 16];
        } else {
#pragma unroll
            for (int ai = 0; ai < 2; ++ai)
#pragma unroll
                for (int m = 0; m < 4; ++m) { const f32x4 pl = *(const f32x4*)(SSQ2 + (size_t)(row0 + ai * HALF + m * 16) * 16 + 4 * fq);
                    rs[ai][m] = rsqrtf(rsum_fq((pl[0] + pl[1]) + (pl[2] + pl[3])) * (1.0f / D) + EPS); }
        }
#pragma unroll
        for (int ai = 0; ai < 2; ++ai)
#pragma unroll
            for (int m = 0; m < 4; ++m) { const int row = row0 + ai * HALF + m * 16; const float r = rs[ai][m], r2 = r * r, c1 = -LOG2E * r;
                f32x4 h0, h1;
#pragma unroll
                for (int n = 0; n < 2; ++n)
#pragma unroll
                    for (int e = 0; e < 4; e += 2) { typedef float f32x2v __attribute__((ext_vector_type(2)));
                        const f32x2v gg2 = {acc[ai][0][m][n][e], acc[ai][0][m][n][e + 1]}, uu2 = {acc[ai][1][m][n][e], acc[ai][1][m][n][e + 1]};
                        const f32x2v cc = gg2 * c1; f32x2v ee; ee.x = __builtin_amdgcn_exp2f(cc.x); ee.y = __builtin_amdgcn_exp2f(cc.y);
                        const f32x2v dd = ee + 1.0f; f32x2v ss; ss.x = __builtin_amdgcn_rcpf(dd.x); ss.y = __builtin_amdgcn_rcpf(dd.y);
                        const f32x2v hh = ((gg2 * uu2) * r2) * ss;
                        if (n == 0) { h0[e] = hh.x; h0[e + 1] = hh.y; } else { h1[e] = hh.x; h1[e + 1] = hh.y; } }
                u32x4 w; w.x = cvt_pk_bf16(h0[0], h0[1]); w.y = cvt_pk_bf16(h0[2], h0[3]); w.z = cvt_pk_bf16(h1[0], h1[1]); w.w = cvt_pk_bf16(h1[2], h1[3]);
                { const int l = fr + 16 * fq; *(u32x4*)(H + (size_t)(u.pm * BM + ai * HALF + wr * 64 + m * 16 + 8 * (wc & 1) + (l >> 3)) * DFF + u.pn * HALF + 64 * (wc >> 1) + (l & 7) * 8) = w; } }
    }
};
struct EpiDown {
    static constexpr int BMAP = 0;
    const bf16_t* X1B; float* out;
    __device__ __forceinline__ void operator()(const f32x4 (&acc)[2][2][4][2], const Unit& u, int wr, int wc, int fr, int fq) const {
        const int row0 = u.pm * BM + wr * 64 + fr, col0 = u.pn * BM + wc * 32 + 4 * fq;
        u32x2 xv[2][4][2][2];
#pragma unroll
        for (int ai = 0; ai < 2; ++ai)
#pragma unroll
            for (int m = 0; m < 4; ++m)
#pragma unroll
                for (int bj = 0; bj < 2; ++bj)
#pragma unroll
                    for (int n = 0; n < 2; ++n) xv[ai][m][bj][n] = *(const u32x2*)(X1B + (size_t)(row0 + ai * HALF + m * 16) * D + col0 + bj * HALF + n * 16);
#pragma unroll
        for (int ai = 0; ai < 2; ++ai)
#pragma unroll
            for (int m = 0; m < 4; ++m) { float* rowp = out + (size_t)(row0 + ai * HALF + m * 16) * D + col0;
#pragma unroll
                for (int bj = 0; bj < 2; ++bj)
#pragma unroll
                    for (int n = 0; n < 2; ++n) { const u32x2 x = xv[ai][m][bj][n];
                        const f32x4 r = {__uint_as_float(x.x << 16), __uint_as_float(x.x & 0xffff0000u), __uint_as_float(x.y << 16), __uint_as_float(x.y & 0xffff0000u)};
                        *(f32x4*)(rowp + bj * HALF + n * 16) = r + acc[ai][bj][m][n]; } }
    }
};
struct EpiNone {
    static constexpr int BMAP = 1;
    __device__ __forceinline__ void operator()(const f32x4 (&acc)[2][2][4][2], const Unit& u, int wr, int wc, int fr, int fq) const {
#pragma unroll
        for (int ai = 0; ai < 2; ++ai)
#pragma unroll
            for (int bj = 0; bj < 2; ++bj)
#pragma unroll
                for (int m = 0; m < 4; ++m)
#pragma unroll
                    for (int n = 0; n < 2; ++n) asm volatile("" :: "v"(acc[ai][bj][m][n]));
    }
};


template <int MODE> struct EpiDownProbe {
    static constexpr int BMAP = 0;
    const bf16_t* X1B; float* out;
    __device__ __forceinline__ void operator()(const f32x4 (&acc)[2][2][4][2], const Unit& u, int wr, int wc, int fr, int fq) const {
        const int row0 = u.pm * BM + wr * 64 + fr, col0 = u.pn * BM + wc * 32 + 4 * fq;
        u32x2 xv[2][4][2][2];
#pragma unroll
        for (int ai = 0; ai < 2; ++ai)
#pragma unroll
            for (int m = 0; m < 4; ++m)
#pragma unroll
                for (int bj = 0; bj < 2; ++bj)
#pragma unroll
                    for (int n = 0; n < 2; ++n) { if (MODE == 2) xv[ai][m][bj][n] = *(const u32x2*)(X1B + (size_t)(row0 + ai * HALF + m * 16) * D + col0 + bj * HALF + n * 16); else xv[ai][m][bj][n] = (u32x2){0u, 0u}; }
#pragma unroll
        for (int ai = 0; ai < 2; ++ai)
#pragma unroll
            for (int m = 0; m < 4; ++m) { float* rowp = out + (size_t)(row0 + ai * HALF + m * 16) * D + col0;
#pragma unroll
                for (int bj = 0; bj < 2; ++bj)
#pragma unroll
                    for (int n = 0; n < 2; ++n) { const u32x2 x = xv[ai][m][bj][n];
                        const f32x4 r = {__uint_as_float(x.x << 16), __uint_as_float(x.x & 0xffff0000u), __uint_as_float(x.y << 16), __uint_as_float(x.y & 0xffff0000u)};
                        const f32x4 v = r + acc[ai][bj][m][n];
                        if (MODE == 1) __builtin_nontemporal_store(v, (f32x4*)(rowp + bj * HALF + n * 16)); else asm volatile("" :: "v"(v)); } }
    }
};

template <class Epi, class Sched, bool ALIGN_EPI, int KMODE = 0>
__device__ __forceinline__ void gemm_phase(PG8_LAS unsigned char* lds, const Gemm g, const Sched& S, const Epi& E) {
    int tid_ = threadIdx.x; asm volatile("" : "+v"(tid_));
    const int tid = tid_, wid = __builtin_amdgcn_readfirstlane(tid >> 6), lane = tid & 63, wr = wid >> 2, wc = wid & 3, fr = lane & 15, fq = lane >> 4;
    const int K = g.K, nt = K / BK;
    unsigned voffA[2], voffB[2];
#pragma unroll
    for (int i = 0; i < 2; ++i) { int R, C; stage_rc(tid * 16 + i * 8192, R, C);
        const int Rb = Epi::BMAP == 0 ? R : Epi::BMAP == 1 ? ((R & ~31) + perm32(R & 31)) : (64 * (R >> 5) + perm32(R & 31));
        voffA[i] = (unsigned)(R * K + C) * 2u; voffB[i] = (unsigned)(Rb * K + C) * 2u; }
    const size_t kstep = (size_t)(BK * 2);
    const size_t hstep = (size_t)HALF * K * 2;
    const size_t hstepB = Epi::BMAP == 2 ? (size_t)32 * K * 2 : hstep;
    const size_t tstep = 2 * hstep;
    const unsigned ldsw = (unsigned)wid * 1024u;
    const int aoff = lds_byte(wr * 64 + fr, fq * 8), boff = lds_byte(wc * 32 + fr, fq * 8);
#define PG8_SA(b, h) (((b) * 2 + (h)) * HTB)
#define PG8_SB(b, h) ((4 + (b) * 2 + (h)) * HTB)
#define PG8_STAGE(bufoff, gbase, voff) do { if (KMODE != 1) { _Pragma("unroll") for (int _i = 0; _i < 2; ++_i) \
        __builtin_amdgcn_global_load_lds((const unsigned*)((const char*)(KMODE == 2 ? (const void*)g.Bt : (const void*)(gbase)) + (voff)[_i]), (PG8_LAS unsigned*)(lds + (bufoff) + ldsw + _i * 8192), 16, 0, 0); } } while (0)
#define PG8_LDA(dst, b, h) do { if (KMODE != 3) { _Pragma("unroll") for (int m = 0; m < 4; ++m) _Pragma("unroll") for (int k = 0; k < 2; ++k) dst[m][k] = *(const PG8_LAS bf16x8*)(lds + PG8_SA(b, h) + aoff + m * 2048 + k * 1024); } else { _Pragma("unroll") for (int m = 0; m < 4; ++m) _Pragma("unroll") for (int k = 0; k < 2; ++k) asm volatile("" : "+v"(dst[m][k])); } } while (0)
#define PG8_LDB(dst, b, h) do { if (KMODE != 3) { _Pragma("unroll") for (int n = 0; n < 2; ++n) _Pragma("unroll") for (int k = 0; k < 2; ++k) dst[n][k] = *(const PG8_LAS bf16x8*)(lds + PG8_SB(b, h) + boff + n * 2048 + k * 1024); } else { _Pragma("unroll") for (int n = 0; n < 2; ++n) _Pragma("unroll") for (int k = 0; k < 2; ++k) asm volatile("" : "+v"(dst[n][k])); } } while (0)
#define PG8_MMA(ai, bj, At, Bt) do { __builtin_amdgcn_s_setprio(1); _Pragma("unroll") for (int m = 0; m < 4; ++m) _Pragma("unroll") for (int n = 0; n < 2; ++n) _Pragma("unroll") for (int k = 0; k < 2; ++k) \
        acc[ai][bj][m][n] = __builtin_amdgcn_mfma_f32_16x16x32_bf16(Bt[n][k], At[m][k], acc[ai][bj][m][n], 0, 0, 0); __builtin_amdgcn_s_setprio(0); } while (0)
#define PG8_WAIT_V(n) asm volatile("s_waitcnt vmcnt(" #n ")" ::: "memory")
#define PG8_WAIT_L(n) asm volatile("s_waitcnt lgkmcnt(" #n ")" ::: "memory")
#define PG8_BAR __builtin_amdgcn_s_barrier()
#define PG8_SCHED __builtin_amdgcn_sched_barrier(0)
    Unit cur, nxt; int ui = 0;
    if (!S.next(0, cur)) return;
    f32x4 acc[2][2][4][2];
#pragma unroll
    for (int a = 0; a < 2; ++a)
#pragma unroll
        for (int b = 0; b < 2; ++b)
#pragma unroll
            for (int m = 0; m < 4; ++m)
#pragma unroll
                for (int n = 0; n < 2; ++n) acc[a][b][m][n] = (f32x4){0.f, 0.f, 0.f, 0.f};
    bf16x8 At[4][2], B0[2][2], B1[2][2];
    if (KMODE == 3) { _Pragma("unroll") for (int m = 0; m < 4; ++m) _Pragma("unroll") for (int k = 0; k < 2; ++k) At[m][k] = (bf16x8){1, 2, 3, 4, 5, 6, 7, 8}; _Pragma("unroll") for (int n = 0; n < 2; ++n) _Pragma("unroll") for (int k = 0; k < 2; ++k) { B0[n][k] = (bf16x8){1, 2, 3, 4, 5, 6, 7, 8}; B1[n][k] = B0[n][k]; } }
    const char* cA = (const char*)g.A + (size_t)cur.pm * tstep; const char* cB = (const char*)g.Bt + (size_t)cur.pn * tstep;
    PG8_STAGE(PG8_SB(0, 0), cB, voffB); PG8_STAGE(PG8_SB(0, 1), cB + hstepB, voffB); PG8_STAGE(PG8_SA(0, 0), cA, voffA); PG8_STAGE(PG8_SA(0, 1), cA + hstep, voffA);
    if (wr == 1) PG8_BAR;
    PG8_WAIT_V(2); PG8_BAR;
    PG8_STAGE(PG8_SB(1, 0), cB + kstep, voffB); PG8_STAGE(PG8_SA(1, 0), cA + kstep, voffA); PG8_STAGE(PG8_SB(1, 1), cB + hstepB + kstep, voffB);
    PG8_WAIT_V(6); PG8_BAR;
    for (;;) {
        const bool has_next = S.next(ui + 1, nxt);
        const char* nA = has_next ? (const char*)g.A + (size_t)nxt.pm * tstep : cA; const char* nB = has_next ? (const char*)g.Bt + (size_t)nxt.pn * tstep : cB;
        for (int t = 0; t < nt; t += 2) {
            const bool last = (t == nt - 2);
            const char* a1 = cA + (size_t)(t + 1) * kstep;
            const char* a2 = last ? nA : cA + (size_t)(t + 2) * kstep; const char* b2 = last ? nB : cB + (size_t)(t + 2) * kstep;
            const char* a3 = a2 + kstep; const char* b3 = b2 + kstep;
            if constexpr (KMODE == 4) {
            PG8_LDB(B0, 0, 0); PG8_LDB(B1, 0, 1); PG8_SCHED; PG8_LDA(At, 0, 0);
            PG8_WAIT_V(6); PG8_WAIT_L(0); PG8_BAR; PG8_STAGE(PG8_SA(1, 1), a1 + hstep, voffA); PG8_MMA(0, 0, At, B0); PG8_MMA(0, 1, At, B1); PG8_BAR; PG8_SCHED;
            PG8_LDA(At, 0, 1);
            PG8_WAIT_V(2); PG8_WAIT_L(0); PG8_BAR; PG8_STAGE(PG8_SB(0, 0), b2, voffB); PG8_STAGE(PG8_SB(0, 1), b2 + hstepB, voffB); PG8_STAGE(PG8_SA(0, 0), a2, voffA); PG8_MMA(1, 0, At, B0); PG8_MMA(1, 1, At, B1); PG8_BAR; PG8_SCHED;
            PG8_LDB(B0, 1, 0); PG8_LDB(B1, 1, 1); PG8_SCHED; PG8_LDA(At, 1, 0);
            PG8_WAIT_V(6); PG8_WAIT_L(0); PG8_BAR; PG8_STAGE(PG8_SA(0, 1), a2 + hstep, voffA); PG8_MMA(0, 0, At, B0); PG8_MMA(0, 1, At, B1); PG8_BAR; PG8_SCHED;
            PG8_LDA(At, 1, 1);
            PG8_WAIT_V(2); PG8_WAIT_L(0); PG8_BAR; PG8_STAGE(PG8_SB(1, 0), b3, voffB); PG8_STAGE(PG8_SB(1, 1), b3 + hstepB, voffB); PG8_STAGE(PG8_SA(1, 0), a3, voffA); PG8_MMA(1, 0, At, B0); PG8_MMA(1, 1, At, B1); PG8_BAR; PG8_SCHED;
            } else {
            PG8_LDB(B0, 0, 0); PG8_LDB(B1, 0, 1); PG8_SCHED; PG8_LDA(At, 0, 0); PG8_STAGE(PG8_SA(1, 1), a1 + hstep, voffA);
            PG8_WAIT_V(8); PG8_WAIT_L(0); PG8_BAR; PG8_MMA(0, 0, At, B0); PG8_MMA(0, 1, At, B1); PG8_BAR; PG8_SCHED;
            PG8_LDA(At, 0, 1); PG8_STAGE(PG8_SB(0, 0), b2, voffB); PG8_STAGE(PG8_SB(0, 1), b2 + hstepB, voffB); PG8_STAGE(PG8_SA(0, 0), a2, voffA);
            PG8_WAIT_V(8); PG8_WAIT_L(0); PG8_BAR; PG8_MMA(1, 0, At, B0); PG8_MMA(1, 1, At, B1); PG8_BAR; PG8_SCHED;
            PG8_LDB(B0, 1, 0); PG8_LDB(B1, 1, 1); PG8_SCHED; PG8_LDA(At, 1, 0); PG8_STAGE(PG8_SA(0, 1), a2 + hstep, voffA);
            PG8_WAIT_V(8); PG8_WAIT_L(0); PG8_BAR; PG8_MMA(0, 0, At, B0); PG8_MMA(0, 1, At, B1); PG8_BAR; PG8_SCHED;
            PG8_LDA(At, 1, 1); PG8_STAGE(PG8_SB(1, 0), b3, voffB); PG8_STAGE(PG8_SB(1, 1), b3 + hstepB, voffB); PG8_STAGE(PG8_SA(1, 0), a3, voffA);
            PG8_WAIT_V(8); PG8_WAIT_L(0); PG8_BAR; PG8_MMA(1, 0, At, B0); PG8_MMA(1, 1, At, B1); PG8_BAR; PG8_SCHED;
                    }
        }
        if constexpr (ALIGN_EPI) { if (wr == 0) PG8_BAR; }
        E(acc, cur, wr, wc, fr, fq);
        if (!has_next) break;
#pragma unroll
        for (int a = 0; a < 2; ++a)
#pragma unroll
            for (int b = 0; b < 2; ++b)
#pragma unroll
                for (int m = 0; m < 4; ++m)
#pragma unroll
                    for (int n = 0; n < 2; ++n) acc[a][b][m][n] = (f32x4){0.f, 0.f, 0.f, 0.f};
        cur = nxt; cA = nA; cB = nB; ++ui;
        if constexpr (ALIGN_EPI) { if (wr == 1) PG8_BAR; }
    }
    PG8_WAIT_V(0);
    if constexpr (!ALIGN_EPI) { if (wr == 0) PG8_BAR; }
    PG8_BAR;
#undef PG8_SA
#undef PG8_SB
#undef PG8_STAGE
#undef PG8_LDA
#undef PG8_LDB
#undef PG8_MMA
#undef PG8_WAIT_V
#undef PG8_WAIT_L
#undef PG8_BAR
#undef PG8_SCHED
}
}
#define LAS __attribute__((address_space(3)))

struct Args;
__device__ __forceinline__ void p0_prologue_naive(const float* const* in, unsigned char* ws, int G) {
    const size_t gt = (size_t)blockIdx.x * 512 + threadIdx.x, GT = (size_t)G * 512;
    for (size_t i = gt; i < NPREP; i += GT) prep_w_elem(i, in[4], in[13], in[15], in[16], in[17], in[9], in[14], ws);
    const int wave = threadIdx.x >> 6, lane = threadIdx.x & 63;
    for (int m = blockIdx.x * 8 + wave; m < M; m += G * 8) xn_row(m, lane, in[0], in[1], in[3], (bf16_t*)(ws + WS_XN));
}


__device__ __forceinline__ unsigned pk2(float lo, float hi) { return f2bf(lo) | (f2bf(hi) << 16); }
__device__ __forceinline__ void p0_item(const float* W, int K, int N, bf16_t* WT, int orow0, const float* kscale, LAS float* scr, int k0, int n0, int lane) {
    typedef unsigned v4u __attribute__((ext_vector_type(4)));
    float wv[32];
#pragma unroll
    for (int i = 0; i < 32; ++i) wv[i] = W[(size_t)(k0 + 2 * i + (lane >> 5)) * N + n0 + (lane & 31)];
    if (kscale) {
#pragma unroll
        for (int i = 0; i < 32; ++i) wv[i] *= kscale[k0 + 2 * i + (lane >> 5)]; }
#pragma unroll
    for (int i = 0; i < 32; ++i) scr[(2 * i + (lane >> 5)) * 33 + (lane & 31)] = wv[i];
    asm volatile("s_waitcnt lgkmcnt(0)" ::: "memory");
    const int c = lane & 7;
#pragma unroll
    for (int j = 0; j < 4; ++j) { const int n = (lane >> 3) + 8 * j; const LAS float* s = scr + (8 * c) * 33 + n;
        v4u o; o.x = pk2(s[0 * 33], s[1 * 33]); o.y = pk2(s[2 * 33], s[3 * 33]); o.z = pk2(s[4 * 33], s[5 * 33]); o.w = pk2(s[6 * 33], s[7 * 33]);
        *(v4u*)(WT + (size_t)(orow0 + n) * K + k0 + 8 * c) = o; }
    asm volatile("s_waitcnt lgkmcnt(0)" ::: "memory");
}
__device__ __forceinline__ void p0_weights(const float* const* in, unsigned char* ws, LAS unsigned char* lds, int it_lo, int it_hi, int w, int nw) {
    const int wave = __builtin_amdgcn_readfirstlane(threadIdx.x >> 6), lane = threadIdx.x & 63;
    LAS float* scr = (LAS float*)(lds + wave * 16384);
    constexpr int I_IN = (D / 64) * (INW / 32), I_O = (D / 64) * (D / 32), I_G = (D / 64) * (DFF / 32);
    bf16_t* WIN = (bf16_t*)(ws + WS_WIN); bf16_t* WO = (bf16_t*)(ws + WS_WO); bf16_t* WGU = (bf16_t*)(ws + WS_WGU); bf16_t* WDN = (bf16_t*)(ws + WS_WDN);
    for (int it = it_lo + w; it < it_hi; it += nw) {
        int r = it;
        if (r < I_IN) { const int nb = r % (INW / 32), kb = r / (INW / 32); p0_item(in[4], D, INW, WIN, 32 * nb, in[3], scr, 64 * kb, 32 * nb, lane); continue; } r -= I_IN;
        if (r < I_O) { const int nb = r % (D / 32), kb = r / (D / 32); p0_item(in[13], D, D, WO, 32 * nb, nullptr, scr, 64 * kb, 32 * nb, lane); continue; } r -= I_O;
        if (r < 2 * I_G) { const int up = r >= I_G; if (up) r -= I_G; const int nb = r % (DFF / 32), kb = r / (DFF / 32), n0 = 32 * nb;
            p0_item(in[up ? 16 : 15], D, DFF, WGU, 256 * (n0 >> 7) + (n0 & 127) + 128 * up, in[14], scr, 64 * kb, n0, lane); continue; } r -= 2 * I_G;
        { const int nb = r % (D / 32), kb = r / (D / 32); p0_item(in[17], DFF, D, WDN, 32 * nb, nullptr, scr, 64 * kb, 32 * nb, lane); }
    }
}
constexpr int P0_I_IN = (D / 64) * (INW / 32), P0_NITEMS = P0_I_IN + (D / 64) * (D / 32) + 2 * (D / 64) * (DFF / 32) + (DFF / 64) * (D / 32);
__device__ __forceinline__ void p0_prologue(const float* const* in, unsigned char* ws, LAS unsigned char* lds, int G) {
    const int wave = __builtin_amdgcn_readfirstlane(threadIdx.x >> 6), lane = threadIdx.x & 63;
    const int gw = (int)blockIdx.x * 8 + wave, NGW = G * 8;
    p0_weights(in, ws, lds, 0, MK_LATE_WEIGHTS ? P0_I_IN : P0_NITEMS, gw, NGW);
    { const size_t gt = (size_t)blockIdx.x * 512 + threadIdx.x; bf16_t* WSB = (bf16_t*)(ws + WS_WS); for (size_t i = gt; i < 8 * 128 * 128; i += (size_t)G * 512) WSB[i] = f2bf(in[9][i]); }
    typedef float f32x4 __attribute__((ext_vector_type(4)));
    bf16_t* XB = (bf16_t*)(ws + WS_XN); float* RS1 = (float*)(ws + WS_RS1);
    for (int m4 = gw * 4; m4 < M; m4 += NGW * 4) {
        const f32x4* xr = (const f32x4*)(m4 < MP ? in[0] + (size_t)m4 * D : in[1] + (size_t)(m4 - MP) * D) + lane;
        f32x4 v[4][4]; float ss[4];
#pragma unroll
        for (int r = 0; r < 4; ++r)
#pragma unroll
            for (int j = 0; j < 4; ++j) v[r][j] = __builtin_nontemporal_load(xr + r * (D / 4) + 64 * j);
#pragma unroll
        for (int r = 0; r < 4; ++r) { ss[r] = 0.f;
            unsigned long long* b8 = (unsigned long long*)(XB + (size_t)(m4 + r) * D) + lane;
#pragma unroll
            for (int j = 0; j < 4; ++j) { ss[r] += (v[r][j][0] * v[r][j][0] + v[r][j][1] * v[r][j][1]) + (v[r][j][2] * v[r][j][2] + v[r][j][3] * v[r][j][3]);
                b8[64 * j] = (unsigned long long)pk2(v[r][j][0], v[r][j][1]) | ((unsigned long long)pk2(v[r][j][2], v[r][j][3]) << 32); } }
#pragma unroll
        for (int o = 1; o < 64; o <<= 1) {
#pragma unroll
            for (int r = 0; r < 4; ++r) ss[r] += __shfl_xor(ss[r], o); }
        if (lane < 4) RS1[m4 + lane] = rsqrtf((lane == 0 ? ss[0] : lane == 1 ? ss[1] : lane == 2 ? ss[2] : ss[3]) * (1.0f / D) + EPS);
    }
}

__device__ __forceinline__ void p2_mixer_naive(const float* const* in, unsigned char* ws, unsigned char* lds_generic, int G) {
    MixNaiveLds* L = (MixNaiveLds*)lds_generic + (threadIdx.x >> 8);
    for (int pr = blockIdx.x; pr < M / 2; pr += G)
        mix_naive_token(2 * pr + (threadIdx.x >> 8), threadIdx.x & 255, *L, (const bf16_t*)(ws + WS_PROJ), (const float*)(ws + WS_VSSQ), (const bf16_t*)(ws + WS_WS), in[2], in[7], in[8], in[10], in[11], in[12], (bf16_t*)(ws + WS_MIX));
}

static void launch_naive_phase(int p, void* const* d_in, float* out, unsigned char* ws, hipStream_t stream) {
    const float* xp = (const float*)d_in[0]; const float* xs = (const float*)d_in[1]; const float* rel = (const float*)d_in[2]; const float* norm1 = (const float*)d_in[3];
    const float* w_in = (const float*)d_in[4]; const float* qg = (const float*)d_in[5]; const float* kg = (const float*)d_in[6]; const float* sink = (const float*)d_in[7];
    const float* vg = (const float*)d_in[8]; const float* w_s = (const float*)d_in[9]; const float* b_s = (const float*)d_in[10]; const float* ag = (const float*)d_in[11];
    const float* gg = (const float*)d_in[12]; const float* w_o = (const float*)d_in[13]; const float* norm2 = (const float*)d_in[14]; const float* w_gate = (const float*)d_in[15];
    const float* w_up = (const float*)d_in[16]; const float* w_down = (const float*)d_in[17];
    bf16_t* WIN = (bf16_t*)(ws + WS_WIN); bf16_t* WO = (bf16_t*)(ws + WS_WO); bf16_t* WGU = (bf16_t*)(ws + WS_WGU); bf16_t* WDN = (bf16_t*)(ws + WS_WDN); bf16_t* WSB = (bf16_t*)(ws + WS_WS);
    float* VSSQ = (float*)(ws + WS_VSSQ); float* SSQ2 = (float*)(ws + WS_SSQ2);
    bf16_t* XN = (bf16_t*)(ws + WS_XN); bf16_t* PROJ = (bf16_t*)(ws + WS_PROJ); bf16_t* H = (bf16_t*)(ws + WS_H); bf16_t* MIX = (bf16_t*)(ws + WS_MIX); bf16_t* X1B = (bf16_t*)(ws + WS_X1B);
    switch (p) {
    case 0: k_prep_w<<<(unsigned)((NPREP + 255) / 256), 256, 0, stream>>>(w_in, w_o, w_gate, w_up, w_down, w_s, norm2, ws);
            k_xn<<<M / 4, 256, 0, stream>>>(xp, xs, norm1, XN); break;
    case 1: k_gemm_naive<NEpiIn, false><<<dim3(INW / 64, M / 64), 256, 0, stream>>>(XN, WIN, D, NEpiIn{PROJ, VSSQ, qg, kg}); break;
    case 2: k_mix_naive<<<M, 256, 0, stream>>>(PROJ, VSSQ, WSB, rel, sink, vg, b_s, ag, gg, MIX); break;
    case 3: k_gemm_naive<NEpiOut, false><<<dim3(D / 64, M / 64), 256, 0, stream>>>(MIX, WO, D, NEpiOut{xp, xs, out, X1B, SSQ2}); break;
    case 4: k_gemm_naive<NEpiUp, true><<<dim3(DFF / 64, M / 64), 256, 0, stream>>>(X1B, WGU, D, NEpiUp{H, SSQ2}); break;
    case 5: k_gemm_naive<NEpiDown, false><<<dim3(D / 64, M / 64), 256, 0, stream>>>(H, WDN, DFF, NEpiDown{out}); break;
    }
}

namespace mix {
typedef short bf16x8 __attribute__((ext_vector_type(8)));
typedef short s16x4 __attribute__((ext_vector_type(4)));
typedef float f32x16 __attribute__((ext_vector_type(16)));
typedef float f32x4 __attribute__((ext_vector_type(4)));
typedef unsigned u32x2 __attribute__((ext_vector_type(2)));
typedef unsigned u32x4 __attribute__((ext_vector_type(4)));
typedef float f32x2_t __attribute__((ext_vector_type(2))); typedef __bf16 bf16x2_t __attribute__((ext_vector_type(2)));
constexpr int L_K = 0, L_V = 40960, L_TAB = 81920, TABN = 392, L_RV = L_TAB + 8 * 4 * TABN * 4, L_SS = L_RV + 512, L_END = L_SS + 2048, L_UA = 65536, L_UB = L_END, L_END2 = L_UB + 16384, L_PAR = L_END2, L_END3 = L_PAR + 2560 * 4;
constexpr int NUNITS = NSEQ * (SEQ / 64);
__device__ __forceinline__ unsigned cvtpk(float lo, float hi) { f32x2_t v = {lo, hi}; bf16x2_t b = __builtin_convertvector(v, bf16x2_t); return __builtin_bit_cast(unsigned, b); }
__device__ __forceinline__ s16x4 trrd(const LAS unsigned char* p) { typedef short v4i16_t __attribute__((ext_vector_type(4))); return __builtin_bit_cast(s16x4, __builtin_amdgcn_ds_read_tr16_b64_v4i16((LAS v4i16_t*)p)); }
__device__ __forceinline__ float xhalf_sum(float v) { auto rr = __builtin_amdgcn_permlane32_swap(__float_as_uint(v), __float_as_uint(v), false, false); return __uint_as_float(rr[0]) + __uint_as_float(rr[1]); }
__device__ __forceinline__ float xhalf_max(float v) { auto rr = __builtin_amdgcn_permlane32_swap(__float_as_uint(v), __float_as_uint(v), false, false); return fmaxf(__uint_as_float(rr[0]), __uint_as_float(rr[1])); }


__device__ __forceinline__ void store_pairs(bf16_t* p, const u32x2 (&w)[4], int hi, bool skip = false) {
    if (skip) { asm volatile("" :: "v"(w[0].x), "v"(w[1].x), "v"(w[2].x), "v"(w[3].x)); return; }
#pragma unroll
    for (int k = 0; k < 4; k += 2) {
        auto rx = __builtin_amdgcn_permlane32_swap(w[k].x, w[k + 1].x, false, false); auto ry = __builtin_amdgcn_permlane32_swap(w[k].y, w[k + 1].y, false, false);
        const u32x4 v = {rx[0], ry[0], rx[1], ry[1]};
        *(u32x4*)(p + 8 * (k + hi)) = v;
    }
}

template <int MODE> __device__ __forceinline__ void stage_rows(LAS unsigned char* img, const bf16_t* src, int row_lo, int row_hi, int wave, int lane, bool nodma) {
    if (nodma) return;
    for (int r8 = (row_lo >> 3) + wave; r8 < (row_hi >> 3); r8 += 8) {
        const int row = 8 * r8 + (lane >> 3), pc = lane & 7, c = MODE == 0 ? (pc ^ ((row >> 1) & 7)) : (pc ^ (((row >> 1) & 1) << 2));
        __builtin_amdgcn_global_load_lds((const unsigned*)(src + (size_t)row * INW + 8 * c), (LAS unsigned*)(img + r8 * 1024), 16, 0, 0);
    }
}


template <bool FAST> __device__ __forceinline__ void attn_tiles(LAS unsigned char* lds, const bf16x8 (&qf)[4], const LAS float* tbp, int kt_lo, int kt_hi, const int (&koff)[4], const int (&voff)[2], int hi, f32x16& o0r, f32x16& o1r) {
    float m = 0.0f, l = hi == 0 ? 1.0f : 0.0f;
    f32x16 o0 = {}, o1 = {};
    for (int kt = kt_lo; kt < kt_hi; ++kt) {
        f32x16 p0, p1;
        { const LAS float* tp = tbp + 64 * kt;
#pragma unroll
          for (int gq = 0; gq < 4; ++gq) { const f32x4 a = *(const LAS f32x4*)(tp + 8 * gq), b = *(const LAS f32x4*)(tp + 32 + 8 * gq);
#pragma unroll
              for (int e = 0; e < 4; ++e) { p0[4 * gq + e] = a[e]; p1[4 * gq + e] = b[e]; } } }
        const LAS unsigned char* kb = lds + L_K + kt * 8192;
#pragma unroll
        for (int d0 = 0; d0 < 4; ++d0) { const bf16x8 k0 = *(const LAS bf16x8*)(kb + koff[d0]), k1 = *(const LAS bf16x8*)(kb + 4096 + koff[d0]);
            p0 = __builtin_amdgcn_mfma_f32_32x32x16_bf16(k0, qf[d0], p0, 0, 0, 0); p1 = __builtin_amdgcn_mfma_f32_32x32x16_bf16(k1, qf[d0], p1, 0, 0, 0); }
        const LAS unsigned char* vb = lds + L_V + kt * 8192;
        bf16x8 vf0[2][2];
#pragma unroll
        for (int sI = 0; sI < 2; ++sI)
#pragma unroll
            for (int dh = 0; dh < 2; ++dh) { const LAS unsigned char* vp = vb + (16 * sI) * 128 + voff[dh];
                const s16x4 lo = trrd(vp), hi4 = trrd(vp + 8 * 128); vf0[sI][dh] = (bf16x8){lo[0], lo[1], lo[2], lo[3], hi4[0], hi4[1], hi4[2], hi4[3]}; }
        float ls = 0.f;
        if (FAST) {
#pragma unroll
            for (int r = 0; r < 16; ++r) { p0[r] = __builtin_amdgcn_exp2f(p0[r]); p1[r] = __builtin_amdgcn_exp2f(p1[r]); }
            { f32x2_t l2 = {0.f, 0.f};
#pragma unroll
              for (int r = 0; r < 16; r += 2) l2 += (f32x2_t){p0[r], p0[r + 1]} + (f32x2_t){p1[r], p1[r + 1]};
              ls = l2.x + l2.y; }
            l += ls;
        } else {
            float rm = fmaxf(p0[0], p1[0]);
#pragma unroll
            for (int r = 1; r < 16; ++r) rm = fmaxf(rm, fmaxf(p0[r], p1[r]));
            rm = xhalf_max(rm);
            const float mn = fmaxf(m, rm), alpha = __builtin_amdgcn_exp2f(m - mn); m = mn;
#pragma unroll
            for (int r = 0; r < 16; ++r) { p0[r] = __builtin_amdgcn_exp2f(p0[r] - m); p1[r] = __builtin_amdgcn_exp2f(p1[r] - m); ls += p0[r] + p1[r]; }
            l = l * alpha + ls;
#pragma unroll
            for (int r = 0; r < 16; ++r) { o0[r] *= alpha; o1[r] *= alpha; }
        }
        u32x4 pw[2][2];
#pragma unroll
        for (int sI = 0; sI < 2; ++sI) { pw[0][sI] = (u32x4){cvtpk(p0[8 * sI], p0[8 * sI + 1]), cvtpk(p0[8 * sI + 2], p0[8 * sI + 3]), cvtpk(p0[8 * sI + 4], p0[8 * sI + 5]), cvtpk(p0[8 * sI + 6], p0[8 * sI + 7])};
                                         pw[1][sI] = (u32x4){cvtpk(p1[8 * sI], p1[8 * sI + 1]), cvtpk(p1[8 * sI + 2], p1[8 * sI + 3]), cvtpk(p1[8 * sI + 4], p1[8 * sI + 5]), cvtpk(p1[8 * sI + 6], p1[8 * sI + 7])}; }
#pragma unroll
        for (int sI = 0; sI < 2; ++sI) { const bf16x8 pf = __builtin_bit_cast(bf16x8, pw[0][sI]);
            o0 = __builtin_amdgcn_mfma_f32_32x32x16_bf16(vf0[sI][0], pf, o0, 0, 0, 0); o1 = __builtin_amdgcn_mfma_f32_32x32x16_bf16(vf0[sI][1], pf, o1, 0, 0, 0); }
#pragma unroll
        for (int sI = 0; sI < 2; ++sI) { const bf16x8 pf = __builtin_bit_cast(bf16x8, pw[1][sI]);
#pragma unroll
            for (int dh = 0; dh < 2; ++dh) { const LAS unsigned char* vp = vb + (32 + 16 * sI) * 128 + voff[dh];
                const s16x4 lo = trrd(vp), hi4 = trrd(vp + 8 * 128); const bf16x8 vf = {lo[0], lo[1], lo[2], lo[3], hi4[0], hi4[1], hi4[2], hi4[3]};
                if (dh == 0) o0 = __builtin_amdgcn_mfma_f32_32x32x16_bf16(vf, pf, o0, 0, 0, 0); else o1 = __builtin_amdgcn_mfma_f32_32x32x16_bf16(vf, pf, o1, 0, 0, 0); } }
    }
    const float inv = 1.0f / xhalf_sum(l);
#pragma unroll
    for (int r = 0; r < 16; ++r) { o0[r] *= inv; o1[r] *= inv; }
    o0r = o0; o1r = o1;
}

__device__ __forceinline__ void p2_mixer(const float* const* in, unsigned char* ws, LAS unsigned char* lds, int G, int pflags) {
    const bool nodma = pflags & 1;
    const int tid = threadIdx.x, wave = __builtin_amdgcn_readfirstlane(tid >> 6), lane = tid & 63, r32 = lane & 31, hi = lane >> 5, hq = wave >> 1, tb = wave & 1;
    const bf16_t* PROJ = (const bf16_t*)(ws + WS_PROJ); const float* VSSQ = (const float*)(ws + WS_VSSQ); const bf16_t* WSB = (const bf16_t*)(ws + WS_WS); bf16_t* MIX = (bf16_t*)(ws + WS_MIX);
    const float* rel_table = in[2]; const float* sink = in[7]; const float* v_gain = in[8]; const float* b_s = in[10]; const float* ag = in[11]; const float* gg = in[12];
    LAS float* TAB = (LAS float*)(lds + L_TAB); LAS float* RV = (LAS float*)(lds + L_RV); LAS float* SS = (LAS float*)(lds + L_SS);
    { LAS float* RT = (LAS float*)(lds + L_K);
      if (tid < 256) RT[tid] = rel_table[tid]; else if (tid < 264) RT[tid] = sink[tid - 256];
      __syncthreads();
      for (int i = tid; i < 8 * 4 * TABN; i += 512) { const int h = i / (4 * TABN), rem = i % (4 * TABN), sh = rem / TABN, e = rem % TABN, bi = e + sh - 64;
          TAB[i] = (bi >= 0 && bi <= 256) ? (RT[t5_bucket(bi - 128) * 8 + h] - RT[256 + h]) * LOG2E : -1e30f; }
      LAS float* PAR = (LAS float*)(lds + L_PAR);
      PAR[tid] = ag[tid]; PAR[512 + tid] = gg[tid]; PAR[1024 + tid] = v_gain[tid]; PAR[1536 + tid] = b_s[tid]; PAR[2048 + tid] = b_s[512 + tid]; }
    const LAS float* PAG = (const LAS float*)(lds + L_PAR); const LAS float* PGG = PAG + 512; const LAS float* PVG = PAG + 1024; const LAS float* PBS = PAG + 1536;
    bool fast;
    { float mq = fabsf(in[5][lane]), mk = fabsf(in[6][lane]), mb = fmaxf(fmaxf(fabsf(rel_table[lane]), fabsf(rel_table[64 + lane])), fmaxf(fabsf(rel_table[128 + lane]), fabsf(rel_table[192 + lane]))), ms = fabsf(sink[lane & 7]);
#pragma unroll
      for (int o = 1; o < 64; o <<= 1) { mq = fmaxf(mq, __shfl_xor(mq, o)); mk = fmaxf(mk, __shfl_xor(mk, o)); mb = fmaxf(mb, __shfl_xor(mb, o)); ms = fmaxf(ms, __shfl_xor(ms, o)); }
      const float bound = (8.0f * mq * mk * 1.02f + mb + ms) * LOG2E;
      fast = __builtin_amdgcn_readfirstlane((int)(bound < 100.0f)) != 0; }
    int koff[4], voff[2], gvoff[2];
    { const int q = (lane & 15) >> 2, sw = (q >> 1) & 1;
#pragma unroll
      for (int d0 = 0; d0 < 4; ++d0) koff[d0] = r32 * 128 + (((2 * d0 + hi) ^ ((r32 >> 1) & 7)) << 4);
#pragma unroll
      for (int dh = 0; dh < 2; ++dh) { const int ch = 4 * (dh ^ sw) + 2 * ((lane >> 4) & 1) + ((lane & 3) >> 1);
          voff[dh] = (4 * hi + q) * 128 + ch * 16 + (lane & 1) * 8; gvoff[dh] = (8 * hi + q) * 128 + ch * 16 + (lane & 1) * 8; } }
    const int e0 = 64 - 32 * tb - r32 + 4 * hi, sh = e0 & 3;
    const int vcu = (G % 8 == 0) ? ((int)blockIdx.x % 8) * (G / 8) + (int)blockIdx.x / 8 : (int)blockIdx.x;

    for (int u = vcu; u < NUNITS; u += G) {
        const int s = u >> 6, t0 = (u & 63) * 64, m0 = s * SEQ + t0;
        const int kt_lo = t0 < 128 ? (128 - t0) >> 6 : 0, kt_hi = (pflags & 2) ? kt_lo : (t0 + 192 > SEQ ? (SEQ + 128 - t0) >> 6 : 5);
        const int mc = m0 - (t0 & 127), pbase = (t0 & 127) + 32 * tb + r32;
        const size_t mrow = (size_t)(m0 + 32 * tb + r32);
        f32x16 oa[2][2];
        __syncthreads();
        if (tid < 128) { const f32x4* vp = (const f32x4*)(VSSQ + (size_t)(mc + tid) * 8); const f32x4 a = vp[0] + vp[1]; RV[tid] = rsqrtf(((a[0] + a[1]) + (a[2] + a[3])) * (1.0f / 512.0f) + EPS); }
#pragma unroll
        for (int g = 0; g < 2; ++g) {
            const int h = 4 * g + hq;
            if (g == 1) __syncthreads();
            { const bf16_t* krow0 = PROJ + (long)(m0 - 128) * INW + 512 + 64 * g;
              stage_rows<0>(lds + L_K, krow0, 64 * kt_lo, 64 * kt_hi, wave, lane, nodma);
              stage_rows<1>(lds + L_V, krow0 + 128, 64 * kt_lo, 64 * kt_hi, wave, lane, nodma); }
            bf16x8 qf[4];
#pragma unroll
            for (int d0 = 0; d0 < 4; ++d0) qf[d0] = *(const bf16x8*)(PROJ + mrow * INW + 64 * h + 16 * d0 + 8 * hi);
            __syncthreads();
            f32x16 o0, o1;
            { const LAS float* tbp = TAB + (h * 4 + sh) * TABN + (e0 - sh);
              if (fast) attn_tiles<true>(lds, qf, tbp, kt_lo, kt_hi, koff, voff, hi, o0, o1); else attn_tiles<false>(lds, qf, tbp, kt_lo, kt_hi, koff, voff, hi, o0, o1); }
            oa[g][0] = o0; oa[g][1] = o1;
        }
        { float ss = 0.f;
#pragma unroll
          for (int g = 0; g < 2; ++g)
#pragma unroll
              for (int dh = 0; dh < 2; ++dh)
#pragma unroll
                  for (int r = 0; r < 16; ++r) ss += oa[g][dh][r] * oa[g][dh][r];
          ss = xhalf_sum(ss); if (hi == 0) SS[wave * 32 + r32] = ss; }
        __syncthreads();
        { const bf16_t* vrow0 = PROJ + (size_t)mc * INW + 1280;
#pragma unroll
          for (int hh = 0; hh < 4; ++hh) stage_rows<1>(lds + hh * 16384, vrow0 + 64 * hh, 0, 128, wave, lane, nodma);
          const bf16_t* urow0 = PROJ + (size_t)m0 * INW + 768;
#pragma unroll
          for (int hh = 0; hh < 4; ++hh) stage_rows<0>(lds + (hh < 2 ? L_UA + hh * 8192 : L_UB + (hh - 2) * 8192), urow0 + 64 * hh, 0, 64, wave, lane, nodma); }
        { const float tot = (SS[tb * 32 + r32] + SS[(2 + tb) * 32 + r32]) + (SS[(4 + tb) * 32 + r32] + SS[(6 + tb) * 32 + r32]);
          const float ra = rsqrtf(tot * (1.0f / 512.0f) + EPS);
#pragma unroll
          for (int g = 0; g < 2; ++g)
#pragma unroll
              for (int dh = 0; dh < 2; ++dh)
                  { u32x2 w[4];
#pragma unroll
                    for (int gq = 0; gq < 4; ++gq) { const int col = 64 * (4 * g + hq) + 32 * dh + 8 * gq + 4 * hi; const f32x4 gn = *(const LAS f32x4*)(PAG + col);
                      const f32x2_t s0 = ((f32x2_t){oa[g][dh][4 * gq], oa[g][dh][4 * gq + 1]} * ra) * (f32x2_t){gn[0], gn[1]}, s1 = ((f32x2_t){oa[g][dh][4 * gq + 2], oa[g][dh][4 * gq + 3]} * ra) * (f32x2_t){gn[2], gn[3]};
                      w[gq].x = cvtpk(s0.x, s0.y); w[gq].y = cvtpk(s1.x, s1.y); }
                    store_pairs(MIX + mrow * D + 64 * (4 * g + hq) + 32 * dh, w, hi, pflags & 8); } }
        f32x16 og[2][2];
#pragma unroll
        for (int rd = 0; rd < 2; ++rd) {
            const int hh = 4 * rd + hq;
            if (rd == 1) { __syncthreads();
                const bf16_t* vrow0 = PROJ + (size_t)mc * INW + 1280 + 256;
#pragma unroll
                for (int h4 = 0; h4 < 4; ++h4) stage_rows<1>(lds + h4 * 16384, vrow0 + 64 * h4, 0, 128, wave, lane, nodma);
                const bf16_t* urow0 = PROJ + (size_t)m0 * INW + 768 + 256;
#pragma unroll
                for (int h4 = 0; h4 < 4; ++h4) stage_rows<0>(lds + (h4 < 2 ? L_UA + h4 * 8192 : L_UB + (h4 - 2) * 8192), urow0 + 64 * h4, 0, 64, wave, lane, nodma); }
            bf16x8 wf[8];
            { const bf16_t* wrow = WSB + ((size_t)hh * 128 + pbase) * 128 + 8 * hi;
#pragma unroll
              for (int sI = 0; sI < 8; ++sI) wf[sI] = *(const bf16x8*)(wrow + 16 * sI); }
            __syncthreads();
            f32x16 a0 = {}, a1 = {};
            const LAS unsigned char* gb = lds + hq * 16384;
            if (!(pflags & 4))
#pragma unroll
            for (int sI = 0; sI < 8; ++sI) {
                const f32x4 ra = *(const LAS f32x4*)(RV + 16 * sI + 8 * hi), rb = *(const LAS f32x4*)(RV + 16 * sI + 8 * hi + 4);
                const u32x4 wu = __builtin_bit_cast(u32x4, wf[sI]); u32x4 ws4;
                { const f32x2_t t0 = (f32x2_t){__uint_as_float(wu.x << 16), __uint_as_float(wu.x & 0xffff0000u)} * (f32x2_t){ra[0], ra[1]}, t1 = (f32x2_t){__uint_as_float(wu.y << 16), __uint_as_float(wu.y & 0xffff0000u)} * (f32x2_t){ra[2], ra[3]};
                  const f32x2_t t2 = (f32x2_t){__uint_as_float(wu.z << 16), __uint_as_float(wu.z & 0xffff0000u)} * (f32x2_t){rb[0], rb[1]}, t3 = (f32x2_t){__uint_as_float(wu.w << 16), __uint_as_float(wu.w & 0xffff0000u)} * (f32x2_t){rb[2], rb[3]};
                  ws4.x = cvtpk(t0.x, t0.y); ws4.y = cvtpk(t1.x, t1.y); ws4.z = cvtpk(t2.x, t2.y); ws4.w = cvtpk(t3.x, t3.y); }
                const bf16x8 bfr = __builtin_bit_cast(bf16x8, ws4);
#pragma unroll
                for (int dh = 0; dh < 2; ++dh) { const LAS unsigned char* vp = gb + (16 * sI) * 128 + gvoff[dh];
                    const s16x4 lo = trrd(vp), hi4 = trrd(vp + 4 * 128); const bf16x8 vf = {lo[0], lo[1], lo[2], lo[3], hi4[0], hi4[1], hi4[2], hi4[3]};
                    if (dh == 0) a0 = __builtin_amdgcn_mfma_f32_32x32x16_bf16(vf, bfr, a0, 0, 0, 0); else a1 = __builtin_amdgcn_mfma_f32_32x32x16_bf16(vf, bfr, a1, 0, 0, 0); }
            }
            const float bsv = PBS[hh * 128 + pbase];
            const LAS unsigned char* ub = lds + (hq < 2 ? L_UA + hq * 8192 : L_UB + (hq - 2) * 8192) + (32 * tb + r32) * 128 + 8 * hi;
#pragma unroll
            for (int dh = 0; dh < 2; ++dh)
#pragma unroll
                for (int gq = 0; gq < 4; ++gq) { const int col = 64 * hh + 32 * dh + 8 * gq + 4 * hi; const f32x4 vg = *(const LAS f32x4*)(PVG + col);
                    const u32x2 uu = *(const LAS u32x2*)(ub + (((4 * dh + gq) ^ ((r32 >> 1) & 7)) << 4));
                    const float u0 = __uint_as_float(uu.x << 16), u1 = __uint_as_float(uu.x & 0xffff0000u), u2 = __uint_as_float(uu.y << 16), u3 = __uint_as_float(uu.y & 0xffff0000u);
                    f32x16& acc = dh == 0 ? a0 : a1;
                    const f32x2_t e0 = (f32x2_t){u0, u1} * ((f32x2_t){vg[0], vg[1]} * (f32x2_t){acc[4 * gq], acc[4 * gq + 1]} + bsv), e1 = (f32x2_t){u2, u3} * ((f32x2_t){vg[2], vg[3]} * (f32x2_t){acc[4 * gq + 2], acc[4 * gq + 3]} + bsv);
                    acc[4 * gq] = e0.x; acc[4 * gq + 1] = e0.y; acc[4 * gq + 2] = e1.x; acc[4 * gq + 3] = e1.y; }
            og[rd][0] = a0; og[rd][1] = a1;
        }
        { float ss = 0.f;
#pragma unroll
          for (int rd = 0; rd < 2; ++rd)
#pragma unroll
              for (int dh = 0; dh < 2; ++dh)
#pragma unroll
                  for (int r = 0; r < 16; ++r) ss += og[rd][dh][r] * og[rd][dh][r];
          ss = xhalf_sum(ss); if (hi == 0) SS[256 + wave * 32 + r32] = ss; }
        __syncthreads();
        { const float tot = (SS[256 + tb * 32 + r32] + SS[256 + (2 + tb) * 32 + r32]) + (SS[256 + (4 + tb) * 32 + r32] + SS[256 + (6 + tb) * 32 + r32]);
          const float rg = rsqrtf(tot * (1.0f / 512.0f) + EPS);
#pragma unroll
          for (int rd = 0; rd < 2; ++rd)
#pragma unroll
              for (int dh = 0; dh < 2; ++dh)
                  { u32x2 w[4];
#pragma unroll
                    for (int gq = 0; gq < 4; ++gq) { const int col = 64 * (4 * rd + hq) + 32 * dh + 8 * gq + 4 * hi; const f32x4 gn = *(const LAS f32x4*)(PGG + col);
                      const f32x2_t s0 = ((f32x2_t){og[rd][dh][4 * gq], og[rd][dh][4 * gq + 1]} * rg) * (f32x2_t){gn[0], gn[1]}, s1 = ((f32x2_t){og[rd][dh][4 * gq + 2], og[rd][dh][4 * gq + 3]} * rg) * (f32x2_t){gn[2], gn[3]};
                      w[gq].x = cvtpk(s0.x, s0.y); w[gq].y = cvtpk(s1.x, s1.y); }
                    store_pairs(MIX + mrow * D + 512 + 64 * (4 * rd + hq) + 32 * dh, w, hi, pflags & 8); } }
    }
    __syncthreads();
}
}

constexpr int NWAVES = 8;
constexpr int N_PHASES = 6;
constexpr int RING_BYTES = 131072;
constexpr int LDSCTL_OFF = 163840 - 2048, MISC_OFF = LDSCTL_OFF + 320;
constexpr int LDS_BYTES = 163840;
static_assert(MISC_OFF + 128 <= LDS_BYTES && mix::L_END3 <= LDSCTL_OFF, "LDS map");
#if MK_MIXER_RING
static_assert(mixr::R_END <= LDSCTL_OFF, "LDS map (ring mixer)");
#endif
constexpr int CW_BAR = 4096;

#define GAS __attribute__((address_space(1)))

typedef GAS unsigned gu32;
#define RLX_AGENT __ATOMIC_RELAXED, __HIP_MEMORY_SCOPE_AGENT

#define XB_TMO      128
#define XB_XCNT(j)  (256  + 64 * (j))
#define XB_XSUB(j)  (1280 + 64 * (j))
#define XB_XGEN(j)  (2304 + 64 * (j))
#define XB_TOP      3328
#define XB_TOPGEN   3392
#define XCD_BAR_WORDS 3456
#define XB_SPIN_CAP (1u << 18)

__device__ __forceinline__ unsigned xb_ld(unsigned* p)              { return __hip_atomic_load(p, __ATOMIC_RELAXED, __HIP_MEMORY_SCOPE_AGENT); }
__device__ __forceinline__ unsigned xb_add(unsigned* p, unsigned v) { return __hip_atomic_fetch_add(p, v, __ATOMIC_RELAXED, __HIP_MEMORY_SCOPE_AGENT); }
__device__ __forceinline__ unsigned xb_xcc_id() { return (unsigned)__builtin_amdgcn_s_getreg((3 << 11) | 20) & 0xFu; }
#define XB_SPIN(cond, bar) do { unsigned _sp = 0; while (cond) { __builtin_amdgcn_s_sleep(1); \
    if ((++_sp & 255u) == 0u) { if (xb_ld(&(bar)[XB_TMO])) break; if (_sp > XB_SPIN_CAP) { atomicAdd(&(bar)[XB_TMO], 1u); break; } } } } while (0)

struct XcdBarrier { unsigned* bar; unsigned x; volatile LAS unsigned* st; };
__device__ __forceinline__ XcdBarrier xcd_barrier_post(unsigned* bar, volatile LAS unsigned* st) {
    XcdBarrier b; b.bar = bar; b.x = xb_xcc_id(); b.st = st;
    if (threadIdx.x == 0) (void)xb_add(&bar[XB_XCNT(b.x)], 1u);
    return b;
}
__device__ __forceinline__ void xcd_barrier_complete(unsigned* bar, unsigned x, unsigned& nloc, unsigned& nx) {
    const unsigned G = gridDim.x * gridDim.y * gridDim.z;
    unsigned sum, cnt, mine, sp = 0u;
    for (;;) {
        sum = 0u; cnt = 0u; mine = 0u;
#pragma unroll
        for (unsigned j = 0; j < 16; ++j) { const unsigned c = xb_ld(&bar[XB_XCNT(j)]); sum += c; cnt += (c > 0u) ? 1u : 0u; mine = (j == x) ? c : mine; }
        if (sum == G) break;
        __builtin_amdgcn_s_sleep(1);
        if ((++sp & 255u) == 0u) { if (xb_ld(&bar[XB_TMO])) break; if (sp > XB_SPIN_CAP) { atomicAdd(&bar[XB_TMO], 1u); break; } }
    }
    nloc = mine > 0u ? mine : 1u; nx = cnt > 0u ? cnt : 1u;
}
__device__ __forceinline__ void xcd_barrier(const XcdBarrier& b) {
    asm volatile("s_waitcnt vmcnt(0)" ::: "memory");
    __syncthreads();
    if (threadIdx.x == 0) {
        unsigned* bar = b.bar;
        __builtin_amdgcn_s_waitcnt(0);
        unsigned nloc = b.st[0], nx = b.st[1];
        if (nloc == 0u) { xcd_barrier_complete(bar, b.x, nloc, nx); b.st[0] = nloc; b.st[1] = nx; }
        const unsigned old = xb_add(&bar[XB_XSUB(b.x)], 1u);
        const unsigned gen = old / nloc;
        if (old + 1u == (gen + 1u) * nloc) {
            __builtin_amdgcn_fence(__ATOMIC_RELEASE, "agent");
            asm volatile("s_waitcnt vmcnt(0)" ::: "memory");
            const unsigned og = xb_add(&bar[XB_TOP], 1u);
            const unsigned tg = og / nx;
            if (og + 1u == (tg + 1u) * nx) xb_add(&bar[XB_TOPGEN], 1u);
            else XB_SPIN(xb_ld(&bar[XB_TOPGEN]) == tg, bar);
            __builtin_amdgcn_fence(__ATOMIC_ACQUIRE, "agent");
            xb_add(&bar[XB_XGEN(b.x)], 1u);
            asm volatile("s_waitcnt vmcnt(0)" ::: "memory");
        } else {
            XB_SPIN(xb_ld(&bar[XB_XGEN(b.x)]) == gen, bar);
            __builtin_amdgcn_fence(__ATOMIC_ACQUIRE, "agent");
            asm volatile("s_waitcnt vmcnt(0)" ::: "memory");
        }
    }
    __syncthreads();
}

struct Args { const float* in[18]; float* out; unsigned char* ws; int ph_lo, ph_hi; };

__global__ void __launch_bounds__(NWAVES * 64, 2) mk_fwd(Args args) {
    extern __shared__ __attribute__((aligned(16))) unsigned char lds_raw[];
    LAS unsigned char* lds = (LAS unsigned char*)lds_raw;
    volatile LAS unsigned* MISC = (volatile LAS unsigned*)(lds + MISC_OFF);
    const int tid = threadIdx.x, G = gridDim.x;
    unsigned char* ws = args.ws;
    gu32* ctl = (gu32*)(ws + WS_CTL);
    for (int u = tid; u < (LDS_BYTES - LDSCTL_OFF) / 4; u += NWAVES * 64) ((LAS unsigned*)(lds + LDSCTL_OFF))[u] = 0u;
    __syncthreads();
    const int lo = args.ph_lo, hi = args.ph_hi;
    const bool multi = hi - lo > 1;
    XcdBarrier bar; bar.bar = (unsigned*)(ctl + CW_BAR); bar.x = 0; bar.st = nullptr;
    if (multi) bar = xcd_barrier_post((unsigned*)(ctl + CW_BAR), MISC + 8);
#define STAMP(k) do {} while (0)
#define STAGGER_TICKS(ticks) do { const unsigned long long t0_ = __builtin_amdgcn_s_memrealtime(), dl_ = (unsigned long long)(ticks); while (__builtin_amdgcn_s_memrealtime() - t0_ < dl_) __builtin_amdgcn_s_sleep(4); } while (0)
#define IN(k) (lo <= (k) && (k) < hi)
#define BOTH(k) (IN(k) && IN((k) + 1))
    const float* xp = args.in[0]; const float* xs = args.in[1];
    bf16_t* WIN = (bf16_t*)(ws + WS_WIN); bf16_t* WO = (bf16_t*)(ws + WS_WO); bf16_t* WGU = (bf16_t*)(ws + WS_WGU); bf16_t* WDN = (bf16_t*)(ws + WS_WDN);
    float* VSSQ = (float*)(ws + WS_VSSQ); float* SSQ2 = (float*)(ws + WS_SSQ2);
    bf16_t* XN = (bf16_t*)(ws + WS_XN); bf16_t* PROJ = (bf16_t*)(ws + WS_PROJ); bf16_t* H = (bf16_t*)(ws + WS_H); bf16_t* MIX = (bf16_t*)(ws + WS_MIX); bf16_t* X1B = (bf16_t*)(ws + WS_X1B);

    for (int rep = 0; rep < 1 + ((MK_REPEAT_MASK >> 0) & 1); ++rep) if (IN(0)) {
#if MK_PROLOGUE_NAIVE
        p0_prologue_naive(args.in, ws, G);
#else
        p0_prologue(args.in, ws, lds, G);
#endif
        if (BOTH(0)) xcd_barrier(bar); STAMP(0); }
    for (int rep = 0; rep < 1 + ((MK_REPEAT_MASK >> 1) & 1); ++rep) if (IN(1)) {
        pg8::Gemm g{XN, WIN, M, INW, D}; pg8::StaticOrder S; S.init(M, INW, G, (int)blockIdx.x);
        LAS float* RSL = (LAS float*)(lds + RING_BYTES);
        { const float* RS1 = (const float*)(ws + WS_RS1);
          float rv[pg8::EpiIn::NS1 / 2];
#pragma unroll
          for (int k = 0; k < pg8::EpiIn::NS1 / 2; ++k) { pg8::Unit uu; rv[k] = S.next((tid >> 8) + 2 * k, uu) ? RS1[uu.pm * 256 + (tid & 255)] : 0.f; }
#pragma unroll
          for (int k = 0; k < pg8::EpiIn::NS1 / 2; ++k) RSL[((tid >> 8) + 2 * k) * 256 + (tid & 255)] = rv[k];
          __syncthreads(); }
        pg8::EpiIn E{PROJ, VSSQ, args.in[5], args.in[6], RSL, (const float*)(ws + WS_RS1)};
        pg8::gemm_phase<pg8::EpiIn, pg8::StaticOrder, true>(lds, g, S, E);
#if MK_LATE_WEIGHTS
        {
          const int rounds = (S.nwg + G - 1) / G, nbusy = S.nwg - (rounds - 1) * G, c = (int)blockIdx.x;
          const int wave = __builtin_amdgcn_readfirstlane(tid >> 6);
          if (nbusy == G) p0_weights(args.in, ws, lds, P0_I_IN, P0_NITEMS, c * 8 + wave, G * 8);
          else if (c >= nbusy) p0_weights(args.in, ws, lds, P0_I_IN, P0_NITEMS, (c - nbusy) * 8 + wave, (G - nbusy) * 8); }
#endif
        if (BOTH(1)) xcd_barrier(bar); STAMP(1);
    }
    for (int rep = 0; rep < 1 + ((MK_REPEAT_MASK >> 2) & 1); ++rep) if (IN(2) || (MK_EXTRA_PHASE >= 14 && MK_EXTRA_PHASE <= 17 && lo == MK_EXTRA_PHASE)) {
#if MK_MIXER_NAIVE
        p2_mixer_naive(args.in, ws, lds_raw, G);
#else
#if MK_MIXER_RING
        mixr::p2_mixer_ring(args.in, ws, lds, G);
#elif 1
        mix::p2_mixer(args.in, ws, lds, G, (MK_EXTRA_PHASE >= 14 && MK_EXTRA_PHASE <= 17 && lo == MK_EXTRA_PHASE) ? (MK_PFLAGS ? MK_PFLAGS : (1 << (MK_EXTRA_PHASE - 14))) : 0);
#endif
#endif
        if (BOTH(2)) xcd_barrier(bar); STAMP(2); }
    for (int rep = 0; rep < 1 + ((MK_REPEAT_MASK >> 3) & 1); ++rep) if (IN(3)) {
        pg8::Gemm g{MIX, WO, M, D, D}; pg8::StaticOrder S; S.init(M, D, G, (int)blockIdx.x);
        pg8::EpiOut E{XN, X1B, SSQ2};
        pg8::gemm_phase<pg8::EpiOut, pg8::StaticOrder, MK_ALIGN35>(lds, g, S, E);
        if (BOTH(3)) xcd_barrier(bar); STAMP(3);
    }
    for (int rep = 0; rep < 1 + ((MK_REPEAT_MASK >> 4) & 1); ++rep) if (IN(4)) {
        pg8::Gemm g{X1B, WGU, M, NGU, D}; pg8::StaticOrder S; S.init(M, NGU, G, (int)blockIdx.x);
        LAS float* RS = (LAS float*)(lds + RING_BYTES);
        { pg8::Unit u0; S.next(0, u0); const int r8 = u0.pm & 7, g0 = ((u0.pm >> 3) / 3) * 3;
          for (int i = tid; i < 768; i += NWAVES * 64) { const int row = (8 * (g0 + (i >> 8)) + r8) * 256 + (i & 255); const pg8::f32x4* sp = (const pg8::f32x4*)(SSQ2 + (size_t)row * 16);
              const pg8::f32x4 sv = (sp[0] + sp[1]) + (sp[2] + sp[3]); RS[i] = rsqrtf(((sv[0] + sv[1]) + (sv[2] + sv[3])) * (1.0f / D) + EPS); }
          if (tid < 3) ((LAS int*)(RS + 768))[tid] = 8 * (g0 + tid) + r8;
          __syncthreads(); }
        pg8::EpiUp E{H, RS, SSQ2};
        pg8::gemm_phase<pg8::EpiUp, pg8::StaticOrder, MK_ALIGN4>(lds, g, S, E);
        if (BOTH(4)) xcd_barrier(bar); STAMP(4);
    }
    if (IN(5)) {
        if (MK_STAGGER_TICKS > 0 && (xb_xcc_id() & 1)) STAGGER_TICKS(MK_STAGGER_TICKS);
        pg8::Gemm g{H, WDN, M, D, DFF}; pg8::StaticOrder S; S.init(M, D, G, (int)blockIdx.x);
        pg8::EpiDown E{X1B, args.out};
        pg8::gemm_phase<pg8::EpiDown, pg8::StaticOrder, MK_ALIGN35>(lds, g, S, E);
        STAMP(5);
    }

#if MK_EXTRA_PHASE >= 6
    if (lo == 6) { pg8::Gemm g{X1B, WGU, M, NGU, D}; pg8::StaticOrder S; S.init(M, NGU, G, (int)blockIdx.x); S.wgm = MK_PFLAGS ? MK_PFLAGS : 8; pg8::EpiNone E; pg8::gemm_phase<pg8::EpiNone, pg8::StaticOrder, true>(lds, g, S, E); }
    if (lo == 7) { pg8::Gemm g{H, WDN, M, D, DFF}; pg8::StaticOrder S; S.init(M, D, G, (int)blockIdx.x); pg8::EpiNone E; pg8::gemm_phase<pg8::EpiNone, pg8::StaticOrder, true>(lds, g, S, E); }
    if (lo == 8) { pg8::Gemm g{X1B, WGU, M, INW, D}; pg8::StaticOrder S; S.init(M, INW, G, (int)blockIdx.x); pg8::EpiNone E; pg8::gemm_phase<pg8::EpiNone, pg8::StaticOrder, true>(lds, g, S, E); }
#endif
#if MK_EXTRA_PHASE == 19
    if (lo == 19) { pg8::Gemm g{X1B, WGU, M, NGU, D}; pg8::StaticOrder S; S.init(M, NGU, G, (int)blockIdx.x);
        LAS float* RS = (LAS float*)(lds + RING_BYTES); for (int i = tid; i < 768; i += NWAVES * 64) RS[i] = 1.0f; __syncthreads();
        pg8::EpiUpFullLine E{H, RS}; pg8::gemm_phase<pg8::EpiUpFullLine, pg8::StaticOrder, true>(lds, g, S, E); }
#endif
#if MK_EXTRA_PHASE == 18
    if (lo == 18) { pg8::Gemm g{MIX, WO, M, D, D}; pg8::StaticOrder S; S.init(M, D, G, (int)blockIdx.x); pg8::EpiNone E; pg8::gemm_phase<pg8::EpiNone, pg8::StaticOrder, true>(lds, g, S, E); }
#endif
#if MK_EXTRA_PHASE >= 11
    if (lo == 20) { pg8::Gemm g{X1B, WGU, M, NGU, D}; pg8::StaticOrder S; S.init(M, NGU, G, (int)blockIdx.x); pg8::EpiNone E; pg8::gemm_phase<pg8::EpiNone, pg8::StaticOrder, true, 4>(lds, g, S, E); }
    if (lo == 11) { pg8::Gemm g{X1B, WGU, M, NGU, D}; pg8::StaticOrder S; S.init(M, NGU, G, (int)blockIdx.x); pg8::EpiNone E; pg8::gemm_phase<pg8::EpiNone, pg8::StaticOrder, true, 1>(lds, g, S, E); }
    if (lo == 12) { pg8::Gemm g{X1B, WGU, M, NGU, D}; pg8::StaticOrder S; S.init(M, NGU, G, (int)blockIdx.x); pg8::EpiNone E; pg8::gemm_phase<pg8::EpiNone, pg8::StaticOrder, true, 2>(lds, g, S, E); }
    if (lo == 13) { pg8::Gemm g{X1B, WGU, M, NGU, D}; pg8::StaticOrder S; S.init(M, NGU, G, (int)blockIdx.x); pg8::EpiNone E; pg8::gemm_phase<pg8::EpiNone, pg8::StaticOrder, true, 3>(lds, g, S, E); }
#endif
#if MK_EXTRA_PHASE >= 9
    if (lo == 9)  { pg8::Gemm g{H, WDN, M, D, DFF}; pg8::StaticOrder S; S.init(M, D, G, (int)blockIdx.x); pg8::EpiDownProbe<1> E{X1B, (float*)(ws + WS_MIX)}; pg8::gemm_phase<pg8::EpiDownProbe<1>, pg8::StaticOrder, true>(lds, g, S, E); }
    if (lo == 10) { pg8::Gemm g{H, WDN, M, D, DFF}; pg8::StaticOrder S; S.init(M, D, G, (int)blockIdx.x); pg8::EpiDownProbe<2> E{X1B, args.out}; pg8::gemm_phase<pg8::EpiDownProbe<2>, pg8::StaticOrder, true>(lds, g, S, E); }
#endif
#undef IN
#undef BOTH
}

extern "C" void kernel_launch(void* const* d_in, const int* in_sizes, int n_in, void* d_out, int out_size, void* d_ws, size_t ws_size, hipStream_t stream) {
    static int grid = 0;
    if (grid == 0) {
        if (n_in != 18 || in_sizes[0] != MP * D || in_sizes[1] != (M - MP) * D || out_size != M * D || ws_size < WS_END) {
            fprintf(stderr, "kernel_launch: unexpected shapes (n_in %d, in0 %d, in1 %d, out %d, ws %zu)\n", n_in, n_in > 0 ? in_sizes[0] : -1, n_in > 1 ? in_sizes[1] : -1, out_size, ws_size); grid = -1; return; }
        int dev = 0, cus = 0, per_cu = 0;
        if (hipGetDevice(&dev) != hipSuccess || hipDeviceGetAttribute(&cus, hipDeviceAttributeMultiprocessorCount, dev) != hipSuccess) { grid = -1; return; }
        if (hipFuncSetAttribute((const void*)mk_fwd, hipFuncAttributeMaxDynamicSharedMemorySize, LDS_BYTES) != hipSuccess) { fprintf(stderr, "kernel_launch: hipFuncSetAttribute failed\n"); grid = -1; return; }
        if (hipOccupancyMaxActiveBlocksPerMultiprocessor(&per_cu, (const void*)mk_fwd, NWAVES * 64, LDS_BYTES) != hipSuccess || per_cu < 1) { fprintf(stderr, "kernel_launch: occupancy query says %d blocks per CU\n", per_cu); grid = -1; return; }
        (void)hipGetLastError();
        grid = cus;
    }
    if (grid < 0) return;
    Args a{};
    for (int i = 0; i < 18; ++i) a.in[i] = (const float*)d_in[i];
    a.out = (float*)d_out; a.ws = (unsigned char*)d_ws;
    unsigned char* ws = (unsigned char*)d_ws;
    static_assert((CW_BAR + XCD_BAR_WORDS) * 4 <= 32768, "control words inside the per-call memset");
    (void)hipMemsetAsync(ws + WS_CTL, 0, 32768, stream);
#if MK_ONE_LAUNCH
#if 0 && MK_EXTRA_PHASE == 3
    a.ph_lo = 0; a.ph_hi = 4; hipLaunchKernelGGL(mk_fwd, dim3(grid), dim3(NWAVES * 64), LDS_BYTES, stream, a);
    (void)hipMemsetAsync(ws + WS_CTL, 0, 1 * MiB, stream);
    a.ph_lo = 3; a.ph_hi = 6; hipLaunchKernelGGL(mk_fwd, dim3(grid), dim3(NWAVES * 64), LDS_BYTES, stream, a);
#else
    a.ph_lo = 0; a.ph_hi = N_PHASES;
#if MK_PLAIN_LAUNCH
    hipLaunchKernelGGL(mk_fwd, dim3(grid), dim3(NWAVES * 64), LDS_BYTES, stream, a);
#else
    { void* kargs[] = {&a}; hipError_t e = hipLaunchCooperativeKernel((const void*)mk_fwd, dim3(grid), dim3(NWAVES * 64), kargs, LDS_BYTES, stream);
      if (e != hipSuccess) fprintf(stderr, "kernel_launch: cooperative launch failed: %s (grid %d)\n", hipGetErrorString(e), grid); }
#endif
#if MK_EXTRA_PHASE >= 0
    a.ph_lo = MK_EXTRA_PHASE; a.ph_hi = MK_EXTRA_PHASE + 1; hipLaunchKernelGGL(mk_fwd, dim3(grid), dim3(NWAVES * 64), LDS_BYTES, stream, a);
#endif
#endif
#else
    for (int p = 0; p < N_PHASES; ++p) {
        if (!(MK_PHASE_MASK & (1 << p))) { launch_naive_phase(p, d_in, (float*)d_out, ws, stream); continue; }
        a.ph_lo = p; a.ph_hi = p + 1;
        hipLaunchKernelGGL(mk_fwd, dim3(grid), dim3(NWAVES * 64), LDS_BYTES, stream, a);
    }
#endif
}
```

```cpp
#include <hip/hip_runtime.h>
#include <cstdio>
#include <cstdint>

typedef unsigned short bf16_t;
constexpr int D = 1024, SEQ = 4096, NSEQ = 12, M = NSEQ * SEQ, MP = 4 * SEQ;
constexpr int INW = 1792, DFF = 2816, NGU = 2 * DFF;
constexpr float EPS = 1e-6f, LOG2E = 1.4426950408889634f, QSCALE = 0.125f * LOG2E;

constexpr size_t MiB = 1u << 20;
constexpr size_t WS_CTL = 0;
constexpr size_t WS_WIN = 1 * MiB;
constexpr size_t WS_WO = 5 * MiB;
constexpr size_t WS_WGU = 7 * MiB;
constexpr size_t WS_WDN = 18 * MiB;
constexpr size_t WS_WS = 24 * MiB;
constexpr size_t WS_VSSQ = 25 * MiB;
constexpr size_t WS_SSQ2 = 27 * MiB;
constexpr size_t WS_RS1 = 30 * MiB;
constexpr size_t WS_XN = 32 * MiB;
constexpr size_t WS_PROJ = 128 * MiB;
constexpr size_t WS_H = 32 * MiB;
constexpr size_t WS_MIX = 296 * MiB;
constexpr size_t WS_X1B = 392 * MiB;
constexpr size_t WS_END = 488 * MiB;

__device__ __forceinline__ unsigned f2bf(float f) { unsigned u = __builtin_bit_cast(unsigned, f); return (u + 0x7fffu + ((u >> 16) & 1u)) >> 16; }
__device__ __forceinline__ float bf2f(bf16_t b) { return __builtin_bit_cast(float, (unsigned)b << 16); }
__device__ __forceinline__ float gelu_tanh(float x) { const float u = x * (-2.302208198f - 0.1029432397f * x * x); return x * __builtin_amdgcn_rcpf(1.0f + __builtin_amdgcn_exp2f(u)); }
__device__ __forceinline__ float silu(float x) { return x * __builtin_amdgcn_rcpf(1.0f + __builtin_amdgcn_exp2f(-LOG2E * x)); }
__device__ __forceinline__ int t5_bucket(int rel) { const int n = rel < 0 ? -rel : rel; int b = n < 8 ? n : (2 + (31 - __builtin_clz(n * n))); b = b > 15 ? 15 : b; return b + (rel > 0 ? 16 : 0); }

__device__ __forceinline__ void prep_w_elem(size_t i, const float* w_in, const float* w_o, const float* w_gate, const float* w_up, const float* w_down, const float* w_s, const float* norm2, unsigned char* ws) {
    const size_t N0 = (size_t)INW * D, N1 = (size_t)D * D, N2 = (size_t)NGU * D, N3 = (size_t)D * DFF, N4 = 8 * 128 * 128;
    if (i < N0) { const int n = i / D, k = i % D; ((bf16_t*)(ws + WS_WIN))[i] = f2bf(w_in[(size_t)k * INW + n]); return; } i -= N0;
    if (i < N1) { const int n = i / D, k = i % D; ((bf16_t*)(ws + WS_WO))[i] = f2bf(w_o[(size_t)k * D + n]); return; } i -= N1;
    if (i < N2) { const int r = i / D, k = i % D; const int pn = r >> 8, bj = (r >> 7) & 1, c = r & 127, col = 128 * pn + c;
        ((bf16_t*)(ws + WS_WGU))[i] = f2bf(norm2[k] * (bj ? w_up : w_gate)[(size_t)k * DFF + col]); return; } i -= N2;
    if (i < N3) { const int n = i / DFF, k = i % DFF; ((bf16_t*)(ws + WS_WDN))[i] = f2bf(w_down[(size_t)k * D + n]); return; } i -= N3;
    if (i < N4) { ((bf16_t*)(ws + WS_WS))[i] = f2bf(w_s[i]); }
}
constexpr size_t NPREP = (size_t)INW * D + (size_t)D * D + (size_t)NGU * D + (size_t)D * DFF + 8 * 128 * 128;
__global__ void __launch_bounds__(256) k_prep_w(const float* w_in, const float* w_o, const float* w_gate, const float* w_up, const float* w_down, const float* w_s, const float* norm2, unsigned char* ws) {
    prep_w_elem((size_t)blockIdx.x * 256 + threadIdx.x, w_in, w_o, w_gate, w_up, w_down, w_s, norm2, ws);
}
__device__ __forceinline__ void xn_row(int m, int lane, const float* xp, const float* xs, const float* norm1, bf16_t* XN) {
    const float* x = m < MP ? xp + (size_t)m * D : xs + (size_t)(m - MP) * D;
    float v[16]; float ss = 0.f;
#pragma unroll
    for (int j = 0; j < 16; ++j) { v[j] = x[lane + 64 * j]; ss += v[j] * v[j]; }
#pragma unroll
    for (int o = 1; o < 64; o <<= 1) ss += __shfl_xor(ss, o);
    const float r = rsqrtf(ss * (1.0f / D) + EPS);
#pragma unroll
    for (int j = 0; j < 16; ++j) XN[(size_t)m * D + lane + 64 * j] = f2bf(v[j] * r * norm1[lane + 64 * j]);
}
__global__ void __launch_bounds__(256) k_xn(const float* xp, const float* xs, const float* norm1, bf16_t* XN) { xn_row(blockIdx.x * 4 + (threadIdx.x >> 6), threadIdx.x & 63, xp, xs, norm1, XN); }

template <class Epi, bool DUAL>
__global__ void __launch_bounds__(256) k_gemm_naive(const bf16_t* A, const bf16_t* Bt, int K, Epi epi) {
    __shared__ float As[32][68], Bs[32][68], B2s[DUAL ? 32 : 1][68], Ct[64][65], C2t[DUAL ? 64 : 1][65];
    const int tid = threadIdx.x, ty = tid >> 4, tx = tid & 15, lr = tid >> 2, kc = (tid & 3) * 8;
    const int m0 = blockIdx.y * 64, n0 = blockIdx.x * 64;
    const bf16_t* ap = A + (size_t)(m0 + lr) * K + kc;
    const int br = epi.brow(n0 + lr);
    const bf16_t* bp = Bt + (size_t)br * K + kc;
    const bf16_t* bp2 = Bt + (size_t)(br + 128) * K + kc;
    float acc[4][4] = {}, acc2[4][4] = {};
    for (int k0 = 0; k0 < K; k0 += 32) {
        const uint4 av = *(const uint4*)(ap + k0), bv = *(const uint4*)(bp + k0);
        const unsigned aw[4] = {av.x, av.y, av.z, av.w}, bw[4] = {bv.x, bv.y, bv.z, bv.w};
#pragma unroll
        for (int j = 0; j < 4; ++j) { As[kc + 2 * j][lr] = __builtin_bit_cast(float, aw[j] << 16); As[kc + 2 * j + 1][lr] = __builtin_bit_cast(float, aw[j] & 0xffff0000u);
                                      Bs[kc + 2 * j][lr] = __builtin_bit_cast(float, bw[j] << 16); Bs[kc + 2 * j + 1][lr] = __builtin_bit_cast(float, bw[j] & 0xffff0000u); }
        if (DUAL) { const uint4 cv = *(const uint4*)(bp2 + k0); const unsigned cw[4] = {cv.x, cv.y, cv.z, cv.w};
#pragma unroll
            for (int j = 0; j < 4; ++j) { B2s[kc + 2 * j][lr] = __builtin_bit_cast(float, cw[j] << 16); B2s[kc + 2 * j + 1][lr] = __builtin_bit_cast(float, cw[j] & 0xffff0000u); } }
        __syncthreads();
#pragma unroll 8
        for (int k = 0; k < 32; ++k) {
            float a[4], b[4], b2[4];
#pragma unroll
            for (int i = 0; i < 4; ++i) { a[i] = As[k][4 * ty + i]; b[i] = Bs[k][4 * tx + i]; b2[i] = DUAL ? B2s[k][4 * tx + i] : 0.f; }
#pragma unroll
            for (int i = 0; i < 4; ++i)
#pragma unroll
                for (int j = 0; j < 4; ++j) { acc[i][j] += a[i] * b[j]; if (DUAL) acc2[i][j] += a[i] * b2[j]; }
        }
        __syncthreads();
    }
#pragma unroll
    for (int i = 0; i < 4; ++i)
#pragma unroll
        for (int j = 0; j < 4; ++j) { Ct[4 * ty + i][4 * tx + j] = acc[i][j]; if (DUAL) C2t[4 * ty + i][4 * tx + j] = acc2[i][j]; }
    __syncthreads();
    const int r = tid >> 2, part = tid & 3;
    epi(m0 + r, n0, part, &Ct[r][part * 16], DUAL ? &C2t[r][part * 16] : nullptr);
}
__device__ __forceinline__ float red4(float v) { v += __shfl_xor(v, 1); v += __shfl_xor(v, 2); return v; }
struct NEpiIn {
    bf16_t* PROJ; float* VSSQ; const float* qg; const float* kg;
    __device__ int brow(int n) const { return n; }
    __device__ void operator()(int row, int n0, int part, const float* c, const float*) const {
        const int ct = n0 >> 6; float v[16];
#pragma unroll
        for (int j = 0; j < 16; ++j) v[j] = c[j];
        if (ct < 10) { float ss = 0.f;
#pragma unroll
            for (int j = 0; j < 16; ++j) ss += v[j] * v[j];
            ss = red4(ss); const float r = rsqrtf(ss * (1.0f / 64.0f) + EPS); const float* g = ct < 8 ? qg : kg; const float sc = ct < 8 ? QSCALE : 1.0f;
#pragma unroll
            for (int j = 0; j < 16; ++j) v[j] = v[j] * r * g[part * 16 + j] * sc;
        } else if (ct >= 12) { float ss = 0.f;
#pragma unroll
            for (int j = 0; j < 16; ++j) { v[j] = gelu_tanh(v[j]); ss += v[j] * v[j]; }
            if (ct >= 20) { ss = red4(ss); if (part == 0) VSSQ[(size_t)row * 8 + (ct - 20)] = ss; }
        }
#pragma unroll
        for (int j = 0; j < 16; ++j) PROJ[(size_t)row * INW + n0 + part * 16 + j] = f2bf(v[j]);
    }
};
struct NEpiOut {
    const float* xp; const float* xs; float* out; bf16_t* X1B; float* SSQ2;
    __device__ int brow(int n) const { return n; }
    __device__ void operator()(int row, int n0, int part, const float* c, const float*) const {
        const float* x = row < MP ? xp + (size_t)row * D : xs + (size_t)(row - MP) * D; float ss = 0.f;
#pragma unroll
        for (int j = 0; j < 16; ++j) { const int col = n0 + part * 16 + j; const float v = x[col] + c[j]; out[(size_t)row * D + col] = v; X1B[(size_t)row * D + col] = f2bf(v); ss += v * v; }
        ss = red4(ss); if (part == 0) SSQ2[(size_t)row * 16 + (n0 >> 6)] = ss;
    }
};
struct NEpiUp {
    bf16_t* H; const float* SSQ2;
    __device__ int brow(int n) const { return 256 * (n >> 7) + (n & 127); }
    __device__ void operator()(int row, int n0, int part, const float* c, const float* c2) const {
        float ss = 0.f;
#pragma unroll
        for (int j = 0; j < 16; ++j) ss += SSQ2[(size_t)row * 16 + j];
        const float r = rsqrtf(ss * (1.0f / D) + EPS);
#pragma unroll
        for (int j = 0; j < 16; ++j) H[(size_t)row * DFF + n0 + part * 16 + j] = f2bf(silu(c[j] * r) * (c2[j] * r));
    }
};
struct NEpiDown {
    float* out;
    __device__ int brow(int n) const { return n; }
    __device__ void operator()(int row, int n0, int part, const float* c, const float*) const {
#pragma unroll
        for (int j = 0; j < 16; ++j) { const size_t o = (size_t)row * D + n0 + part * 16 + j; out[o] = out[o] + c[j]; }
    }
};

struct MixNaiveLds { float ps[4][320], qs[4][64], arow[512], grow[512], rv[128], red[4]; };
__device__ __forceinline__ void mix_naive_token(int m, int tid, MixNaiveLds& L, const bf16_t* PROJ, const float* VSSQ, const bf16_t* WSB, const float* rel_table, const float* sink, const float* v_gain,
                                                const float* b_s, const float* ag, const float* gg, bf16_t* MIX) {
    const int s = m / SEQ, t = m % SEQ, w = tid >> 6, lane = tid & 63;
    const bf16_t* prow = PROJ + (size_t)m * INW;
    const int jlo = t - 128 < 0 ? 0 : t - 128, jhi = t + 128 > SEQ - 1 ? SEQ - 1 : t + 128, nk = jhi - jlo + 1;
    for (int hh = 0; hh < 2; ++hh) {
        const int h = w * 2 + hh, g = h >> 2;
        L.qs[w][lane] = bf2f(prow[64 * h + lane]);
        __syncthreads();
        const float sink2 = sink[h] * LOG2E; float sc[5]; float mx = sink2;
#pragma unroll
        for (int i = 0; i < 5; ++i) { const int j = jlo + lane + 64 * i; sc[i] = -1e30f;
            if (j <= jhi) { const bf16_t* kr = PROJ + (size_t)(s * SEQ + j) * INW + 512 + 64 * g; float dot = 0.f;
                for (int d = 0; d < 64; ++d) dot += L.qs[w][d] * bf2f(kr[d]);
                dot += rel_table[t5_bucket(j - t) * 8 + h] * LOG2E; sc[i] = dot; mx = fmaxf(mx, dot); } }
#pragma unroll
        for (int o = 1; o < 64; o <<= 1) mx = fmaxf(mx, __shfl_xor(mx, o));
        float l = 0.f;
#pragma unroll
        for (int i = 0; i < 5; ++i) { const int j = jlo + lane + 64 * i; const float p = j <= jhi ? exp2f(sc[i] - mx) : 0.f; l += p; L.ps[w][lane + 64 * i] = p; }
#pragma unroll
        for (int o = 1; o < 64; o <<= 1) l += __shfl_xor(l, o);
        l += exp2f(sink2 - mx);
        __syncthreads();
        float o = 0.f;
        for (int jj = 0; jj < nk; ++jj) o += L.ps[w][jj] * bf2f(PROJ[(size_t)(s * SEQ + jlo + jj) * INW + 640 + 64 * g + lane]);
        L.arow[64 * h + lane] = o / l;
        __syncthreads();
    }
    const int mc = m - (t & 127), p = t & 127;
    if (tid < 128) { float ss = 0.f; for (int i = 0; i < 8; ++i) ss += VSSQ[(size_t)(mc + tid) * 8 + i]; L.rv[tid] = rsqrtf(ss * (1.0f / 512.0f) + EPS); }
    __syncthreads();
    for (int c = tid; c < 512; c += 256) { const int h = c >> 6; float a = 0.f; const float vg = v_gain[c];
        for (int q = 0; q < 128; ++q) a += bf2f(WSB[(h * 128 + p) * 128 + q]) * (bf2f(PROJ[(size_t)(mc + q) * INW + 1280 + c]) * L.rv[q] * vg);
        L.grow[c] = bf2f(prow[768 + c]) * (a + b_s[h * 128 + p]); }
    __syncthreads();
    float sa = L.arow[tid] * L.arow[tid] + L.arow[tid + 256] * L.arow[tid + 256], sg = L.grow[tid] * L.grow[tid] + L.grow[tid + 256] * L.grow[tid + 256];
#pragma unroll
    for (int o = 1; o < 64; o <<= 1) { sa += __shfl_xor(sa, o); sg += __shfl_xor(sg, o); }
    if (lane == 0) { L.red[w] = sa; } __syncthreads(); sa = L.red[0] + L.red[1] + L.red[2] + L.red[3]; __syncthreads();
    if (lane == 0) { L.red[w] = sg; } __syncthreads(); sg = L.red[0] + L.red[1] + L.red[2] + L.red[3];
    const float ra = rsqrtf(sa * (1.0f / 512.0f) + EPS), rg = rsqrtf(sg * (1.0f / 512.0f) + EPS);
    for (int c = tid; c < 512; c += 256) { MIX[(size_t)m * D + c] = f2bf(L.arow[c] * ra * ag[c]); MIX[(size_t)m * D + 512 + c] = f2bf(L.grow[c] * rg * gg[c]); }
    __syncthreads();
}
__global__ void __launch_bounds__(256) k_mix_naive(const bf16_t* PROJ, const float* VSSQ, const bf16_t* WSB, const float* rel_table, const float* sink, const float* v_gain,
                                                  const float* b_s, const float* ag, const float* gg, bf16_t* MIX) {
    __shared__ MixNaiveLds L;
    mix_naive_token(blockIdx.x, threadIdx.x, L, PROJ, VSSQ, WSB, rel_table, sink, v_gain, b_s, ag, gg, MIX);
}

#define MK_ONE_LAUNCH 1
#define MK_PHASE_MASK 0x3F
#define MK_MIXER_NAIVE 0
#define MK_PROLOGUE_NAIVE 0
#define MK_REPEAT_MASK 0
#define MK_EXTRA_PHASE -1
#define MK_STAGGER_TICKS 0
#define MK_PFLAGS 0
#define MK_MIXER_RING 0
#define MK_NST 0
#define MK_PLAIN_LAUNCH 0
#define MK_ALIGN35 true
#define MK_ALIGN4 true
#define MK_LATE_WEIGHTS 1
#define MK_REV5 2
#define MK_REV2 1

namespace pg8 {
#define PG8_LAS __attribute__((address_space(3)))
typedef short bf16x8 __attribute__((ext_vector_type(8)));
typedef float f32x4 __attribute__((ext_vector_type(4)));
typedef unsigned u32x4 __attribute__((ext_vector_type(4)));
typedef unsigned u32x2 __attribute__((ext_vector_type(2)));
constexpr int BM = 256, BK = 64, HALF = 128, HTB = HALF * BK * 2  , STAGE_BYTES = 8 * HTB, NXCD = 8, WGM = 8;

__host__ __device__ __forceinline__ int lds_byte(int r, int c) { const int st = (r >> 4) * 2 + (c >> 5), rr = r & 15, cc = c & 31, ob = rr * 64 + cc * 2; return st * 1024 + (ob ^ (((ob >> 9) & 1) << 5)); }
__host__ __device__ __forceinline__ void stage_rc(int b, int& R, int& C) { const int st = b / 1024, sb = b % 1024, swz = sb ^ (((sb >> 9) & 1) << 5); R = (st >> 1) * 16 + swz / 64; C = (st & 1) * 32 + (swz % 64) / 2; }
__host__ __device__ __forceinline__ int perm32(int rho) { const int n = rho >> 4, i = rho & 15; return 8 * (i >> 2) + 4 * n + (i & 3); }

struct Unit { int pm, pn, ui; };
struct Gemm { const bf16_t* A; const bf16_t* Bt; int M, N, K; };

struct StaticOrder {
    int nM, nN, nwg, G, c, wgm, rev;
    __host__ __device__ __forceinline__ void init(int M_, int N_, int G_, int c_) { nM = M_ / BM; nN = N_ / BM; nwg = nM * nN; G = G_; c = c_; wgm = WGM; rev = 0; }
    __host__ __device__ __forceinline__ void reverse() { rev = c < nwg ? (nwg - c + G - 1) / G : 0; }
    __host__ __device__ __forceinline__ bool next(int i, Unit& u) const {
        if (rev > 0 && i >= rev) return false;
        const long L = (long)(rev > 0 ? rev - 1 - i : i) * G + c; if (L >= nwg) return false;
        int wgid = (int)L; { const int q = nwg / NXCD, r = nwg % NXCD, xcd = wgid % NXCD, off = wgid / NXCD; wgid = (xcd < r ? xcd * (q + 1) : r * (q + 1) + (xcd - r) * q) + off; }
        const int nig = wgm * nN, gid = wgid / nig, fm = gid * wgm, gsz = (nM - fm) < wgm ? (nM - fm) : wgm;
        u.pm = fm + ((wgid % nig) % gsz); u.pn = (wgid % nig) / gsz; u.ui = i; return true;
    }
};

__device__ __forceinline__ unsigned cvt_pk_bf16(float lo, float hi) { unsigned r; asm volatile("v_cvt_pk_bf16_f32 %0, %1, %2" : "=v"(r) : "v"(lo), "v"(hi)); return r; }
__device__ __forceinline__ float rsum_fq(float s) { s += __shfl_xor(s, 16); s += __shfl_xor(s, 32); return s; }

struct EpiIn {
    static constexpr int BMAP = 2, NS1 = 8;
    bf16_t* PROJ; float* VSSQ; const float* qg; const float* kg; const PG8_LAS float* RSL; const float* RS1;
    __device__ __forceinline__ void operator()(const f32x4 (&acc)[2][2][4][2], const Unit& u, int wr, int wc, int fr, int fq) const {
        const int ct = 4 * u.pn + wc;
        const int row0 = u.pm * BM + wr * 64 + fr, col0 = u.pn * BM + wc * 64 + 8 * fq;
        float r1[2][4];
        if (u.ui < NS1) { const PG8_LAS float* rp = RSL + u.ui * 256 + wr * 64 + fr;
#pragma unroll
            for (int ai = 0; ai < 2; ++ai)
#pragma unroll
                for (int m = 0; m < 4; ++m) r1[ai][m] = rp[ai * HALF + m * 16];
        } else {
#pragma unroll
            for (int ai = 0; ai < 2; ++ai)
#pragma unroll
                for (int m = 0; m < 4; ++m) r1[ai][m] = RS1[row0 + ai * HALF + m * 16];
        }
        if (ct < 10) {
            const float* g = (ct < 8 ? qg : kg) + 8 * fq; const float sc = ct < 8 ? QSCALE : 1.0f;
            f32x4 gv[2][2];
#pragma unroll
            for (int bj = 0; bj < 2; ++bj)
#pragma unroll
                for (int n = 0; n < 2; ++n) gv[bj][n] = *(const f32x4*)(g + 32 * bj + 4 * n) * sc;
#pragma unroll
            for (int ai = 0; ai < 2; ++ai)
#pragma unroll
                for (int m = 0; m < 4; ++m) {
                    float ss = 0.f;
#pragma unroll
                    for (int bj = 0; bj < 2; ++bj)
#pragma unroll
                        for (int n = 0; n < 2; ++n) { const f32x4 x = acc[ai][bj][m][n]; ss += (x[0] * x[0] + x[1] * x[1]) + (x[2] * x[2] + x[3] * x[3]); }
                    const float rr = r1[ai][m];
                    ss = rsum_fq(ss) * (rr * rr); const float r = rsqrtf(ss * (1.0f / 64.0f) + EPS) * rr;
                    bf16_t* rowp = PROJ + (size_t)(row0 + ai * HALF + m * 16) * INW + col0;
#pragma unroll
                    for (int bj = 0; bj < 2; ++bj) { const f32x4 v0 = acc[ai][bj][m][0] * r * gv[bj][0], v1 = acc[ai][bj][m][1] * r * gv[bj][1];
                        u32x4 w; w.x = cvt_pk_bf16(v0[0], v0[1]); w.y = cvt_pk_bf16(v0[2], v0[3]); w.z = cvt_pk_bf16(v1[0], v1[1]); w.w = cvt_pk_bf16(v1[2], v1[3]);
                        *(u32x4*)(rowp + 32 * bj) = w; }
                }
        } else if (ct < 12) {
#pragma unroll
            for (int ai = 0; ai < 2; ++ai)
#pragma unroll
                for (int m = 0; m < 4; ++m) { bf16_t* rowp = PROJ + (size_t)(row0 + ai * HALF + m * 16) * INW + col0; const float rr = r1[ai][m];
#pragma unroll
                    for (int bj = 0; bj < 2; ++bj) { const f32x4 v0 = acc[ai][bj][m][0] * rr, v1 = acc[ai][bj][m][1] * rr;
                        u32x4 w; w.x = cvt_pk_bf16(v0[0], v0[1]); w.y = cvt_pk_bf16(v0[2], v0[3]); w.z = cvt_pk_bf16(v1[0], v1[1]); w.w = cvt_pk_bf16(v1[2], v1[3]);
                        *(u32x4*)(rowp + 32 * bj) = w; } }
        } else {
#pragma unroll
            for (int ai = 0; ai < 2; ++ai)
#pragma unroll
                for (int m = 0; m < 4; ++m) { const int row = row0 + ai * HALF + m * 16; bf16_t* rowp = PROJ + (size_t)row * INW + col0; float ss = 0.f; const float rr = r1[ai][m];
#pragma unroll
                    for (int bj = 0; bj < 2; ++bj) { f32x4 v0 = acc[ai][bj][m][0] * rr, v1 = acc[ai][bj][m][1] * rr;
#pragma unroll
                        for (int e = 0; e < 4; e += 2) { typedef float f32x2v __attribute__((ext_vector_type(2)));
                            f32x2v x0 = {v0[e], v0[e + 1]}, x1 = {v1[e], v1[e + 1]};
                            const f32x2v u0 = x0 * ((x0 * x0) * (-0.1029432397f) + (-2.302208198f)), u1 = x1 * ((x1 * x1) * (-0.1029432397f) + (-2.302208198f));
                            f32x2v e0, e1; e0.x = __builtin_amdgcn_exp2f(u0.x); e0.y = __builtin_amdgcn_exp2f(u0.y); e1.x = __builtin_amdgcn_exp2f(u1.x); e1.y = __builtin_amdgcn_exp2f(u1.y);
                            const f32x2v d0 = e0 + 1.0f, d1 = e1 + 1.0f; f32x2v s0, s1; s0.x = __builtin_amdgcn_rcpf(d0.x); s0.y = __builtin_amdgcn_rcpf(d0.y); s1.x = __builtin_amdgcn_rcpf(d1.x); s1.y = __builtin_amdgcn_rcpf(d1.y);
                            x0 = x0 * s0; x1 = x1 * s1; v0[e] = x0.x; v0[e + 1] = x0.y; v1[e] = x1.x; v1[e + 1] = x1.y;
                            const f32x2v q = x0 * x0 + x1 * x1; ss += q.x + q.y; }
                        u32x4 w; w.x = cvt_pk_bf16(v0[0], v0[1]); w.y = cvt_pk_bf16(v0[2], v0[3]); w.z = cvt_pk_bf16(v1[0], v1[1]); w.w = cvt_pk_bf16(v1[2], v1[3]);
                        *(u32x4*)(rowp + 32 * bj) = w; }
                    if (ct >= 20) { ss = rsum_fq(ss); if (fq == 0) VSSQ[(size_t)row * 8 + (ct - 20)] = ss; }
                }
        }
    }
};
struct EpiOut {
    static constexpr int BMAP = 1;
    const bf16_t* XB; bf16_t* X1B; float* SSQ2;
    __device__ __forceinline__ void operator()(const f32x4 (&acc)[2][2][4][2], const Unit& u, int wr, int wc, int fr, int fq) const {
        const int row0 = u.pm * BM + wr * 64 + fr, col0 = u.pn * BM + wc * 32 + 8 * fq;
        u32x4 xv[2][4][2];
#pragma unroll
        for (int ai = 0; ai < 2; ++ai)
#pragma unroll
            for (int m = 0; m < 4; ++m)
#pragma unroll
                for (int bj = 0; bj < 2; ++bj) xv[ai][m][bj] = *(const u32x4*)(XB + (size_t)(row0 + ai * HALF + m * 16) * D + col0 + bj * HALF);
#pragma unroll
        for (int ai = 0; ai < 2; ++ai)
#pragma unroll
            for (int m = 0; m < 4; ++m) { const int row = row0 + ai * HALF + m * 16; bf16_t* rowp = X1B + (size_t)row * D + col0; float ss = 0.f;
#pragma unroll
                for (int bj = 0; bj < 2; ++bj) { const u32x4 x = xv[ai][m][bj];
                    const f32x4 r0 = {__uint_as_float(x.x << 16), __uint_as_float(x.x & 0xffff0000u), __uint_as_float(x.y << 16), __uint_as_float(x.y & 0xffff0000u)};
                    const f32x4 r1 = {__uint_as_float(x.z << 16), __uint_as_float(x.z & 0xffff0000u), __uint_as_float(x.w << 16), __uint_as_float(x.w & 0xffff0000u)};
                    const f32x4 v0 = r0 + acc[ai][bj][m][0], v1 = r1 + acc[ai][bj][m][1];
                    u32x4 w; w.x = cvt_pk_bf16(v0[0], v0[1]); w.y = cvt_pk_bf16(v0[2], v0[3]); w.z = cvt_pk_bf16(v1[0], v1[1]); w.w = cvt_pk_bf16(v1[2], v1[3]);
                    *(u32x4*)(rowp + bj * HALF) = w;
                    ss += ((v0[0] * v0[0] + v0[1] * v0[1]) + (v0[2] * v0[2] + v0[3] * v0[3])) + ((v1[0] * v1[0] + v1[1] * v1[1]) + (v1[2] * v1[2] + v1[3] * v1[3])); }
                ss = rsum_fq(ss); if (fq == 0) SSQ2[(size_t)row * 16 + 4 * u.pn + wc] = ss; }
    }
};
struct EpiUp {
    static constexpr int BMAP = 1;
    bf16_t* H; const PG8_LAS float* RS; const float* SSQ2;
    __device__ __forceinline__ void operator()(const f32x4 (&acc)[2][2][4][2], const Unit& u, int wr, int wc, int fr, int fq) const {
        const int row0 = u.pm * BM + wr * 64 + fr, col0 = u.pn * HALF + wc * 32 + 8 * fq;
        const int slot = (u.pm >> 3) % 3;
        float rs[2][4];
        if (((const PG8_LAS int*)(RS + 768))[slot] == u.pm) {
            const PG8_LAS float* rsp = RS + slot * 256 + wr * 64 + fr;
#pragma unroll
            for (int ai = 0; ai < 2; ++ai)
#pragma unroll
                for (int m = 0; m < 4; ++m) rs[ai][m] = rsp[ai * HALF + m * 16];
        } else {
#pragma unroll
            for (int ai = 0; ai < 2; ++ai)
#pragma unroll
                for (int m = 0; m < 4; ++m) { const f32x4 pl = *(const f32x4*)(SSQ2 + (size_t)(row0 + ai * HALF + m * 16) * 16 + 4 * fq);
                    rs[ai][m] = rsqrtf(rsum_fq((pl[0] + pl[1]) + (pl[2] + pl[3])) * (1.0f / D) + EPS); }
        }
#pragma unroll
        for (int ai = 0; ai < 2; ++ai)
#pragma unroll
            for (int m = 0; m < 4; ++m) { const int row = row0 + ai * HALF + m * 16; const float r = rs[ai][m], r2 = r * r, c1 = -LOG2E * r;
                f32x4 h0, h1;
#pragma unroll
                for (int n = 0; n < 2; ++n)
#pragma unroll
                    for (int e = 0; e < 4; e += 2) { typedef float f32x2v __attribute__((ext_vector_type(2)));
                        const f32x2v gg2 = {acc[ai][0][m][n][e], acc[ai][0][m][n][e + 1]}, uu2 = {acc[ai][1][m][n][e], acc[ai][1][m][n][e + 1]};
                        const f32x2v cc = gg2 * c1; f32x2v ee; ee.x = __builtin_amdgcn_exp2f(cc.x); ee.y = __builtin_amdgcn_exp2f(cc.y);
                        const f32x2v dd = ee + 1.0f; f32x2v ss; ss.x = __builtin_amdgcn_rcpf(dd.x); ss.y = __builtin_amdgcn_rcpf(dd.y);
                        const f32x2v hh = ((gg2 * uu2) * r2) * ss;
                        if (n == 0) { h0[e] = hh.x; h0[e + 1] = hh.y; } else { h1[e] = hh.x; h1[e + 1] = hh.y; } }
                u32x4 w; w.x = cvt_pk_bf16(h0[0], h0[1]); w.y = cvt_pk_bf16(h0[2], h0[3]); w.z = cvt_pk_bf16(h1[0], h1[1]); w.w = cvt_pk_bf16(h1[2], h1[3]);
                *(u32x4*)(H + (size_t)row * DFF + col0) = w; }
    }
};
struct EpiUpFullLine {
    static constexpr int BMAP = 1;
    bf16_t* H; const PG8_LAS float* RS; const float* SSQ2;
    __device__ __forceinline__ void operator()(const f32x4 (&acc)[2][2][4][2], const Unit& u, int wr, int wc, int fr, int fq) const {
        const int row0 = u.pm * BM + wr * 64 + fr, col0 = u.pn * HALF + wc * 32 + 8 * fq;
        const int slot = (u.pm >> 3) % 3;
        float rs[2][4];
        if (((const PG8_LAS int*)(RS + 768))[slot] == u.pm) {
            const PG8_LAS float* rsp = RS + slot * 256 + wr * 64 + fr;
#pragma unroll
            for (int ai = 0; ai < 2; ++ai)
#pragma unroll
                for (int m = 0; m < 4; ++m) rs[ai][m] = rsp[ai * HALF + m * 16];
        } else {
#pragma unroll
            for (int ai = 0; ai < 2; ++ai)
#pragma unroll
                for (int m = 0; m < 4; ++m) { const f32x4 pl = *(const f32x4*)(SSQ2 + (size_t)(row0 + ai * HALF + m * 16) * 16 + 4 * fq);
                    rs[ai][m] = rsqrtf(rsum_fq((pl[0] + pl[1]) + (pl[2] + pl[3])) * (1.0f / D) + EPS); }
        }
#pragma unroll
        for (int ai = 0; ai < 2; ++ai)
#pragma unroll
            for (int m = 0; m < 4; ++m) { const int row = row0 + ai * HALF + m * 16; const float r = rs[ai][m], r2 = r * r, c1 = -LOG2E * r;
                f32x4 h0, h1;
#pragma unroll
                for (int n = 0; n < 2; ++n)
#pragma unroll
                    for (int e = 0; e < 4; e += 2) { typedef float f32x2v __attribute__((ext_vector_type(2)));
                        const f32x2v gg2 = {acc[ai][0][m][n][e], acc[ai][0][m][n][e + 1]}, uu2 = {acc[ai][1][m][n][e], acc[ai][1][m][n][e + 1]};
                        const f32x2v cc = gg2 * c1; f32x2v ee; ee.x = __builtin_amdgcn_exp2f(cc.x); ee.y = __builtin_amdgcn_exp2f(cc.y);
                        const f32x2v dd = ee + 1.0f; f32x2v ss; ss.x = __builtin_amdgcn_rcpf(dd.x); ss.y = __builtin_amdgcn_rcpf(dd.y);
                        const f32x2v hh = ((gg2 * uu2) * r2) * ss;
                        if (n == 0) { h0[e] = hh.x; h0[e + 1] = hh.y; } else { h1[e] = hh.x; h1[e + 1] = hh.y; } }
                u32x4 w; w.x = cvt_pk_bf16(h0[0], h0[1]); w.y = cvt_pk_bf16(h0[2], h0[3]); w.z = cvt_pk_bf16(h1[0], h1[1]); w.w = cvt_pk_bf16(h1[2], h1[3]);
                { const int l = fr + 16 * fq; *(u32x4*)(H + (size_t)(u.pm * BM + ai * HALF + wr * 64 + m * 16 + 8 * (wc & 1) + (l >> 3)) * DFF + u.pn * HALF + 64 * (wc >> 1) + (l & 7) * 8) = w; } }
    }
};
struct EpiDown {
    static constexpr int BMAP = 0;
    const bf16_t* X1B; float* out;
    __device__ __forceinline__ void operator()(const f32x4 (&acc)[2][2][4][2], const Unit& u, int wr, int wc, int fr, int fq) const {
        const int row0 = u.pm * BM + wr * 64 + fr, col0 = u.pn * BM + wc * 32 + 4 * fq;
        u32x2 xv[2][4][2][2];
#pragma unroll
        for (int ai = 0; ai < 2; ++ai)
#pragma unroll
            for (int m = 0; m < 4; ++m)
#pragma unroll
                for (int bj = 0; bj < 2; ++bj)
#pragma unroll
                    for (int n = 0; n < 2; ++n) xv[ai][m][bj][n] = *(const u32x2*)(X1B + (size_t)(row0 + ai * HALF + m * 16) * D + col0 + bj * HALF + n * 16);
#pragma unroll
        for (int ai = 0; ai < 2; ++ai)
#pragma unroll
            for (int m = 0; m < 4; ++m) { float* rowp = out + (size_t)(row0 + ai * HALF + m * 16) * D + col0;
#pragma unroll
                for (int bj = 0; bj < 2; ++bj)
#pragma unroll
                    for (int n = 0; n < 2; ++n) { const u32x2 x = xv[ai][m][bj][n];
                        const f32x4 r = {__uint_as_float(x.x << 16), __uint_as_float(x.x & 0xffff0000u), __uint_as_float(x.y << 16), __uint_as_float(x.y & 0xffff0000u)};
                        *(f32x4*)(rowp + bj * HALF + n * 16) = r + acc[ai][bj][m][n]; } }
    }
};
struct EpiNone {
    static constexpr int BMAP = 1;
    __device__ __forceinline__ void operator()(const f32x4 (&acc)[2][2][4][2], const Unit& u, int wr, int wc, int fr, int fq) const {
#pragma unroll
        for (int ai = 0; ai < 2; ++ai)
#pragma unroll
            for (int bj = 0; bj < 2; ++bj)
#pragma unroll
                for (int m = 0; m < 4; ++m)
#pragma unroll
                    for (int n = 0; n < 2; ++n) asm volatile("" :: "v"(acc[ai][bj][m][n]));
    }
};


template <int MODE> struct EpiDownProbe {
    static constexpr int BMAP = 0;
    const bf16_t* X1B; float* out;
    __device__ __forceinline__ void operator()(const f32x4 (&acc)[2][2][4][2], const Unit& u, int wr, int wc, int fr, int fq) const {
        const int row0 = u.pm * BM + wr * 64 + fr, col0 = u.pn * BM + wc * 32 + 4 * fq;
        u32x2 xv[2][4][2][2];
#pragma unroll
        for (int ai = 0; ai < 2; ++ai)
#pragma unroll
            for (int m = 0; m < 4; ++m)
#pragma unroll
                for (int bj = 0; bj < 2; ++bj)
#pragma unroll
                    for (int n = 0; n < 2; ++n) { if (MODE == 2) xv[ai][m][bj][n] = *(const u32x2*)(X1B + (size_t)(row0 + ai * HALF + m * 16) * D + col0 + bj * HALF + n * 16); else xv[ai][m][bj][n] = (u32x2){0u, 0u}; }
#pragma unroll
        for (int ai = 0; ai < 2; ++ai)
#pragma unroll
            for (int m = 0; m < 4; ++m) { float* rowp = out + (size_t)(row0 + ai * HALF + m * 16) * D + col0;
#pragma unroll
                for (int bj = 0; bj < 2; ++bj)
#pragma unroll
                    for (int n = 0; n < 2; ++n) { const u32x2 x = xv[ai][m][bj][n];
                        const f32x4 r = {__uint_as_float(x.x << 16), __uint_as_float(x.x & 0xffff0000u), __uint_as_float(x.y << 16), __uint_as_float(x.y & 0xffff0000u)};
                        const f32x4 v = r + acc[ai][bj][m][n];
                        if (MODE == 1) __builtin_nontemporal_store(v, (f32x4*)(rowp + bj * HALF + n * 16)); else asm volatile("" :: "v"(v)); } }
    }
};

template <class Epi, class Sched, bool ALIGN_EPI, int KMODE = 0>
__device__ __forceinline__ void gemm_phase(PG8_LAS unsigned char* lds, const Gemm g, const Sched& S, const Epi& E) {
    int tid_ = threadIdx.x; asm volatile("" : "+v"(tid_));
    const int tid = tid_, wid = __builtin_amdgcn_readfirstlane(tid >> 6), lane = tid & 63, wr = wid >> 2, wc = wid & 3, fr = lane & 15, fq = lane >> 4;
    const int K = g.K, nt = K / BK;
    unsigned voffA[2], voffB[2];
#pragma unroll
    for (int i = 0; i < 2; ++i) { int R, C; stage_rc(tid * 16 + i * 8192, R, C);
        const int Rb = Epi::BMAP == 0 ? R : Epi::BMAP == 1 ? ((R & ~31) + perm32(R & 31)) : (64 * (R >> 5) + perm32(R & 31));
        voffA[i] = (unsigned)(R * K + C) * 2u; voffB[i] = (unsigned)(Rb * K + C) * 2u; }
    const size_t kstep = (size_t)(BK * 2);
    const size_t hstep = (size_t)HALF * K * 2;
    const size_t hstepB = Epi::BMAP == 2 ? (size_t)32 * K * 2 : hstep;
    const size_t tstep = 2 * hstep;
    const unsigned ldsw = (unsigned)wid * 1024u;
    const int aoff = lds_byte(wr * 64 + fr, fq * 8), boff = lds_byte(wc * 32 + fr, fq * 8);
#define PG8_SA(b, h) (((b) * 2 + (h)) * HTB)
#define PG8_SB(b, h) ((4 + (b) * 2 + (h)) * HTB)
#define PG8_STAGE(bufoff, gbase, voff) do { if (KMODE != 1) { _Pragma("unroll") for (int _i = 0; _i < 2; ++_i) \
        __builtin_amdgcn_global_load_lds((const unsigned*)((const char*)(KMODE == 2 ? (const void*)g.Bt : (const void*)(gbase)) + (voff)[_i]), (PG8_LAS unsigned*)(lds + (bufoff) + ldsw + _i * 8192), 16, 0, 0); } } while (0)
#define PG8_LDA(dst, b, h) do { if (KMODE != 3) { _Pragma("unroll") for (int m = 0; m < 4; ++m) _Pragma("unroll") for (int k = 0; k < 2; ++k) dst[m][k] = *(const PG8_LAS bf16x8*)(lds + PG8_SA(b, h) + aoff + m * 2048 + k * 1024); } else { _Pragma("unroll") for (int m = 0; m < 4; ++m) _Pragma("unroll") for (int k = 0; k < 2; ++k) asm volatile("" : "+v"(dst[m][k])); } } while (0)
#define PG8_LDB(dst, b, h) do { if (KMODE != 3) { _Pragma("unroll") for (int n = 0; n < 2; ++n) _Pragma("unroll") for (int k = 0; k < 2; ++k) dst[n][k] = *(const PG8_LAS bf16x8*)(lds + PG8_SB(b, h) + boff + n * 2048 + k * 1024); } else { _Pragma("unroll") for (int n = 0; n < 2; ++n) _Pragma("unroll") for (int k = 0; k < 2; ++k) asm volatile("" : "+v"(dst[n][k])); } } while (0)
#define PG8_MMA(ai, bj, At, Bt) do { __builtin_amdgcn_s_setprio(1); _Pragma("unroll") for (int m = 0; m < 4; ++m) _Pragma("unroll") for (int n = 0; n < 2; ++n) _Pragma("unroll") for (int k = 0; k < 2; ++k) \
        acc[ai][bj][m][n] = __builtin_amdgcn_mfma_f32_16x16x32_bf16(Bt[n][k], At[m][k], acc[ai][bj][m][n], 0, 0, 0); __builtin_amdgcn_s_setprio(0); } while (0)
#define PG8_WAIT_V(n) asm volatile("s_waitcnt vmcnt(" #n ")" ::: "memory")
#define PG8_WAIT_L(n) asm volatile("s_waitcnt lgkmcnt(" #n ")" ::: "memory")
#define PG8_BAR __builtin_amdgcn_s_barrier()
#define PG8_SCHED __builtin_amdgcn_sched_barrier(0)
    Unit cur, nxt; int ui = 0;
    if (!S.next(0, cur)) return;
    f32x4 acc[2][2][4][2];
#pragma unroll
    for (int a = 0; a < 2; ++a)
#pragma unroll
        for (int b = 0; b < 2; ++b)
#pragma unroll
            for (int m = 0; m < 4; ++m)
#pragma unroll
                for (int n = 0; n < 2; ++n) acc[a][b][m][n] = (f32x4){0.f, 0.f, 0.f, 0.f};
    bf16x8 At[4][2], B0[2][2], B1[2][2];
    if (KMODE == 3) { _Pragma("unroll") for (int m = 0; m < 4; ++m) _Pragma("unroll") for (int k = 0; k < 2; ++k) At[m][k] = (bf16x8){1, 2, 3, 4, 5, 6, 7, 8}; _Pragma("unroll") for (int n = 0; n < 2; ++n) _Pragma("unroll") for (int k = 0; k < 2; ++k) { B0[n][k] = (bf16x8){1, 2, 3, 4, 5, 6, 7, 8}; B1[n][k] = B0[n][k]; } }
    const char* cA = (const char*)g.A + (size_t)cur.pm * tstep; const char* cB = (const char*)g.Bt + (size_t)cur.pn * tstep;
    PG8_STAGE(PG8_SB(0, 0), cB, voffB); PG8_STAGE(PG8_SB(0, 1), cB + hstepB, voffB); PG8_STAGE(PG8_SA(0, 0), cA, voffA); PG8_STAGE(PG8_SA(0, 1), cA + hstep, voffA);
    if (wr == 1) PG8_BAR;
    PG8_WAIT_V(2); PG8_BAR;
    PG8_STAGE(PG8_SB(1, 0), cB + kstep, voffB); PG8_STAGE(PG8_SA(1, 0), cA + kstep, voffA); PG8_STAGE(PG8_SB(1, 1), cB + hstepB + kstep, voffB);
    PG8_WAIT_V(6); PG8_BAR;
    for (;;) {
        const bool has_next = S.next(ui + 1, nxt);
        const char* nA = has_next ? (const char*)g.A + (size_t)nxt.pm * tstep : cA; const char* nB = has_next ? (const char*)g.Bt + (size_t)nxt.pn * tstep : cB;
        for (int t = 0; t < nt; t += 2) {
            const bool last = (t == nt - 2);
            const char* a1 = cA + (size_t)(t + 1) * kstep;
            const char* a2 = last ? nA : cA + (size_t)(t + 2) * kstep; const char* b2 = last ? nB : cB + (size_t)(t + 2) * kstep;
            const char* a3 = a2 + kstep; const char* b3 = b2 + kstep;
            if constexpr (KMODE == 4) {
            PG8_LDB(B0, 0, 0); PG8_LDB(B1, 0, 1); PG8_SCHED; PG8_LDA(At, 0, 0);
            PG8_WAIT_V(6); PG8_WAIT_L(0); PG8_BAR; PG8_STAGE(PG8_SA(1, 1), a1 + hstep, voffA); PG8_MMA(0, 0, At, B0); PG8_MMA(0, 1, At, B1); PG8_BAR; PG8_SCHED;
            PG8_LDA(At, 0, 1);
            PG8_WAIT_V(2); PG8_WAIT_L(0); PG8_BAR; PG8_STAGE(PG8_SB(0, 0), b2, voffB); PG8_STAGE(PG8_SB(0, 1), b2 + hstepB, voffB); PG8_STAGE(PG8_SA(0, 0), a2, voffA); PG8_MMA(1, 0, At, B0); PG8_MMA(1, 1, At, B1); PG8_BAR; PG8_SCHED;
            PG8_LDB(B0, 1, 0); PG8_LDB(B1, 1, 1); PG8_SCHED; PG8_LDA(At, 1, 0);
            PG8_WAIT_V(6); PG8_WAIT_L(0); PG8_BAR; PG8_STAGE(PG8_SA(0, 1), a2 + hstep, voffA); PG8_MMA(0, 0, At, B0); PG8_MMA(0, 1, At, B1); PG8_BAR; PG8_SCHED;
            PG8_LDA(At, 1, 1);
            PG8_WAIT_V(2); PG8_WAIT_L(0); PG8_BAR; PG8_STAGE(PG8_SB(1, 0), b3, voffB); PG8_STAGE(PG8_SB(1, 1), b3 + hstepB, voffB); PG8_STAGE(PG8_SA(1, 0), a3, voffA); PG8_MMA(1, 0, At, B0); PG8_MMA(1, 1, At, B1); PG8_BAR; PG8_SCHED;
            } else {
            PG8_LDB(B0, 0, 0); PG8_LDB(B1, 0, 1); PG8_SCHED; PG8_LDA(At, 0, 0); PG8_STAGE(PG8_SA(1, 1), a1 + hstep, voffA);
            PG8_WAIT_V(8); PG8_WAIT_L(0); PG8_BAR; PG8_MMA(0, 0, At, B0); PG8_MMA(0, 1, At, B1); PG8_BAR; PG8_SCHED;
            PG8_LDA(At, 0, 1); PG8_STAGE(PG8_SB(0, 0), b2, voffB); PG8_STAGE(PG8_SB(0, 1), b2 + hstepB, voffB); PG8_STAGE(PG8_SA(0, 0), a2, voffA);
            PG8_WAIT_V(8); PG8_WAIT_L(0); PG8_BAR; PG8_MMA(1, 0, At, B0); PG8_MMA(1, 1, At, B1); PG8_BAR; PG8_SCHED;
            PG8_LDB(B0, 1, 0); PG8_LDB(B1, 1, 1); PG8_SCHED; PG8_LDA(At, 1, 0); PG8_STAGE(PG8_SA(0, 1), a2 + hstep, voffA);
            PG8_WAIT_V(8); PG8_WAIT_L(0); PG8_BAR; PG8_MMA(0, 0, At, B0); PG8_MMA(0, 1, At, B1); PG8_BAR; PG8_SCHED;
            PG8_LDA(At, 1, 1); PG8_STAGE(PG8_SB(1, 0), b3, voffB); PG8_STAGE(PG8_SB(1, 1), b3 + hstepB, voffB); PG8_STAGE(PG8_SA(1, 0), a3, voffA);
            PG8_WAIT_V(8); PG8_WAIT_L(0); PG8_BAR; PG8_MMA(1, 0, At, B0); PG8_MMA(1, 1, At, B1); PG8_BAR; PG8_SCHED;
                    }
        }
        if constexpr (ALIGN_EPI) { if (wr == 0) PG8_BAR; }
        E(acc, cur, wr, wc, fr, fq);
        if (!has_next) break;
#pragma unroll
        for (int a = 0; a < 2; ++a)
#pragma unroll
            for (int b = 0; b < 2; ++b)
#pragma unroll
                for (int m = 0; m < 4; ++m)
#pragma unroll
                    for (int n = 0; n < 2; ++n) acc[a][b][m][n] = (f32x4){0.f, 0.f, 0.f, 0.f};
        cur = nxt; cA = nA; cB = nB; ++ui;
        if constexpr (ALIGN_EPI) { if (wr == 1) PG8_BAR; }
    }
    PG8_WAIT_V(0);
    if constexpr (!ALIGN_EPI) { if (wr == 0) PG8_BAR; }
    PG8_BAR;
#undef PG8_SA
#undef PG8_SB
#undef PG8_STAGE
#undef PG8_LDA
#undef PG8_LDB
#undef PG8_MMA
#undef PG8_WAIT_V
#undef PG8_WAIT_L
#undef PG8_BAR
#undef PG8_SCHED
}
}
#define LAS __attribute__((address_space(3)))

struct Args;
__device__ __forceinline__ void p0_prologue_naive(const float* const* in, unsigned char* ws, int G) {
    const size_t gt = (size_t)blockIdx.x * 512 + threadIdx.x, GT = (size_t)G * 512;
    for (size_t i = gt; i < NPREP; i += GT) prep_w_elem(i, in[4], in[13], in[15], in[16], in[17], in[9], in[14], ws);
    const int wave = threadIdx.x >> 6, lane = threadIdx.x & 63;
    for (int m = blockIdx.x * 8 + wave; m < M; m += G * 8) xn_row(m, lane, in[0], in[1], in[3], (bf16_t*)(ws + WS_XN));
}


__device__ __forceinline__ unsigned pk2(float lo, float hi) { return f2bf(lo) | (f2bf(hi) << 16); }
__device__ __forceinline__ void p0_item(const float* W, int K, int N, bf16_t* WT, int orow0, const float* kscale, LAS float* scr, int k0, int n0, int lane) {
    typedef unsigned v4u __attribute__((ext_vector_type(4)));
    float wv[32];
#pragma unroll
    for (int i = 0; i < 32; ++i) wv[i] = W[(size_t)(k0 + 2 * i + (lane >> 5)) * N + n0 + (lane & 31)];
    if (kscale) {
#pragma unroll
        for (int i = 0; i < 32; ++i) wv[i] *= kscale[k0 + 2 * i + (lane >> 5)]; }
#pragma unroll
    for (int i = 0; i < 32; ++i) scr[(2 * i + (lane >> 5)) * 33 + (lane & 31)] = wv[i];
    asm volatile("s_waitcnt lgkmcnt(0)" ::: "memory");
    const int c = lane & 7;
#pragma unroll
    for (int j = 0; j < 4; ++j) { const int n = (lane >> 3) + 8 * j; const LAS float* s = scr + (8 * c) * 33 + n;
        v4u o; o.x = pk2(s[0 * 33], s[1 * 33]); o.y = pk2(s[2 * 33], s[3 * 33]); o.z = pk2(s[4 * 33], s[5 * 33]); o.w = pk2(s[6 * 33], s[7 * 33]);
        *(v4u*)(WT + (size_t)(orow0 + n) * K + k0 + 8 * c) = o; }
    asm volatile("s_waitcnt lgkmcnt(0)" ::: "memory");
}
__device__ __forceinline__ void p0_weights(const float* const* in, unsigned char* ws, LAS unsigned char* lds, int it_lo, int it_hi, int w, int nw) {
    const int wave = __builtin_amdgcn_readfirstlane(threadIdx.x >> 6), lane = threadIdx.x & 63;
    LAS float* scr = (LAS float*)(lds + wave * 16384);
    constexpr int I_IN = (D / 64) * (INW / 32), I_O = (D / 64) * (D / 32), I_G = (D / 64) * (DFF / 32);
    bf16_t* WIN = (bf16_t*)(ws + WS_WIN); bf16_t* WO = (bf16_t*)(ws + WS_WO); bf16_t* WGU = (bf16_t*)(ws + WS_WGU); bf16_t* WDN = (bf16_t*)(ws + WS_WDN);
    for (int it = it_lo + w; it < it_hi; it += nw) {
        int r = it;
        if (r < I_IN) { const int nb = r % (INW / 32), kb = r / (INW / 32); p0_item(in[4], D, INW, WIN, 32 * nb, in[3], scr, 64 * kb, 32 * nb, lane); continue; } r -= I_IN;
        if (r < I_O) { const int nb = r % (D / 32), kb = r / (D / 32); p0_item(in[13], D, D, WO, 32 * nb, nullptr, scr, 64 * kb, 32 * nb, lane); continue; } r -= I_O;
        if (r < 2 * I_G) { const int up = r >= I_G; if (up) r -= I_G; const int nb = r % (DFF / 32), kb = r / (DFF / 32), n0 = 32 * nb;
            p0_item(in[up ? 16 : 15], D, DFF, WGU, 256 * (n0 >> 7) + (n0 & 127) + 128 * up, in[14], scr, 64 * kb, n0, lane); continue; } r -= 2 * I_G;
        { const int nb = r % (D / 32), kb = r / (D / 32); p0_item(in[17], DFF, D, WDN, 32 * nb, nullptr, scr, 64 * kb, 32 * nb, lane); }
    }
}
constexpr int P0_I_IN = (D / 64) * (INW / 32), P0_NITEMS = P0_I_IN + (D / 64) * (D / 32) + 2 * (D / 64) * (DFF / 32) + (DFF / 64) * (D / 32);
__device__ __forceinline__ void p0_prologue(const float* const* in, unsigned char* ws, LAS unsigned char* lds, int G) {
    const int wave = __builtin_amdgcn_readfirstlane(threadIdx.x >> 6), lane = threadIdx.x & 63;
    const int gw = (int)blockIdx.x * 8 + wave, NGW = G * 8;
    p0_weights(in, ws, lds, 0, MK_LATE_WEIGHTS ? P0_I_IN : P0_NITEMS, gw, NGW);
    { const size_t gt = (size_t)blockIdx.x * 512 + threadIdx.x; bf16_t* WSB = (bf16_t*)(ws + WS_WS); for (size_t i = gt; i < 8 * 128 * 128; i += (size_t)G * 512) WSB[i] = f2bf(in[9][i]); }
    typedef float f32x4 __attribute__((ext_vector_type(4)));
    bf16_t* XB = (bf16_t*)(ws + WS_XN); float* RS1 = (float*)(ws + WS_RS1);
    for (int m4 = gw * 4; m4 < M; m4 += NGW * 4) {
        const f32x4* xr = (const f32x4*)(m4 < MP ? in[0] + (size_t)m4 * D : in[1] + (size_t)(m4 - MP) * D) + lane;
        f32x4 v[4][4]; float ss[4];
#pragma unroll
        for (int r = 0; r < 4; ++r)
#pragma unroll
            for (int j = 0; j < 4; ++j) v[r][j] = __builtin_nontemporal_load(xr + r * (D / 4) + 64 * j);
#pragma unroll
        for (int r = 0; r < 4; ++r) { ss[r] = 0.f;
            unsigned long long* b8 = (unsigned long long*)(XB + (size_t)(m4 + r) * D) + lane;
#pragma unroll
            for (int j = 0; j < 4; ++j) { ss[r] += (v[r][j][0] * v[r][j][0] + v[r][j][1] * v[r][j][1]) + (v[r][j][2] * v[r][j][2] + v[r][j][3] * v[r][j][3]);
                b8[64 * j] = (unsigned long long)pk2(v[r][j][0], v[r][j][1]) | ((unsigned long long)pk2(v[r][j][2], v[r][j][3]) << 32); } }
#pragma unroll
        for (int o = 1; o < 64; o <<= 1) {
#pragma unroll
            for (int r = 0; r < 4; ++r) ss[r] += __shfl_xor(ss[r], o); }
        if (lane < 4) RS1[m4 + lane] = rsqrtf((lane == 0 ? ss[0] : lane == 1 ? ss[1] : lane == 2 ? ss[2] : ss[3]) * (1.0f / D) + EPS);
    }
}

__device__ __forceinline__ void p2_mixer_naive(const float* const* in, unsigned char* ws, unsigned char* lds_generic, int G) {
    MixNaiveLds* L = (MixNaiveLds*)lds_generic + (threadIdx.x >> 8);
    for (int pr = blockIdx.x; pr < M / 2; pr += G)
        mix_naive_token(2 * pr + (threadIdx.x >> 8), threadIdx.x & 255, *L, (const bf16_t*)(ws + WS_PROJ), (const float*)(ws + WS_VSSQ), (const bf16_t*)(ws + WS_WS), in[2], in[7], in[8], in[10], in[11], in[12], (bf16_t*)(ws + WS_MIX));
}

static void launch_naive_phase(int p, void* const* d_in, float* out, unsigned char* ws, hipStream_t stream) {
    const float* xp = (const float*)d_in[0]; const float* xs = (const float*)d_in[1]; const float* rel = (const float*)d_in[2]; const float* norm1 = (const float*)d_in[3];
    const float* w_in = (const float*)d_in[4]; const float* qg = (const float*)d_in[5]; const float* kg = (const float*)d_in[6]; const float* sink = (const float*)d_in[7];
    const float* vg = (const float*)d_in[8]; const float* w_s = (const float*)d_in[9]; const float* b_s = (const float*)d_in[10]; const float* ag = (const float*)d_in[11];
    const float* gg = (const float*)d_in[12]; const float* w_o = (const float*)d_in[13]; const float* norm2 = (const float*)d_in[14]; const float* w_gate = (const float*)d_in[15];
    const float* w_up = (const float*)d_in[16]; const float* w_down = (const float*)d_in[17];
    bf16_t* WIN = (bf16_t*)(ws + WS_WIN); bf16_t* WO = (bf16_t*)(ws + WS_WO); bf16_t* WGU = (bf16_t*)(ws + WS_WGU); bf16_t* WDN = (bf16_t*)(ws + WS_WDN); bf16_t* WSB = (bf16_t*)(ws + WS_WS);
    float* VSSQ = (float*)(ws + WS_VSSQ); float* SSQ2 = (float*)(ws + WS_SSQ2);
    bf16_t* XN = (bf16_t*)(ws + WS_XN); bf16_t* PROJ = (bf16_t*)(ws + WS_PROJ); bf16_t* H = (bf16_t*)(ws + WS_H); bf16_t* MIX = (bf16_t*)(ws + WS_MIX); bf16_t* X1B = (bf16_t*)(ws + WS_X1B);
    switch (p) {
    case 0: k_prep_w<<<(unsigned)((NPREP + 255) / 256), 256, 0, stream>>>(w_in, w_o, w_gate, w_up, w_down, w_s, norm2, ws);
            k_xn<<<M / 4, 256, 0, stream>>>(xp, xs, norm1, XN); break;
    case 1: k_gemm_naive<NEpiIn, false><<<dim3(INW / 64, M / 64), 256, 0, stream>>>(XN, WIN, D, NEpiIn{PROJ, VSSQ, qg, kg}); break;
    case 2: k_mix_naive<<<M, 256, 0, stream>>>(PROJ, VSSQ, WSB, rel, sink, vg, b_s, ag, gg, MIX); break;
    case 3: k_gemm_naive<NEpiOut, false><<<dim3(D / 64, M / 64), 256, 0, stream>>>(MIX, WO, D, NEpiOut{xp, xs, out, X1B, SSQ2}); break;
    case 4: k_gemm_naive<NEpiUp, true><<<dim3(DFF / 64, M / 64), 256, 0, stream>>>(X1B, WGU, D, NEpiUp{H, SSQ2}); break;
    case 5: k_gemm_naive<NEpiDown, false><<<dim3(D / 64, M / 64), 256, 0, stream>>>(H, WDN, DFF, NEpiDown{out}); break;
    }
}

namespace mix {
typedef short bf16x8 __attribute__((ext_vector_type(8)));
typedef short s16x4 __attribute__((ext_vector_type(4)));
typedef float f32x16 __attribute__((ext_vector_type(16)));
typedef float f32x4 __attribute__((ext_vector_type(4)));
typedef unsigned u32x2 __attribute__((ext_vector_type(2)));
typedef unsigned u32x4 __attribute__((ext_vector_type(4)));
typedef float f32x2_t __attribute__((ext_vector_type(2))); typedef __bf16 bf16x2_t __attribute__((ext_vector_type(2)));
constexpr int L_K = 0, L_V = 40960, L_TAB = 81920, TABN = 392, L_RV = L_TAB + 8 * 4 * TABN * 4, L_SS = L_RV + 512, L_END = L_SS + 2048, L_UA = 65536, L_UB = L_END, L_END2 = L_UB + 16384, L_PAR = L_END2, L_END3 = L_PAR + 2560 * 4;
constexpr int NUNITS = NSEQ * (SEQ / 64);
__device__ __forceinline__ unsigned cvtpk(float lo, float hi) { f32x2_t v = {lo, hi}; bf16x2_t b = __builtin_convertvector(v, bf16x2_t); return __builtin_bit_cast(unsigned, b); }
__device__ __forceinline__ s16x4 trrd(const LAS unsigned char* p) { typedef short v4i16_t __attribute__((ext_vector_type(4))); return __builtin_bit_cast(s16x4, __builtin_amdgcn_ds_read_tr16_b64_v4i16((LAS v4i16_t*)p)); }
__device__ __forceinline__ float xhalf_sum(float v) { auto rr = __builtin_amdgcn_permlane32_swap(__float_as_uint(v), __float_as_uint(v), false, false); return __uint_as_float(rr[0]) + __uint_as_float(rr[1]); }
__device__ __forceinline__ float xhalf_max(float v) { auto rr = __builtin_amdgcn_permlane32_swap(__float_as_uint(v), __float_as_uint(v), false, false); return fmaxf(__uint_as_float(rr[0]), __uint_as_float(rr[1])); }


__device__ __forceinline__ void store_pairs(bf16_t* p, const u32x2 (&w)[4], int hi, bool skip = false) {
    if (skip) { asm volatile("" :: "v"(w[0].x), "v"(w[1].x), "v"(w[2].x), "v"(w[3].x)); return; }
#pragma unroll
    for (int k = 0; k < 4; k += 2) {
        auto rx = __builtin_amdgcn_permlane32_swap(w[k].x, w[k + 1].x, false, false); auto ry = __builtin_amdgcn_permlane32_swap(w[k].y, w[k + 1].y, false, false);
        const u32x4 v = {rx[0], ry[0], rx[1], ry[1]};
        *(u32x4*)(p + 8 * (k + hi)) = v;
    }
}

template <int MODE> __device__ __forceinline__ void stage_rows(LAS unsigned char* img, const bf16_t* src, int row_lo, int row_hi, int wave, int lane, bool nodma) {
    if (nodma) return;
    for (int r8 = (row_lo >> 3) + wave; r8 < (row_hi >> 3); r8 += 8) {
        const int row = 8 * r8 + (lane >> 3), pc = lane & 7, c = MODE == 0 ? (pc ^ ((row >> 1) & 7)) : (pc ^ (((row >> 1) & 1) << 2));
        __builtin_amdgcn_global_load_lds((const unsigned*)(src + (size_t)row * INW + 8 * c), (LAS unsigned*)(img + r8 * 1024), 16, 0, 0);
    }
}


template <bool FAST> __device__ __forceinline__ void attn_tiles(LAS unsigned char* lds, const bf16x8 (&qf)[4], const LAS float* tbp, int kt_lo, int kt_hi, const int (&koff)[4], const int (&voff)[2], int hi, f32x16& o0r, f32x16& o1r) {
    float m = 0.0f, l = hi == 0 ? 1.0f : 0.0f;
    f32x16 o0 = {}, o1 = {};
    for (int kt = kt_lo; kt < kt_hi; ++kt) {
        f32x16 p0, p1;
        { const LAS float* tp = tbp + 64 * kt;
#pragma unroll
          for (int gq = 0; gq < 4; ++gq) { const f32x4 a = *(const LAS f32x4*)(tp + 8 * gq), b = *(const LAS f32x4*)(tp + 32 + 8 * gq);
#pragma unroll
              for (int e = 0; e < 4; ++e) { p0[4 * gq + e] = a[e]; p1[4 * gq + e] = b[e]; } } }
        const LAS unsigned char* kb = lds + L_K + kt * 8192;
#pragma unroll
        for (int d0 = 0; d0 < 4; ++d0) { const bf16x8 k0 = *(const LAS bf16x8*)(kb + koff[d0]), k1 = *(const LAS bf16x8*)(kb + 4096 + koff[d0]);
            p0 = __builtin_amdgcn_mfma_f32_32x32x16_bf16(k0, qf[d0], p0, 0, 0, 0); p1 = __builtin_amdgcn_mfma_f32_32x32x16_bf16(k1, qf[d0], p1, 0, 0, 0); }
        const LAS unsigned char* vb = lds + L_V + kt * 8192;
        bf16x8 vf0[2][2];
#pragma unroll
        for (int sI = 0; sI < 2; ++sI)
#pragma unroll
            for (int dh = 0; dh < 2; ++dh) { const LAS unsigned char* vp = vb + (16 * sI) * 128 + voff[dh];
                const s16x4 lo = trrd(vp), hi4 = trrd(vp + 8 * 128); vf0[sI][dh] = (bf16x8){lo[0], lo[1], lo[2], lo[3], hi4[0], hi4[1], hi4[2], hi4[3]}; }
        float ls = 0.f;
        if (FAST) {
#pragma unroll
            for (int r = 0; r < 16; ++r) { p0[r] = __builtin_amdgcn_exp2f(p0[r]); p1[r] = __builtin_amdgcn_exp2f(p1[r]); }
            { f32x2_t l2 = {0.f, 0.f};
#pragma unroll
              for (int r = 0; r < 16; r += 2) l2 += (f32x2_t){p0[r], p0[r + 1]} + (f32x2_t){p1[r], p1[r + 1]};
              ls = l2.x + l2.y; }
            l += ls;
        } else {
            float rm = fmaxf(p0[0], p1[0]);
#pragma unroll
            for (int r = 1; r < 16; ++r) rm = fmaxf(rm, fmaxf(p0[r], p1[r]));
            rm = xhalf_max(rm);
            const float mn = fmaxf(m, rm), alpha = __builtin_amdgcn_exp2f(m - mn); m = mn;
#pragma unroll
            for (int r = 0; r < 16; ++r) { p0[r] = __builtin_amdgcn_exp2f(p0[r] - m); p1[r] = __builtin_amdgcn_exp2f(p1[r] - m); ls += p0[r] + p1[r]; }
            l = l * alpha + ls;
#pragma unroll
            for (int r = 0; r < 16; ++r) { o0[r] *= alpha; o1[r] *= alpha; }
        }
        u32x4 pw[2][2];
#pragma unroll
        for (int sI = 0; sI < 2; ++sI) { pw[0][sI] = (u32x4){cvtpk(p0[8 * sI], p0[8 * sI + 1]), cvtpk(p0[8 * sI + 2], p0[8 * sI + 3]), cvtpk(p0[8 * sI + 4], p0[8 * sI + 5]), cvtpk(p0[8 * sI + 6], p0[8 * sI + 7])};
                                         pw[1][sI] = (u32x4){cvtpk(p1[8 * sI], p1[8 * sI + 1]), cvtpk(p1[8 * sI + 2], p1[8 * sI + 3]), cvtpk(p1[8 * sI + 4], p1[8 * sI + 5]), cvtpk(p1[8 * sI + 6], p1[8 * sI + 7])}; }
#pragma unroll
        for (int sI = 0; sI < 2; ++sI) { const bf16x8 pf = __builtin_bit_cast(bf16x8, pw[0][sI]);
            o0 = __builtin_amdgcn_mfma_f32_32x32x16_bf16(vf0[sI][0], pf, o0, 0, 0, 0); o1 = __builtin_amdgcn_mfma_f32_32x32x16_bf16(vf0[sI][1], pf, o1, 0, 0, 0); }
#pragma unroll
        for (int sI = 0; sI < 2; ++sI) { const bf16x8 pf = __builtin_bit_cast(bf16x8, pw[1][sI]);
#pragma unroll
            for (int dh = 0; dh < 2; ++dh) { const LAS unsigned char* vp = vb + (32 + 16 * sI) * 128 + voff[dh];
                const s16x4 lo = trrd(vp), hi4 = trrd(vp + 8 * 128); const bf16x8 vf = {lo[0], lo[1], lo[2], lo[3], hi4[0], hi4[1], hi4[2], hi4[3]};
                if (dh == 0) o0 = __builtin_amdgcn_mfma_f32_32x32x16_bf16(vf, pf, o0, 0, 0, 0); else o1 = __builtin_amdgcn_mfma_f32_32x32x16_bf16(vf, pf, o1, 0, 0, 0); } }
    }
    const float inv = 1.0f / xhalf_sum(l);
#pragma unroll
    for (int r = 0; r < 16; ++r) { o0[r] *= inv; o1[r] *= inv; }
    o0r = o0; o1r = o1;
}

__device__ __forceinline__ void p2_mixer(const float* const* in, unsigned char* ws, LAS unsigned char* lds, int G, int pflags) {
    const bool nodma = pflags & 1;
    const int tid = threadIdx.x, wave = __builtin_amdgcn_readfirstlane(tid >> 6), lane = tid & 63, r32 = lane & 31, hi = lane >> 5, hq = wave >> 1, tb = wave & 1;
    const bf16_t* PROJ = (const bf16_t*)(ws + WS_PROJ); const float* VSSQ = (const float*)(ws + WS_VSSQ); const bf16_t* WSB = (const bf16_t*)(ws + WS_WS); bf16_t* MIX = (bf16_t*)(ws + WS_MIX);
    const float* rel_table = in[2]; const float* sink = in[7]; const float* v_gain = in[8]; const float* b_s = in[10]; const float* ag = in[11]; const float* gg = in[12];
    LAS float* TAB = (LAS float*)(lds + L_TAB); LAS float* RV = (LAS float*)(lds + L_RV); LAS float* SS = (LAS float*)(lds + L_SS);
    { LAS float* RT = (LAS float*)(lds + L_K);
      if (tid < 256) RT[tid] = rel_table[tid]; else if (tid < 264) RT[tid] = sink[tid - 256];
      __syncthreads();
      for (int i = tid; i < 8 * 4 * TABN; i += 512) { const int h = i / (4 * TABN), rem = i % (4 * TABN), sh = rem / TABN, e = rem % TABN, bi = e + sh - 64;
          TAB[i] = (bi >= 0 && bi <= 256) ? (RT[t5_bucket(bi - 128) * 8 + h] - RT[256 + h]) * LOG2E : -1e30f; }
      LAS float* PAR = (LAS float*)(lds + L_PAR);
      PAR[tid] = ag[tid]; PAR[512 + tid] = gg[tid]; PAR[1024 + tid] = v_gain[tid]; PAR[1536 + tid] = b_s[tid]; PAR[2048 + tid] = b_s[512 + tid]; }
    const LAS float* PAG = (const LAS float*)(lds + L_PAR); const LAS float* PGG = PAG + 512; const LAS float* PVG = PAG + 1024; const LAS float* PBS = PAG + 1536;
    bool fast;
    { float mq = fabsf(in[5][lane]), mk = fabsf(in[6][lane]), mb = fmaxf(fmaxf(fabsf(rel_table[lane]), fabsf(rel_table[64 + lane])), fmaxf(fabsf(rel_table[128 + lane]), fabsf(rel_table[192 + lane]))), ms = fabsf(sink[lane & 7]);
#pragma unroll
      for (int o = 1; o < 64; o <<= 1) { mq = fmaxf(mq, __shfl_xor(mq, o)); mk = fmaxf(mk, __shfl_xor(mk, o)); mb = fmaxf(mb, __shfl_xor(mb, o)); ms = fmaxf(ms, __shfl_xor(ms, o)); }
      const float bound = (8.0f * mq * mk * 1.02f + mb + ms) * LOG2E;
      fast = __builtin_amdgcn_readfirstlane((int)(bound < 100.0f)) != 0; }
    int koff[4], voff[2], gvoff[2];
    { const int q = (lane & 15) >> 2, sw = (q >> 1) & 1;
#pragma unroll
      for (int d0 = 0; d0 < 4; ++d0) koff[d0] = r32 * 128 + (((2 * d0 + hi) ^ ((r32 >> 1) & 7)) << 4);
#pragma unroll
      for (int dh = 0; dh < 2; ++dh) { const int ch = 4 * (dh ^ sw) + 2 * ((lane >> 4) & 1) + ((lane & 3) >> 1);
          voff[dh] = (4 * hi + q) * 128 + ch * 16 + (lane & 1) * 8; gvoff[dh] = (8 * hi + q) * 128 + ch * 16 + (lane & 1) * 8; } }
    const int e0 = 64 - 32 * tb - r32 + 4 * hi, sh = e0 & 3;
    const int vcu = (G % 8 == 0) ? ((int)blockIdx.x % 8) * (G / 8) + (int)blockIdx.x / 8 : (int)blockIdx.x;

    for (int ri = 0; ; ++ri) {
        int u;
        if (MK_REV2 && G == 256 && NUNITS == 768) { if (ri >= 3) break; u = 4 * (24 * (vcu >> 5) + 8 * (2 - ri) + ((vcu & 31) >> 2)) + (vcu & 3); }
        else { u = vcu + ri * G; if (u >= NUNITS) break; }
        const int s = u >> 6, t0 = (u & 63) * 64, m0 = s * SEQ + t0;
        const int kt_lo = t0 < 128 ? (128 - t0) >> 6 : 0, kt_hi = (pflags & 2) ? kt_lo : (t0 + 192 > SEQ ? (SEQ + 128 - t0) >> 6 : 5);
        const int mc = m0 - (t0 & 127), pbase = (t0 & 127) + 32 * tb + r32;
        const size_t mrow = (size_t)(m0 + 32 * tb + r32);
        f32x16 oa[2][2];
        __syncthreads();
        if (tid < 128) { const f32x4* vp = (const f32x4*)(VSSQ + (size_t)(mc + tid) * 8); const f32x4 a = vp[0] + vp[1]; RV[tid] = rsqrtf(((a[0] + a[1]) + (a[2] + a[3])) * (1.0f / 512.0f) + EPS); }
#pragma unroll
        for (int g = 0; g < 2; ++g) {
            const int h = 4 * g + hq;
            if (g == 1) __syncthreads();
            { const bf16_t* krow0 = PROJ + (long)(m0 - 128) * INW + 512 + 64 * g;
              stage_rows<0>(lds + L_K, krow0, 64 * kt_lo, 64 * kt_hi, wave, lane, nodma);
              stage_rows<1>(lds + L_V, krow0 + 128, 64 * kt_lo, 64 * kt_hi, wave, lane, nodma); }
            bf16x8 qf[4];
#pragma unroll
            for (int d0 = 0; d0 < 4; ++d0) qf[d0] = *(const bf16x8*)(PROJ + mrow * INW + 64 * h + 16 * d0 + 8 * hi);
            __syncthreads();
            f32x16 o0, o1;
            { const LAS float* tbp = TAB + (h * 4 + sh) * TABN + (e0 - sh);
              if (fast) attn_tiles<true>(lds, qf, tbp, kt_lo, kt_hi, koff, voff, hi, o0, o1); else attn_tiles<false>(lds, qf, tbp, kt_lo, kt_hi, koff, voff, hi, o0, o1); }
            oa[g][0] = o0; oa[g][1] = o1;
        }
        { float ss = 0.f;
#pragma unroll
          for (int g = 0; g < 2; ++g)
#pragma unroll
              for (int dh = 0; dh < 2; ++dh)
#pragma unroll
                  for (int r = 0; r < 16; ++r) ss += oa[g][dh][r] * oa[g][dh][r];
          ss = xhalf_sum(ss); if (hi == 0) SS[wave * 32 + r32] = ss; }
        __syncthreads();
        { const bf16_t* vrow0 = PROJ + (size_t)mc * INW + 1280;
#pragma unroll
          for (int hh = 0; hh < 4; ++hh) stage_rows<1>(lds + hh * 16384, vrow0 + 64 * hh, 0, 128, wave, lane, nodma);
          const bf16_t* urow0 = PROJ + (size_t)m0 * INW + 768;
#pragma unroll
          for (int hh = 0; hh < 4; ++hh) stage_rows<0>(lds + (hh < 2 ? L_UA + hh * 8192 : L_UB + (hh - 2) * 8192), urow0 + 64 * hh, 0, 64, wave, lane, nodma); }
        { const float tot = (SS[tb * 32 + r32] + SS[(2 + tb) * 32 + r32]) + (SS[(4 + tb) * 32 + r32] + SS[(6 + tb) * 32 + r32]);
          const float ra = rsqrtf(tot * (1.0f / 512.0f) + EPS);
#pragma unroll
          for (int g = 0; g < 2; ++g)
#pragma unroll
              for (int dh = 0; dh < 2; ++dh)
                  { u32x2 w[4];
#pragma unroll
                    for (int gq = 0; gq < 4; ++gq) { const int col = 64 * (4 * g + hq) + 32 * dh + 8 * gq + 4 * hi; const f32x4 gn = *(const LAS f32x4*)(PAG + col);
                      const f32x2_t s0 = ((f32x2_t){oa[g][dh][4 * gq], oa[g][dh][4 * gq + 1]} * ra) * (f32x2_t){gn[0], gn[1]}, s1 = ((f32x2_t){oa[g][dh][4 * gq + 2], oa[g][dh][4 * gq + 3]} * ra) * (f32x2_t){gn[2], gn[3]};
                      w[gq].x = cvtpk(s0.x, s0.y); w[gq].y = cvtpk(s1.x, s1.y); }
                    store_pairs(MIX + mrow * D + 64 * (4 * g + hq) + 32 * dh, w, hi, pflags & 8); } }
        f32x16 og[2][2];
#pragma unroll
        for (int rd = 0; rd < 2; ++rd) {
            const int hh = 4 * rd + hq;
            if (rd == 1) { __syncthreads();
                const bf16_t* vrow0 = PROJ + (size_t)mc * INW + 1280 + 256;
#pragma unroll
                for (int h4 = 0; h4 < 4; ++h4) stage_rows<1>(lds + h4 * 16384, vrow0 + 64 * h4, 0, 128, wave, lane, nodma);
                const bf16_t* urow0 = PROJ + (size_t)m0 * INW + 768 + 256;
#pragma unroll
                for (int h4 = 0; h4 < 4; ++h4) stage_rows<0>(lds + (h4 < 2 ? L_UA + h4 * 8192 : L_UB + (h4 - 2) * 8192), urow0 + 64 * h4, 0, 64, wave, lane, nodma); }
            bf16x8 wf[8];
            { const bf16_t* wrow = WSB + ((size_t)hh * 128 + pbase) * 128 + 8 * hi;
#pragma unroll
              for (int sI = 0; sI < 8; ++sI) wf[sI] = *(const bf16x8*)(wrow + 16 * sI); }
            __syncthreads();
            f32x16 a0 = {}, a1 = {};
            const LAS unsigned char* gb = lds + hq * 16384;
            if (!(pflags & 4))
#pragma unroll
            for (int sI = 0; sI < 8; ++sI) {
                const f32x4 ra = *(const LAS f32x4*)(RV + 16 * sI + 8 * hi), rb = *(const LAS f32x4*)(RV + 16 * sI + 8 * hi + 4);
                const u32x4 wu = __builtin_bit_cast(u32x4, wf[sI]); u32x4 ws4;
                { const f32x2_t t0 = (f32x2_t){__uint_as_float(wu.x << 16), __uint_as_float(wu.x & 0xffff0000u)} * (f32x2_t){ra[0], ra[1]}, t1 = (f32x2_t){__uint_as_float(wu.y << 16), __uint_as_float(wu.y & 0xffff0000u)} * (f32x2_t){ra[2], ra[3]};
                  const f32x2_t t2 = (f32x2_t){__uint_as_float(wu.z << 16), __uint_as_float(wu.z & 0xffff0000u)} * (f32x2_t){rb[0], rb[1]}, t3 = (f32x2_t){__uint_as_float(wu.w << 16), __uint_as_float(wu.w & 0xffff0000u)} * (f32x2_t){rb[2], rb[3]};
                  ws4.x = cvtpk(t0.x, t0.y); ws4.y = cvtpk(t1.x, t1.y); ws4.z = cvtpk(t2.x, t2.y); ws4.w = cvtpk(t3.x, t3.y); }
                const bf16x8 bfr = __builtin_bit_cast(bf16x8, ws4);
#pragma unroll
                for (int dh = 0; dh < 2; ++dh) { const LAS unsigned char* vp = gb + (16 * sI) * 128 + gvoff[dh];
                    const s16x4 lo = trrd(vp), hi4 = trrd(vp + 4 * 128); const bf16x8 vf = {lo[0], lo[1], lo[2], lo[3], hi4[0], hi4[1], hi4[2], hi4[3]};
                    if (dh == 0) a0 = __builtin_amdgcn_mfma_f32_32x32x16_bf16(vf, bfr, a0, 0, 0, 0); else a1 = __builtin_amdgcn_mfma_f32_32x32x16_bf16(vf, bfr, a1, 0, 0, 0); }
            }
            const float bsv = PBS[hh * 128 + pbase];
            const LAS unsigned char* ub = lds + (hq < 2 ? L_UA + hq * 8192 : L_UB + (hq - 2) * 8192) + (32 * tb + r32) * 128 + 8 * hi;
#pragma unroll
            for (int dh = 0; dh < 2; ++dh)
#pragma unroll
                for (int gq = 0; gq < 4; ++gq) { const int col = 64 * hh + 32 * dh + 8 * gq + 4 * hi; const f32x4 vg = *(const LAS f32x4*)(PVG + col);
                    const u32x2 uu = *(const LAS u32x2*)(ub + (((4 * dh + gq) ^ ((r32 >> 1) & 7)) << 4));
                    const float u0 = __uint_as_float(uu.x << 16), u1 = __uint_as_float(uu.x & 0xffff0000u), u2 = __uint_as_float(uu.y << 16), u3 = __uint_as_float(uu.y & 0xffff0000u);
                    f32x16& acc = dh == 0 ? a0 : a1;
                    const f32x2_t e0 = (f32x2_t){u0, u1} * ((f32x2_t){vg[0], vg[1]} * (f32x2_t){acc[4 * gq], acc[4 * gq + 1]} + bsv), e1 = (f32x2_t){u2, u3} * ((f32x2_t){vg[2], vg[3]} * (f32x2_t){acc[4 * gq + 2], acc[4 * gq + 3]} + bsv);
                    acc[4 * gq] = e0.x; acc[4 * gq + 1] = e0.y; acc[4 * gq + 2] = e1.x; acc[4 * gq + 3] = e1.y; }
            og[rd][0] = a0; og[rd][1] = a1;
        }
        { float ss = 0.f;
#pragma unroll
          for (int rd = 0; rd < 2; ++rd)
#pragma unroll
              for (int dh = 0; dh < 2; ++dh)
#pragma unroll
                  for (int r = 0; r < 16; ++r) ss += og[rd][dh][r] * og[rd][dh][r];
          ss = xhalf_sum(ss); if (hi == 0) SS[256 + wave * 32 + r32] = ss; }
        __syncthreads();
        { const float tot = (SS[256 + tb * 32 + r32] + SS[256 + (2 + tb) * 32 + r32]) + (SS[256 + (4 + tb) * 32 + r32] + SS[256 + (6 + tb) * 32 + r32]);
          const float rg = rsqrtf(tot * (1.0f / 512.0f) + EPS);
#pragma unroll
          for (int rd = 0; rd < 2; ++rd)
#pragma unroll
              for (int dh = 0; dh < 2; ++dh)
                  { u32x2 w[4];
#pragma unroll
                    for (int gq = 0; gq < 4; ++gq) { const int col = 64 * (4 * rd + hq) + 32 * dh + 8 * gq + 4 * hi; const f32x4 gn = *(const LAS f32x4*)(PGG + col);
                      const f32x2_t s0 = ((f32x2_t){og[rd][dh][4 * gq], og[rd][dh][4 * gq + 1]} * rg) * (f32x2_t){gn[0], gn[1]}, s1 = ((f32x2_t){og[rd][dh][4 * gq + 2], og[rd][dh][4 * gq + 3]} * rg) * (f32x2_t){gn[2], gn[3]};
                      w[gq].x = cvtpk(s0.x, s0.y); w[gq].y = cvtpk(s1.x, s1.y); }
                    store_pairs(MIX + mrow * D + 512 + 64 * (4 * rd + hq) + 32 * dh, w, hi, pflags & 8); } }
    }
    __syncthreads();
}
}

constexpr int NWAVES = 8;
constexpr int N_PHASES = 6;
constexpr int RING_BYTES = 131072;
constexpr int LDSCTL_OFF = 163840 - 2048, MISC_OFF = LDSCTL_OFF + 320;
constexpr int LDS_BYTES = 163840;
static_assert(MISC_OFF + 128 <= LDS_BYTES && mix::L_END3 <= LDSCTL_OFF, "LDS map");
#if MK_MIXER_RING
static_assert(mixr::R_END <= LDSCTL_OFF, "LDS map (ring mixer)");
#endif
constexpr int CW_BAR = 4096;

#define GAS __attribute__((address_space(1)))

typedef GAS unsigned gu32;
#define RLX_AGENT __ATOMIC_RELAXED, __HIP_MEMORY_SCOPE_AGENT

#define XB_TMO      128
#define XB_XCNT(j)  (256  + 64 * (j))
#define XB_XSUB(j)  (1280 + 64 * (j))
#define XB_XGEN(j)  (2304 + 64 * (j))
#define XB_TOP      3328
#define XB_TOPGEN   3392
#define XCD_BAR_WORDS 3456
#define XB_SPIN_CAP (1u << 18)

__device__ __forceinline__ unsigned xb_ld(unsigned* p)              { return __hip_atomic_load(p, __ATOMIC_RELAXED, __HIP_MEMORY_SCOPE_AGENT); }
__device__ __forceinline__ unsigned xb_add(unsigned* p, unsigned v) { return __hip_atomic_fetch_add(p, v, __ATOMIC_RELAXED, __HIP_MEMORY_SCOPE_AGENT); }
__device__ __forceinline__ unsigned xb_xcc_id() { return (unsigned)__builtin_amdgcn_s_getreg((3 << 11) | 20) & 0xFu; }
#define XB_SPIN(cond, bar) do { unsigned _sp = 0; while (cond) { __builtin_amdgcn_s_sleep(1); \
    if ((++_sp & 255u) == 0u) { if (xb_ld(&(bar)[XB_TMO])) break; if (_sp > XB_SPIN_CAP) { atomicAdd(&(bar)[XB_TMO], 1u); break; } } } } while (0)

struct XcdBarrier { unsigned* bar; unsigned x; volatile LAS unsigned* st; };
__device__ __forceinline__ XcdBarrier xcd_barrier_post(unsigned* bar, volatile LAS unsigned* st) {
    XcdBarrier b; b.bar = bar; b.x = xb_xcc_id(); b.st = st;
    if (threadIdx.x == 0) (void)xb_add(&bar[XB_XCNT(b.x)], 1u);
    return b;
}
__device__ __forceinline__ void xcd_barrier_complete(unsigned* bar, unsigned x, unsigned& nloc, unsigned& nx) {
    const unsigned G = gridDim.x * gridDim.y * gridDim.z;
    unsigned sum, cnt, mine, sp = 0u;
    for (;;) {
        sum = 0u; cnt = 0u; mine = 0u;
#pragma unroll
        for (unsigned j = 0; j < 16; ++j) { const unsigned c = xb_ld(&bar[XB_XCNT(j)]); sum += c; cnt += (c > 0u) ? 1u : 0u; mine = (j == x) ? c : mine; }
        if (sum == G) break;
        __builtin_amdgcn_s_sleep(1);
        if ((++sp & 255u) == 0u) { if (xb_ld(&bar[XB_TMO])) break; if (sp > XB_SPIN_CAP) { atomicAdd(&bar[XB_TMO], 1u); break; } }
    }
    nloc = mine > 0u ? mine : 1u; nx = cnt > 0u ? cnt : 1u;
}
__device__ __forceinline__ void xcd_barrier(const XcdBarrier& b) {
    asm volatile("s_waitcnt vmcnt(0)" ::: "memory");
    __syncthreads();
    if (threadIdx.x == 0) {
        unsigned* bar = b.bar;
        __builtin_amdgcn_s_waitcnt(0);
        unsigned nloc = b.st[0], nx = b.st[1];
        if (nloc == 0u) { xcd_barrier_complete(bar, b.x, nloc, nx); b.st[0] = nloc; b.st[1] = nx; }
        const unsigned old = xb_add(&bar[XB_XSUB(b.x)], 1u);
        const unsigned gen = old / nloc;
        if (old + 1u == (gen + 1u) * nloc) {
            __builtin_amdgcn_fence(__ATOMIC_RELEASE, "agent");
            asm volatile("s_waitcnt vmcnt(0)" ::: "memory");
            const unsigned og = xb_add(&bar[XB_TOP], 1u);
            const unsigned tg = og / nx;
            if (og + 1u == (tg + 1u) * nx) xb_add(&bar[XB_TOPGEN], 1u);
            else XB_SPIN(xb_ld(&bar[XB_TOPGEN]) == tg, bar);
            __builtin_amdgcn_fence(__ATOMIC_ACQUIRE, "agent");
            xb_add(&bar[XB_XGEN(b.x)], 1u);
            asm volatile("s_waitcnt vmcnt(0)" ::: "memory");
        } else {
            XB_SPIN(xb_ld(&bar[XB_XGEN(b.x)]) == gen, bar);
            __builtin_amdgcn_fence(__ATOMIC_ACQUIRE, "agent");
            asm volatile("s_waitcnt vmcnt(0)" ::: "memory");
        }
    }
    __syncthreads();
}

struct Args { const float* in[18]; float* out; unsigned char* ws; int ph_lo, ph_hi; };

__global__ void __launch_bounds__(NWAVES * 64, 2) mk_fwd(Args args) {
    extern __shared__ __attribute__((aligned(16))) unsigned char lds_raw[];
    LAS unsigned char* lds = (LAS unsigned char*)lds_raw;
    volatile LAS unsigned* MISC = (volatile LAS unsigned*)(lds + MISC_OFF);
    const int tid = threadIdx.x, G = gridDim.x;
    unsigned char* ws = args.ws;
    gu32* ctl = (gu32*)(ws + WS_CTL);
    for (int u = tid; u < (LDS_BYTES - LDSCTL_OFF) / 4; u += NWAVES * 64) ((LAS unsigned*)(lds + LDSCTL_OFF))[u] = 0u;
    __syncthreads();
    const int lo = args.ph_lo, hi = args.ph_hi;
    const bool multi = hi - lo > 1;
    XcdBarrier bar; bar.bar = (unsigned*)(ctl + CW_BAR); bar.x = 0; bar.st = nullptr;
    if (multi) bar = xcd_barrier_post((unsigned*)(ctl + CW_BAR), MISC + 8);
#define STAMP(k) do {} while (0)
#define STAGGER_TICKS(ticks) do { const unsigned long long t0_ = __builtin_amdgcn_s_memrealtime(), dl_ = (unsigned long long)(ticks); while (__builtin_amdgcn_s_memrealtime() - t0_ < dl_) __builtin_amdgcn_s_sleep(4); } while (0)
#define IN(k) (lo <= (k) && (k) < hi)
#define BOTH(k) (IN(k) && IN((k) + 1))
    const float* xp = args.in[0]; const float* xs = args.in[1];
    bf16_t* WIN = (bf16_t*)(ws + WS_WIN); bf16_t* WO = (bf16_t*)(ws + WS_WO); bf16_t* WGU = (bf16_t*)(ws + WS_WGU); bf16_t* WDN = (bf16_t*)(ws + WS_WDN);
    float* VSSQ = (float*)(ws + WS_VSSQ); float* SSQ2 = (float*)(ws + WS_SSQ2);
    bf16_t* XN = (bf16_t*)(ws + WS_XN); bf16_t* PROJ = (bf16_t*)(ws + WS_PROJ); bf16_t* H = (bf16_t*)(ws + WS_H); bf16_t* MIX = (bf16_t*)(ws + WS_MIX); bf16_t* X1B = (bf16_t*)(ws + WS_X1B);

    for (int rep = 0; rep < 1 + ((MK_REPEAT_MASK >> 0) & 1); ++rep) if (IN(0)) {
#if MK_PROLOGUE_NAIVE
        p0_prologue_naive(args.in, ws, G);
#else
        p0_prologue(args.in, ws, lds, G);
#endif
        if (BOTH(0)) xcd_barrier(bar); STAMP(0); }
    for (int rep = 0; rep < 1 + ((MK_REPEAT_MASK >> 1) & 1); ++rep) if (IN(1)) {
        pg8::Gemm g{XN, WIN, M, INW, D}; pg8::StaticOrder S; S.init(M, INW, G, (int)blockIdx.x);
        LAS float* RSL = (LAS float*)(lds + RING_BYTES);
        { const float* RS1 = (const float*)(ws + WS_RS1);
          float rv[pg8::EpiIn::NS1 / 2];
#pragma unroll
          for (int k = 0; k < pg8::EpiIn::NS1 / 2; ++k) { pg8::Unit uu; rv[k] = S.next((tid >> 8) + 2 * k, uu) ? RS1[uu.pm * 256 + (tid & 255)] : 0.f; }
#pragma unroll
          for (int k = 0; k < pg8::EpiIn::NS1 / 2; ++k) RSL[((tid >> 8) + 2 * k) * 256 + (tid & 255)] = rv[k];
          __syncthreads(); }
        pg8::EpiIn E{PROJ, VSSQ, args.in[5], args.in[6], RSL, (const float*)(ws + WS_RS1)};
        pg8::gemm_phase<pg8::EpiIn, pg8::StaticOrder, true>(lds, g, S, E);
#if MK_LATE_WEIGHTS
        {
          const int rounds = (S.nwg + G - 1) / G, nbusy = S.nwg - (rounds - 1) * G, c = (int)blockIdx.x;
          const int wave = __builtin_amdgcn_readfirstlane(tid >> 6);
          if (nbusy == G) p0_weights(args.in, ws, lds, P0_I_IN, P0_NITEMS, c * 8 + wave, G * 8);
          else if (c >= nbusy) p0_weights(args.in, ws, lds, P0_I_IN, P0_NITEMS, (c - nbusy) * 8 + wave, (G - nbusy) * 8); }
#endif
        if (BOTH(1)) xcd_barrier(bar); STAMP(1);
    }
    for (int rep = 0; rep < 1 + ((MK_REPEAT_MASK >> 2) & 1); ++rep) if (IN(2) || (MK_EXTRA_PHASE >= 14 && MK_EXTRA_PHASE <= 17 && lo == MK_EXTRA_PHASE)) {
#if MK_MIXER_NAIVE
        p2_mixer_naive(args.in, ws, lds_raw, G);
#else
#if MK_MIXER_RING
        mixr::p2_mixer_ring(args.in, ws, lds, G);
#elif 1
        mix::p2_mixer(args.in, ws, lds, G, (MK_EXTRA_PHASE >= 14 && MK_EXTRA_PHASE <= 17 && lo == MK_EXTRA_PHASE) ? (MK_PFLAGS ? MK_PFLAGS : (1 << (MK_EXTRA_PHASE - 14))) : 0);
#endif
#endif
        if (BOTH(2)) xcd_barrier(bar); STAMP(2); }
    for (int rep = 0; rep < 1 + ((MK_REPEAT_MASK >> 3) & 1); ++rep) if (IN(3)) {
        pg8::Gemm g{MIX, WO, M, D, D}; pg8::StaticOrder S; S.init(M, D, G, (int)blockIdx.x);
        pg8::EpiOut E{XN, X1B, SSQ2};
        pg8::gemm_phase<pg8::EpiOut, pg8::StaticOrder, MK_ALIGN35>(lds, g, S, E);
        if (BOTH(3)) xcd_barrier(bar); STAMP(3);
    }
    for (int rep = 0; rep < 1 + ((MK_REPEAT_MASK >> 4) & 1); ++rep) if (IN(4)) {
        pg8::Gemm g{X1B, WGU, M, NGU, D}; pg8::StaticOrder S; S.init(M, NGU, G, (int)blockIdx.x); if (MK_REV5 == 2) S.reverse();
        LAS float* RS = (LAS float*)(lds + RING_BYTES);
        { pg8::Unit u0; S.next(0, u0); const int r8 = u0.pm & 7, g0 = ((u0.pm >> 3) / 3) * 3;
          for (int i = tid; i < 768; i += NWAVES * 64) { const int row = (8 * (g0 + (i >> 8)) + r8) * 256 + (i & 255); const pg8::f32x4* sp = (const pg8::f32x4*)(SSQ2 + (size_t)row * 16);
              const pg8::f32x4 sv = (sp[0] + sp[1]) + (sp[2] + sp[3]); RS[i] = rsqrtf(((sv[0] + sv[1]) + (sv[2] + sv[3])) * (1.0f / D) + EPS); }
          if (tid < 3) ((LAS int*)(RS + 768))[tid] = 8 * (g0 + tid) + r8;
          __syncthreads(); }
        pg8::EpiUp E{H, RS, SSQ2};
        pg8::gemm_phase<pg8::EpiUp, pg8::StaticOrder, MK_ALIGN4>(lds, g, S, E);
        if (BOTH(4)) xcd_barrier(bar); STAMP(4);
    }
    if (IN(5)) {
        if (MK_STAGGER_TICKS > 0 && (xb_xcc_id() & 1)) STAGGER_TICKS(MK_STAGGER_TICKS);
        pg8::Gemm g{H, WDN, M, D, DFF}; pg8::StaticOrder S; S.init(M, D, G, (int)blockIdx.x); if (MK_REV5 == 1) S.reverse();
        pg8::EpiDown E{X1B, args.out};
        pg8::gemm_phase<pg8::EpiDown, pg8::StaticOrder, MK_ALIGN35>(lds, g, S, E);
        STAMP(5);
    }

#if MK_EXTRA_PHASE >= 6
    if (lo == 6) { pg8::Gemm g{X1B, WGU, M, NGU, D}; pg8::StaticOrder S; S.init(M, NGU, G, (int)blockIdx.x); S.wgm = MK_PFLAGS ? MK_PFLAGS : 8; pg8::EpiNone E; pg8::gemm_phase<pg8::EpiNone, pg8::StaticOrder, true>(lds, g, S, E); }
    if (lo == 7) { pg8::Gemm g{H, WDN, M, D, DFF}; pg8::StaticOrder S; S.init(M, D, G, (int)blockIdx.x); pg8::EpiNone E; pg8::gemm_phase<pg8::EpiNone, pg8::StaticOrder, true>(lds, g, S, E); }
    if (lo == 8) { pg8::Gemm g{X1B, WGU, M, INW, D}; pg8::StaticOrder S; S.init(M, INW, G, (int)blockIdx.x); pg8::EpiNone E; pg8::gemm_phase<pg8::EpiNone, pg8::StaticOrder, true>(lds, g, S, E); }
#endif
#if MK_EXTRA_PHASE == 19
    if (lo == 19) { pg8::Gemm g{X1B, WGU, M, NGU, D}; pg8::StaticOrder S; S.init(M, NGU, G, (int)blockIdx.x);
        LAS float* RS = (LAS float*)(lds + RING_BYTES); for (int i = tid; i < 768; i += NWAVES * 64) RS[i] = 1.0f; __syncthreads();
        pg8::EpiUpFullLine E{H, RS}; pg8::gemm_phase<pg8::EpiUpFullLine, pg8::StaticOrder, true>(lds, g, S, E); }
#endif
#if MK_EXTRA_PHASE == 18
    if (lo == 18) { pg8::Gemm g{MIX, WO, M, D, D}; pg8::StaticOrder S; S.init(M, D, G, (int)blockIdx.x); pg8::EpiNone E; pg8::gemm_phase<pg8::EpiNone, pg8::StaticOrder, true>(lds, g, S, E); }
#endif
#if MK_EXTRA_PHASE >= 11
    if (lo == 20) { pg8::Gemm g{X1B, WGU, M, NGU, D}; pg8::StaticOrder S; S.init(M, NGU, G, (int)blockIdx.x); pg8::EpiNone E; pg8::gemm_phase<pg8::EpiNone, pg8::StaticOrder, true, 4>(lds, g, S, E); }
    if (lo == 11) { pg8::Gemm g{X1B, WGU, M, NGU, D}; pg8::StaticOrder S; S.init(M, NGU, G, (int)blockIdx.x); pg8::EpiNone E; pg8::gemm_phase<pg8::EpiNone, pg8::StaticOrder, true, 1>(lds, g, S, E); }
    if (lo == 12) { pg8::Gemm g{X1B, WGU, M, NGU, D}; pg8::StaticOrder S; S.init(M, NGU, G, (int)blockIdx.x); pg8::EpiNone E; pg8::gemm_phase<pg8::EpiNone, pg8::StaticOrder, true, 2>(lds, g, S, E); }
    if (lo == 13) { pg8::Gemm g{X1B, WGU, M, NGU, D}; pg8::StaticOrder S; S.init(M, NGU, G, (int)blockIdx.x); pg8::EpiNone E; pg8::gemm_phase<pg8::EpiNone, pg8::StaticOrder, true, 3>(lds, g, S, E); }
#endif
#if MK_EXTRA_PHASE >= 9
    if (lo == 9)  { pg8::Gemm g{H, WDN, M, D, DFF}; pg8::StaticOrder S; S.init(M, D, G, (int)blockIdx.x); pg8::EpiDownProbe<1> E{X1B, (float*)(ws + WS_MIX)}; pg8::gemm_phase<pg8::EpiDownProbe<1>, pg8::StaticOrder, true>(lds, g, S, E); }
    if (lo == 10) { pg8::Gemm g{H, WDN, M, D, DFF}; pg8::StaticOrder S; S.init(M, D, G, (int)blockIdx.x); pg8::EpiDownProbe<2> E{X1B, args.out}; pg8::gemm_phase<pg8::EpiDownProbe<2>, pg8::StaticOrder, true>(lds, g, S, E); }
#endif
#undef IN
#undef BOTH
}

extern "C" void kernel_launch(void* const* d_in, const int* in_sizes, int n_in, void* d_out, int out_size, void* d_ws, size_t ws_size, hipStream_t stream) {
    static int grid = 0;
    if (grid == 0) {
        if (n_in != 18 || in_sizes[0] != MP * D || in_sizes[1] != (M - MP) * D || out_size != M * D || ws_size < WS_END) {
            fprintf(stderr, "kernel_launch: unexpected shapes (n_in %d, in0 %d, in1 %d, out %d, ws %zu)\n", n_in, n_in > 0 ? in_sizes[0] : -1, n_in > 1 ? in_sizes[1] : -1, out_size, ws_size); grid = -1; return; }
        int dev = 0, cus = 0, per_cu = 0;
        if (hipGetDevice(&dev) != hipSuccess || hipDeviceGetAttribute(&cus, hipDeviceAttributeMultiprocessorCount, dev) != hipSuccess) { grid = -1; return; }
        if (hipFuncSetAttribute((const void*)mk_fwd, hipFuncAttributeMaxDynamicSharedMemorySize, LDS_BYTES) != hipSuccess) { fprintf(stderr, "kernel_launch: hipFuncSetAttribute failed\n"); grid = -1; return; }
        if (hipOccupancyMaxActiveBlocksPerMultiprocessor(&per_cu, (const void*)mk_fwd, NWAVES * 64, LDS_BYTES) != hipSuccess || per_cu < 1) { fprintf(stderr, "kernel_launch: occupancy query says %d blocks per CU\n", per_cu); grid = -1; return; }
        (void)hipGetLastError();
        grid = cus;
    }
    if (grid < 0) return;
    Args a{};
    for (int i = 0; i < 18; ++i) a.in[i] = (const float*)d_in[i];
    a.out = (float*)d_out; a.ws = (unsigned char*)d_ws;
    unsigned char* ws = (unsigned char*)d_ws;
    static_assert((CW_BAR + XCD_BAR_WORDS) * 4 <= 32768, "control words inside the per-call memset");
    (void)hipMemsetAsync(ws + WS_CTL, 0, 32768, stream);
#if MK_ONE_LAUNCH
#if 0 && MK_EXTRA_PHASE == 3
    a.ph_lo = 0; a.ph_hi = 4; hipLaunchKernelGGL(mk_fwd, dim3(grid), dim3(NWAVES * 64), LDS_BYTES, stream, a);
    (void)hipMemsetAsync(ws + WS_CTL, 0, 1 * MiB, stream);
    a.ph_lo = 3; a.ph_hi = 6; hipLaunchKernelGGL(mk_fwd, dim3(grid), dim3(NWAVES * 64), LDS_BYTES, stream, a);
#else
    a.ph_lo = 0; a.ph_hi = N_PHASES;
#if MK_PLAIN_LAUNCH
    hipLaunchKernelGGL(mk_fwd, dim3(grid), dim3(NWAVES * 64), LDS_BYTES, stream, a);
#else
    { void* kargs[] = {&a}; hipError_t e = hipLaunchCooperativeKernel((const void*)mk_fwd, dim3(grid), dim3(NWAVES * 64), kargs, LDS_BYTES, stream);
      if (e != hipSuccess) fprintf(stderr, "kernel_launch: cooperative launch failed: %s (grid %d)\n", hipGetErrorString(e), grid); }
#endif
#if MK_EXTRA_PHASE >= 0
    a.ph_lo = MK_EXTRA_PHASE; a.ph_hi = MK_EXTRA_PHASE + 1; hipLaunchKernelGGL(mk_fwd, dim3(grid), dim3(NWAVES * 64), LDS_BYTES, stream, a);
#endif
#endif
#else
    for (int p = 0; p < N_PHASES; ++p) {
        if (!(MK_PHASE_MASK & (1 << p))) { launch_naive_phase(p, d_in, (float*)d_out, ws, stream); continue; }
        a.ph_lo = p; a.ph_hi = p + 1;
        hipLaunchKernelGGL(mk_fwd, dim3(grid), dim3(NWAVES * 64), LDS_BYTES, stream, a);
    }
#endif
}
```

```cpp
#include <hip/hip_runtime.h>
#include <cstdio>
#include <cstdint>

typedef unsigned short bf16_t;
constexpr int D = 1024, SEQ = 4096, NSEQ = 12, M = NSEQ * SEQ, MP = 4 * SEQ;
constexpr int INW = 1792, DFF = 2816, NGU = 2 * DFF;
constexpr float EPS = 1e-6f, LOG2E = 1.4426950408889634f, QSCALE = 0.125f * LOG2E;

constexpr size_t MiB = 1u << 20;
constexpr size_t WS_CTL = 0;
constexpr size_t WS_WIN = 1 * MiB;
constexpr size_t WS_WO = 5 * MiB;
constexpr size_t WS_WGU = 7 * MiB;
constexpr size_t WS_WDN = 18 * MiB;
constexpr size_t WS_WS = 24 * MiB;
constexpr size_t WS_VSSQ = 25 * MiB;
constexpr size_t WS_SSQ2 = 27 * MiB;
constexpr size_t WS_RS1 = 30 * MiB;
constexpr size_t WS_XN = 32 * MiB;
constexpr size_t WS_PROJ = 128 * MiB;
constexpr size_t WS_H = 32 * MiB;
constexpr size_t WS_MIX = 296 * MiB;
constexpr size_t WS_X1B = 392 * MiB;
constexpr size_t WS_END = 488 * MiB;

__device__ __forceinline__ unsigned f2bf(float f) { unsigned u = __builtin_bit_cast(unsigned, f); return (u + 0x7fffu + ((u >> 16) & 1u)) >> 16; }
__device__ __forceinline__ float bf2f(bf16_t b) { return __builtin_bit_cast(float, (unsigned)b << 16); }
__device__ __forceinline__ float gelu_tanh(float x) { const float u = x * (-2.302208198f - 0.1029432397f * x * x); return x * __builtin_amdgcn_rcpf(1.0f + __builtin_amdgcn_exp2f(u)); }
__device__ __forceinline__ float silu(float x) { return x * __builtin_amdgcn_rcpf(1.0f + __builtin_amdgcn_exp2f(-LOG2E * x)); }
__device__ __forceinline__ int t5_bucket(int rel) { const int n = rel < 0 ? -rel : rel; int b = n < 8 ? n : (2 + (31 - __builtin_clz(n * n))); b = b > 15 ? 15 : b; return b + (rel > 0 ? 16 : 0); }

__device__ __forceinline__ void prep_w_elem(size_t i, const float* w_in, const float* w_o, const float* w_gate, const float* w_up, const float* w_down, const float* w_s, const float* norm2, unsigned char* ws) {
    const size_t N0 = (size_t)INW * D, N1 = (size_t)D * D, N2 = (size_t)NGU * D, N3 = (size_t)D * DFF, N4 = 8 * 128 * 128;
    if (i < N0) { const int n = i / D, k = i % D; ((bf16_t*)(ws + WS_WIN))[i] = f2bf(w_in[(size_t)k * INW + n]); return; } i -= N0;
    if (i < N1) { const int n = i / D, k = i % D; ((bf16_t*)(ws + WS_WO))[i] = f2bf(w_o[(size_t)k * D + n]); return; } i -= N1;
    if (i < N2) { const int r = i / D, k = i % D; const int pn = r >> 8, bj = (r >> 7) & 1, c = r & 127, col = 128 * pn + c;
        ((bf16_t*)(ws + WS_WGU))[i] = f2bf(norm2[k] * (bj ? w_up : w_gate)[(size_t)k * DFF + col]); return; } i -= N2;
    if (i < N3) { const int n = i / DFF, k = i % DFF; ((bf16_t*)(ws + WS_WDN))[i] = f2bf(w_down[(size_t)k * D + n]); return; } i -= N3;
    if (i < N4) { ((bf16_t*)(ws + WS_WS))[i] = f2bf(w_s[i]); }
}
constexpr size_t NPREP = (size_t)INW * D + (size_t)D * D + (size_t)NGU * D + (size_t)D * DFF + 8 * 128 * 128;
__global__ void __launch_bounds__(256) k_prep_w(const float* w_in, const float* w_o, const float* w_gate, const float* w_up, const float* w_down, const float* w_s, const float* norm2, unsigned char* ws) {
    prep_w_elem((size_t)blockIdx.x * 256 + threadIdx.x, w_in, w_o, w_gate, w_up, w_down, w_s, norm2, ws);
}
__device__ __forceinline__ void xn_row(int m, int lane, const float* xp, const float* xs, const float* norm1, bf16_t* XN) {
    const float* x = m < MP ? xp + (size_t)m * D : xs + (size_t)(m - MP) * D;
    float v[16]; float ss = 0.f;
#pragma unroll
    for (int j = 0; j < 16; ++j) { v[j] = x[lane + 64 * j]; ss += v[j] * v[j]; }
#pragma unroll
    for (int o = 1; o < 64; o <<= 1) ss += __shfl_xor(ss, o);
    const float r = rsqrtf(ss * (1.0f / D) + EPS);
#pragma unroll
    for (int j = 0; j < 16; ++j) XN[(size_t)m * D + lane + 64 * j] = f2bf(v[j] * r * norm1[lane + 64 * j]);
}
__global__ void __launch_bounds__(256) k_xn(const float* xp, const float* xs, const float* norm1, bf16_t* XN) { xn_row(blockIdx.x * 4 + (threadIdx.x >> 6), threadIdx.x & 63, xp, xs, norm1, XN); }

template <class Epi, bool DUAL>
__global__ void __launch_bounds__(256) k_gemm_naive(const bf16_t* A, const bf16_t* Bt, int K, Epi epi) {
    __shared__ float As[32][68], Bs[32][68], B2s[DUAL ? 32 : 1][68], Ct[64][65], C2t[DUAL ? 64 : 1][65];
    const int tid = threadIdx.x, ty = tid >> 4, tx = tid & 15, lr = tid >> 2, kc = (tid & 3) * 8;
    const int m0 = blockIdx.y * 64, n0 = blockIdx.x * 64;
    const bf16_t* ap = A + (size_t)(m0 + lr) * K + kc;
    const int br = epi.brow(n0 + lr);
    const bf16_t* bp = Bt + (size_t)br * K + kc;
    const bf16_t* bp2 = Bt + (size_t)(br + 128) * K + kc;
    float acc[4][4] = {}, acc2[4][4] = {};
    for (int k0 = 0; k0 < K; k0 += 32) {
        const uint4 av = *(const uint4*)(ap + k0), bv = *(const uint4*)(bp + k0);
        const unsigned aw[4] = {av.x, av.y, av.z, av.w}, bw[4] = {bv.x, bv.y, bv.z, bv.w};
#pragma unroll
        for (int j = 0; j < 4; ++j) { As[kc + 2 * j][lr] = __builtin_bit_cast(float, aw[j] << 16); As[kc + 2 * j + 1][lr] = __builtin_bit_cast(float, aw[j] & 0xffff0000u);
                                      Bs[kc + 2 * j][lr] = __builtin_bit_cast(float, bw[j] << 16); Bs[kc + 2 * j + 1][lr] = __builtin_bit_cast(float, bw[j] & 0xffff0000u); }
        if (DUAL) { const uint4 cv = *(const uint4*)(bp2 + k0); const unsigned cw[4] = {cv.x, cv.y, cv.z, cv.w};
#pragma unroll
            for (int j = 0; j < 4; ++j) { B2s[kc + 2 * j][lr] = __builtin_bit_cast(float, cw[j] << 16); B2s[kc + 2 * j + 1][lr] = __builtin_bit_cast(float, cw[j] & 0xffff0000u); } }
        __syncthreads();
#pragma unroll 8
        for (int k = 0; k < 32; ++k) {
            float a[4], b[4], b2[4];
#pragma unroll
            for (int i = 0; i < 4; ++i) { a[i] = As[k][4 * ty + i]; b[i] = Bs[k][4 * tx + i]; b2[i] = DUAL ? B2s[k][4 * tx + i] : 0.f; }
#pragma unroll
            for (int i = 0; i < 4; ++i)
#pragma unroll
                for (int j = 0; j < 4; ++j) { acc[i][j] += a[i] * b[j]; if (DUAL) acc2[i][j] += a[i] * b2[j]; }
        }
        __syncthreads();
    }
#pragma unroll
    for (int i = 0; i < 4; ++i)
#pragma unroll
        for (int j = 0; j < 4; ++j) { Ct[4 * ty + i][4 * tx + j] = acc[i][j]; if (DUAL) C2t[4 * ty + i][4 * tx + j] = acc2[i][j]; }
    __syncthreads();
    const int r = tid >> 2, part = tid & 3;
    epi(m0 + r, n0, part, &Ct[r][part * 16], DUAL ? &C2t[r][part * 16] : nullptr);
}
__device__ __forceinline__ float red4(float v) { v += __shfl_xor(v, 1); v += __shfl_xor(v, 2); return v; }
struct NEpiIn {
    bf16_t* PROJ; float* VSSQ; const float* qg; const float* kg;
    __device__ int brow(int n) const { return n; }
    __device__ void operator()(int row, int n0, int part, const float* c, const float*) const {
        const int ct = n0 >> 6; float v[16];
#pragma unroll
        for (int j = 0; j < 16; ++j) v[j] = c[j];
        if (ct < 10) { float ss = 0.f;
#pragma unroll
            for (int j = 0; j < 16; ++j) ss += v[j] * v[j];
            ss = red4(ss); const float r = rsqrtf(ss * (1.0f / 64.0f) + EPS); const float* g = ct < 8 ? qg : kg; const float sc = ct < 8 ? QSCALE : 1.0f;
#pragma unroll
            for (int j = 0; j < 16; ++j) v[j] = v[j] * r * g[part * 16 + j] * sc;
        } else if (ct >= 12) { float ss = 0.f;
#pragma unroll
            for (int j = 0; j < 16; ++j) { v[j] = gelu_tanh(v[j]); ss += v[j] * v[j]; }
            if (ct >= 20) { ss = red4(ss); if (part == 0) VSSQ[(size_t)row * 8 + (ct - 20)] = ss; }
        }
#pragma unroll
        for (int j = 0; j < 16; ++j) PROJ[(size_t)row * INW + n0 + part * 16 + j] = f2bf(v[j]);
    }
};
struct NEpiOut {
    const float* xp; const float* xs; float* out; bf16_t* X1B; float* SSQ2;
    __device__ int brow(int n) const { return n; }
    __device__ void operator()(int row, int n0, int part, const float* c, const float*) const {
        const float* x = row < MP ? xp + (size_t)row * D : xs + (size_t)(row - MP) * D; float ss = 0.f;
#pragma unroll
        for (int j = 0; j < 16; ++j) { const int col = n0 + part * 16 + j; const float v = x[col] + c[j]; out[(size_t)row * D + col] = v; X1B[(size_t)row * D + col] = f2bf(v); ss += v * v; }
        ss = red4(ss); if (part == 0) SSQ2[(size_t)row * 16 + (n0 >> 6)] = ss;
    }
};
struct NEpiUp {
    bf16_t* H; const float* SSQ2;
    __device__ int brow(int n) const { return 256 * (n >> 7) + (n & 127); }
    __device__ void operator()(int row, int n0, int part, const float* c, const float* c2) const {
        float ss = 0.f;
#pragma unroll
        for (int j = 0; j < 16; ++j) ss += SSQ2[(size_t)row * 16 + j];
        const float r = rsqrtf(ss * (1.0f / D) + EPS);
#pragma unroll
        for (int j = 0; j < 16; ++j) H[(size_t)row * DFF + n0 + part * 16 + j] = f2bf(silu(c[j] * r) * (c2[j] * r));
    }
};
struct NEpiDown {
    float* out;
    __device__ int brow(int n) const { return n; }
    __device__ void operator()(int row, int n0, int part, const float* c, const float*) const {
#pragma unroll
        for (int j = 0; j < 16; ++j) { const size_t o = (size_t)row * D + n0 + part * 16 + j; out[o] = out[o] + c[j]; }
    }
};

struct MixNaiveLds { float ps[4][320], qs[4][64], arow[512], grow[512], rv[128], red[4]; };
__device__ __forceinline__ void mix_naive_token(int m, int tid, MixNaiveLds& L, const bf16_t* PROJ, const float* VSSQ, const bf16_t* WSB, const float* rel_table, const float* sink, const float* v_gain,
                                                const float* b_s, const float* ag, const float* gg, bf16_t* MIX) {
    const int s = m / SEQ, t = m % SEQ, w = tid >> 6, lane = tid & 63;
    const bf16_t* prow = PROJ + (size_t)m * INW;
    const int jlo = t - 128 < 0 ? 0 : t - 128, jhi = t + 128 > SEQ - 1 ? SEQ - 1 : t + 128, nk = jhi - jlo + 1;
    for (int hh = 0; hh < 2; ++hh) {
        const int h = w * 2 + hh, g = h >> 2;
        L.qs[w][lane] = bf2f(prow[64 * h + lane]);
        __syncthreads();
        const float sink2 = sink[h] * LOG2E; float sc[5]; float mx = sink2;
#pragma unroll
        for (int i = 0; i < 5; ++i) { const int j = jlo + lane + 64 * i; sc[i] = -1e30f;
            if (j <= jhi) { const bf16_t* kr = PROJ + (size_t)(s * SEQ + j) * INW + 512 + 64 * g; float dot = 0.f;
                for (int d = 0; d < 64; ++d) dot += L.qs[w][d] * bf2f(kr[d]);
                dot += rel_table[t5_bucket(j - t) * 8 + h] * LOG2E; sc[i] = dot; mx = fmaxf(mx, dot); } }
#pragma unroll
        for (int o = 1; o < 64; o <<= 1) mx = fmaxf(mx, __shfl_xor(mx, o));
        float l = 0.f;
#pragma unroll
        for (int i = 0; i < 5; ++i) { const int j = jlo + lane + 64 * i; const float p = j <= jhi ? exp2f(sc[i] - mx) : 0.f; l += p; L.ps[w][lane + 64 * i] = p; }
#pragma unroll
        for (int o = 1; o < 64; o <<= 1) l += __shfl_xor(l, o);
        l += exp2f(sink2 - mx);
        __syncthreads();
        float o = 0.f;
        for (int jj = 0; jj < nk; ++jj) o += L.ps[w][jj] * bf2f(PROJ[(size_t)(s * SEQ + jlo + jj) * INW + 640 + 64 * g + lane]);
        L.arow[64 * h + lane] = o / l;
        __syncthreads();
    }
    const int mc = m - (t & 127), p = t & 127;
    if (tid < 128) { float ss = 0.f; for (int i = 0; i < 8; ++i) ss += VSSQ[(size_t)(mc + tid) * 8 + i]; L.rv[tid] = rsqrtf(ss * (1.0f / 512.0f) + EPS); }
    __syncthreads();
    for (int c = tid; c < 512; c += 256) { const int h = c >> 6; float a = 0.f; const float vg = v_gain[c];
        for (int q = 0; q < 128; ++q) a += bf2f(WSB[(h * 128 + p) * 128 + q]) * (bf2f(PROJ[(size_t)(mc + q) * INW + 1280 + c]) * L.rv[q] * vg);
        L.grow[c] = bf2f(prow[768 + c]) * (a + b_s[h * 128 + p]); }
    __syncthreads();
    float sa = L.arow[tid] * L.arow[tid] + L.arow[tid + 256] * L.arow[tid + 256], sg = L.grow[tid] * L.grow[tid] + L.grow[tid + 256] * L.grow[tid + 256];
#pragma unroll
    for (int o = 1; o < 64; o <<= 1) { sa += __shfl_xor(sa, o); sg += __shfl_xor(sg, o); }
    if (lane == 0) { L.red[w] = sa; } __syncthreads(); sa = L.red[0] + L.red[1] + L.red[2] + L.red[3]; __syncthreads();
    if (lane == 0) { L.red[w] = sg; } __syncthreads(); sg = L.red[0] + L.red[1] + L.red[2] + L.red[3];
    const float ra = rsqrtf(sa * (1.0f / 512.0f) + EPS), rg = rsqrtf(sg * (1.0f / 512.0f) + EPS);
    for (int c = tid; c < 512; c += 256) { MIX[(size_t)m * D + c] = f2bf(L.arow[c] * ra * ag[c]); MIX[(size_t)m * D + 512 + c] = f2bf(L.grow[c] * rg * gg[c]); }
    __syncthreads();
}
__global__ void __launch_bounds__(256) k_mix_naive(const bf16_t* PROJ, const float* VSSQ, const bf16_t* WSB, const float* rel_table, const float* sink, const float* v_gain,
                                                  const float* b_s, const float* ag, const float* gg, bf16_t* MIX) {
    __shared__ MixNaiveLds L;
    mix_naive_token(blockIdx.x, threadIdx.x, L, PROJ, VSSQ, WSB, rel_table, sink, v_gain, b_s, ag, gg, MIX);
}

#define MK_ONE_LAUNCH 1
#define MK_PHASE_MASK 0x3F
#define MK_MIXER_NAIVE 0
#define MK_PROLOGUE_NAIVE 0
#define MK_REPEAT_MASK 0
#define MK_EXTRA_PHASE -1
#define MK_STAGGER_TICKS 0
#define MK_PFLAGS 0
#define MK_MIXER_RING 0
#define MK_NST 0
#define MK_PLAIN_LAUNCH 0
#define MK_ALIGN35 true
#define MK_ALIGN4 true
#define MK_LATE_WEIGHTS 1
#define MK_REV5 2
#define MK_REV2 1

namespace pg8 {
#define PG8_LAS __attribute__((address_space(3)))
typedef short bf16x8 __attribute__((ext_vector_type(8)));
typedef float f32x4 __attribute__((ext_vector_type(4)));
typedef unsigned u32x4 __attribute__((ext_vector_type(4)));
typedef unsigned u32x2 __attribute__((ext_vector_type(2)));
constexpr int BM = 256, BK = 64, HALF = 128, HTB = HALF * BK * 2  , STAGE_BYTES = 8 * HTB, NXCD = 8, WGM = 8;

__host__ __device__ __forceinline__ int lds_byte(int r, int c) { const int st = (r >> 4) * 2 + (c >> 5), rr = r & 15, cc = c & 31, ob = rr * 64 + cc * 2; return st * 1024 + (ob ^ (((ob >> 9) & 1) << 5)); }
__host__ __device__ __forceinline__ void stage_rc(int b, int& R, int& C) { const int st = b / 1024, sb = b % 1024, swz = sb ^ (((sb >> 9) & 1) << 5); R = (st >> 1) * 16 + swz / 64; C = (st & 1) * 32 + (swz % 64) / 2; }
__host__ __device__ __forceinline__ int perm32(int rho) { const int n = rho >> 4, i = rho & 15; return 8 * (i >> 2) + 4 * n + (i & 3); }

struct Unit { int pm, pn, ui; };
struct Gemm { const bf16_t* A; const bf16_t* Bt; int M, N, K; };

struct StaticOrder {
    int nM, nN, nwg, G, c, wgm, rev;
    __host__ __device__ __forceinline__ void init(int M_, int N_, int G_, int c_) { nM = M_ / BM; nN = N_ / BM; nwg = nM * nN; G = G_; c = c_; wgm = WGM; rev = 0; }
    __host__ __device__ __forceinline__ void reverse() { rev = c < nwg ? (nwg - c + G - 1) / G : 0; }
    __host__ __device__ __forceinline__ bool next(int i, Unit& u) const {
        if (rev > 0 && i >= rev) return false;
        const long L = (long)(rev > 0 ? rev - 1 - i : i) * G + c; if (L >= nwg) return false;
        int wgid = (int)L; { const int q = nwg / NXCD, r = nwg % NXCD, xcd = wgid % NXCD, off = wgid / NXCD; wgid = (xcd < r ? xcd * (q + 1) : r * (q + 1) + (xcd - r) * q) + off; }
        const int nig = wgm * nN, gid = wgid / nig, fm = gid * wgm, gsz = (nM - fm) < wgm ? (nM - fm) : wgm;
        u.pm = fm + ((wgid % nig) % gsz); u.pn = (wgid % nig) / gsz; u.ui = i; return true;
    }
};

__device__ __forceinline__ unsigned cvt_pk_bf16(float lo, float hi) { unsigned r; asm volatile("v_cvt_pk_bf16_f32 %0, %1, %2" : "=v"(r) : "v"(lo), "v"(hi)); return r; }
__device__ __forceinline__ float rsum_fq(float s) { s += __shfl_xor(s, 16); s += __shfl_xor(s, 32); return s; }

struct EpiIn {
    static constexpr int BMAP = 2, NS1 = 8;
    bf16_t* PROJ; float* VSSQ; const float* qg; const float* kg; const PG8_LAS float* RSL; const float* RS1;
    __device__ __forceinline__ void operator()(const f32x4 (&acc)[2][2][4][2], const Unit& u, int wr, int wc, int fr, int fq) const {
        const int ct = 4 * u.pn + wc;
        const int row0 = u.pm * BM + wr * 64 + fr, col0 = u.pn * BM + wc * 64 + 8 * fq;
        float r1[2][4];
        if (u.ui < NS1) { const PG8_LAS float* rp = RSL + u.ui * 256 + wr * 64 + fr;
#pragma unroll
            for (int ai = 0; ai < 2; ++ai)
#pragma unroll
                for (int m = 0; m < 4; ++m) r1[ai][m] = rp[ai * HALF + m * 16];
        } else {
#pragma unroll
            for (int ai = 0; ai < 2; ++ai)
#pragma unroll
                for (int m = 0; m < 4; ++m) r1[ai][m] = RS1[row0 + ai * HALF + m * 16];
        }
        if (ct < 10) {
            const float* g = (ct < 8 ? qg : kg) + 8 * fq; const float sc = ct < 8 ? QSCALE : 1.0f;
            f32x4 gv[2][2];
#pragma unroll
            for (int bj = 0; bj < 2; ++bj)
#pragma unroll
                for (int n = 0; n < 2; ++n) gv[bj][n] = *(const f32x4*)(g + 32 * bj + 4 * n) * sc;
#pragma unroll
            for (int ai = 0; ai < 2; ++ai)
#pragma unroll
                for (int m = 0; m < 4; ++m) {
                    float ss = 0.f;
#pragma unroll
                    for (int bj = 0; bj < 2; ++bj)
#pragma unroll
                        for (int n = 0; n < 2; ++n) { const f32x4 x = acc[ai][bj][m][n]; ss += (x[0] * x[0] + x[1] * x[1]) + (x[2] * x[2] + x[3] * x[3]); }
                    const float rr = r1[ai][m];
                    ss = rsum_fq(ss) * (rr * rr); const float r = rsqrtf(ss * (1.0f / 64.0f) + EPS) * rr;
                    bf16_t* rowp = PROJ + (size_t)(row0 + ai * HALF + m * 16) * INW + col0;
#pragma unroll
                    for (int bj = 0; bj < 2; ++bj) { const f32x4 v0 = acc[ai][bj][m][0] * r * gv[bj][0], v1 = acc[ai][bj][m][1] * r * gv[bj][1];
                        u32x4 w; w.x = cvt_pk_bf16(v0[0], v0[1]); w.y = cvt_pk_bf16(v0[2], v0[3]); w.z = cvt_pk_bf16(v1[0], v1[1]); w.w = cvt_pk_bf16(v1[2], v1[3]);
                        *(u32x4*)(rowp + 32 * bj) = w; }
                }
        } else if (ct < 12) {
#pragma unroll
            for (int ai = 0; ai < 2; ++ai)
#pragma unroll
                for (int m = 0; m < 4; ++m) { bf16_t* rowp = PROJ + (size_t)(row0 + ai * HALF + m * 16) * INW + col0; const float rr = r1[ai][m];
#pragma unroll
                    for (int bj = 0; bj < 2; ++bj) { const f32x4 v0 = acc[ai][bj][m][0] * rr, v1 = acc[ai][bj][m][1] * rr;
                        u32x4 w; w.x = cvt_pk_bf16(v0[0], v0[1]); w.y = cvt_pk_bf16(v0[2], v0[3]); w.z = cvt_pk_bf16(v1[0], v1[1]); w.w = cvt_pk_bf16(v1[2], v1[3]);
                        *(u32x4*)(rowp + 32 * bj) = w; } }
        } else {
#pragma unroll
            for (int ai = 0; ai < 2; ++ai)
#pragma unroll
                for (int m = 0; m < 4; ++m) { const int row = row0 + ai * HALF + m * 16; bf16_t* rowp = PROJ + (size_t)row * INW + col0; float ss = 0.f; const float rr = r1[ai][m];
#pragma unroll
                    for (int bj = 0; bj < 2; ++bj) { f32x4 v0 = acc[ai][bj][m][0] * rr, v1 = acc[ai][bj][m][1] * rr;
#pragma unroll
                        for (int e = 0; e < 4; e += 2) { typedef float f32x2v __attribute__((ext_vector_type(2)));
                            f32x2v x0 = {v0[e], v0[e + 1]}, x1 = {v1[e], v1[e + 1]};
                            const f32x2v u0 = x0 * ((x0 * x0) * (-0.1029432397f) + (-2.302208198f)), u1 = x1 * ((x1 * x1) * (-0.1029432397f) + (-2.302208198f));
                            f32x2v e0, e1; e0.x = __builtin_amdgcn_exp2f(u0.x); e0.y = __builtin_amdgcn_exp2f(u0.y); e1.x = __builtin_amdgcn_exp2f(u1.x); e1.y = __builtin_amdgcn_exp2f(u1.y);
                            const f32x2v d0 = e0 + 1.0f, d1 = e1 + 1.0f; f32x2v s0, s1; s0.x = __builtin_amdgcn_rcpf(d0.x); s0.y = __builtin_amdgcn_rcpf(d0.y); s1.x = __builtin_amdgcn_rcpf(d1.x); s1.y = __builtin_amdgcn_rcpf(d1.y);
                            x0 = x0 * s0; x1 = x1 * s1; v0[e] = x0.x; v0[e + 1] = x0.y; v1[e] = x1.x; v1[e + 1] = x1.y;
                            const f32x2v q = x0 * x0 + x1 * x1; ss += q.x + q.y; }
                        u32x4 w; w.x = cvt_pk_bf16(v0[0], v0[1]); w.y = cvt_pk_bf16(v0[2], v0[3]); w.z = cvt_pk_bf16(v1[0], v1[1]); w.w = cvt_pk_bf16(v1[2], v1[3]);
                        *(u32x4*)(rowp + 32 * bj) = w; }
                    if (ct >= 20) { ss = rsum_fq(ss); if (fq == 0) VSSQ[(size_t)row * 8 + (ct - 20)] = ss; }
                }
        }
    }
};
struct EpiOut {
    static constexpr int BMAP = 1;
    const bf16_t* XB; bf16_t* X1B; float* SSQ2;
    __device__ __forceinline__ void operator()(const f32x4 (&acc)[2][2][4][2], const Unit& u, int wr, int wc, int fr, int fq) const {
        const int row0 = u.pm * BM + wr * 64 + fr, col0 = u.pn * BM + wc * 32 + 8 * fq;
        u32x4 xv[2][4][2];
#pragma unroll
        for (int ai = 0; ai < 2; ++ai)
#pragma unroll
            for (int m = 0; m < 4; ++m)
#pragma unroll
                for (int bj = 0; bj < 2; ++bj) xv[ai][m][bj] = *(const u32x4*)(XB + (size_t)(row0 + ai * HALF + m * 16) * D + col0 + bj * HALF);
#pragma unroll
        for (int ai = 0; ai < 2; ++ai)
#pragma unroll
            for (int m = 0; m < 4; ++m) { const int row = row0 + ai * HALF + m * 16; bf16_t* rowp = X1B + (size_t)row * D + col0; float ss = 0.f;
#pragma unroll
                for (int bj = 0; bj < 2; ++bj) { const u32x4 x = xv[ai][m][bj];
                    const f32x4 r0 = {__uint_as_float(x.x << 16), __uint_as_float(x.x & 0xffff0000u), __uint_as_float(x.y << 16), __uint_as_float(x.y & 0xffff0000u)};
                    const f32x4 r1 = {__uint_as_float(x.z << 16), __uint_as_float(x.z & 0xffff0000u), __uint_as_float(x.w << 16), __uint_as_float(x.w & 0xffff0000u)};
                    const f32x4 v0 = r0 + acc[ai][bj][m][0], v1 = r1 + acc[ai][bj][m][1];
                    u32x4 w; w.x = cvt_pk_bf16(v0[0], v0[1]); w.y = cvt_pk_bf16(v0[2], v0[3]); w.z = cvt_pk_bf16(v1[0], v1[1]); w.w = cvt_pk_bf16(v1[2], v1[3]);
                    *(u32x4*)(rowp + bj * HALF) = w;
                    ss += ((v0[0] * v0[0] + v0[1] * v0[1]) + (v0[2] * v0[2] + v0[3] * v0[3])) + ((v1[0] * v1[0] + v1[1] * v1[1]) + (v1[2] * v1[2] + v1[3] * v1[3])); }
                ss = rsum_fq(ss); if (fq == 0) SSQ2[(size_t)row * 16 + 4 * u.pn + wc] = ss; }
    }
};
struct EpiUp {
    static constexpr int BMAP = 1;
    bf16_t* H; const PG8_LAS float* RS; const float* SSQ2;
    __device__ __forceinline__ void operator()(const f32x4 (&acc)[2][2][4][2], const Unit& u, int wr, int wc, int fr, int fq) const {
        const int row0 = u.pm * BM + wr * 64 + fr, col0 = u.pn * HALF + wc * 32 + 8 * fq;
        const int slot = (u.pm >> 3) % 3;
        float rs[2][4];
        if (((const PG8_LAS int*)(RS + 768))[slot] == u.pm) {
            const PG8_LAS float* rsp = RS + slot * 256 + wr * 64 + fr;
#pragma unroll
            for (int ai = 0; ai < 2; ++ai)
#pragma unroll
                for (int m = 0; m < 4; ++m) rs[ai][m] = rsp[ai * HALF + m * 16];
        } else {
#pragma unroll
            for (int ai = 0; ai < 2; ++ai)
#pragma unroll
                for (int m = 0; m < 4; ++m) { const f32x4 pl = *(const f32x4*)(SSQ2 + (size_t)(row0 + ai * HALF + m * 16) * 16 + 4 * fq);
                    rs[ai][m] = rsqrtf(rsum_fq((pl[0] + pl[1]) + (pl[2] + pl[3])) * (1.0f / D) + EPS); }
        }
#pragma unroll
        for (int ai = 0; ai < 2; ++ai)
#pragma unroll
            for (int m = 0; m < 4; ++m) { const int row = row0 + ai * HALF + m * 16; const float r = rs[ai][m], r2 = r * r, c1 = -LOG2E * r;
                f32x4 h0, h1;
#pragma unroll
                for (int n = 0; n < 2; ++n)
#pragma unroll
                    for (int e = 0; e < 4; e += 2) { typedef float f32x2v __attribute__((ext_vector_type(2)));
                        const f32x2v gg2 = {acc[ai][0][m][n][e], acc[ai][0][m][n][e + 1]}, uu2 = {acc[ai][1][m][n][e], acc[ai][1][m][n][e + 1]};
                        const f32x2v cc = gg2 * c1; f32x2v ee; ee.x = __builtin_amdgcn_exp2f(cc.x); ee.y = __builtin_amdgcn_exp2f(cc.y);
                        const f32x2v dd = ee + 1.0f; f32x2v ss; ss.x = __builtin_amdgcn_rcpf(dd.x); ss.y = __builtin_amdgcn_rcpf(dd.y);
                        const f32x2v hh = ((gg2 * uu2) * r2) * ss;
                        if (n == 0) { h0[e] = hh.x; h0[e + 1] = hh.y; } else { h1[e] = hh.x; h1[e + 1] = hh.y; } }
                u32x4 w; w.x = cvt_pk_bf16(h0[0], h0[1]); w.y = cvt_pk_bf16(h0[2], h0[3]); w.z = cvt_pk_bf16(h1[0], h1[1]); w.w = cvt_pk_bf16(h1[2], h1[3]);
                *(u32x4*)(H + (size_t)row * DFF + col0) = w; }
    }
};
struct EpiUpFullLine {
    static constexpr int BMAP = 1;
    bf16_t* H; const PG8_LAS float* RS; const float* SSQ2;
    __device__ __forceinline__ void operator()(const f32x4 (&acc)[2][2][4][2], const Unit& u, int wr, int wc, int fr, int fq) const {
        const int row0 = u.pm * BM + wr * 64 + fr, col0 = u.pn * HALF + wc * 32 + 8 * fq;
        const int slot = (u.pm >> 3) % 3;
        float rs[2][4];
        if (((const PG8_LAS int*)(RS + 768))[slot] == u.pm) {
            const PG8_LAS float* rsp = RS + slot * 256 + wr * 64 + fr;
#pragma unroll
            for (int ai = 0; ai < 2; ++ai)
#pragma unroll
                for (int m = 0; m < 4; ++m) rs[ai][m] = rsp[ai * HALF + m * 16];
        } else {
#pragma unroll
            for (int ai = 0; ai < 2; ++ai)
#pragma unroll
                for (int m = 0; m < 4; ++m) { const f32x4 pl = *(const f32x4*)(SSQ2 + (size_t)(row0 + ai * HALF + m * 16) * 16 + 4 * fq);
                    rs[ai][m] = rsqrtf(rsum_fq((pl[0] + pl[1]) + (pl[2] + pl[3])) * (1.0f / D) + EPS); }
        }
#pragma unroll
        for (int ai = 0; ai < 2; ++ai)
#pragma unroll
            for (int m = 0; m < 4; ++m) { const int row = row0 + ai * HALF + m * 16; const float r = rs[ai][m], r2 = r * r, c1 = -LOG2E * r;
                f32x4 h0, h1;
#pragma unroll
                for (int n = 0; n < 2; ++n)
#pragma unroll
                    for (int e = 0; e < 4; e += 2) { typedef float f32x2v __attribute__((ext_vector_type(2)));
                        const f32x2v gg2 = {acc[ai][0][m][n][e], acc[ai][0][m][n][e + 1]}, uu2 = {acc[ai][1][m][n][e], acc[ai][1][m][n][e + 1]};
                        const f32x2v cc = gg2 * c1; f32x2v ee; ee.x = __builtin_amdgcn_exp2f(cc.x); ee.y = __builtin_amdgcn_exp2f(cc.y);
                        const f32x2v dd = ee + 1.0f; f32x2v ss; ss.x = __builtin_amdgcn_rcpf(dd.x); ss.y = __builtin_amdgcn_rcpf(dd.y);
                        const f32x2v hh = ((gg2 * uu2) * r2) * ss;
                        if (n == 0) { h0[e] = hh.x; h0[e + 1] = hh.y; } else { h1[e] = hh.x; h1[e + 1] = hh.y; } }
                u32x4 w; w.x = cvt_pk_bf16(h0[0], h0[1]); w.y = cvt_pk_bf16(h0[2], h0[3]); w.z = cvt_pk_bf16(h1[0], h1[1]); w.w = cvt_pk_bf16(h1[2], h1[3]);
                { const int l = fr + 16 * fq; *(u32x4*)(H + (size_t)(u.pm * BM + ai * HALF + wr * 64 + m * 16 + 8 * (wc & 1) + (l >> 3)) * DFF + u.pn * HALF + 64 * (wc >> 1) + (l & 7) * 8) = w; } }
    }
};
struct EpiDown {
    static constexpr int BMAP = 0;
    const bf16_t* X1B; float* out;
    __device__ __forceinline__ void operator()(const f32x4 (&acc)[2][2][4][2], const Unit& u, int wr, int wc, int fr, int fq) const {
        const int row0 = u.pm * BM + wr * 64 + fr, col0 = u.pn * BM + wc * 32 + 4 * fq;
        u32x2 xv[2][4][2][2];
#pragma unroll
        for (int ai = 0; ai < 2; ++ai)
#pragma unroll
            for (int m = 0; m < 4; ++m)
#pragma unroll
                for (int bj = 0; bj < 2; ++bj)
#pragma unroll
                    for (int n = 0; n < 2; ++n) xv[ai][m][bj][n] = *(const u32x2*)(X1B + (size_t)(row0 + ai * HALF + m * 16) * D + col0 + bj * HALF + n * 16);
#pragma unroll
        for (int ai = 0; ai < 2; ++ai)
#pragma unroll
            for (int m = 0; m < 4; ++m) { float* rowp = out + (size_t)(row0 + ai * HALF + m * 16) * D + col0;
#pragma unroll
                for (int bj = 0; bj < 2; ++bj)
#pragma unroll
                    for (int n = 0; n < 2; ++n) { const u32x2 x = xv[ai][m][bj][n];
                        const f32x4 r = {__uint_as_float(x.x << 16), __uint_as_float(x.x & 0xffff0000u), __uint_as_float(x.y << 16), __uint_as_float(x.y & 0xffff0000u)};
                        *(f32x4*)(rowp + bj * HALF + n * 16) = r + acc[ai][bj][m][n]; } }
    }
};
struct EpiNone {
    static constexpr int BMAP = 1;
    __device__ __forceinline__ void operator()(const f32x4 (&acc)[2][2][4][2], const Unit& u, int wr, int wc, int fr, int fq) const {
#pragma unroll
        for (int ai = 0; ai < 2; ++ai)
#pragma unroll
            for (int bj = 0; bj < 2; ++bj)
#pragma unroll
                for (int m = 0; m < 4; ++m)
#pragma unroll
                    for (int n = 0; n < 2; ++n) asm volatile("" :: "v"(acc[ai][bj][m][n]));
    }
};


template <int MODE> struct EpiDownProbe {
    static constexpr int BMAP = 0;
    const bf16_t* X1B; float* out;
    __device__ __forceinline__ void operator()(const f32x4 (&acc)[2][2][4][2], const Unit& u, int wr, int wc, int fr, int fq) const {
        const int row0 = u.pm * BM + wr * 64 + fr, col0 = u.pn * BM + wc * 32 + 4 * fq;
        u32x2 xv[2][4][2][2];
#pragma unroll
        for (int ai = 0; ai < 2; ++ai)
#pragma unroll
            for (int m = 0; m < 4; ++m)
#pragma unroll
                for (int bj = 0; bj < 2; ++bj)
#pragma unroll
                    for (int n = 0; n < 2; ++n) { if (MODE == 2) xv[ai][m][bj][n] = *(const u32x2*)(X1B + (size_t)(row0 + ai * HALF + m * 16) * D + col0 + bj * HALF + n * 16); else xv[ai][m][bj][n] = (u32x2){0u, 0u}; }
#pragma unroll
        for (int ai = 0; ai < 2; ++ai)
#pragma unroll
            for (int m = 0; m < 4; ++m) { float* rowp = out + (size_t)(row0 + ai * HALF + m * 16) * D + col0;
#pragma unroll
                for (int bj = 0; bj < 2; ++bj)
#pragma unroll
                    for (int n = 0; n < 2; ++n) { const u32x2 x = xv[ai][m][bj][n];
                        const f32x4 r = {__uint_as_float(x.x << 16), __uint_as_float(x.x & 0xffff0000u), __uint_as_float(x.y << 16), __uint_as_float(x.y & 0xffff0000u)};
                        const f32x4 v = r + acc[ai][bj][m][n];
                        if (MODE == 1) __builtin_nontemporal_store(v, (f32x4*)(rowp + bj * HALF + n * 16)); else asm volatile("" :: "v"(v)); } }
    }
};

template <class Epi, class Sched, bool ALIGN_EPI, int KMODE = 0>
__device__ __forceinline__ void gemm_phase(PG8_LAS unsigned char* lds, const Gemm g, const Sched& S, const Epi& E) {
    int tid_ = threadIdx.x; asm volatile("" : "+v"(tid_));
    const int tid = tid_, wid = __builtin_amdgcn_readfirstlane(tid >> 6), lane = tid & 63, wr = wid >> 2, wc = wid & 3, fr = lane & 15, fq = lane >> 4;
    const int K = g.K, nt = K / BK;
    unsigned voffA[2], voffB[2];
#pragma unroll
    for (int i = 0; i < 2; ++i) { int R, C; stage_rc(tid * 16 + i * 8192, R, C);
        const int Rb = Epi::BMAP == 0 ? R : Epi::BMAP == 1 ? ((R & ~31) + perm32(R & 31)) : (64 * (R >> 5) + perm32(R & 31));
        voffA[i] = (unsigned)(R * K + C) * 2u; voffB[i] = (unsigned)(Rb * K + C) * 2u; }
    const size_t kstep = (size_t)(BK * 2);
    const size_t hstep = (size_t)HALF * K * 2;
    const size_t hstepB = Epi::BMAP == 2 ? (size_t)32 * K * 2 : hstep;
    const size_t tstep = 2 * hstep;
    const unsigned ldsw = (unsigned)wid * 1024u;
    const int aoff = lds_byte(wr * 64 + fr, fq * 8), boff = lds_byte(wc * 32 + fr, fq * 8);
#define PG8_SA(b, h) (((b) * 2 + (h)) * HTB)
#define PG8_SB(b, h) ((4 + (b) * 2 + (h)) * HTB)
#define PG8_STAGE(bufoff, gbase, voff) do { if (KMODE != 1) { _Pragma("unroll") for (int _i = 0; _i < 2; ++_i) \
        __builtin_amdgcn_global_load_lds((const unsigned*)((const char*)(KMODE == 2 ? (const void*)g.Bt : (const void*)(gbase)) + (voff)[_i]), (PG8_LAS unsigned*)(lds + (bufoff) + ldsw + _i * 8192), 16, 0, 0); } } while (0)
#define PG8_LDA(dst, b, h) do { if (KMODE != 3) { _Pragma("unroll") for (int m = 0; m < 4; ++m) _Pragma("unroll") for (int k = 0; k < 2; ++k) dst[m][k] = *(const PG8_LAS bf16x8*)(lds + PG8_SA(b, h) + aoff + m * 2048 + k * 1024); } else { _Pragma("unroll") for (int m = 0; m < 4; ++m) _Pragma("unroll") for (int k = 0; k < 2; ++k) asm volatile("" : "+v"(dst[m][k])); } } while (0)
#define PG8_LDB(dst, b, h) do { if (KMODE != 3) { _Pragma("unroll") for (int n = 0; n < 2; ++n) _Pragma("unroll") for (int k = 0; k < 2; ++k) dst[n][k] = *(const PG8_LAS bf16x8*)(lds + PG8_SB(b, h) + boff + n * 2048 + k * 1024); } else { _Pragma("unroll") for (int n = 0; n < 2; ++n) _Pragma("unroll") for (int k = 0; k < 2; ++k) asm volatile("" : "+v"(dst[n][k])); } } while (0)
#define PG8_MMA(ai, bj, At, Bt) do { __builtin_amdgcn_s_setprio(1); _Pragma("unroll") for (int m = 0; m < 4; ++m) _Pragma("unroll") for (int n = 0; n < 2; ++n) _Pragma("unroll") for (int k = 0; k < 2; ++k) \
        acc[ai][bj][m][n] = __builtin_amdgcn_mfma_f32_16x16x32_bf16(Bt[n][k], At[m][k], acc[ai][bj][m][n], 0, 0, 0); __builtin_amdgcn_s_setprio(0); } while (0)
#define PG8_WAIT_V(n) asm volatile("s_waitcnt vmcnt(" #n ")" ::: "memory")
#define PG8_WAIT_L(n) asm volatile("s_waitcnt lgkmcnt(" #n ")" ::: "memory")
#define PG8_BAR __builtin_amdgcn_s_barrier()
#define PG8_SCHED __builtin_amdgcn_sched_barrier(0)
    Unit cur, nxt; int ui = 0;
    if (!S.next(0, cur)) return;
    f32x4 acc[2][2][4][2];
#pragma unroll
    for (int a = 0; a < 2; ++a)
#pragma unroll
        for (int b = 0; b < 2; ++b)
#pragma unroll
            for (int m = 0; m < 4; ++m)
#pragma unroll
                for (int n = 0; n < 2; ++n) acc[a][b][m][n] = (f32x4){0.f, 0.f, 0.f, 0.f};
    bf16x8 At[4][2], B0[2][2], B1[2][2];
    if (KMODE == 3) { _Pragma("unroll") for (int m = 0; m < 4; ++m) _Pragma("unroll") for (int k = 0; k < 2; ++k) At[m][k] = (bf16x8){1, 2, 3, 4, 5, 6, 7, 8}; _Pragma("unroll") for (int n = 0; n < 2; ++n) _Pragma("unroll") for (int k = 0; k < 2; ++k) { B0[n][k] = (bf16x8){1, 2, 3, 4, 5, 6, 7, 8}; B1[n][k] = B0[n][k]; } }
    const char* cA = (const char*)g.A + (size_t)cur.pm * tstep; const char* cB = (const char*)g.Bt + (size_t)cur.pn * tstep;
    PG8_STAGE(PG8_SB(0, 0), cB, voffB); PG8_STAGE(PG8_SB(0, 1), cB + hstepB, voffB); PG8_STAGE(PG8_SA(0, 0), cA, voffA); PG8_STAGE(PG8_SA(0, 1), cA + hstep, voffA);
    if (wr == 1) PG8_BAR;
    PG8_WAIT_V(2); PG8_BAR;
    PG8_STAGE(PG8_SB(1, 0), cB + kstep, voffB); PG8_STAGE(PG8_SA(1, 0), cA + kstep, voffA); PG8_STAGE(PG8_SB(1, 1), cB + hstepB + kstep, voffB);
    PG8_WAIT_V(6); PG8_BAR;
    for (;;) {
        const bool has_next = S.next(ui + 1, nxt);
        const char* nA = has_next ? (const char*)g.A + (size_t)nxt.pm * tstep : cA; const char* nB = has_next ? (const char*)g.Bt + (size_t)nxt.pn * tstep : cB;
        for (int t = 0; t < nt; t += 2) {
            const bool last = (t == nt - 2);
            const char* a1 = cA + (size_t)(t + 1) * kstep;
            const char* a2 = last ? nA : cA + (size_t)(t + 2) * kstep; const char* b2 = last ? nB : cB + (size_t)(t + 2) * kstep;
            const char* a3 = a2 + kstep; const char* b3 = b2 + kstep;
            if constexpr (KMODE == 4) {
            PG8_LDB(B0, 0, 0); PG8_LDB(B1, 0, 1); PG8_SCHED; PG8_LDA(At, 0, 0);
            PG8_WAIT_V(6); PG8_WAIT_L(0); PG8_BAR; PG8_STAGE(PG8_SA(1, 1), a1 + hstep, voffA); PG8_MMA(0, 0, At, B0); PG8_MMA(0, 1, At, B1); PG8_BAR; PG8_SCHED;
            PG8_LDA(At, 0, 1);
            PG8_WAIT_V(2); PG8_WAIT_L(0); PG8_BAR; PG8_STAGE(PG8_SB(0, 0), b2, voffB); PG8_STAGE(PG8_SB(0, 1), b2 + hstepB, voffB); PG8_STAGE(PG8_SA(0, 0), a2, voffA); PG8_MMA(1, 0, At, B0); PG8_MMA(1, 1, At, B1); PG8_BAR; PG8_SCHED;
            PG8_LDB(B0, 1, 0); PG8_LDB(B1, 1, 1); PG8_SCHED; PG8_LDA(At, 1, 0);
            PG8_WAIT_V(6); PG8_WAIT_L(0); PG8_BAR; PG8_STAGE(PG8_SA(0, 1), a2 + hstep, voffA); PG8_MMA(0, 0, At, B0); PG8_MMA(0, 1, At, B1); PG8_BAR; PG8_SCHED;
            PG8_LDA(At, 1, 1);
            PG8_WAIT_V(2); PG8_WAIT_L(0); PG8_BAR; PG8_STAGE(PG8_SB(1, 0), b3, voffB); PG8_STAGE(PG8_SB(1, 1), b3 + hstepB, voffB); PG8_STAGE(PG8_SA(1, 0), a3, voffA); PG8_MMA(1, 0, At, B0); PG8_MMA(1, 1, At, B1); PG8_BAR; PG8_SCHED;
            } else {
            PG8_LDB(B0, 0, 0); PG8_LDB(B1, 0, 1); PG8_SCHED; PG8_LDA(At, 0, 0); PG8_STAGE(PG8_SA(1, 1), a1 + hstep, voffA);
            PG8_WAIT_V(8); PG8_WAIT_L(0); PG8_BAR; PG8_MMA(0, 0, At, B0); PG8_MMA(0, 1, At, B1); PG8_BAR; PG8_SCHED;
            PG8_LDA(At, 0, 1); PG8_STAGE(PG8_SB(0, 0), b2, voffB); PG8_STAGE(PG8_SB(0, 1), b2 + hstepB, voffB); PG8_STAGE(PG8_SA(0, 0), a2, voffA);
            PG8_WAIT_V(8); PG8_WAIT_L(0); PG8_BAR; PG8_MMA(1, 0, At, B0); PG8_MMA(1, 1, At, B1); PG8_BAR; PG8_SCHED;
            PG8_LDB(B0, 1, 0); PG8_LDB(B1, 1, 1); PG8_SCHED; PG8_LDA(At, 1, 0); PG8_STAGE(PG8_SA(0, 1), a2 + hstep, voffA);
            PG8_WAIT_V(8); PG8_WAIT_L(0); PG8_BAR; PG8_MMA(0, 0, At, B0); PG8_MMA(0, 1, At, B1); PG8_BAR; PG8_SCHED;
            PG8_LDA(At, 1, 1); PG8_STAGE(PG8_SB(1, 0), b3, voffB); PG8_STAGE(PG8_SB(1, 1), b3 + hstepB, voffB); PG8_STAGE(PG8_SA(1, 0), a3, voffA);
            PG8_WAIT_V(8); PG8_WAIT_L(0); PG8_BAR; PG8_MMA(1, 0, At, B0); PG8_MMA(1, 1, At, B1); PG8_BAR; PG8_SCHED;
                    }
        }
        if constexpr (ALIGN_EPI) { if (wr == 0) PG8_BAR; }
        E(acc, cur, wr, wc, fr, fq);
        if (!has_next) break;
#pragma unroll
        for (int a = 0; a < 2; ++a)
#pragma unroll
            for (int b = 0; b < 2; ++b)
#pragma unroll
                for (int m = 0; m < 4; ++m)
#pragma unroll
                    for (int n = 0; n < 2; ++n) acc[a][b][m][n] = (f32x4){0.f, 0.f, 0.f, 0.f};
        cur = nxt; cA = nA; cB = nB; ++ui;
        if constexpr (ALIGN_EPI) { if (wr == 1) PG8_BAR; }
    }
    PG8_WAIT_V(0);
    if constexpr (!ALIGN_EPI) { if (wr == 0) PG8_BAR; }
    PG8_BAR;
#undef PG8_SA
#undef PG8_SB
#undef PG8_STAGE
#undef PG8_LDA
#undef PG8_LDB
#undef PG8_MMA
#undef PG8_WAIT_V
#undef PG8_WAIT_L
#undef PG8_BAR
#undef PG8_SCHED
}
}
#define LAS __attribute__((address_space(3)))

struct Args;
__device__ __forceinline__ void p0_prologue_naive(const float* const* in, unsigned char* ws, int G) {
    const size_t gt = (size_t)blockIdx.x * 512 + threadIdx.x, GT = (size_t)G * 512;
    for (size_t i = gt; i < NPREP; i += GT) prep_w_elem(i, in[4], in[13], in[15], in[16], in[17], in[9], in[14], ws);
    const int wave = threadIdx.x >> 6, lane = threadIdx.x & 63;
    for (int m = blockIdx.x * 8 + wave; m < M; m += G * 8) xn_row(m, lane, in[0], in[1], in[3], (bf16_t*)(ws + WS_XN));
}


__device__ __forceinline__ unsigned pk2(float lo, float hi) { return f2bf(lo) | (f2bf(hi) << 16); }
__device__ __forceinline__ void p0_item(const float* W, int K, int N, bf16_t* WT, int orow0, const float* kscale, LAS float* scr, int k0, int n0, int lane) {
    typedef unsigned v4u __attribute__((ext_vector_type(4)));
    float wv[32];
#pragma unroll
    for (int i = 0; i < 32; ++i) wv[i] = W[(size_t)(k0 + 2 * i + (lane >> 5)) * N + n0 + (lane & 31)];
    if (kscale) {
#pragma unroll
        for (int i = 0; i < 32; ++i) wv[i] *= kscale[k0 + 2 * i + (lane >> 5)]; }
#pragma unroll
    for (int i = 0; i < 32; ++i) scr[(2 * i + (lane >> 5)) * 33 + (lane & 31)] = wv[i];
    asm volatile("s_waitcnt lgkmcnt(0)" ::: "memory");
    const int c = lane & 7;
#pragma unroll
    for (int j = 0; j < 4; ++j) { const int n = (lane >> 3) + 8 * j; const LAS float* s = scr + (8 * c) * 33 + n;
        v4u o; o.x = pk2(s[0 * 33], s[1 * 33]); o.y = pk2(s[2 * 33], s[3 * 33]); o.z = pk2(s[4 * 33], s[5 * 33]); o.w = pk2(s[6 * 33], s[7 * 33]);
        *(v4u*)(WT + (size_t)(orow0 + n) * K + k0 + 8 * c) = o; }
    asm volatile("s_waitcnt lgkmcnt(0)" ::: "memory");
}
__device__ __forceinline__ void p0_weights(const float* const* in, unsigned char* ws, LAS unsigned char* lds, int it_lo, int it_hi, int w, int nw) {
    const int wave = __builtin_amdgcn_readfirstlane(threadIdx.x >> 6), lane = threadIdx.x & 63;
    LAS float* scr = (LAS float*)(lds + wave * 16384);
    constexpr int I_IN = (D / 64) * (INW / 32), I_O = (D / 64) * (D / 32), I_G = (D / 64) * (DFF / 32);
    bf16_t* WIN = (bf16_t*)(ws + WS_WIN); bf16_t* WO = (bf16_t*)(ws + WS_WO); bf16_t* WGU = (bf16_t*)(ws + WS_WGU); bf16_t* WDN = (bf16_t*)(ws + WS_WDN);
    for (int it = it_lo + w; it < it_hi; it += nw) {
        int r = it;
        if (r < I_IN) { const int nb = r % (INW / 32), kb = r / (INW / 32); p0_item(in[4], D, INW, WIN, 32 * nb, in[3], scr, 64 * kb, 32 * nb, lane); continue; } r -= I_IN;
        if (r < I_O) { const int nb = r % (D / 32), kb = r / (D / 32); p0_item(in[13], D, D, WO, 32 * nb, nullptr, scr, 64 * kb, 32 * nb, lane); continue; } r -= I_O;
        if (r < 2 * I_G) { const int up = r >= I_G; if (up) r -= I_G; const int nb = r % (DFF / 32), kb = r / (DFF / 32), n0 = 32 * nb;
            p0_item(in[up ? 16 : 15], D, DFF, WGU, 256 * (n0 >> 7) + (n0 & 127) + 128 * up, in[14], scr, 64 * kb, n0, lane); continue; } r -= 2 * I_G;
        { const int nb = r % (D / 32), kb = r / (D / 32); p0_item(in[17], DFF, D, WDN, 32 * nb, nullptr, scr, 64 * kb, 32 * nb, lane); }
    }
}
constexpr int P0_I_IN = (D / 64) * (INW / 32), P0_NITEMS = P0_I_IN + (D / 64) * (D / 32) + 2 * (D / 64) * (DFF / 32) + (DFF / 64) * (D / 32);
__device__ __forceinline__ void p0_prologue(const float* const* in, unsigned char* ws, LAS unsigned char* lds, int G) {
    const int wave = __builtin_amdgcn_readfirstlane(threadIdx.x >> 6), lane = threadIdx.x & 63;
    const int gw = (int)blockIdx.x * 8 + wave, NGW = G * 8;
    p0_weights(in, ws, lds, 0, MK_LATE_WEIGHTS ? P0_I_IN : P0_NITEMS, gw, NGW);
    { const size_t gt = (size_t)blockIdx.x * 512 + threadIdx.x; bf16_t* WSB = (bf16_t*)(ws + WS_WS); for (size_t i = gt; i < 8 * 128 * 128; i += (size_t)G * 512) WSB[i] = f2bf(in[9][i]); }
    typedef float f32x4 __attribute__((ext_vector_type(4)));
    bf16_t* XB = (bf16_t*)(ws + WS_XN); float* RS1 = (float*)(ws + WS_RS1);
    for (int m4 = gw * 4; m4 < M; m4 += NGW * 4) {
        const f32x4* xr = (const f32x4*)(m4 < MP ? in[0] + (size_t)m4 * D : in[1] + (size_t)(m4 - MP) * D) + lane;
        f32x4 v[4][4]; float ss[4];
#pragma unroll
        for (int r = 0; r < 4; ++r)
#pragma unroll
            for (int j = 0; j < 4; ++j) v[r][j] = __builtin_nontemporal_load(xr + r * (D / 4) + 64 * j);
#pragma unroll
        for (int r = 0; r < 4; ++r) { ss[r] = 0.f;
            unsigned long long* b8 = (unsigned long long*)(XB + (size_t)(m4 + r) * D) + lane;
#pragma unroll
            for (int j = 0; j < 4; ++j) { ss[r] += (v[r][j][0] * v[r][j][0] + v[r][j][1] * v[r][j][1]) + (v[r][j][2] * v[r][j][2] + v[r][j][3] * v[r][j][3]);
                b8[64 * j] = (unsigned long long)pk2(v[r][j][0], v[r][j][1]) | ((unsigned long long)pk2(v[r][j][2], v[r][j][3]) << 32); } }
#pragma unroll
        for (int o = 1; o < 64; o <<= 1) {
#pragma unroll
            for (int r = 0; r < 4; ++r) ss[r] += __shfl_xor(ss[r], o); }
        if (lane < 4) RS1[m4 + lane] = rsqrtf((lane == 0 ? ss[0] : lane == 1 ? ss[1] : lane == 2 ? ss[2] : ss[3]) * (1.0f / D) + EPS);
    }
}

__device__ __forceinline__ void p2_mixer_naive(const float* const* in, unsigned char* ws, unsigned char* lds_generic, int G) {
    MixNaiveLds* L = (MixNaiveLds*)lds_generic + (threadIdx.x >> 8);
    for (int pr = blockIdx.x; pr < M / 2; pr += G)
        mix_naive_token(2 * pr + (threadIdx.x >> 8), threadIdx.x & 255, *L, (const bf16_t*)(ws + WS_PROJ), (const float*)(ws + WS_VSSQ), (const bf16_t*)(ws + WS_WS), in[2], in[7], in[8], in[10], in[11], in[12], (bf16_t*)(ws + WS_MIX));
}

static void launch_naive_phase(int p, void* const* d_in, float* out, unsigned char* ws, hipStream_t stream) {
    const float* xp = (const float*)d_in[0]; const float* xs = (const float*)d_in[1]; const float* rel = (const float*)d_in[2]; const float* norm1 = (const float*)d_in[3];
    const float* w_in = (const float*)d_in[4]; const float* qg = (const float*)d_in[5]; const float* kg = (const float*)d_in[6]; const float* sink = (const float*)d_in[7];
    const float* vg = (const float*)d_in[8]; const float* w_s = (const float*)d_in[9]; const float* b_s = (const float*)d_in[10]; const float* ag = (const float*)d_in[11];
    const float* gg = (const float*)d_in[12]; const float* w_o = (const float*)d_in[13]; const float* norm2 = (const float*)d_in[14]; const float* w_gate = (const float*)d_in[15];
    const float* w_up = (const float*)d_in[16]; const float* w_down = (const float*)d_in[17];
    bf16_t* WIN = (bf16_t*)(ws + WS_WIN); bf16_t* WO = (bf16_t*)(ws + WS_WO); bf16_t* WGU = (bf16_t*)(ws + WS_WGU); bf16_t* WDN = (bf16_t*)(ws + WS_WDN); bf16_t* WSB = (bf16_t*)(ws + WS_WS);
    float* VSSQ = (float*)(ws + WS_VSSQ); float* SSQ2 = (float*)(ws + WS_SSQ2);
    bf16_t* XN = (bf16_t*)(ws + WS_XN); bf16_t* PROJ = (bf16_t*)(ws + WS_PROJ); bf16_t* H = (bf16_t*)(ws + WS_H); bf16_t* MIX = (bf16_t*)(ws + WS_MIX); bf16_t* X1B = (bf16_t*)(ws + WS_X1B);
    switch (p) {
    case 0: k_prep_w<<<(unsigned)((NPREP + 255) / 256), 256, 0, stream>>>(w_in, w_o, w_gate, w_up, w_down, w_s, norm2, ws);
            k_xn<<<M / 4, 256, 0, stream>>>(xp, xs, norm1, XN); break;
    case 1: k_gemm_naive<NEpiIn, false><<<dim3(INW / 64, M / 64), 256, 0, stream>>>(XN, WIN, D, NEpiIn{PROJ, VSSQ, qg, kg}); break;
    case 2: k_mix_naive<<<M, 256, 0, stream>>>(PROJ, VSSQ, WSB, rel, sink, vg, b_s, ag, gg, MIX); break;
    case 3: k_gemm_naive<NEpiOut, false><<<dim3(D / 64, M / 64), 256, 0, stream>>>(MIX, WO, D, NEpiOut{xp, xs, out, X1B, SSQ2}); break;
    case 4: k_gemm_naive<NEpiUp, true><<<dim3(DFF / 64, M / 64), 256, 0, stream>>>(X1B, WGU, D, NEpiUp{H, SSQ2}); break;
    case 5: k_gemm_naive<NEpiDown, false><<<dim3(D / 64, M / 64), 256, 0, stream>>>(H, WDN, DFF, NEpiDown{out}); break;
    }
}

namespace mix {
typedef short bf16x8 __attribute__((ext_vector_type(8)));
typedef short s16x4 __attribute__((ext_vector_type(4)));
typedef float f32x16 __attribute__((ext_vector_type(16)));
typedef float f32x4 __attribute__((ext_vector_type(4)));
typedef unsigned u32x2 __attribute__((ext_vector_type(2)));
typedef unsigned u32x4 __attribute__((ext_vector_type(4)));
typedef float f32x2_t __attribute__((ext_vector_type(2))); typedef __bf16 bf16x2_t __attribute__((ext_vector_type(2)));
constexpr int L_K = 0, L_V = 40960, L_TAB = 81920, TABN = 392, L_RV = L_TAB + 8 * 4 * TABN * 4, L_SS = L_RV + 512, L_END = L_SS + 2048, L_UA = 65536, L_UB = L_END, L_END2 = L_UB + 16384, L_PAR = L_END2, L_END3 = L_PAR + 2560 * 4;
constexpr int NUNITS = NSEQ * (SEQ / 64);
__device__ __forceinline__ unsigned cvtpk(float lo, float hi) { f32x2_t v = {lo, hi}; bf16x2_t b = __builtin_convertvector(v, bf16x2_t); return __builtin_bit_cast(unsigned, b); }
__device__ __forceinline__ s16x4 trrd(const LAS unsigned char* p) { typedef short v4i16_t __attribute__((ext_vector_type(4))); return __builtin_bit_cast(s16x4, __builtin_amdgcn_ds_read_tr16_b64_v4i16((LAS v4i16_t*)p)); }
__device__ __forceinline__ float xhalf_sum(float v) { auto rr = __builtin_amdgcn_permlane32_swap(__float_as_uint(v), __float_as_uint(v), false, false); return __uint_as_float(rr[0]) + __uint_as_float(rr[1]); }
__device__ __forceinline__ float xhalf_max(float v) { auto rr = __builtin_amdgcn_permlane32_swap(__float_as_uint(v), __float_as_uint(v), false, false); return fmaxf(__uint_as_float(rr[0]), __uint_as_float(rr[1])); }


__device__ __forceinline__ void store_pairs(bf16_t* p, const u32x2 (&w)[4], int hi, bool skip = false) {
    if (skip) { asm volatile("" :: "v"(w[0].x), "v"(w[1].x), "v"(w[2].x), "v"(w[3].x)); return; }
#pragma unroll
    for (int k = 0; k < 4; k += 2) {
        auto rx = __builtin_amdgcn_permlane32_swap(w[k].x, w[k + 1].x, false, false); auto ry = __builtin_amdgcn_permlane32_swap(w[k].y, w[k + 1].y, false, false);
        const u32x4 v = {rx[0], ry[0], rx[1], ry[1]};
        *(u32x4*)(p + 8 * (k + hi)) = v;
    }
}

__device__ __forceinline__ void pack_pairs(u32x4 (&out)[2], const u32x2 (&w)[4]) {
#pragma unroll
    for (int k = 0; k < 4; k += 2) {
        auto rx = __builtin_amdgcn_permlane32_swap(w[k].x, w[k + 1].x, false, false); auto ry = __builtin_amdgcn_permlane32_swap(w[k].y, w[k + 1].y, false, false);
        out[k >> 1] = (u32x4){rx[0], ry[0], rx[1], ry[1]};
    }
}

template <int MODE> __device__ __forceinline__ void stage_rows(LAS unsigned char* img, const bf16_t* src, int row_lo, int row_hi, int wave, int lane, bool nodma) {
    if (nodma) return;
    for (int r8 = (row_lo >> 3) + wave; r8 < (row_hi >> 3); r8 += 8) {
        const int row = 8 * r8 + (lane >> 3), pc = lane & 7, c = MODE == 0 ? (pc ^ ((row >> 1) & 7)) : (pc ^ (((row >> 1) & 1) << 2));
        __builtin_amdgcn_global_load_lds((const unsigned*)(src + (size_t)row * INW + 8 * c), (LAS unsigned*)(img + r8 * 1024), 16, 0, 0);
    }
}


template <bool FAST> __device__ __forceinline__ void attn_tiles(LAS unsigned char* lds, const bf16x8 (&qf)[4], const LAS float* tbp, int kt_lo, int kt_hi, const int (&koff)[4], const int (&voff)[2], int hi, f32x16& o0r, f32x16& o1r) {
    float m = 0.0f, l = hi == 0 ? 1.0f : 0.0f;
    f32x16 o0 = {}, o1 = {};
    for (int kt = kt_lo; kt < kt_hi; ++kt) {
        f32x16 p0, p1;
        { const LAS float* tp = tbp + 64 * kt;
#pragma unroll
          for (int gq = 0; gq < 4; ++gq) { const f32x4 a = *(const LAS f32x4*)(tp + 8 * gq), b = *(const LAS f32x4*)(tp + 32 + 8 * gq);
#pragma unroll
              for (int e = 0; e < 4; ++e) { p0[4 * gq + e] = a[e]; p1[4 * gq + e] = b[e]; } } }
        const LAS unsigned char* kb = lds + L_K + kt * 8192;
#pragma unroll
        for (int d0 = 0; d0 < 4; ++d0) { const bf16x8 k0 = *(const LAS bf16x8*)(kb + koff[d0]), k1 = *(const LAS bf16x8*)(kb + 4096 + koff[d0]);
            p0 = __builtin_amdgcn_mfma_f32_32x32x16_bf16(k0, qf[d0], p0, 0, 0, 0); p1 = __builtin_amdgcn_mfma_f32_32x32x16_bf16(k1, qf[d0], p1, 0, 0, 0); }
        const LAS unsigned char* vb = lds + L_V + kt * 8192;
        bf16x8 vf0[2][2];
#pragma unroll
        for (int sI = 0; sI < 2; ++sI)
#pragma unroll
            for (int dh = 0; dh < 2; ++dh) { const LAS unsigned char* vp = vb + (16 * sI) * 128 + voff[dh];
                const s16x4 lo = trrd(vp), hi4 = trrd(vp + 8 * 128); vf0[sI][dh] = (bf16x8){lo[0], lo[1], lo[2], lo[3], hi4[0], hi4[1], hi4[2], hi4[3]}; }
        float ls = 0.f;
        if (FAST) {
#pragma unroll
            for (int r = 0; r < 16; ++r) { p0[r] = __builtin_amdgcn_exp2f(p0[r]); p1[r] = __builtin_amdgcn_exp2f(p1[r]); }
            { f32x2_t l2 = {0.f, 0.f};
#pragma unroll
              for (int r = 0; r < 16; r += 2) l2 += (f32x2_t){p0[r], p0[r + 1]} + (f32x2_t){p1[r], p1[r + 1]};
              ls = l2.x + l2.y; }
            l += ls;
        } else {
            float rm = fmaxf(p0[0], p1[0]);
#pragma unroll
            for (int r = 1; r < 16; ++r) rm = fmaxf(rm, fmaxf(p0[r], p1[r]));
            rm = xhalf_max(rm);
            const float mn = fmaxf(m, rm), alpha = __builtin_amdgcn_exp2f(m - mn); m = mn;
#pragma unroll
            for (int r = 0; r < 16; ++r) { p0[r] = __builtin_amdgcn_exp2f(p0[r] - m); p1[r] = __builtin_amdgcn_exp2f(p1[r] - m); ls += p0[r] + p1[r]; }
            l = l * alpha + ls;
#pragma unroll
            for (int r = 0; r < 16; ++r) { o0[r] *= alpha; o1[r] *= alpha; }
        }
        u32x4 pw[2][2];
#pragma unroll
        for (int sI = 0; sI < 2; ++sI) { pw[0][sI] = (u32x4){cvtpk(p0[8 * sI], p0[8 * sI + 1]), cvtpk(p0[8 * sI + 2], p0[8 * sI + 3]), cvtpk(p0[8 * sI + 4], p0[8 * sI + 5]), cvtpk(p0[8 * sI + 6], p0[8 * sI + 7])};
                                         pw[1][sI] = (u32x4){cvtpk(p1[8 * sI], p1[8 * sI + 1]), cvtpk(p1[8 * sI + 2], p1[8 * sI + 3]), cvtpk(p1[8 * sI + 4], p1[8 * sI + 5]), cvtpk(p1[8 * sI + 6], p1[8 * sI + 7])}; }
#pragma unroll
        for (int sI = 0; sI < 2; ++sI) { const bf16x8 pf = __builtin_bit_cast(bf16x8, pw[0][sI]);
            o0 = __builtin_amdgcn_mfma_f32_32x32x16_bf16(vf0[sI][0], pf, o0, 0, 0, 0); o1 = __builtin_amdgcn_mfma_f32_32x32x16_bf16(vf0[sI][1], pf, o1, 0, 0, 0); }
#pragma unroll
        for (int sI = 0; sI < 2; ++sI) { const bf16x8 pf = __builtin_bit_cast(bf16x8, pw[1][sI]);
#pragma unroll
            for (int dh = 0; dh < 2; ++dh) { const LAS unsigned char* vp = vb + (32 + 16 * sI) * 128 + voff[dh];
                const s16x4 lo = trrd(vp), hi4 = trrd(vp + 8 * 128); const bf16x8 vf = {lo[0], lo[1], lo[2], lo[3], hi4[0], hi4[1], hi4[2], hi4[3]};
                if (dh == 0) o0 = __builtin_amdgcn_mfma_f32_32x32x16_bf16(vf, pf, o0, 0, 0, 0); else o1 = __builtin_amdgcn_mfma_f32_32x32x16_bf16(vf, pf, o1, 0, 0, 0); } }
    }
    const float inv = 1.0f / xhalf_sum(l);
#pragma unroll
    for (int r = 0; r < 16; ++r) { o0[r] *= inv; o1[r] *= inv; }
    o0r = o0; o1r = o1;
}

__device__ __forceinline__ void p2_mixer(const float* const* in, unsigned char* ws, LAS unsigned char* lds, int G, int pflags) {
    const bool nodma = pflags & 1;
    const int tid = threadIdx.x, wave = __builtin_amdgcn_readfirstlane(tid >> 6), lane = tid & 63, r32 = lane & 31, hi = lane >> 5, hq = wave >> 1, tb = wave & 1;
    const bf16_t* PROJ = (const bf16_t*)(ws + WS_PROJ); const float* VSSQ = (const float*)(ws + WS_VSSQ); const bf16_t* WSB = (const bf16_t*)(ws + WS_WS); bf16_t* MIX = (bf16_t*)(ws + WS_MIX);
    const float* rel_table = in[2]; const float* sink = in[7]; const float* v_gain = in[8]; const float* b_s = in[10]; const float* ag = in[11]; const float* gg = in[12];
    LAS float* TAB = (LAS float*)(lds + L_TAB); LAS float* RV = (LAS float*)(lds + L_RV); LAS float* SS = (LAS float*)(lds + L_SS);
    { LAS float* RT = (LAS float*)(lds + L_K);
      if (tid < 256) RT[tid] = rel_table[tid]; else if (tid < 264) RT[tid] = sink[tid - 256];
      __syncthreads();
      for (int i = tid; i < 8 * 4 * TABN; i += 512) { const int h = i / (4 * TABN), rem = i % (4 * TABN), sh = rem / TABN, e = rem % TABN, bi = e + sh - 64;
          TAB[i] = (bi >= 0 && bi <= 256) ? (RT[t5_bucket(bi - 128) * 8 + h] - RT[256 + h]) * LOG2E : -1e30f; }
      LAS float* PAR = (LAS float*)(lds + L_PAR);
      PAR[tid] = ag[tid]; PAR[512 + tid] = gg[tid]; PAR[1024 + tid] = v_gain[tid]; PAR[1536 + tid] = b_s[tid]; PAR[2048 + tid] = b_s[512 + tid]; }
    const LAS float* PAG = (const LAS float*)(lds + L_PAR); const LAS float* PGG = PAG + 512; const LAS float* PVG = PAG + 1024; const LAS float* PBS = PAG + 1536;
    bool fast;
    { float mq = fabsf(in[5][lane]), mk = fabsf(in[6][lane]), mb = fmaxf(fmaxf(fabsf(rel_table[lane]), fabsf(rel_table[64 + lane])), fmaxf(fabsf(rel_table[128 + lane]), fabsf(rel_table[192 + lane]))), ms = fabsf(sink[lane & 7]);
#pragma unroll
      for (int o = 1; o < 64; o <<= 1) { mq = fmaxf(mq, __shfl_xor(mq, o)); mk = fmaxf(mk, __shfl_xor(mk, o)); mb = fmaxf(mb, __shfl_xor(mb, o)); ms = fmaxf(ms, __shfl_xor(ms, o)); }
      const float bound = (8.0f * mq * mk * 1.02f + mb + ms) * LOG2E;
      fast = __builtin_amdgcn_readfirstlane((int)(bound < 100.0f)) != 0; }
    int koff[4], voff[2], gvoff[2];
    { const int q = (lane & 15) >> 2, sw = (q >> 1) & 1;
#pragma unroll
      for (int d0 = 0; d0 < 4; ++d0) koff[d0] = r32 * 128 + (((2 * d0 + hi) ^ ((r32 >> 1) & 7)) << 4);
#pragma unroll
      for (int dh = 0; dh < 2; ++dh) { const int ch = 4 * (dh ^ sw) + 2 * ((lane >> 4) & 1) + ((lane & 3) >> 1);
          voff[dh] = (4 * hi + q) * 128 + ch * 16 + (lane & 1) * 8; gvoff[dh] = (8 * hi + q) * 128 + ch * 16 + (lane & 1) * 8; } }
    const int e0 = 64 - 32 * tb - r32 + 4 * hi, sh = e0 & 3;
    const int vcu = (G % 8 == 0) ? ((int)blockIdx.x % 8) * (G / 8) + (int)blockIdx.x / 8 : (int)blockIdx.x;

    for (int ri = 0; ; ++ri) {
        int u;
        if (MK_REV2 && G == 256 && NUNITS == 768) { if (ri >= 3) break; u = 4 * (24 * (vcu >> 5) + 8 * (2 - ri) + ((vcu & 31) >> 2)) + (vcu & 3); }
        else { u = vcu + ri * G; if (u >= NUNITS) break; }
        const int s = u >> 6, t0 = (u & 63) * 64, m0 = s * SEQ + t0;
        const int kt_lo = t0 < 128 ? (128 - t0) >> 6 : 0, kt_hi = (pflags & 2) ? kt_lo : (t0 + 192 > SEQ ? (SEQ + 128 - t0) >> 6 : 5);
        const int mc = m0 - (t0 & 127), pbase = (t0 & 127) + 32 * tb + r32;
        const size_t mrow = (size_t)(m0 + 32 * tb + r32);
        f32x16 oa[2][2];
        __syncthreads();
        if (tid < 128) { const f32x4* vp = (const f32x4*)(VSSQ + (size_t)(mc + tid) * 8); const f32x4 a = vp[0] + vp[1]; RV[tid] = rsqrtf(((a[0] + a[1]) + (a[2] + a[3])) * (1.0f / 512.0f) + EPS); }
#pragma unroll
        for (int g = 0; g < 2; ++g) {
            const int h = 4 * g + hq;
            if (g == 1) __syncthreads();
            { const bf16_t* krow0 = PROJ + (long)(m0 - 128) * INW + 512 + 64 * g;
              stage_rows<0>(lds + L_K, krow0, 64 * kt_lo, 64 * kt_hi, wave, lane, nodma);
              stage_rows<1>(lds + L_V, krow0 + 128, 64 * kt_lo, 64 * kt_hi, wave, lane, nodma); }
            bf16x8 qf[4];
#pragma unroll
            for (int d0 = 0; d0 < 4; ++d0) qf[d0] = *(const bf16x8*)(PROJ + mrow * INW + 64 * h + 16 * d0 + 8 * hi);
            __syncthreads();
            f32x16 o0, o1;
            { const LAS float* tbp = TAB + (h * 4 + sh) * TABN + (e0 - sh);
              if (fast) attn_tiles<true>(lds, qf, tbp, kt_lo, kt_hi, koff, voff, hi, o0, o1); else attn_tiles<false>(lds, qf, tbp, kt_lo, kt_hi, koff, voff, hi, o0, o1); }
            oa[g][0] = o0; oa[g][1] = o1;
        }
        { float ss = 0.f;
#pragma unroll
          for (int g = 0; g < 2; ++g)
#pragma unroll
              for (int dh = 0; dh < 2; ++dh)
#pragma unroll
                  for (int r = 0; r < 16; ++r) ss += oa[g][dh][r] * oa[g][dh][r];
          ss = xhalf_sum(ss); if (hi == 0) SS[wave * 32 + r32] = ss; }
        __syncthreads();
        { const bf16_t* vrow0 = PROJ + (size_t)mc * INW + 1280;
#pragma unroll
          for (int hh = 0; hh < 4; ++hh) stage_rows<1>(lds + hh * 16384, vrow0 + 64 * hh, 0, 128, wave, lane, nodma);
          const bf16_t* urow0 = PROJ + (size_t)m0 * INW + 768;
#pragma unroll
          for (int hh = 0; hh < 4; ++hh) stage_rows<0>(lds + (hh < 2 ? L_UA + hh * 8192 : L_UB + (hh - 2) * 8192), urow0 + 64 * hh, 0, 64, wave, lane, nodma); }
        u32x4 aout[2][2][2];
        { const float tot = (SS[tb * 32 + r32] + SS[(2 + tb) * 32 + r32]) + (SS[(4 + tb) * 32 + r32] + SS[(6 + tb) * 32 + r32]);
          const float ra = rsqrtf(tot * (1.0f / 512.0f) + EPS);
#pragma unroll
          for (int g = 0; g < 2; ++g)
#pragma unroll
              for (int dh = 0; dh < 2; ++dh)
                  { u32x2 w[4];
#pragma unroll
                    for (int gq = 0; gq < 4; ++gq) { const int col = 64 * (4 * g + hq) + 32 * dh + 8 * gq + 4 * hi; const f32x4 gn = *(const LAS f32x4*)(PAG + col);
                      const f32x2_t s0 = ((f32x2_t){oa[g][dh][4 * gq], oa[g][dh][4 * gq + 1]} * ra) * (f32x2_t){gn[0], gn[1]}, s1 = ((f32x2_t){oa[g][dh][4 * gq + 2], oa[g][dh][4 * gq + 3]} * ra) * (f32x2_t){gn[2], gn[3]};
                      w[gq].x = cvtpk(s0.x, s0.y); w[gq].y = cvtpk(s1.x, s1.y); }
                    pack_pairs(aout[g][dh], w); } }
        f32x16 og[2][2];
#pragma unroll
        for (int rd = 0; rd < 2; ++rd) {
            const int hh = 4 * rd + hq;
            if (rd == 1) { __syncthreads();
                const bf16_t* vrow0 = PROJ + (size_t)mc * INW + 1280 + 256;
#pragma unroll
                for (int h4 = 0; h4 < 4; ++h4) stage_rows<1>(lds + h4 * 16384, vrow0 + 64 * h4, 0, 128, wave, lane, nodma);
                const bf16_t* urow0 = PROJ + (size_t)m0 * INW + 768 + 256;
#pragma unroll
                for (int h4 = 0; h4 < 4; ++h4) stage_rows<0>(lds + (h4 < 2 ? L_UA + h4 * 8192 : L_UB + (h4 - 2) * 8192), urow0 + 64 * h4, 0, 64, wave, lane, nodma); }
            bf16x8 wf[8];
            { const bf16_t* wrow = WSB + ((size_t)hh * 128 + pbase) * 128 + 8 * hi;
#pragma unroll
              for (int sI = 0; sI < 8; ++sI) wf[sI] = *(const bf16x8*)(wrow + 16 * sI); }
            __syncthreads();
            if (rd == 0 && !(pflags & 8)) {
#pragma unroll
                for (int g = 0; g < 2; ++g)
#pragma unroll
                    for (int dh = 0; dh < 2; ++dh) { bf16_t* pp = MIX + mrow * D + 64 * (4 * g + hq) + 32 * dh;
                        *(u32x4*)(pp + 8 * hi) = aout[g][dh][0]; *(u32x4*)(pp + 8 * (2 + hi)) = aout[g][dh][1]; } }
            f32x16 a0 = {}, a1 = {};
            const LAS unsigned char* gb = lds + hq * 16384;
            if (!(pflags & 4))
#pragma unroll
            for (int sI = 0; sI < 8; ++sI) {
                const f32x4 ra = *(const LAS f32x4*)(RV + 16 * sI + 8 * hi), rb = *(const LAS f32x4*)(RV + 16 * sI + 8 * hi + 4);
                const u32x4 wu = __builtin_bit_cast(u32x4, wf[sI]); u32x4 ws4;
                { const f32x2_t t0 = (f32x2_t){__uint_as_float(wu.x << 16), __uint_as_float(wu.x & 0xffff0000u)} * (f32x2_t){ra[0], ra[1]}, t1 = (f32x2_t){__uint_as_float(wu.y << 16), __uint_as_float(wu.y & 0xffff0000u)} * (f32x2_t){ra[2], ra[3]};
                  const f32x2_t t2 = (f32x2_t){__uint_as_float(wu.z << 16), __uint_as_float(wu.z & 0xffff0000u)} * (f32x2_t){rb[0], rb[1]}, t3 = (f32x2_t){__uint_as_float(wu.w << 16), __uint_as_float(wu.w & 0xffff0000u)} * (f32x2_t){rb[2], rb[3]};
                  ws4.x = cvtpk(t0.x, t0.y); ws4.y = cvtpk(t1.x, t1.y); ws4.z = cvtpk(t2.x, t2.y); ws4.w = cvtpk(t3.x, t3.y); }
                const bf16x8 bfr = __builtin_bit_cast(bf16x8, ws4);
#pragma unroll
                for (int dh = 0; dh < 2; ++dh) { const LAS unsigned char* vp = gb + (16 * sI) * 128 + gvoff[dh];
                    const s16x4 lo = trrd(vp), hi4 = trrd(vp + 4 * 128); const bf16x8 vf = {lo[0], lo[1], lo[2], lo[3], hi4[0], hi4[1], hi4[2], hi4[3]};
                    if (dh == 0) a0 = __builtin_amdgcn_mfma_f32_32x32x16_bf16(vf, bfr, a0, 0, 0, 0); else a1 = __builtin_amdgcn_mfma_f32_32x32x16_bf16(vf, bfr, a1, 0, 0, 0); }
            }
            const float bsv = PBS[hh * 128 + pbase];
            const LAS unsigned char* ub = lds + (hq < 2 ? L_UA + hq * 8192 : L_UB + (hq - 2) * 8192) + (32 * tb + r32) * 128 + 8 * hi;
#pragma unroll
            for (int dh = 0; dh < 2; ++dh)
#pragma unroll
                for (int gq = 0; gq < 4; ++gq) { const int col = 64 * hh + 32 * dh + 8 * gq + 4 * hi; const f32x4 vg = *(const LAS f32x4*)(PVG + col);
                    const u32x2 uu = *(const LAS u32x2*)(ub + (((4 * dh + gq) ^ ((r32 >> 1) & 7)) << 4));
                    const float u0 = __uint_as_float(uu.x << 16), u1 = __uint_as_float(uu.x & 0xffff0000u), u2 = __uint_as_float(uu.y << 16), u3 = __uint_as_float(uu.y & 0xffff0000u);
                    f32x16& acc = dh == 0 ? a0 : a1;
                    const f32x2_t e0 = (f32x2_t){u0, u1} * ((f32x2_t){vg[0], vg[1]} * (f32x2_t){acc[4 * gq], acc[4 * gq + 1]} + bsv), e1 = (f32x2_t){u2, u3} * ((f32x2_t){vg[2], vg[3]} * (f32x2_t){acc[4 * gq + 2], acc[4 * gq + 3]} + bsv);
                    acc[4 * gq] = e0.x; acc[4 * gq + 1] = e0.y; acc[4 * gq + 2] = e1.x; acc[4 * gq + 3] = e1.y; }
            og[rd][0] = a0; og[rd][1] = a1;
        }
        { float ss = 0.f;
#pragma unroll
          for (int rd = 0; rd < 2; ++rd)
#pragma unroll
              for (int dh = 0; dh < 2; ++dh)
#pragma unroll
                  for (int r = 0; r < 16; ++r) ss += og[rd][dh][r] * og[rd][dh][r];
          ss = xhalf_sum(ss); if (hi == 0) SS[256 + wave * 32 + r32] = ss; }
        __syncthreads();
        { const float tot = (SS[256 + tb * 32 + r32] + SS[256 + (2 + tb) * 32 + r32]) + (SS[256 + (4 + tb) * 32 + r32] + SS[256 + (6 + tb) * 32 + r32]);
          const float rg = rsqrtf(tot * (1.0f / 512.0f) + EPS);
#pragma unroll
          for (int rd = 0; rd < 2; ++rd)
#pragma unroll
              for (int dh = 0; dh < 2; ++dh)
                  { u32x2 w[4];
#pragma unroll
                    for (int gq = 0; gq < 4; ++gq) { const int col = 64 * (4 * rd + hq) + 32 * dh + 8 * gq + 4 * hi; const f32x4 gn = *(const LAS f32x4*)(PGG + col);
                      const f32x2_t s0 = ((f32x2_t){og[rd][dh][4 * gq], og[rd][dh][4 * gq + 1]} * rg) * (f32x2_t){gn[0], gn[1]}, s1 = ((f32x2_t){og[rd][dh][4 * gq + 2], og[rd][dh][4 * gq + 3]} * rg) * (f32x2_t){gn[2], gn[3]};
                      w[gq].x = cvtpk(s0.x, s0.y); w[gq].y = cvtpk(s1.x, s1.y); }
                    store_pairs(MIX + mrow * D + 512 + 64 * (4 * rd + hq) + 32 * dh, w, hi, pflags & 8); } }
    }
    __syncthreads();
}
}

constexpr int NWAVES = 8;
constexpr int N_PHASES = 6;
constexpr int RING_BYTES = 131072;
constexpr int LDSCTL_OFF = 163840 - 2048, MISC_OFF = LDSCTL_OFF + 320;
constexpr int LDS_BYTES = 163840;
static_assert(MISC_OFF + 128 <= LDS_BYTES && mix::L_END3 <= LDSCTL_OFF, "LDS map");
#if MK_MIXER_RING
static_assert(mixr::R_END <= LDSCTL_OFF, "LDS map (ring mixer)");
#endif
constexpr int CW_BAR = 4096;

#define GAS __attribute__((address_space(1)))

typedef GAS unsigned gu32;
#define RLX_AGENT __ATOMIC_RELAXED, __HIP_MEMORY_SCOPE_AGENT

#define XB_TMO      128
#define XB_XCNT(j)  (256  + 64 * (j))
#define XB_XSUB(j)  (1280 + 64 * (j))
#define XB_XGEN(j)  (2304 + 64 * (j))
#define XB_TOP      3328
#define XB_TOPGEN   3392
#define XCD_BAR_WORDS 3456
#define XB_SPIN_CAP (1u << 18)

__device__ __forceinline__ unsigned xb_ld(unsigned* p)              { return __hip_atomic_load(p, __ATOMIC_RELAXED, __HIP_MEMORY_SCOPE_AGENT); }
__device__ __forceinline__ unsigned xb_add(unsigned* p, unsigned v) { return __hip_atomic_fetch_add(p, v, __ATOMIC_RELAXED, __HIP_MEMORY_SCOPE_AGENT); }
__device__ __forceinline__ unsigned xb_xcc_id() { return (unsigned)__builtin_amdgcn_s_getreg((3 << 11) | 20) & 0xFu; }
#define XB_SPIN(cond, bar) do { unsigned _sp = 0; while (cond) { __builtin_amdgcn_s_sleep(1); \
    if ((++_sp & 255u) == 0u) { if (xb_ld(&(bar)[XB_TMO])) break; if (_sp > XB_SPIN_CAP) { atomicAdd(&(bar)[XB_TMO], 1u); break; } } } } while (0)

struct XcdBarrier { unsigned* bar; unsigned x; volatile LAS unsigned* st; };
__device__ __forceinline__ XcdBarrier xcd_barrier_post(unsigned* bar, volatile LAS unsigned* st) {
    XcdBarrier b; b.bar = bar; b.x = xb_xcc_id(); b.st = st;
    if (threadIdx.x == 0) (void)xb_add(&bar[XB_XCNT(b.x)], 1u);
    return b;
}
__device__ __forceinline__ void xcd_barrier_complete(unsigned* bar, unsigned x, unsigned& nloc, unsigned& nx) {
    const unsigned G = gridDim.x * gridDim.y * gridDim.z;
    unsigned sum, cnt, mine, sp = 0u;
    for (;;) {
        sum = 0u; cnt = 0u; mine = 0u;
#pragma unroll
        for (unsigned j = 0; j < 16; ++j) { const unsigned c = xb_ld(&bar[XB_XCNT(j)]); sum += c; cnt += (c > 0u) ? 1u : 0u; mine = (j == x) ? c : mine; }
        if (sum == G) break;
        __builtin_amdgcn_s_sleep(1);
        if ((++sp & 255u) == 0u) { if (xb_ld(&bar[XB_TMO])) break; if (sp > XB_SPIN_CAP) { atomicAdd(&bar[XB_TMO], 1u); break; } }
    }
    nloc = mine > 0u ? mine : 1u; nx = cnt > 0u ? cnt : 1u;
}
__device__ __forceinline__ void xcd_barrier(const XcdBarrier& b) {
    asm volatile("s_waitcnt vmcnt(0)" ::: "memory");
    __syncthreads();
    if (threadIdx.x == 0) {
        unsigned* bar = b.bar;
        __builtin_amdgcn_s_waitcnt(0);
        unsigned nloc = b.st[0], nx = b.st[1];
        if (nloc == 0u) { xcd_barrier_complete(bar, b.x, nloc, nx); b.st[0] = nloc; b.st[1] = nx; }
        const unsigned old = xb_add(&bar[XB_XSUB(b.x)], 1u);
        const unsigned gen = old / nloc;
        if (old + 1u == (gen + 1u) * nloc) {
            __builtin_amdgcn_fence(__ATOMIC_RELEASE, "agent");
            asm volatile("s_waitcnt vmcnt(0)" ::: "memory");
            const unsigned og = xb_add(&bar[XB_TOP], 1u);
            const unsigned tg = og / nx;
            if (og + 1u == (tg + 1u) * nx) xb_add(&bar[XB_TOPGEN], 1u);
            else XB_SPIN(xb_ld(&bar[XB_TOPGEN]) == tg, bar);
            __builtin_amdgcn_fence(__ATOMIC_ACQUIRE, "agent");
            xb_add(&bar[XB_XGEN(b.x)], 1u);
            asm volatile("s_waitcnt vmcnt(0)" ::: "memory");
        } else {
            XB_SPIN(xb_ld(&bar[XB_XGEN(b.x)]) == gen, bar);
            __builtin_amdgcn_fence(__ATOMIC_ACQUIRE, "agent");
            asm volatile("s_waitcnt vmcnt(0)" ::: "memory");
        }
    }
    __syncthreads();
}

struct Args { const float* in[18]; float* out; unsigned char* ws; int ph_lo, ph_hi; };

__global__ void __launch_bounds__(NWAVES * 64, 2) mk_fwd(Args args) {
    extern __shared__ __attribute__((aligned(16))) unsigned char lds_raw[];
    LAS unsigned char* lds = (LAS unsigned char*)lds_raw;
    volatile LAS unsigned* MISC = (volatile LAS unsigned*)(lds + MISC_OFF);
    const int tid = threadIdx.x, G = gridDim.x;
    unsigned char* ws = args.ws;
    gu32* ctl = (gu32*)(ws + WS_CTL);
    for (int u = tid; u < (LDS_BYTES - LDSCTL_OFF) / 4; u += NWAVES * 64) ((LAS unsigned*)(lds + LDSCTL_OFF))[u] = 0u;
    __syncthreads();
    const int lo = args.ph_lo, hi = args.ph_hi;
    const bool multi = hi - lo > 1;
    XcdBarrier bar; bar.bar = (unsigned*)(ctl + CW_BAR); bar.x = 0; bar.st = nullptr;
    if (multi) bar = xcd_barrier_post((unsigned*)(ctl + CW_BAR), MISC + 8);
#define STAMP(k) do {} while (0)
#define STAGGER_TICKS(ticks) do { const unsigned long long t0_ = __builtin_amdgcn_s_memrealtime(), dl_ = (unsigned long long)(ticks); while (__builtin_amdgcn_s_memrealtime() - t0_ < dl_) __builtin_amdgcn_s_sleep(4); } while (0)
#define IN(k) (lo <= (k) && (k) < hi)
#define BOTH(k) (IN(k) && IN((k) + 1))
    const float* xp = args.in[0]; const float* xs = args.in[1];
    bf16_t* WIN = (bf16_t*)(ws + WS_WIN); bf16_t* WO = (bf16_t*)(ws + WS_WO); bf16_t* WGU = (bf16_t*)(ws + WS_WGU); bf16_t* WDN = (bf16_t*)(ws + WS_WDN);
    float* VSSQ = (float*)(ws + WS_VSSQ); float* SSQ2 = (float*)(ws + WS_SSQ2);
    bf16_t* XN = (bf16_t*)(ws + WS_XN); bf16_t* PROJ = (bf16_t*)(ws + WS_PROJ); bf16_t* H = (bf16_t*)(ws + WS_H); bf16_t* MIX = (bf16_t*)(ws + WS_MIX); bf16_t* X1B = (bf16_t*)(ws + WS_X1B);

    for (int rep = 0; rep < 1 + ((MK_REPEAT_MASK >> 0) & 1); ++rep) if (IN(0)) {
#if MK_PROLOGUE_NAIVE
        p0_prologue_naive(args.in, ws, G);
#else
        p0_prologue(args.in, ws, lds, G);
#endif
        if (BOTH(0)) xcd_barrier(bar); STAMP(0); }
    for (int rep = 0; rep < 1 + ((MK_REPEAT_MASK >> 1) & 1); ++rep) if (IN(1)) {
        pg8::Gemm g{XN, WIN, M, INW, D}; pg8::StaticOrder S; S.init(M, INW, G, (int)blockIdx.x);
        LAS float* RSL = (LAS float*)(lds + RING_BYTES);
        { const float* RS1 = (const float*)(ws + WS_RS1);
          float rv[pg8::EpiIn::NS1 / 2];
#pragma unroll
          for (int k = 0; k < pg8::EpiIn::NS1 / 2; ++k) { pg8::Unit uu; rv[k] = S.next((tid >> 8) + 2 * k, uu) ? RS1[uu.pm * 256 + (tid & 255)] : 0.f; }
#pragma unroll
          for (int k = 0; k < pg8::EpiIn::NS1 / 2; ++k) RSL[((tid >> 8) + 2 * k) * 256 + (tid & 255)] = rv[k];
          __syncthreads(); }
        pg8::EpiIn E{PROJ, VSSQ, args.in[5], args.in[6], RSL, (const float*)(ws + WS_RS1)};
        pg8::gemm_phase<pg8::EpiIn, pg8::StaticOrder, true>(lds, g, S, E);
#if MK_LATE_WEIGHTS
        {
          const int rounds = (S.nwg + G - 1) / G, nbusy = S.nwg - (rounds - 1) * G, c = (int)blockIdx.x;
          const int wave = __builtin_amdgcn_readfirstlane(tid >> 6);
          if (nbusy == G) p0_weights(args.in, ws, lds, P0_I_IN, P0_NITEMS, c * 8 + wave, G * 8);
          else if (c >= nbusy) p0_weights(args.in, ws, lds, P0_I_IN, P0_NITEMS, (c - nbusy) * 8 + wave, (G - nbusy) * 8); }
#endif
        if (BOTH(1)) xcd_barrier(bar); STAMP(1);
    }
    for (int rep = 0; rep < 1 + ((MK_REPEAT_MASK >> 2) & 1); ++rep) if (IN(2) || (MK_EXTRA_PHASE >= 14 && MK_EXTRA_PHASE <= 17 && lo == MK_EXTRA_PHASE)) {
#if MK_MIXER_NAIVE
        p2_mixer_naive(args.in, ws, lds_raw, G);
#else
#if MK_MIXER_RING
        mixr::p2_mixer_ring(args.in, ws, lds, G);
#elif 1
        mix::p2_mixer(args.in, ws, lds, G, (MK_EXTRA_PHASE >= 14 && MK_EXTRA_PHASE <= 17 && lo == MK_EXTRA_PHASE) ? (MK_PFLAGS ? MK_PFLAGS : (1 << (MK_EXTRA_PHASE - 14))) : 0);
#endif
#endif
        if (BOTH(2)) xcd_barrier(bar); STAMP(2); }
    for (int rep = 0; rep < 1 + ((MK_REPEAT_MASK >> 3) & 1); ++rep) if (IN(3)) {
        pg8::Gemm g{MIX, WO, M, D, D}; pg8::StaticOrder S; S.init(M, D, G, (int)blockIdx.x);
        pg8::EpiOut E{XN, X1B, SSQ2};
        pg8::gemm_phase<pg8::EpiOut, pg8::StaticOrder, MK_ALIGN35>(lds, g, S, E);
        if (BOTH(3)) xcd_barrier(bar); STAMP(3);
    }
    for (int rep = 0; rep < 1 + ((MK_REPEAT_MASK >> 4) & 1); ++rep) if (IN(4)) {
        pg8::Gemm g{X1B, WGU, M, NGU, D}; pg8::StaticOrder S; S.init(M, NGU, G, (int)blockIdx.x); if (MK_REV5 == 2) S.reverse();
        LAS float* RS = (LAS float*)(lds + RING_BYTES);
        { pg8::Unit u0; S.next(0, u0); const int r8 = u0.pm & 7, g0 = ((u0.pm >> 3) / 3) * 3;
          for (int i = tid; i < 768; i += NWAVES * 64) { const int row = (8 * (g0 + (i >> 8)) + r8) * 256 + (i & 255); const pg8::f32x4* sp = (const pg8::f32x4*)(SSQ2 + (size_t)row * 16);
              const pg8::f32x4 sv = (sp[0] + sp[1]) + (sp[2] + sp[3]); RS[i] = rsqrtf(((sv[0] + sv[1]) + (sv[2] + sv[3])) * (1.0f / D) + EPS); }
          if (tid < 3) ((LAS int*)(RS + 768))[tid] = 8 * (g0 + tid) + r8;
          __syncthreads(); }
        pg8::EpiUp E{H, RS, SSQ2};
        pg8::gemm_phase<pg8::EpiUp, pg8::StaticOrder, MK_ALIGN4>(lds, g, S, E);
        if (BOTH(4)) xcd_barrier(bar); STAMP(4);
    }
    if (IN(5)) {
        if (MK_STAGGER_TICKS > 0 && (xb_xcc_id() & 1)) STAGGER_TICKS(MK_STAGGER_TICKS);
        pg8::Gemm g{H, WDN, M, D, DFF}; pg8::StaticOrder S; S.init(M, D, G, (int)blockIdx.x); if (MK_REV5 == 1) S.reverse();
        pg8::EpiDown E{X1B, args.out};
        pg8::gemm_phase<pg8::EpiDown, pg8::StaticOrder, MK_ALIGN35>(lds, g, S, E);
        STAMP(5);
    }

#if MK_EXTRA_PHASE >= 6
    if (lo == 6) { pg8::Gemm g{X1B, WGU, M, NGU, D}; pg8::StaticOrder S; S.init(M, NGU, G, (int)blockIdx.x); S.wgm = MK_PFLAGS ? MK_PFLAGS : 8; pg8::EpiNone E; pg8::gemm_phase<pg8::EpiNone, pg8::StaticOrder, true>(lds, g, S, E); }
    if (lo == 7) { pg8::Gemm g{H, WDN, M, D, DFF}; pg8::StaticOrder S; S.init(M, D, G, (int)blockIdx.x); pg8::EpiNone E; pg8::gemm_phase<pg8::EpiNone, pg8::StaticOrder, true>(lds, g, S, E); }
    if (lo == 8) { pg8::Gemm g{X1B, WGU, M, INW, D}; pg8::StaticOrder S; S.init(M, INW, G, (int)blockIdx.x); pg8::EpiNone E; pg8::gemm_phase<pg8::EpiNone, pg8::StaticOrder, true>(lds, g, S, E); }
#endif
#if MK_EXTRA_PHASE == 19
    if (lo == 19) { pg8::Gemm g{X1B, WGU, M, NGU, D}; pg8::StaticOrder S; S.init(M, NGU, G, (int)blockIdx.x);
        LAS float* RS = (LAS float*)(lds + RING_BYTES); for (int i = tid; i < 768; i += NWAVES * 64) RS[i] = 1.0f; __syncthreads();
        pg8::EpiUpFullLine E{H, RS}; pg8::gemm_phase<pg8::EpiUpFullLine, pg8::StaticOrder, true>(lds, g, S, E); }
#endif
#if MK_EXTRA_PHASE == 18
    if (lo == 18) { pg8::Gemm g{MIX, WO, M, D, D}; pg8::StaticOrder S; S.init(M, D, G, (int)blockIdx.x); pg8::EpiNone E; pg8::gemm_phase<pg8::EpiNone, pg8::StaticOrder, true>(lds, g, S, E); }
#endif
#if MK_EXTRA_PHASE >= 11
    if (lo == 20) { pg8::Gemm g{X1B, WGU, M, NGU, D}; pg8::StaticOrder S; S.init(M, NGU, G, (int)blockIdx.x); pg8::EpiNone E; pg8::gemm_phase<pg8::EpiNone, pg8::StaticOrder, true, 4>(lds, g, S, E); }
    if (lo == 11) { pg8::Gemm g{X1B, WGU, M, NGU, D}; pg8::StaticOrder S; S.init(M, NGU, G, (int)blockIdx.x); pg8::EpiNone E; pg8::gemm_phase<pg8::EpiNone, pg8::StaticOrder, true, 1>(lds, g, S, E); }
    if (lo == 12) { pg8::Gemm g{X1B, WGU, M, NGU, D}; pg8::StaticOrder S; S.init(M, NGU, G, (int)blockIdx.x); pg8::EpiNone E; pg8::gemm_phase<pg8::EpiNone, pg8::StaticOrder, true, 2>(lds, g, S, E); }
    if (lo == 13) { pg8::Gemm g{X1B, WGU, M, NGU, D}; pg8::StaticOrder S; S.init(M, NGU, G, (int)blockIdx.x); pg8::EpiNone E; pg8::gemm_phase<pg8::EpiNone, pg8::StaticOrder, true, 3>(lds, g, S, E); }
#endif
#if MK_EXTRA_PHASE >= 9
    if (lo == 9)  { pg8::Gemm g{H, WDN, M, D, DFF}; pg8::StaticOrder S; S.init(M, D, G, (int)blockIdx.x); pg8::EpiDownProbe<1> E{X1B, (float*)(ws + WS_MIX)}; pg8::gemm_phase<pg8::EpiDownProbe<1>, pg8::StaticOrder, true>(lds, g, S, E); }
    if (lo == 10) { pg8::Gemm g{H, WDN, M, D, DFF}; pg8::StaticOrder S; S.init(M, D, G, (int)blockIdx.x); pg8::EpiDownProbe<2> E{X1B, args.out}; pg8::gemm_phase<pg8::EpiDownProbe<2>, pg8::StaticOrder, true>(lds, g, S, E); }
#endif
#undef IN
#undef BOTH
}

extern "C" void kernel_launch(void* const* d_in, const int* in_sizes, int n_in, void* d_out, int out_size, void* d_ws, size_t ws_size, hipStream_t stream) {
    static int grid = 0;
    if (grid == 0) {
        if (n_in != 18 || in_sizes[0] != MP * D || in_sizes[1] != (M - MP) * D || out_size != M * D || ws_size < WS_END) {
            fprintf(stderr, "kernel_launch: unexpected shapes (n_in %d, in0 %d, in1 %d, out %d, ws %zu)\n", n_in, n_in > 0 ? in_sizes[0] : -1, n_in > 1 ? in_sizes[1] : -1, out_size, ws_size); grid = -1; return; }
        int dev = 0, cus = 0, per_cu = 0;
        if (hipGetDevice(&dev) != hipSuccess || hipDeviceGetAttribute(&cus, hipDeviceAttributeMultiprocessorCount, dev) != hipSuccess) { grid = -1; return; }
        if (hipFuncSetAttribute((const void*)mk_fwd, hipFuncAttributeMaxDynamicSharedMemorySize, LDS_BYTES) != hipSuccess) { fprintf(stderr, "kernel_launch: hipFuncSetAttribute failed\n"); grid = -1; return; }
        if (hipOccupancyMaxActiveBlocksPerMultiprocessor(&per_cu, (const void*)mk_fwd, NWAVES * 64, LDS_BYTES) != hipSuccess || per_cu < 1) { fprintf(stderr, "kernel_launch: occupancy query says %d blocks per CU\n", per_cu); grid = -1; return; }
        (void)hipGetLastError();
        grid = cus;
    }
    if (grid < 0) return;
    Args a{};
    for (int i = 0; i < 18; ++i) a.in[i] = (const float*)d_in[i];
    a.out = (float*)d_out; a.ws = (unsigned char*)d_ws;
    unsigned char* ws = (unsigned char*)d_ws;
    static_assert((CW_BAR + XCD_BAR_WORDS) * 4 <= 32768, "control words inside the per-call memset");
    (void)hipMemsetAsync(ws + WS_CTL, 0, 32768, stream);
#if MK_ONE_LAUNCH
#if 0 && MK_EXTRA_PHASE == 3
    a.ph_lo = 0; a.ph_hi = 4; hipLaunchKernelGGL(mk_fwd, dim3(grid), dim3(NWAVES * 64), LDS_BYTES, stream, a);
    (void)hipMemsetAsync(ws + WS_CTL, 0, 1 * MiB, stream);
    a.ph_lo = 3; a.ph_hi = 6; hipLaunchKernelGGL(mk_fwd, dim3(grid), dim3(NWAVES * 64), LDS_BYTES, stream, a);
#else
    a.ph_lo = 0; a.ph_hi = N_PHASES;
#if MK_PLAIN_LAUNCH
    hipLaunchKernelGGL(mk_fwd, dim3(grid), dim3(NWAVES * 64), LDS_BYTES, stream, a);
#else
    { void* kargs[] = {&a}; hipError_t e = hipLaunchCooperativeKernel((const void*)mk_fwd, dim3(grid), dim3(NWAVES * 64), kargs, LDS_BYTES, stream);
      if (e != hipSuccess) fprintf(stderr, "kernel_launch: cooperative launch failed: %s (grid %d)\n", hipGetErrorString(e), grid); }
#endif
#if MK_EXTRA_PHASE >= 0
    a.ph_lo = MK_EXTRA_PHASE; a.ph_hi = MK_EXTRA_PHASE + 1; hipLaunchKernelGGL(mk_fwd, dim3(grid), dim3(NWAVES * 64), LDS_BYTES, stream, a);
#endif
#endif
#else
    for (int p = 0; p < N_PHASES; ++p) {
        if (!(MK_PHASE_MASK & (1 << p))) { launch_naive_phase(p, d_in, (float*)d_out, ws, stream); continue; }
        a.ph_lo = p; a.ph_hi = p + 1;
        hipLaunchKernelGGL(mk_fwd, dim3(grid), dim3(NWAVES * 64), LDS_BYTES, stream, a);
    }
#endif
}
```

```cpp
#include <hip/hip_runtime.h>
#include <cstdio>
#include <cstdint>

typedef unsigned short bf16_t;
constexpr int D = 1024, SEQ = 4096, NSEQ = 12, M = NSEQ * SEQ, MP = 4 * SEQ;
constexpr int INW = 1792, DFF = 2816, NGU = 2 * DFF;
constexpr float EPS = 1e-6f, LOG2E = 1.4426950408889634f, QSCALE = 0.125f * LOG2E;

constexpr size_t MiB = 1u << 20;
constexpr size_t WS_CTL = 0;
constexpr size_t WS_WIN = 1 * MiB;
constexpr size_t WS_WO = 5 * MiB;
constexpr size_t WS_WGU = 7 * MiB;
constexpr size_t WS_WDN = 18 * MiB;
constexpr size_t WS_WS = 24 * MiB;
constexpr size_t WS_VSSQ = 25 * MiB;
constexpr size_t WS_SSQ2 = 27 * MiB;
constexpr size_t WS_RS1 = 30 * MiB;
constexpr size_t WS_XN = 32 * MiB;
constexpr size_t WS_PROJ = 128 * MiB;
constexpr size_t WS_H = 32 * MiB;
constexpr size_t WS_MIX = 296 * MiB;
constexpr size_t WS_X1B = 392 * MiB;
constexpr size_t WS_END = 488 * MiB;

__device__ __forceinline__ unsigned f2bf(float f) { unsigned u = __builtin_bit_cast(unsigned, f); return (u + 0x7fffu + ((u >> 16) & 1u)) >> 16; }
__device__ __forceinline__ float bf2f(bf16_t b) { return __builtin_bit_cast(float, (unsigned)b << 16); }
__device__ __forceinline__ float gelu_tanh(float x) { const float u = x * (-2.302208198f - 0.1029432397f * x * x); return x * __builtin_amdgcn_rcpf(1.0f + __builtin_amdgcn_exp2f(u)); }
__device__ __forceinline__ float silu(float x) { return x * __builtin_amdgcn_rcpf(1.0f + __builtin_amdgcn_exp2f(-LOG2E * x)); }
__device__ __forceinline__ int t5_bucket(int rel) { const int n = rel < 0 ? -rel : rel; int b = n < 8 ? n : (2 + (31 - __builtin_clz(n * n))); b = b > 15 ? 15 : b; return b + (rel > 0 ? 16 : 0); }

__device__ __forceinline__ void prep_w_elem(size_t i, const float* w_in, const float* w_o, const float* w_gate, const float* w_up, const float* w_down, const float* w_s, const float* norm2, unsigned char* ws) {
    const size_t N0 = (size_t)INW * D, N1 = (size_t)D * D, N2 = (size_t)NGU * D, N3 = (size_t)D * DFF, N4 = 8 * 128 * 128;
    if (i < N0) { const int n = i / D, k = i % D; ((bf16_t*)(ws + WS_WIN))[i] = f2bf(w_in[(size_t)k * INW + n]); return; } i -= N0;
    if (i < N1) { const int n = i / D, k = i % D; ((bf16_t*)(ws + WS_WO))[i] = f2bf(w_o[(size_t)k * D + n]); return; } i -= N1;
    if (i < N2) { const int r = i / D, k = i % D; const int pn = r >> 8, bj = (r >> 7) & 1, c = r & 127, col = 128 * pn + c;
        ((bf16_t*)(ws + WS_WGU))[i] = f2bf(norm2[k] * (bj ? w_up : w_gate)[(size_t)k * DFF + col]); return; } i -= N2;
    if (i < N3) { const int n = i / DFF, k = i % DFF; ((bf16_t*)(ws + WS_WDN))[i] = f2bf(w_down[(size_t)k * D + n]); return; } i -= N3;
    if (i < N4) { ((bf16_t*)(ws + WS_WS))[i] = f2bf(w_s[i]); }
}
constexpr size_t NPREP = (size_t)INW * D + (size_t)D * D + (size_t)NGU * D + (size_t)D * DFF + 8 * 128 * 128;
__global__ void __launch_bounds__(256) k_prep_w(const float* w_in, const float* w_o, const float* w_gate, const float* w_up, const float* w_down, const float* w_s, const float* norm2, unsigned char* ws) {
    prep_w_elem((size_t)blockIdx.x * 256 + threadIdx.x, w_in, w_o, w_gate, w_up, w_down, w_s, norm2, ws);
}
__device__ __forceinline__ void xn_row(int m, int lane, const float* xp, const float* xs, const float* norm1, bf16_t* XN) {
    const float* x = m < MP ? xp + (size_t)m * D : xs + (size_t)(m - MP) * D;
    float v[16]; float ss = 0.f;
#pragma unroll
    for (int j = 0; j < 16; ++j) { v[j] = x[lane + 64 * j]; ss += v[j] * v[j]; }
#pragma unroll
    for (int o = 1; o < 64; o <<= 1) ss += __shfl_xor(ss, o);
    const float r = rsqrtf(ss * (1.0f / D) + EPS);
#pragma unroll
    for (int j = 0; j < 16; ++j) XN[(size_t)m * D + lane + 64 * j] = f2bf(v[j] * r * norm1[lane + 64 * j]);
}
__global__ void __launch_bounds__(256) k_xn(const float* xp, const float* xs, const float* norm1, bf16_t* XN) { xn_row(blockIdx.x * 4 + (threadIdx.x >> 6), threadIdx.x & 63, xp, xs, norm1, XN); }

template <class Epi, bool DUAL>
__global__ void __launch_bounds__(256) k_gemm_naive(const bf16_t* A, const bf16_t* Bt, int K, Epi epi) {
    __shared__ float As[32][68], Bs[32][68], B2s[DUAL ? 32 : 1][68], Ct[64][65], C2t[DUAL ? 64 : 1][65];
    const int tid = threadIdx.x, ty = tid >> 4, tx = tid & 15, lr = tid >> 2, kc = (tid & 3) * 8;
    const int m0 = blockIdx.y * 64, n0 = blockIdx.x * 64;
    const bf16_t* ap = A + (size_t)(m0 + lr) * K + kc;
    const int br = epi.brow(n0 + lr);
    const bf16_t* bp = Bt + (size_t)br * K + kc;
    const bf16_t* bp2 = Bt + (size_t)(br + 128) * K + kc;
    float acc[4][4] = {}, acc2[4][4] = {};
    for (int k0 = 0; k0 < K; k0 += 32) {
        const uint4 av = *(const uint4*)(ap + k0), bv = *(const uint4*)(bp + k0);
        const unsigned aw[4] = {av.x, av.y, av.z, av.w}, bw[4] = {bv.x, bv.y, bv.z, bv.w};
#pragma unroll
        for (int j = 0; j < 4; ++j) { As[kc + 2 * j][lr] = __builtin_bit_cast(float, aw[j] << 16); As[kc + 2 * j + 1][lr] = __builtin_bit_cast(float, aw[j] & 0xffff0000u);
                                      Bs[kc + 2 * j][lr] = __builtin_bit_cast(float, bw[j] << 16); Bs[kc + 2 * j + 1][lr] = __builtin_bit_cast(float, bw[j] & 0xffff0000u); }
        if (DUAL) { const uint4 cv = *(const uint4*)(bp2 + k0); const unsigned cw[4] = {cv.x, cv.y, cv.z, cv.w};
#pragma unroll
            for (int j = 0; j < 4; ++j) { B2s[kc + 2 * j][lr] = __builtin_bit_cast(float, cw[j] << 16); B2s[kc + 2 * j + 1][lr] = __builtin_bit_cast(float, cw[j] & 0xffff0000u); } }
        __syncthreads();
#pragma unroll 8
        for (int k = 0; k < 32; ++k) {
            float a[4], b[4], b2[4];
#pragma unroll
            for (int i = 0; i < 4; ++i) { a[i] = As[k][4 * ty + i]; b[i] = Bs[k][4 * tx + i]; b2[i] = DUAL ? B2s[k][4 * tx + i] : 0.f; }
#pragma unroll
            for (int i = 0; i < 4; ++i)
#pragma unroll
                for (int j = 0; j < 4; ++j) { acc[i][j] += a[i] * b[j]; if (DUAL) acc2[i][j] += a[i] * b2[j]; }
        }
        __syncthreads();
    }
#pragma unroll
    for (int i = 0; i < 4; ++i)
#pragma unroll
        for (int j = 0; j < 4; ++j) { Ct[4 * ty + i][4 * tx + j] = acc[i][j]; if (DUAL) C2t[4 * ty + i][4 * tx + j] = acc2[i][j]; }
    __syncthreads();
    const int r = tid >> 2, part = tid & 3;
    epi(m0 + r, n0, part, &Ct[r][part * 16], DUAL ? &C2t[r][part * 16] : nullptr);
}
__device__ __forceinline__ float red4(float v) { v += __shfl_xor(v, 1); v += __shfl_xor(v, 2); return v; }
struct NEpiIn {
    bf16_t* PROJ; float* VSSQ; const float* qg; const float* kg;
    __device__ int brow(int n) const { return n; }
    __device__ void operator()(int row, int n0, int part, const float* c, const float*) const {
        const int ct = n0 >> 6; float v[16];
#pragma unroll
        for (int j = 0; j < 16; ++j) v[j] = c[j];
        if (ct < 10) { float ss = 0.f;
#pragma unroll
            for (int j = 0; j < 16; ++j) ss += v[j] * v[j];
            ss = red4(ss); const float r = rsqrtf(ss * (1.0f / 64.0f) + EPS); const float* g = ct < 8 ? qg : kg; const float sc = ct < 8 ? QSCALE : 1.0f;
#pragma unroll
            for (int j = 0; j < 16; ++j) v[j] = v[j] * r * g[part * 16 + j] * sc;
        } else if (ct >= 12) { float ss = 0.f;
#pragma unroll
            for (int j = 0; j < 16; ++j) { v[j] = gelu_tanh(v[j]); ss += v[j] * v[j]; }
            if (ct >= 20) { ss = red4(ss); if (part == 0) VSSQ[(size_t)row * 8 + (ct - 20)] = ss; }
        }
#pragma unroll
        for (int j = 0; j < 16; ++j) PROJ[(size_t)row * INW + n0 + part * 16 + j] = f2bf(v[j]);
    }
};
struct NEpiOut {
    const float* xp; const float* xs; float* out; bf16_t* X1B; float* SSQ2;
    __device__ int brow(int n) const { return n; }
    __device__ void operator()(int row, int n0, int part, const float* c, const float*) const {
        const float* x = row < MP ? xp + (size_t)row * D : xs + (size_t)(row - MP) * D; float ss = 0.f;
#pragma unroll
        for (int j = 0; j < 16; ++j) { const int col = n0 + part * 16 + j; const float v = x[col] + c[j]; out[(size_t)row * D + col] = v; X1B[(size_t)row * D + col] = f2bf(v); ss += v * v; }
        ss = red4(ss); if (part == 0) SSQ2[(size_t)row * 16 + (n0 >> 6)] = ss;
    }
};
struct NEpiUp {
    bf16_t* H; const float* SSQ2;
    __device__ int brow(int n) const { return 256 * (n >> 7) + (n & 127); }
    __device__ void operator()(int row, int n0, int part, const float* c, const float* c2) const {
        float ss = 0.f;
#pragma unroll
        for (int j = 0; j < 16; ++j) ss += SSQ2[(size_t)row * 16 + j];
        const float r = rsqrtf(ss * (1.0f / D) + EPS);
#pragma unroll
        for (int j = 0; j < 16; ++j) H[(size_t)row * DFF + n0 + part * 16 + j] = f2bf(silu(c[j] * r) * (c2[j] * r));
    }
};
struct NEpiDown {
    float* out;
    __device__ int brow(int n) const { return n; }
    __device__ void operator()(int row, int n0, int part, const float* c, const float*) const {
#pragma unroll
        for (int j = 0; j < 16; ++j) { const size_t o = (size_t)row * D + n0 + part * 16 + j; out[o] = out[o] + c[j]; }
    }
};

struct MixNaiveLds { float ps[4][320], qs[4][64], arow[512], grow[512], rv[128], red[4]; };
__device__ __forceinline__ void mix_naive_token(int m, int tid, MixNaiveLds& L, const bf16_t* PROJ, const float* VSSQ, const bf16_t* WSB, const float* rel_table, const float* sink, const float* v_gain,
                                                const float* b_s, const float* ag, const float* gg, bf16_t* MIX) {
    const int s = m / SEQ, t = m % SEQ, w = tid >> 6, lane = tid & 63;
    const bf16_t* prow = PROJ + (size_t)m * INW;
    const int jlo = t - 128 < 0 ? 0 : t - 128, jhi = t + 128 > SEQ - 1 ? SEQ - 1 : t + 128, nk = jhi - jlo + 1;
    for (int hh = 0; hh < 2; ++hh) {
        const int h = w * 2 + hh, g = h >> 2;
        L.qs[w][lane] = bf2f(prow[64 * h + lane]);
        __syncthreads();
        const float sink2 = sink[h] * LOG2E; float sc[5]; float mx = sink2;
#pragma unroll
        for (int i = 0; i < 5; ++i) { const int j = jlo + lane + 64 * i; sc[i] = -1e30f;
            if (j <= jhi) { const bf16_t* kr = PROJ + (size_t)(s * SEQ + j) * INW + 512 + 64 * g; float dot = 0.f;
                for (int d = 0; d < 64; ++d) dot += L.qs[w][d] * bf2f(kr[d]);
                dot += rel_table[t5_bucket(j - t) * 8 + h] * LOG2E; sc[i] = dot; mx = fmaxf(mx, dot); } }
#pragma unroll
        for (int o = 1; o < 64; o <<= 1) mx = fmaxf(mx, __shfl_xor(mx, o));
        float l = 0.f;
#pragma unroll
        for (int i = 0; i < 5; ++i) { const int j = jlo + lane + 64 * i; const float p = j <= jhi ? exp2f(sc[i] - mx) : 0.f; l += p; L.ps[w][lane + 64 * i] = p; }
#pragma unroll
        for (int o = 1; o < 64; o <<= 1) l += __shfl_xor(l, o);
        l += exp2f(sink2 - mx);
        __syncthreads();
        float o = 0.f;
        for (int jj = 0; jj < nk; ++jj) o += L.ps[w][jj] * bf2f(PROJ[(size_t)(s * SEQ + jlo + jj) * INW + 640 + 64 * g + lane]);
        L.arow[64 * h + lane] = o / l;
        __syncthreads();
    }
    const int mc = m - (t & 127), p = t & 127;
    if (tid < 128) { float ss = 0.f; for (int i = 0; i < 8; ++i) ss += VSSQ[(size_t)(mc + tid) * 8 + i]; L.rv[tid] = rsqrtf(ss * (1.0f / 512.0f) + EPS); }
    __syncthreads();
    for (int c = tid; c < 512; c += 256) { const int h = c >> 6; float a = 0.f; const float vg = v_gain[c];
        for (int q = 0; q < 128; ++q) a += bf2f(WSB[(h * 128 + p) * 128 + q]) * (bf2f(PROJ[(size_t)(mc + q) * INW + 1280 + c]) * L.rv[q] * vg);
        L.grow[c] = bf2f(prow[768 + c]) * (a + b_s[h * 128 + p]); }
    __syncthreads();
    float sa = L.arow[tid] * L.arow[tid] + L.arow[tid + 256] * L.arow[tid + 256], sg = L.grow[tid] * L.grow[tid] + L.grow[tid + 256] * L.grow[tid + 256];
#pragma unroll
    for (int o = 1; o < 64; o <<= 1) { sa += __shfl_xor(sa, o); sg += __shfl_xor(sg, o); }
    if (lane == 0) { L.red[w] = sa; } __syncthreads(); sa = L.red[0] + L.red[1] + L.red[2] + L.red[3]; __syncthreads();
    if (lane == 0) { L.red[w] = sg; } __syncthreads(); sg = L.red[0] + L.red[1] + L.red[2] + L.red[3];
    const float ra = rsqrtf(sa * (1.0f / 512.0f) + EPS), rg = rsqrtf(sg * (1.0f / 512.0f) + EPS);
    for (int c = tid; c < 512; c += 256) { MIX[(size_t)m * D + c] = f2bf(L.arow[c] * ra * ag[c]); MIX[(size_t)m * D + 512 + c] = f2bf(L.grow[c] * rg * gg[c]); }
    __syncthreads();
}
__global__ void __launch_bounds__(256) k_mix_naive(const bf16_t* PROJ, const float* VSSQ, const bf16_t* WSB, const float* rel_table, const float* sink, const float* v_gain,
                                                  const float* b_s, const float* ag, const float* gg, bf16_t* MIX) {
    __shared__ MixNaiveLds L;
    mix_naive_token(blockIdx.x, threadIdx.x, L, PROJ, VSSQ, WSB, rel_table, sink, v_gain, b_s, ag, gg, MIX);
}

#define MK_ONE_LAUNCH 1
#define MK_PHASE_MASK 0x3F
#define MK_MIXER_NAIVE 0
#define MK_PROLOGUE_NAIVE 0
#define MK_REPEAT_MASK 0
#define MK_EXTRA_PHASE -1
#define MK_STAGGER_TICKS 0
#define MK_PFLAGS 0
#define MK_MIXER_RING 0
#define MK_NST 0
#define MK_PLAIN_LAUNCH 0
#define MK_ALIGN35 true
#define MK_ALIGN4 true
#define MK_LATE_WEIGHTS 1
#define MK_REV5 2
#define MK_REV2 1

namespace pg8 {
#define PG8_LAS __attribute__((address_space(3)))
typedef short bf16x8 __attribute__((ext_vector_type(8)));
typedef float f32x4 __attribute__((ext_vector_type(4)));
typedef unsigned u32x4 __attribute__((ext_vector_type(4)));
typedef unsigned u32x2 __attribute__((ext_vector_type(2)));
constexpr int BM = 256, BK = 64, HALF = 128, HTB = HALF * BK * 2  , STAGE_BYTES = 8 * HTB, NXCD = 8, WGM = 8;

__host__ __device__ __forceinline__ int lds_byte(int r, int c) { const int st = (r >> 4) * 2 + (c >> 5), rr = r & 15, cc = c & 31, ob = rr * 64 + cc * 2; return st * 1024 + (ob ^ (((ob >> 9) & 1) << 5)); }
__host__ __device__ __forceinline__ void stage_rc(int b, int& R, int& C) { const int st = b / 1024, sb = b % 1024, swz = sb ^ (((sb >> 9) & 1) << 5); R = (st >> 1) * 16 + swz / 64; C = (st & 1) * 32 + (swz % 64) / 2; }
__host__ __device__ __forceinline__ int perm32(int rho) { const int n = rho >> 4, i = rho & 15; return 8 * (i >> 2) + 4 * n + (i & 3); }

struct Unit { int pm, pn, ui; };
struct Gemm { const bf16_t* A; const bf16_t* Bt; int M, N, K; };

struct StaticOrder {
    int nM, nN, nwg, G, c, wgm, rev;
    __host__ __device__ __forceinline__ void init(int M_, int N_, int G_, int c_) { nM = M_ / BM; nN = N_ / BM; nwg = nM * nN; G = G_; c = c_; wgm = WGM; rev = 0; }
    __host__ __device__ __forceinline__ void reverse() { rev = c < nwg ? (nwg - c + G - 1) / G : 0; }
    __host__ __device__ __forceinline__ bool next(int i, Unit& u) const {
        if (rev > 0 && i >= rev) return false;
        const long L = (long)(rev > 0 ? rev - 1 - i : i) * G + c; if (L >= nwg) return false;
        int wgid = (int)L; { const int q = nwg / NXCD, r = nwg % NXCD, xcd = wgid % NXCD, off = wgid / NXCD; wgid = (xcd < r ? xcd * (q + 1) : r * (q + 1) + (xcd - r) * q) + off; }
        const int nig = wgm * nN, gid = wgid / nig, fm = gid * wgm, gsz = (nM - fm) < wgm ? (nM - fm) : wgm;
        u.pm = fm + ((wgid % nig) % gsz); u.pn = (wgid % nig) / gsz; u.ui = i; return true;
    }
};

__device__ __forceinline__ unsigned cvt_pk_bf16(float lo, float hi) { unsigned r; asm volatile("v_cvt_pk_bf16_f32 %0, %1, %2" : "=v"(r) : "v"(lo), "v"(hi)); return r; }
__device__ __forceinline__ float rsum_fq(float s) { s += __shfl_xor(s, 16); s += __shfl_xor(s, 32); return s; }

struct EpiIn {
    static constexpr int BMAP = 2, NS1 = 8;
    bf16_t* PROJ; float* VSSQ; const float* qg; const float* kg; const PG8_LAS float* RSL; const float* RS1;
    __device__ __forceinline__ void operator()(const f32x4 (&acc)[2][2][4][2], const Unit& u, int wr, int wc, int fr, int fq) const {
        const int ct = 4 * u.pn + wc;
        const int row0 = u.pm * BM + wr * 64 + fr, col0 = u.pn * BM + wc * 64 + 8 * fq;
        float r1[2][4];
        if (u.ui < NS1) { const PG8_LAS float* rp = RSL + u.ui * 256 + wr * 64 + fr;
#pragma unroll
            for (int ai = 0; ai < 2; ++ai)
#pragma unroll
                for (int m = 0; m < 4; ++m) r1[ai][m] = rp[ai * HALF + m * 16];
        } else {
#pragma unroll
            for (int ai = 0; ai < 2; ++ai)
#pragma unroll
                for (int m = 0; m < 4; ++m) r1[ai][m] = RS1[row0 + ai * HALF + m * 16];
        }
        if (ct < 10) {
            const float* g = (ct < 8 ? qg : kg) + 8 * fq; const float sc = ct < 8 ? QSCALE : 1.0f;
            f32x4 gv[2][2];
#pragma unroll
            for (int bj = 0; bj < 2; ++bj)
#pragma unroll
                for (int n = 0; n < 2; ++n) gv[bj][n] = *(const f32x4*)(g + 32 * bj + 4 * n) * sc;
#pragma unroll
            for (int ai = 0; ai < 2; ++ai)
#pragma unroll
                for (int m = 0; m < 4; ++m) {
                    float ss = 0.f;
#pragma unroll
                    for (int bj = 0; bj < 2; ++bj)
#pragma unroll
                        for (int n = 0; n < 2; ++n) { const f32x4 x = acc[ai][bj][m][n]; ss += (x[0] * x[0] + x[1] * x[1]) + (x[2] * x[2] + x[3] * x[3]); }
                    const float rr = r1[ai][m];
                    ss = rsum_fq(ss) * (rr * rr); const float r = rsqrtf(ss * (1.0f / 64.0f) + EPS) * rr;
                    bf16_t* rowp = PROJ + (size_t)(row0 + ai * HALF + m * 16) * INW + col0;
#pragma unroll
                    for (int bj = 0; bj < 2; ++bj) { const f32x4 v0 = acc[ai][bj][m][0] * r * gv[bj][0], v1 = acc[ai][bj][m][1] * r * gv[bj][1];
                        u32x4 w; w.x = cvt_pk_bf16(v0[0], v0[1]); w.y = cvt_pk_bf16(v0[2], v0[3]); w.z = cvt_pk_bf16(v1[0], v1[1]); w.w = cvt_pk_bf16(v1[2], v1[3]);
                        *(u32x4*)(rowp + 32 * bj) = w; }
                }
        } else if (ct < 12) {
#pragma unroll
            for (int ai = 0; ai < 2; ++ai)
#pragma unroll
                for (int m = 0; m < 4; ++m) { bf16_t* rowp = PROJ + (size_t)(row0 + ai * HALF + m * 16) * INW + col0; const float rr = r1[ai][m];
#pragma unroll
                    for (int bj = 0; bj < 2; ++bj) { const f32x4 v0 = acc[ai][bj][m][0] * rr, v1 = acc[ai][bj][m][1] * rr;
                        u32x4 w; w.x = cvt_pk_bf16(v0[0], v0[1]); w.y = cvt_pk_bf16(v0[2], v0[3]); w.z = cvt_pk_bf16(v1[0], v1[1]); w.w = cvt_pk_bf16(v1[2], v1[3]);
                        *(u32x4*)(rowp + 32 * bj) = w; } }
        } else {
#pragma unroll
            for (int ai = 0; ai < 2; ++ai)
#pragma unroll
                for (int m = 0; m < 4; ++m) { const int row = row0 + ai * HALF + m * 16; bf16_t* rowp = PROJ + (size_t)row * INW + col0; float ss = 0.f; const float rr = r1[ai][m];
#pragma unroll
                    for (int bj = 0; bj < 2; ++bj) { f32x4 v0 = acc[ai][bj][m][0] * rr, v1 = acc[ai][bj][m][1] * rr;
#pragma unroll
                        for (int e = 0; e < 4; e += 2) { typedef float f32x2v __attribute__((ext_vector_type(2)));
                            f32x2v x0 = {v0[e], v0[e + 1]}, x1 = {v1[e], v1[e + 1]};
                            const f32x2v u0 = x0 * ((x0 * x0) * (-0.1029432397f) + (-2.302208198f)), u1 = x1 * ((x1 * x1) * (-0.1029432397f) + (-2.302208198f));
                            f32x2v e0, e1; e0.x = __builtin_amdgcn_exp2f(u0.x); e0.y = __builtin_amdgcn_exp2f(u0.y); e1.x = __builtin_amdgcn_exp2f(u1.x); e1.y = __builtin_amdgcn_exp2f(u1.y);
                            const f32x2v d0 = e0 + 1.0f, d1 = e1 + 1.0f; f32x2v s0, s1; s0.x = __builtin_amdgcn_rcpf(d0.x); s0.y = __builtin_amdgcn_rcpf(d0.y); s1.x = __builtin_amdgcn_rcpf(d1.x); s1.y = __builtin_amdgcn_rcpf(d1.y);
                            x0 = x0 * s0; x1 = x1 * s1; v0[e] = x0.x; v0[e + 1] = x0.y; v1[e] = x1.x; v1[e + 1] = x1.y;
                            const f32x2v q = x0 * x0 + x1 * x1; ss += q.x + q.y; }
                        u32x4 w; w.x = cvt_pk_bf16(v0[0], v0[1]); w.y = cvt_pk_bf16(v0[2], v0[3]); w.z = cvt_pk_bf16(v1[0], v1[1]); w.w = cvt_pk_bf16(v1[2], v1[3]);
                        *(u32x4*)(rowp + 32 * bj) = w; }
                    if (ct >= 20) { ss = rsum_fq(ss); if (fq == 0) VSSQ[(size_t)row * 8 + (ct - 20)] = ss; }
                }
        }
    }
};
struct EpiOut {
    static constexpr int BMAP = 1;
    const bf16_t* XB; bf16_t* X1B; float* SSQ2;
    __device__ __forceinline__ void operator()(const f32x4 (&acc)[2][2][4][2], const Unit& u, int wr, int wc, int fr, int fq) const {
        const int row0 = u.pm * BM + wr * 64 + fr, col0 = u.pn * BM + wc * 32 + 8 * fq;
        u32x4 xv[2][4][2];
#pragma unroll
        for (int ai = 0; ai < 2; ++ai)
#pragma unroll
            for (int m = 0; m < 4; ++m)
#pragma unroll
                for (int bj = 0; bj < 2; ++bj) xv[ai][m][bj] = *(const u32x4*)(XB + (size_t)(row0 + ai * HALF + m * 16) * D + col0 + bj * HALF);
#pragma unroll
        for (int ai = 0; ai < 2; ++ai)
#pragma unroll
            for (int m = 0; m < 4; ++m) { const int row = row0 + ai * HALF + m * 16; bf16_t* rowp = X1B + (size_t)row * D + col0; float ss = 0.f;
#pragma unroll
                for (int bj = 0; bj < 2; ++bj) { const u32x4 x = xv[ai][m][bj];
                    const f32x4 r0 = {__uint_as_float(x.x << 16), __uint_as_float(x.x & 0xffff0000u), __uint_as_float(x.y << 16), __uint_as_float(x.y & 0xffff0000u)};
                    const f32x4 r1 = {__uint_as_float(x.z << 16), __uint_as_float(x.z & 0xffff0000u), __uint_as_float(x.w << 16), __uint_as_float(x.w & 0xffff0000u)};
                    const f32x4 v0 = r0 + acc[ai][bj][m][0], v1 = r1 + acc[ai][bj][m][1];
                    u32x4 w; w.x = cvt_pk_bf16(v0[0], v0[1]); w.y = cvt_pk_bf16(v0[2], v0[3]); w.z = cvt_pk_bf16(v1[0], v1[1]); w.w = cvt_pk_bf16(v1[2], v1[3]);
                    *(u32x4*)(rowp + bj * HALF) = w;
                    ss += ((v0[0] * v0[0] + v0[1] * v0[1]) + (v0[2] * v0[2] + v0[3] * v0[3])) + ((v1[0] * v1[0] + v1[1] * v1[1]) + (v1[2] * v1[2] + v1[3] * v1[3])); }
                ss = rsum_fq(ss); if (fq == 0) SSQ2[(size_t)row * 16 + 4 * u.pn + wc] = ss; }
    }
};
struct EpiUp {
    static constexpr int BMAP = 1;
    bf16_t* H; const PG8_LAS float* RS; const float* SSQ2;
    __device__ __forceinline__ void operator()(const f32x4 (&acc)[2][2][4][2], const Unit& u, int wr, int wc, int fr, int fq) const {
        const int row0 = u.pm * BM + wr * 64 + fr, col0 = u.pn * HALF + wc * 32 + 8 * fq;
        const int slot = (u.pm >> 3) % 3;
        float rs[2][4];
        if (((const PG8_LAS int*)(RS + 768))[slot] == u.pm) {
            const PG8_LAS float* rsp = RS + slot * 256 + wr * 64 + fr;
#pragma unroll
            for (int ai = 0; ai < 2; ++ai)
#pragma unroll
                for (int m = 0; m < 4; ++m) rs[ai][m] = rsp[ai * HALF + m * 16];
        } else {
#pragma unroll
            for (int ai = 0; ai < 2; ++ai)
#pragma unroll
                for (int m = 0; m < 4; ++m) { const f32x4 pl = *(const f32x4*)(SSQ2 + (size_t)(row0 + ai * HALF + m * 16) * 16 + 4 * fq);
                    rs[ai][m] = rsqrtf(rsum_fq((pl[0] + pl[1]) + (pl[2] + pl[3])) * (1.0f / D) + EPS); }
        }
#pragma unroll
        for (int ai = 0; ai < 2; ++ai)
#pragma unroll
            for (int m = 0; m < 4; ++m) { const int row = row0 + ai * HALF + m * 16; const float r = rs[ai][m], r2 = r * r, c1 = -LOG2E * r;
                f32x4 h0, h1;
#pragma unroll
                for (int n = 0; n < 2; ++n)
#pragma unroll
                    for (int e = 0; e < 4; e += 2) { typedef float f32x2v __attribute__((ext_vector_type(2)));
                        const f32x2v gg2 = {acc[ai][0][m][n][e], acc[ai][0][m][n][e + 1]}, uu2 = {acc[ai][1][m][n][e], acc[ai][1][m][n][e + 1]};
                        const f32x2v cc = gg2 * c1; f32x2v ee; ee.x = __builtin_amdgcn_exp2f(cc.x); ee.y = __builtin_amdgcn_exp2f(cc.y);
                        const f32x2v dd = ee + 1.0f; f32x2v ss; ss.x = __builtin_amdgcn_rcpf(dd.x); ss.y = __builtin_amdgcn_rcpf(dd.y);
                        const f32x2v hh = ((gg2 * uu2) * r2) * ss;
                        if (n == 0) { h0[e] = hh.x; h0[e + 1] = hh.y; } else { h1[e] = hh.x; h1[e + 1] = hh.y; } }
                u32x4 w; w.x = cvt_pk_bf16(h0[0], h0[1]); w.y = cvt_pk_bf16(h0[2], h0[3]); w.z = cvt_pk_bf16(h1[0], h1[1]); w.w = cvt_pk_bf16(h1[2], h1[3]);
                *(u32x4*)(H + (size_t)row * DFF + col0) = w; }
    }
};
struct EpiUpFullLine {
    static constexpr int BMAP = 1;
    bf16_t* H; const PG8_LAS float* RS; const float* SSQ2;
    __device__ __forceinline__ void operator()(const f32x4 (&acc)[2][2][4][2], const Unit& u, int wr, int wc, int fr, int fq) const {
        const int row0 = u.pm * BM + wr * 64 + fr, col0 = u.pn * HALF + wc * 32 + 8 * fq;
        const int slot = (u.pm >> 3) % 3;
        float rs[2][4];
        if (((const PG8_LAS int*)(RS + 768))[slot] == u.pm) {
            const PG8_LAS float* rsp = RS + slot * 256 + wr * 64 + fr;
#pragma unroll
            for (int ai = 0; ai < 2; ++ai)
#pragma unroll
                for (int m = 0; m < 4; ++m) rs[ai][m] = rsp[ai * HALF + m * 16];
        } else {
#pragma unroll
            for (int ai = 0; ai < 2; ++ai)
#pragma unroll
                for (int m = 0; m < 4; ++m) { const f32x4 pl = *(const f32x4*)(SSQ2 + (size_t)(row0 + ai * HALF + m * 16) * 16 + 4 * fq);
                    rs[ai][m] = rsqrtf(rsum_fq((pl[0] + pl[1]) + (pl[2] + pl[3])) * (1.0f / D) + EPS); }
        }
#pragma unroll
        for (int ai = 0; ai < 2; ++ai)
#pragma unroll
            for (int m = 0; m < 4; ++m) { const int row = row0 + ai * HALF + m * 16; const float r = rs[ai][m], r2 = r * r, c1 = -LOG2E * r;
                f32x4 h0, h1;
#pragma unroll
                for (int n = 0; n < 2; ++n)
#pragma unroll
                    for (int e = 0; e < 4; e += 2) { typedef float f32x2v __attribute__((ext_vector_type(2)));
                        const f32x2v gg2 = {acc[ai][0][m][n][e], acc[ai][0][m][n][e + 1]}, uu2 = {acc[ai][1][m][n][e], acc[ai][1][m][n][e + 1]};
                        const f32x2v cc = gg2 * c1; f32x2v ee; ee.x = __builtin_amdgcn_exp2f(cc.x); ee.y = __builtin_amdgcn_exp2f(cc.y);
                        const f32x2v dd = ee + 1.0f; f32x2v ss; ss.x = __builtin_amdgcn_rcpf(dd.x); ss.y = __builtin_amdgcn_rcpf(dd.y);
                        const f32x2v hh = ((gg2 * uu2) * r2) * ss;
                        if (n == 0) { h0[e] = hh.x; h0[e + 1] = hh.y; } else { h1[e] = hh.x; h1[e + 1] = hh.y; } }
                u32x4 w; w.x = cvt_pk_bf16(h0[0], h0[1]); w.y = cvt_pk_bf16(h0[2], h0[3]); w.z = cvt_pk_bf16(h1[0], h1[1]); w.w = cvt_pk_bf16(h1[2], h1[3]);
                { const int l = fr + 16 * fq; *(u32x4*)(H + (size_t)(u.pm * BM + ai * HALF + wr * 64 + m * 16 + 8 * (wc & 1) + (l >> 3)) * DFF + u.pn * HALF + 64 * (wc >> 1) + (l & 7) * 8) = w; } }
    }
};
struct EpiDown {
    static constexpr int BMAP = 0;
    const bf16_t* X1B; float* out;
    __device__ __forceinline__ void operator()(const f32x4 (&acc)[2][2][4][2], const Unit& u, int wr, int wc, int fr, int fq) const {
        const int row0 = u.pm * BM + wr * 64 + fr, col0 = u.pn * BM + wc * 32 + 4 * fq;
        u32x2 xv[2][4][2][2];
#pragma unroll
        for (int ai = 0; ai < 2; ++ai)
#pragma unroll
            for (int m = 0; m < 4; ++m)
#pragma unroll
                for (int bj = 0; bj < 2; ++bj)
#pragma unroll
                    for (int n = 0; n < 2; ++n) xv[ai][m][bj][n] = *(const u32x2*)(X1B + (size_t)(row0 + ai * HALF + m * 16) * D + col0 + bj * HALF + n * 16);
#pragma unroll
        for (int ai = 0; ai < 2; ++ai)
#pragma unroll
            for (int m = 0; m < 4; ++m) { float* rowp = out + (size_t)(row0 + ai * HALF + m * 16) * D + col0;
#pragma unroll
                for (int bj = 0; bj < 2; ++bj)
#pragma unroll
                    for (int n = 0; n < 2; ++n) { const u32x2 x = xv[ai][m][bj][n];
                        const f32x4 r = {__uint_as_float(x.x << 16), __uint_as_float(x.x & 0xffff0000u), __uint_as_float(x.y << 16), __uint_as_float(x.y & 0xffff0000u)};
                        *(f32x4*)(rowp + bj * HALF + n * 16) = r + acc[ai][bj][m][n]; } }
    }
};
struct EpiNone {
    static constexpr int BMAP = 1;
    __device__ __forceinline__ void operator()(const f32x4 (&acc)[2][2][4][2], const Unit& u, int wr, int wc, int fr, int fq) const {
#pragma unroll
        for (int ai = 0; ai < 2; ++ai)
#pragma unroll
            for (int bj = 0; bj < 2; ++bj)
#pragma unroll
                for (int m = 0; m < 4; ++m)
#pragma unroll
                    for (int n = 0; n < 2; ++n) asm volatile("" :: "v"(acc[ai][bj][m][n]));
    }
};


template <int MODE> struct EpiDownProbe {
    static constexpr int BMAP = 0;
    const bf16_t* X1B; float* out;
    __device__ __forceinline__ void operator()(const f32x4 (&acc)[2][2][4][2], const Unit& u, int wr, int wc, int fr, int fq) const {
        const int row0 = u.pm * BM + wr * 64 + fr, col0 = u.pn * BM + wc * 32 + 4 * fq;
        u32x2 xv[2][4][2][2];
#pragma unroll
        for (int ai = 0; ai < 2; ++ai)
#pragma unroll
            for (int m = 0; m < 4; ++m)
#pragma unroll
                for (int bj = 0; bj < 2; ++bj)
#pragma unroll
                    for (int n = 0; n < 2; ++n) { if (MODE == 2) xv[ai][m][bj][n] = *(const u32x2*)(X1B + (size_t)(row0 + ai * HALF + m * 16) * D + col0 + bj * HALF + n * 16); else xv[ai][m][bj][n] = (u32x2){0u, 0u}; }
#pragma unroll
        for (int ai = 0; ai < 2; ++ai)
#pragma unroll
            for (int m = 0; m < 4; ++m) { float* rowp = out + (size_t)(row0 + ai * HALF + m * 16) * D + col0;
#pragma unroll
                for (int bj = 0; bj < 2; ++bj)
#pragma unroll
                    for (int n = 0; n < 2; ++n) { const u32x2 x = xv[ai][m][bj][n];
                        const f32x4 r = {__uint_as_float(x.x << 16), __uint_as_float(x.x & 0xffff0000u), __uint_as_float(x.y << 16), __uint_as_float(x.y & 0xffff0000u)};
                        const f32x4 v = r + acc[ai][bj][m][n];
                        if (MODE == 1) __builtin_nontemporal_store(v, (f32x4*)(rowp + bj * HALF + n * 16)); else asm volatile("" :: "v"(v)); } }
    }
};

template <class Epi, class Sched, bool ALIGN_EPI, int KMODE = 0>
__device__ __forceinline__ void gemm_phase(PG8_LAS unsigned char* lds, const Gemm g, const Sched& S, const Epi& E) {
    int tid_ = threadIdx.x; asm volatile("" : "+v"(tid_));
    const int tid = tid_, wid = __builtin_amdgcn_readfirstlane(tid >> 6), lane = tid & 63, wr = wid >> 2, wc = wid & 3, fr = lane & 15, fq = lane >> 4;
    const int K = g.K, nt = K / BK;
    unsigned voffA[2], voffB[2];
#pragma unroll
    for (int i = 0; i < 2; ++i) { int R, C; stage_rc(tid * 16 + i * 8192, R, C);
        const int Rb = Epi::BMAP == 0 ? R : Epi::BMAP == 1 ? ((R & ~31) + perm32(R & 31)) : (64 * (R >> 5) + perm32(R & 31));
        voffA[i] = (unsigned)(R * K + C) * 2u; voffB[i] = (unsigned)(Rb * K + C) * 2u; }
    const size_t kstep = (size_t)(BK * 2);
    const size_t hstep = (size_t)HALF * K * 2;
    const size_t hstepB = Epi::BMAP == 2 ? (size_t)32 * K * 2 : hstep;
    const size_t tstep = 2 * hstep;
    const unsigned ldsw = (unsigned)wid * 1024u;
    const int aoff = lds_byte(wr * 64 + fr, fq * 8), boff = lds_byte(wc * 32 + fr, fq * 8);
#define PG8_SA(b, h) (((b) * 2 + (h)) * HTB)
#define PG8_SB(b, h) ((4 + (b) * 2 + (h)) * HTB)
#define PG8_STAGE(bufoff, gbase, voff) do { if (KMODE != 1) { _Pragma("unroll") for (int _i = 0; _i < 2; ++_i) \
        __builtin_amdgcn_global_load_lds((const unsigned*)((const char*)(KMODE == 2 ? (const void*)g.Bt : (const void*)(gbase)) + (voff)[_i]), (PG8_LAS unsigned*)(lds + (bufoff) + ldsw + _i * 8192), 16, 0, 0); } } while (0)
#define PG8_LDA(dst, b, h) do { if (KMODE != 3) { _Pragma("unroll") for (int m = 0; m < 4; ++m) _Pragma("unroll") for (int k = 0; k < 2; ++k) dst[m][k] = *(const PG8_LAS bf16x8*)(lds + PG8_SA(b, h) + aoff + m * 2048 + k * 1024); } else { _Pragma("unroll") for (int m = 0; m < 4; ++m) _Pragma("unroll") for (int k = 0; k < 2; ++k) asm volatile("" : "+v"(dst[m][k])); } } while (0)
#define PG8_LDB(dst, b, h) do { if (KMODE != 3) { _Pragma("unroll") for (int n = 0; n < 2; ++n) _Pragma("unroll") for (int k = 0; k < 2; ++k) dst[n][k] = *(const PG8_LAS bf16x8*)(lds + PG8_SB(b, h) + boff + n * 2048 + k * 1024); } else { _Pragma("unroll") for (int n = 0; n < 2; ++n) _Pragma("unroll") for (int k = 0; k < 2; ++k) asm volatile("" : "+v"(dst[n][k])); } } while (0)
#define PG8_MMA(ai, bj, At, Bt) do { __builtin_amdgcn_s_setprio(1); _Pragma("unroll") for (int m = 0; m < 4; ++m) _Pragma("unroll") for (int n = 0; n < 2; ++n) _Pragma("unroll") for (int k = 0; k < 2; ++k) \
        acc[ai][bj][m][n] = __builtin_amdgcn_mfma_f32_16x16x32_bf16(Bt[n][k], At[m][k], acc[ai][bj][m][n], 0, 0, 0); __builtin_amdgcn_s_setprio(0); } while (0)
#define PG8_WAIT_V(n) asm volatile("s_waitcnt vmcnt(" #n ")" ::: "memory")
#define PG8_WAIT_L(n) asm volatile("s_waitcnt lgkmcnt(" #n ")" ::: "memory")
#define PG8_BAR __builtin_amdgcn_s_barrier()
#define PG8_SCHED __builtin_amdgcn_sched_barrier(0)
    Unit cur, nxt; int ui = 0;
    if (!S.next(0, cur)) return;
    f32x4 acc[2][2][4][2];
#pragma unroll
    for (int a = 0; a < 2; ++a)
#pragma unroll
        for (int b = 0; b < 2; ++b)
#pragma unroll
            for (int m = 0; m < 4; ++m)
#pragma unroll
                for (int n = 0; n < 2; ++n) acc[a][b][m][n] = (f32x4){0.f, 0.f, 0.f, 0.f};
    bf16x8 At[4][2], B0[2][2], B1[2][2];
    if (KMODE == 3) { _Pragma("unroll") for (int m = 0; m < 4; ++m) _Pragma("unroll") for (int k = 0; k < 2; ++k) At[m][k] = (bf16x8){1, 2, 3, 4, 5, 6, 7, 8}; _Pragma("unroll") for (int n = 0; n < 2; ++n) _Pragma("unroll") for (int k = 0; k < 2; ++k) { B0[n][k] = (bf16x8){1, 2, 3, 4, 5, 6, 7, 8}; B1[n][k] = B0[n][k]; } }
    const char* cA = (const char*)g.A + (size_t)cur.pm * tstep; const char* cB = (const char*)g.Bt + (size_t)cur.pn * tstep;
    PG8_STAGE(PG8_SB(0, 0), cB, voffB); PG8_STAGE(PG8_SB(0, 1), cB + hstepB, voffB); PG8_STAGE(PG8_SA(0, 0), cA, voffA); PG8_STAGE(PG8_SA(0, 1), cA + hstep, voffA);
    if (wr == 1) PG8_BAR;
    PG8_WAIT_V(2); PG8_BAR;
    PG8_STAGE(PG8_SB(1, 0), cB + kstep, voffB); PG8_STAGE(PG8_SA(1, 0), cA + kstep, voffA); PG8_STAGE(PG8_SB(1, 1), cB + hstepB + kstep, voffB);
    PG8_WAIT_V(6); PG8_BAR;
    for (;;) {
        const bool has_next = S.next(ui + 1, nxt);
        const char* nA = has_next ? (const char*)g.A + (size_t)nxt.pm * tstep : cA; const char* nB = has_next ? (const char*)g.Bt + (size_t)nxt.pn * tstep : cB;
        for (int t = 0; t < nt; t += 2) {
            const bool last = (t == nt - 2);
            const char* a1 = cA + (size_t)(t + 1) * kstep;
            const char* a2 = last ? nA : cA + (size_t)(t + 2) * kstep; const char* b2 = last ? nB : cB + (size_t)(t + 2) * kstep;
            const char* a3 = a2 + kstep; const char* b3 = b2 + kstep;
            if constexpr (KMODE == 4) {
            PG8_LDB(B0, 0, 0); PG8_LDB(B1, 0, 1); PG8_SCHED; PG8_LDA(At, 0, 0);
            PG8_WAIT_V(6); PG8_WAIT_L(0); PG8_BAR; PG8_STAGE(PG8_SA(1, 1), a1 + hstep, voffA); PG8_MMA(0, 0, At, B0); PG8_MMA(0, 1, At, B1); PG8_BAR; PG8_SCHED;
            PG8_LDA(At, 0, 1);
            PG8_WAIT_V(2); PG8_WAIT_L(0); PG8_BAR; PG8_STAGE(PG8_SB(0, 0), b2, voffB); PG8_STAGE(PG8_SB(0, 1), b2 + hstepB, voffB); PG8_STAGE(PG8_SA(0, 0), a2, voffA); PG8_MMA(1, 0, At, B0); PG8_MMA(1, 1, At, B1); PG8_BAR; PG8_SCHED;
            PG8_LDB(B0, 1, 0); PG8_LDB(B1, 1, 1); PG8_SCHED; PG8_LDA(At, 1, 0);
            PG8_WAIT_V(6); PG8_WAIT_L(0); PG8_BAR; PG8_STAGE(PG8_SA(0, 1), a2 + hstep, voffA); PG8_MMA(0, 0, At, B0); PG8_MMA(0, 1, At, B1); PG8_BAR; PG8_SCHED;
            PG8_LDA(At, 1, 1);
            PG8_WAIT_V(2); PG8_WAIT_L(0); PG8_BAR; PG8_STAGE(PG8_SB(1, 0), b3, voffB); PG8_STAGE(PG8_SB(1, 1), b3 + hstepB, voffB); PG8_STAGE(PG8_SA(1, 0), a3, voffA); PG8_MMA(1, 0, At, B0); PG8_MMA(1, 1, At, B1); PG8_BAR; PG8_SCHED;
            } else {
            PG8_LDB(B0, 0, 0); PG8_LDB(B1, 0, 1); PG8_SCHED; PG8_LDA(At, 0, 0); PG8_STAGE(PG8_SA(1, 1), a1 + hstep, voffA);
            PG8_WAIT_V(8); PG8_WAIT_L(0); PG8_BAR; PG8_MMA(0, 0, At, B0); PG8_MMA(0, 1, At, B1); PG8_BAR; PG8_SCHED;
            PG8_LDA(At, 0, 1); PG8_STAGE(PG8_SB(0, 0), b2, voffB); PG8_STAGE(PG8_SB(0, 1), b2 + hstepB, voffB); PG8_STAGE(PG8_SA(0, 0), a2, voffA);
            PG8_WAIT_V(8); PG8_WAIT_L(0); PG8_BAR; PG8_MMA(1, 0, At, B0); PG8_MMA(1, 1, At, B1); PG8_BAR; PG8_SCHED;
            PG8_LDB(B0, 1, 0); PG8_LDB(B1, 1, 1); PG8_SCHED; PG8_LDA(At, 1, 0); PG8_STAGE(PG8_SA(0, 1), a2 + hstep, voffA);
            PG8_WAIT_V(8); PG8_WAIT_L(0); PG8_BAR; PG8_MMA(0, 0, At, B0); PG8_MMA(0, 1, At, B1); PG8_BAR; PG8_SCHED;
            PG8_LDA(At, 1, 1); PG8_STAGE(PG8_SB(1, 0), b3, voffB); PG8_STAGE(PG8_SB(1, 1), b3 + hstepB, voffB); PG8_STAGE(PG8_SA(1, 0), a3, voffA);
            PG8_WAIT_V(8); PG8_WAIT_L(0); PG8_BAR; PG8_MMA(1, 0, At, B0); PG8_MMA(1, 1, At, B1); PG8_BAR; PG8_SCHED;
                    }
        }
        if constexpr (ALIGN_EPI) { if (wr == 0) PG8_BAR; }
        E(acc, cur, wr, wc, fr, fq);
        if (!has_next) break;
#pragma unroll
        for (int a = 0; a < 2; ++a)
#pragma unroll
            for (int b = 0; b < 2; ++b)
#pragma unroll
                for (int m = 0; m < 4; ++m)
#pragma unroll
                    for (int n = 0; n < 2; ++n) acc[a][b][m][n] = (f32x4){0.f, 0.f, 0.f, 0.f};
        cur = nxt; cA = nA; cB = nB; ++ui;
        if constexpr (ALIGN_EPI) { if (wr == 1) PG8_BAR; }
    }
    PG8_WAIT_V(0);
    if constexpr (!ALIGN_EPI) { if (wr == 0) PG8_BAR; }
    PG8_BAR;
#undef PG8_SA
#undef PG8_SB
#undef PG8_STAGE
#undef PG8_LDA
#undef PG8_LDB
#undef PG8_MMA
#undef PG8_WAIT_V
#undef PG8_WAIT_L
#undef PG8_BAR
#undef PG8_SCHED
}
}
#define LAS __attribute__((address_space(3)))

struct Args;
__device__ __forceinline__ void p0_prologue_naive(const float* const* in, unsigned char* ws, int G) {
    const size_t gt = (size_t)blockIdx.x * 512 + threadIdx.x, GT = (size_t)G * 512;
    for (size_t i = gt; i < NPREP; i += GT) prep_w_elem(i, in[4], in[13], in[15], in[16], in[17], in[9], in[14], ws);
    const int wave = threadIdx.x >> 6, lane = threadIdx.x & 63;
    for (int m = blockIdx.x * 8 + wave; m < M; m += G * 8) xn_row(m, lane, in[0], in[1], in[3], (bf16_t*)(ws + WS_XN));
}


__device__ __forceinline__ unsigned pk2(float lo, float hi) { return f2bf(lo) | (f2bf(hi) << 16); }
__device__ __forceinline__ void p0_item(const float* W, int K, int N, bf16_t* WT, int orow0, const float* kscale, LAS float* scr, int k0, int n0, int lane) {
    typedef unsigned v4u __attribute__((ext_vector_type(4)));
    float wv[32];
#pragma unroll
    for (int i = 0; i < 32; ++i) wv[i] = W[(size_t)(k0 + 2 * i + (lane >> 5)) * N + n0 + (lane & 31)];
    if (kscale) {
#pragma unroll
        for (int i = 0; i < 32; ++i) wv[i] *= kscale[k0 + 2 * i + (lane >> 5)]; }
#pragma unroll
    for (int i = 0; i < 32; ++i) scr[(2 * i + (lane >> 5)) * 33 + (lane & 31)] = wv[i];
    asm volatile("s_waitcnt lgkmcnt(0)" ::: "memory");
    const int c = lane & 7;
#pragma unroll
    for (int j = 0; j < 4; ++j) { const int n = (lane >> 3) + 8 * j; const LAS float* s = scr + (8 * c) * 33 + n;
        v4u o; o.x = pk2(s[0 * 33], s[1 * 33]); o.y = pk2(s[2 * 33], s[3 * 33]); o.z = pk2(s[4 * 33], s[5 * 33]); o.w = pk2(s[6 * 33], s[7 * 33]);
        *(v4u*)(WT + (size_t)(orow0 + n) * K + k0 + 8 * c) = o; }
    asm volatile("s_waitcnt lgkmcnt(0)" ::: "memory");
}
__device__ __forceinline__ void p0_weights(const float* const* in, unsigned char* ws, LAS unsigned char* lds, int it_lo, int it_hi, int w, int nw) {
    const int wave = __builtin_amdgcn_readfirstlane(threadIdx.x >> 6), lane = threadIdx.x & 63;
    LAS float* scr = (LAS float*)(lds + wave * 16384);
    constexpr int I_IN = (D / 64) * (INW / 32), I_O = (D / 64) * (D / 32), I_G = (D / 64) * (DFF / 32);
    bf16_t* WIN = (bf16_t*)(ws + WS_WIN); bf16_t* WO = (bf16_t*)(ws + WS_WO); bf16_t* WGU = (bf16_t*)(ws + WS_WGU); bf16_t* WDN = (bf16_t*)(ws + WS_WDN);
    for (int it = it_lo + w; it < it_hi; it += nw) {
        int r = it;
        if (r < I_IN) { const int nb = r % (INW / 32), kb = r / (INW / 32); p0_item(in[4], D, INW, WIN, 32 * nb, in[3], scr, 64 * kb, 32 * nb, lane); continue; } r -= I_IN;
        if (r < I_O) { const int nb = r % (D / 32), kb = r / (D / 32); p0_item(in[13], D, D, WO, 32 * nb, nullptr, scr, 64 * kb, 32 * nb, lane); continue; } r -= I_O;
        if (r < 2 * I_G) { const int up = r >= I_G; if (up) r -= I_G; const int nb = r % (DFF / 32), kb = r / (DFF / 32), n0 = 32 * nb;
            p0_item(in[up ? 16 : 15], D, DFF, WGU, 256 * (n0 >> 7) + (n0 & 127) + 128 * up, in[14], scr, 64 * kb, n0, lane); continue; } r -= 2 * I_G;
        { const int nb = r % (D / 32), kb = r / (D / 32); p0_item(in[17], DFF, D, WDN, 32 * nb, nullptr, scr, 64 * kb, 32 * nb, lane); }
    }
}
constexpr int P0_I_IN = (D / 64) * (INW / 32), P0_NITEMS = P0_I_IN + (D / 64) * (D / 32) + 2 * (D / 64) * (DFF / 32) + (DFF / 64) * (D / 32);
__device__ __forceinline__ void p0_prologue(const float* const* in, unsigned char* ws, LAS unsigned char* lds, int G) {
    const int wave = __builtin_amdgcn_readfirstlane(threadIdx.x >> 6), lane = threadIdx.x & 63;
    const int gw = (int)blockIdx.x * 8 + wave, NGW = G * 8;
    p0_weights(in, ws, lds, 0, MK_LATE_WEIGHTS ? P0_I_IN : P0_NITEMS, gw, NGW);
    { const size_t gt = (size_t)blockIdx.x * 512 + threadIdx.x; bf16_t* WSB = (bf16_t*)(ws + WS_WS); for (size_t i = gt; i < 8 * 128 * 128; i += (size_t)G * 512) WSB[i] = f2bf(in[9][i]); }
    typedef float f32x4 __attribute__((ext_vector_type(4)));
    bf16_t* XB = (bf16_t*)(ws + WS_XN); float* RS1 = (float*)(ws + WS_RS1);
    for (int m4 = gw * 4; m4 < M; m4 += NGW * 4) {
        const f32x4* xr = (const f32x4*)(m4 < MP ? in[0] + (size_t)m4 * D : in[1] + (size_t)(m4 - MP) * D) + lane;
        f32x4 v[4][4]; float ss[4];
#pragma unroll
        for (int r = 0; r < 4; ++r)
#pragma unroll
            for (int j = 0; j < 4; ++j) v[r][j] = __builtin_nontemporal_load(xr + r * (D / 4) + 64 * j);
#pragma unroll
        for (int r = 0; r < 4; ++r) { ss[r] = 0.f;
            unsigned long long* b8 = (unsigned long long*)(XB + (size_t)(m4 + r) * D) + lane;
#pragma unroll
            for (int j = 0; j < 4; ++j) { ss[r] += (v[r][j][0] * v[r][j][0] + v[r][j][1] * v[r][j][1]) + (v[r][j][2] * v[r][j][2] + v[r][j][3] * v[r][j][3]);
                b8[64 * j] = (unsigned long long)pk2(v[r][j][0], v[r][j][1]) | ((unsigned long long)pk2(v[r][j][2], v[r][j][3]) << 32); } }
#pragma unroll
        for (int o = 1; o < 64; o <<= 1) {
#pragma unroll
            for (int r = 0; r < 4; ++r) ss[r] += __shfl_xor(ss[r], o); }
        if (lane < 4) RS1[m4 + lane] = rsqrtf((lane == 0 ? ss[0] : lane == 1 ? ss[1] : lane == 2 ? ss[2] : ss[3]) * (1.0f / D) + EPS);
    }
}

__device__ __forceinline__ void p2_mixer_naive(const float* const* in, unsigned char* ws, unsigned char* lds_generic, int G) {
    MixNaiveLds* L = (MixNaiveLds*)lds_generic + (threadIdx.x >> 8);
    for (int pr = blockIdx.x; pr < M / 2; pr += G)
        mix_naive_token(2 * pr + (threadIdx.x >> 8), threadIdx.x & 255, *L, (const bf16_t*)(ws + WS_PROJ), (const float*)(ws + WS_VSSQ), (const bf16_t*)(ws + WS_WS), in[2], in[7], in[8], in[10], in[11], in[12], (bf16_t*)(ws + WS_MIX));
}

static void launch_naive_phase(int p, void* const* d_in, float* out, unsigned char* ws, hipStream_t stream) {
    const float* xp = (const float*)d_in[0]; const float* xs = (const float*)d_in[1]; const float* rel = (const float*)d_in[2]; const float* norm1 = (const float*)d_in[3];
    const float* w_in = (const float*)d_in[4]; const float* qg = (const float*)d_in[5]; const float* kg = (const float*)d_in[6]; const float* sink = (const float*)d_in[7];
    const float* vg = (const float*)d_in[8]; const float* w_s = (const float*)d_in[9]; const float* b_s = (const float*)d_in[10]; const float* ag = (const float*)d_in[11];
    const float* gg = (const float*)d_in[12]; const float* w_o = (const float*)d_in[13]; const float* norm2 = (const float*)d_in[14]; const float* w_gate = (const float*)d_in[15];
    const float* w_up = (const float*)d_in[16]; const float* w_down = (const float*)d_in[17];
    bf16_t* WIN = (bf16_t*)(ws + WS_WIN); bf16_t* WO = (bf16_t*)(ws + WS_WO); bf16_t* WGU = (bf16_t*)(ws + WS_WGU); bf16_t* WDN = (bf16_t*)(ws + WS_WDN); bf16_t* WSB = (bf16_t*)(ws + WS_WS);
    float* VSSQ = (float*)(ws + WS_VSSQ); float* SSQ2 = (float*)(ws + WS_SSQ2);
    bf16_t* XN = (bf16_t*)(ws + WS_XN); bf16_t* PROJ = (bf16_t*)(ws + WS_PROJ); bf16_t* H = (bf16_t*)(ws + WS_H); bf16_t* MIX = (bf16_t*)(ws + WS_MIX); bf16_t* X1B = (bf16_t*)(ws + WS_X1B);
    switch (p) {
    case 0: k_prep_w<<<(unsigned)((NPREP + 255) / 256), 256, 0, stream>>>(w_in, w_o, w_gate, w_up, w_down, w_s, norm2, ws);
            k_xn<<<M / 4, 256, 0, stream>>>(xp, xs, norm1, XN); break;
    case 1: k_gemm_naive<NEpiIn, false><<<dim3(INW / 64, M / 64), 256, 0, stream>>>(XN, WIN, D, NEpiIn{PROJ, VSSQ, qg, kg}); break;
    case 2: k_mix_naive<<<M, 256, 0, stream>>>(PROJ, VSSQ, WSB, rel, sink, vg, b_s, ag, gg, MIX); break;
    case 3: k_gemm_naive<NEpiOut, false><<<dim3(D / 64, M / 64), 256, 0, stream>>>(MIX, WO, D, NEpiOut{xp, xs, out, X1B, SSQ2}); break;
    case 4: k_gemm_naive<NEpiUp, true><<<dim3(DFF / 64, M / 64), 256, 0, stream>>>(X1B, WGU, D, NEpiUp{H, SSQ2}); break;
    case 5: k_gemm_naive<NEpiDown, false><<<dim3(D / 64, M / 64), 256, 0, stream>>>(H, WDN, DFF, NEpiDown{out}); break;
    }
}

namespace mix {
typedef short bf16x8 __attribute__((ext_vector_type(8)));
typedef short s16x4 __attribute__((ext_vector_type(4)));
typedef float f32x16 __attribute__((ext_vector_type(16)));
typedef float f32x4 __attribute__((ext_vector_type(4)));
typedef unsigned u32x2 __attribute__((ext_vector_type(2)));
typedef unsigned u32x4 __attribute__((ext_vector_type(4)));
typedef float f32x2_t __attribute__((ext_vector_type(2))); typedef __bf16 bf16x2_t __attribute__((ext_vector_type(2)));
constexpr int L_K = 0, L_V = 40960, L_TAB = 81920, TABN = 392, L_RV = L_TAB + 8 * 4 * TABN * 4, L_SS = L_RV + 512, L_END = L_SS + 2048, L_UA = 65536, L_UB = L_END, L_END2 = L_UB + 16384, L_PAR = L_END2, L_END3 = L_PAR + 2560 * 4;
constexpr int NUNITS = NSEQ * (SEQ / 64);
__device__ __forceinline__ unsigned cvtpk(float lo, float hi) { f32x2_t v = {lo, hi}; bf16x2_t b = __builtin_convertvector(v, bf16x2_t); return __builtin_bit_cast(unsigned, b); }
__device__ __forceinline__ s16x4 trrd(const LAS unsigned char* p) { typedef short v4i16_t __attribute__((ext_vector_type(4))); return __builtin_bit_cast(s16x4, __builtin_amdgcn_ds_read_tr16_b64_v4i16((LAS v4i16_t*)p)); }
__device__ __forceinline__ float xhalf_sum(float v) { auto rr = __builtin_amdgcn_permlane32_swap(__float_as_uint(v), __float_as_uint(v), false, false); return __uint_as_float(rr[0]) + __uint_as_float(rr[1]); }
__device__ __forceinline__ float xhalf_max(float v) { auto rr = __builtin_amdgcn_permlane32_swap(__float_as_uint(v), __float_as_uint(v), false, false); return fmaxf(__uint_as_float(rr[0]), __uint_as_float(rr[1])); }


__device__ __forceinline__ void store_pairs(bf16_t* p, const u32x2 (&w)[4], int hi, bool skip = false) {
    if (skip) { asm volatile("" :: "v"(w[0].x), "v"(w[1].x), "v"(w[2].x), "v"(w[3].x)); return; }
#pragma unroll
    for (int k = 0; k < 4; k += 2) {
        auto rx = __builtin_amdgcn_permlane32_swap(w[k].x, w[k + 1].x, false, false); auto ry = __builtin_amdgcn_permlane32_swap(w[k].y, w[k + 1].y, false, false);
        const u32x4 v = {rx[0], ry[0], rx[1], ry[1]};
        *(u32x4*)(p + 8 * (k + hi)) = v;
    }
}

__device__ __forceinline__ void pack_pairs(u32x4 (&out)[2], const u32x2 (&w)[4]) {
#pragma unroll
    for (int k = 0; k < 4; k += 2) {
        auto rx = __builtin_amdgcn_permlane32_swap(w[k].x, w[k + 1].x, false, false); auto ry = __builtin_amdgcn_permlane32_swap(w[k].y, w[k + 1].y, false, false);
        out[k >> 1] = (u32x4){rx[0], ry[0], rx[1], ry[1]};
    }
}

template <int MODE> __device__ __forceinline__ void stage_rows(LAS unsigned char* img, const bf16_t* src, int row_lo, int row_hi, int wave, int lane, bool nodma) {
    if (nodma) return;
    for (int r8 = (row_lo >> 3) + wave; r8 < (row_hi >> 3); r8 += 8) {
        const int row = 8 * r8 + (lane >> 3), pc = lane & 7, c = MODE == 0 ? (pc ^ ((row >> 1) & 7)) : (pc ^ (((row >> 1) & 1) << 2));
        __builtin_amdgcn_global_load_lds((const unsigned*)(src + (size_t)row * INW + 8 * c), (LAS unsigned*)(img + r8 * 1024), 16, 0, 0);
    }
}


template <bool FAST> __device__ __forceinline__ void attn_tiles(LAS unsigned char* lds, const bf16x8 (&qf)[4], const LAS float* tbp, int kt_lo, int kt_hi, const int (&koff)[4], const int (&voff)[2], int hi, f32x16& o0r, f32x16& o1r) {
    float m = 0.0f, l = hi == 0 ? 1.0f : 0.0f;
    f32x16 o0 = {}, o1 = {};
    for (int kt = kt_lo; kt < kt_hi; ++kt) {
        f32x16 p0, p1;
        { const LAS float* tp = tbp + 64 * kt;
#pragma unroll
          for (int gq = 0; gq < 4; ++gq) { const f32x4 a = *(const LAS f32x4*)(tp + 8 * gq), b = *(const LAS f32x4*)(tp + 32 + 8 * gq);
#pragma unroll
              for (int e = 0; e < 4; ++e) { p0[4 * gq + e] = a[e]; p1[4 * gq + e] = b[e]; } } }
        const LAS unsigned char* kb = lds + L_K + kt * 8192;
#pragma unroll
        for (int d0 = 0; d0 < 4; ++d0) { const bf16x8 k0 = *(const LAS bf16x8*)(kb + koff[d0]), k1 = *(const LAS bf16x8*)(kb + 4096 + koff[d0]);
            p0 = __builtin_amdgcn_mfma_f32_32x32x16_bf16(k0, qf[d0], p0, 0, 0, 0); p1 = __builtin_amdgcn_mfma_f32_32x32x16_bf16(k1, qf[d0], p1, 0, 0, 0); }
        const LAS unsigned char* vb = lds + L_V + kt * 8192;
        bf16x8 vf0[2][2];
#pragma unroll
        for (int sI = 0; sI < 2; ++sI)
#pragma unroll
            for (int dh = 0; dh < 2; ++dh) { const LAS unsigned char* vp = vb + (16 * sI) * 128 + voff[dh];
                const s16x4 lo = trrd(vp), hi4 = trrd(vp + 8 * 128); vf0[sI][dh] = (bf16x8){lo[0], lo[1], lo[2], lo[3], hi4[0], hi4[1], hi4[2], hi4[3]}; }
        float ls = 0.f;
        if (FAST) {
#pragma unroll
            for (int r = 0; r < 16; ++r) { p0[r] = __builtin_amdgcn_exp2f(p0[r]); p1[r] = __builtin_amdgcn_exp2f(p1[r]); }
            { f32x2_t l2 = {0.f, 0.f};
#pragma unroll
              for (int r = 0; r < 16; r += 2) l2 += (f32x2_t){p0[r], p0[r + 1]} + (f32x2_t){p1[r], p1[r + 1]};
              ls = l2.x + l2.y; }
            l += ls;
        } else {
            float rm = fmaxf(p0[0], p1[0]);
#pragma unroll
            for (int r = 1; r < 16; ++r) rm = fmaxf(rm, fmaxf(p0[r], p1[r]));
            rm = xhalf_max(rm);
            const float mn = fmaxf(m, rm), alpha = __builtin_amdgcn_exp2f(m - mn); m = mn;
#pragma unroll
            for (int r = 0; r < 16; ++r) { p0[r] = __builtin_amdgcn_exp2f(p0[r] - m); p1[r] = __builtin_amdgcn_exp2f(p1[r] - m); ls += p0[r] + p1[r]; }
            l = l * alpha + ls;
#pragma unroll
            for (int r = 0; r < 16; ++r) { o0[r] *= alpha; o1[r] *= alpha; }
        }
        u32x4 pw[2][2];
#pragma unroll
        for (int sI = 0; sI < 2; ++sI) { pw[0][sI] = (u32x4){cvtpk(p0[8 * sI], p0[8 * sI + 1]), cvtpk(p0[8 * sI + 2], p0[8 * sI + 3]), cvtpk(p0[8 * sI + 4], p0[8 * sI + 5]), cvtpk(p0[8 * sI + 6], p0[8 * sI + 7])};
                                         pw[1][sI] = (u32x4){cvtpk(p1[8 * sI], p1[8 * sI + 1]), cvtpk(p1[8 * sI + 2], p1[8 * sI + 3]), cvtpk(p1[8 * sI + 4], p1[8 * sI + 5]), cvtpk(p1[8 * sI + 6], p1[8 * sI + 7])}; }
#pragma unroll
        for (int sI = 0; sI < 2; ++sI) { const bf16x8 pf = __builtin_bit_cast(bf16x8, pw[0][sI]);
            o0 = __builtin_amdgcn_mfma_f32_32x32x16_bf16(vf0[sI][0], pf, o0, 0, 0, 0); o1 = __builtin_amdgcn_mfma_f32_32x32x16_bf16(vf0[sI][1], pf, o1, 0, 0, 0); }
#pragma unroll
        for (int sI = 0; sI < 2; ++sI) { const bf16x8 pf = __builtin_bit_cast(bf16x8, pw[1][sI]);
#pragma unroll
            for (int dh = 0; dh < 2; ++dh) { const LAS unsigned char* vp = vb + (32 + 16 * sI) * 128 + voff[dh];
                const s16x4 lo = trrd(vp), hi4 = trrd(vp + 8 * 128); const bf16x8 vf = {lo[0], lo[1], lo[2], lo[3], hi4[0], hi4[1], hi4[2], hi4[3]};
                if (dh == 0) o0 = __builtin_amdgcn_mfma_f32_32x32x16_bf16(vf, pf, o0, 0, 0, 0); else o1 = __builtin_amdgcn_mfma_f32_32x32x16_bf16(vf, pf, o1, 0, 0, 0); } }
    }
    const float inv = 1.0f / xhalf_sum(l);
#pragma unroll
    for (int r = 0; r < 16; ++r) { o0[r] *= inv; o1[r] *= inv; }
    o0r = o0; o1r = o1;
}

__device__ __forceinline__ void p2_mixer(const float* const* in, unsigned char* ws, LAS unsigned char* lds, int G, int pflags) {
    const bool nodma = pflags & 1;
    const int tid = threadIdx.x, wave = __builtin_amdgcn_readfirstlane(tid >> 6), lane = tid & 63, r32 = lane & 31, hi = lane >> 5, hq = wave >> 1, tb = wave & 1;
    const bf16_t* PROJ = (const bf16_t*)(ws + WS_PROJ); const float* VSSQ = (const float*)(ws + WS_VSSQ); const bf16_t* WSB = (const bf16_t*)(ws + WS_WS); bf16_t* MIX = (bf16_t*)(ws + WS_MIX);
    const float* rel_table = in[2]; const float* sink = in[7]; const float* v_gain = in[8]; const float* b_s = in[10]; const float* ag = in[11]; const float* gg = in[12];
    LAS float* TAB = (LAS float*)(lds + L_TAB); LAS float* RV = (LAS float*)(lds + L_RV); LAS float* SS = (LAS float*)(lds + L_SS);
    { LAS float* RT = (LAS float*)(lds + L_K);
      if (tid < 256) RT[tid] = rel_table[tid]; else if (tid < 264) RT[tid] = sink[tid - 256];
      __syncthreads();
      for (int i = tid; i < 8 * 4 * TABN; i += 512) { const int h = i / (4 * TABN), rem = i % (4 * TABN), sh = rem / TABN, e = rem % TABN, bi = e + sh - 64;
          TAB[i] = (bi >= 0 && bi <= 256) ? (RT[t5_bucket(bi - 128) * 8 + h] - RT[256 + h]) * LOG2E : -1e30f; }
      LAS float* PAR = (LAS float*)(lds + L_PAR);
      PAR[tid] = ag[tid]; PAR[512 + tid] = gg[tid]; PAR[1024 + tid] = v_gain[tid]; PAR[1536 + tid] = b_s[tid]; PAR[2048 + tid] = b_s[512 + tid]; }
    const LAS float* PAG = (const LAS float*)(lds + L_PAR); const LAS float* PGG = PAG + 512; const LAS float* PVG = PAG + 1024; const LAS float* PBS = PAG + 1536;
    bool fast;
    { float mq = fabsf(in[5][lane]), mk = fabsf(in[6][lane]), mb = fmaxf(fmaxf(fabsf(rel_table[lane]), fabsf(rel_table[64 + lane])), fmaxf(fabsf(rel_table[128 + lane]), fabsf(rel_table[192 + lane]))), ms = fabsf(sink[lane & 7]);
#pragma unroll
      for (int o = 1; o < 64; o <<= 1) { mq = fmaxf(mq, __shfl_xor(mq, o)); mk = fmaxf(mk, __shfl_xor(mk, o)); mb = fmaxf(mb, __shfl_xor(mb, o)); ms = fmaxf(ms, __shfl_xor(ms, o)); }
      const float bound = (8.0f * mq * mk * 1.02f + mb + ms) * LOG2E;
      fast = __builtin_amdgcn_readfirstlane((int)(bound < 100.0f)) != 0; }
    int koff[4], voff[2], gvoff[2];
    { const int q = (lane & 15) >> 2, sw = (q >> 1) & 1;
#pragma unroll
      for (int d0 = 0; d0 < 4; ++d0) koff[d0] = r32 * 128 + (((2 * d0 + hi) ^ ((r32 >> 1) & 7)) << 4);
#pragma unroll
      for (int dh = 0; dh < 2; ++dh) { const int ch = 4 * (dh ^ sw) + 2 * ((lane >> 4) & 1) + ((lane & 3) >> 1);
          voff[dh] = (4 * hi + q) * 128 + ch * 16 + (lane & 1) * 8; gvoff[dh] = (8 * hi + q) * 128 + ch * 16 + (lane & 1) * 8; } }
    const int e0 = 64 - 32 * tb - r32 + 4 * hi, sh = e0 & 3;
    const int vcu = (G % 8 == 0) ? ((int)blockIdx.x % 8) * (G / 8) + (int)blockIdx.x / 8 : (int)blockIdx.x;

    u32x4 aout[2][2][2]; u32x4 gout[2][2][2]; bool pend = false; size_t prow = 0;
#define MIX_GOUT_STORES() do { if (!(pflags & 8)) { _Pragma("unroll") for (int rd_ = 0; rd_ < 2; ++rd_) _Pragma("unroll") for (int dh_ = 0; dh_ < 2; ++dh_) { bf16_t* pp_ = MIX + prow * D + 512 + 64 * (4 * rd_ + hq) + 32 * dh_; \
        *(u32x4*)(pp_ + 8 * hi) = gout[rd_][dh_][0]; *(u32x4*)(pp_ + 8 * (2 + hi)) = gout[rd_][dh_][1]; \
        bf16_t* pa_ = MIX + prow * D + 64 * (4 * rd_ + hq) + 32 * dh_; *(u32x4*)(pa_ + 8 * hi) = aout[rd_][dh_][0]; *(u32x4*)(pa_ + 8 * (2 + hi)) = aout[rd_][dh_][1]; } } } while (0)
    for (int ri = 0; ; ++ri) {
        int u;
        if (MK_REV2 && G == 256 && NUNITS == 768) { if (ri >= 3) break; u = 4 * (24 * (vcu >> 5) + 8 * (2 - ri) + ((vcu & 31) >> 2)) + (vcu & 3); }
        else { u = vcu + ri * G; if (u >= NUNITS) break; }
        const int s = u >> 6, t0 = (u & 63) * 64, m0 = s * SEQ + t0;
        const int kt_lo = t0 < 128 ? (128 - t0) >> 6 : 0, kt_hi = (pflags & 2) ? kt_lo : (t0 + 192 > SEQ ? (SEQ + 128 - t0) >> 6 : 5);
        const int mc = m0 - (t0 & 127), pbase = (t0 & 127) + 32 * tb + r32;
        const size_t mrow = (size_t)(m0 + 32 * tb + r32);
        f32x16 oa[2][2];
        __syncthreads();
        if (tid < 128) { const f32x4* vp = (const f32x4*)(VSSQ + (size_t)(mc + tid) * 8); const f32x4 a = vp[0] + vp[1]; RV[tid] = rsqrtf(((a[0] + a[1]) + (a[2] + a[3])) * (1.0f / 512.0f) + EPS); }
#pragma unroll
        for (int g = 0; g < 2; ++g) {
            const int h = 4 * g + hq;
            if (g == 1) __syncthreads();
            { const bf16_t* krow0 = PROJ + (long)(m0 - 128) * INW + 512 + 64 * g;
              stage_rows<0>(lds + L_K, krow0, 64 * kt_lo, 64 * kt_hi, wave, lane, nodma);
              stage_rows<1>(lds + L_V, krow0 + 128, 64 * kt_lo, 64 * kt_hi, wave, lane, nodma); }
            bf16x8 qf[4];
#pragma unroll
            for (int d0 = 0; d0 < 4; ++d0) qf[d0] = *(const bf16x8*)(PROJ + mrow * INW + 64 * h + 16 * d0 + 8 * hi);
            __syncthreads();
            if (g == 0 && pend) MIX_GOUT_STORES();
            f32x16 o0, o1;
            { const LAS float* tbp = TAB + (h * 4 + sh) * TABN + (e0 - sh);
              if (fast) attn_tiles<true>(lds, qf, tbp, kt_lo, kt_hi, koff, voff, hi, o0, o1); else attn_tiles<false>(lds, qf, tbp, kt_lo, kt_hi, koff, voff, hi, o0, o1); }
            oa[g][0] = o0; oa[g][1] = o1;
        }
        { float ss = 0.f;
#pragma unroll
          for (int g = 0; g < 2; ++g)
#pragma unroll
              for (int dh = 0; dh < 2; ++dh)
#pragma unroll
                  for (int r = 0; r < 16; ++r) ss += oa[g][dh][r] * oa[g][dh][r];
          ss = xhalf_sum(ss); if (hi == 0) SS[wave * 32 + r32] = ss; }
        __syncthreads();
        { const bf16_t* vrow0 = PROJ + (size_t)mc * INW + 1280;
#pragma unroll
          for (int hh = 0; hh < 4; ++hh) stage_rows<1>(lds + hh * 16384, vrow0 + 64 * hh, 0, 128, wave, lane, nodma);
          const bf16_t* urow0 = PROJ + (size_t)m0 * INW + 768;
#pragma unroll
          for (int hh = 0; hh < 4; ++hh) stage_rows<0>(lds + (hh < 2 ? L_UA + hh * 8192 : L_UB + (hh - 2) * 8192), urow0 + 64 * hh, 0, 64, wave, lane, nodma); }
        { const float tot = (SS[tb * 32 + r32] + SS[(2 + tb) * 32 + r32]) + (SS[(4 + tb) * 32 + r32] + SS[(6 + tb) * 32 + r32]);
          const float ra = rsqrtf(tot * (1.0f / 512.0f) + EPS);
#pragma unroll
          for (int g = 0; g < 2; ++g)
#pragma unroll
              for (int dh = 0; dh < 2; ++dh)
                  { u32x2 w[4];
#pragma unroll
                    for (int gq = 0; gq < 4; ++gq) { const int col = 64 * (4 * g + hq) + 32 * dh + 8 * gq + 4 * hi; const f32x4 gn = *(const LAS f32x4*)(PAG + col);
                      const f32x2_t s0 = ((f32x2_t){oa[g][dh][4 * gq], oa[g][dh][4 * gq + 1]} * ra) * (f32x2_t){gn[0], gn[1]}, s1 = ((f32x2_t){oa[g][dh][4 * gq + 2], oa[g][dh][4 * gq + 3]} * ra) * (f32x2_t){gn[2], gn[3]};
                      w[gq].x = cvtpk(s0.x, s0.y); w[gq].y = cvtpk(s1.x, s1.y); }
                    pack_pairs(aout[g][dh], w); } }
        f32x16 og[2][2];
#pragma unroll
        for (int rd = 0; rd < 2; ++rd) {
            const int hh = 4 * rd + hq;
            if (rd == 1) { __syncthreads();
                const bf16_t* vrow0 = PROJ + (size_t)mc * INW + 1280 + 256;
#pragma unroll
                for (int h4 = 0; h4 < 4; ++h4) stage_rows<1>(lds + h4 * 16384, vrow0 + 64 * h4, 0, 128, wave, lane, nodma);
                const bf16_t* urow0 = PROJ + (size_t)m0 * INW + 768 + 256;
#pragma unroll
                for (int h4 = 0; h4 < 4; ++h4) stage_rows<0>(lds + (h4 < 2 ? L_UA + h4 * 8192 : L_UB + (h4 - 2) * 8192), urow0 + 64 * h4, 0, 64, wave, lane, nodma); }
            bf16x8 wf[8];
            { const bf16_t* wrow = WSB + ((size_t)hh * 128 + pbase) * 128 + 8 * hi;
#pragma unroll
              for (int sI = 0; sI < 8; ++sI) wf[sI] = *(const bf16x8*)(wrow + 16 * sI); }
            __syncthreads();
            f32x16 a0 = {}, a1 = {};
            const LAS unsigned char* gb = lds + hq * 16384;
            if (!(pflags & 4))
#pragma unroll
            for (int sI = 0; sI < 8; ++sI) {
                const f32x4 ra = *(const LAS f32x4*)(RV + 16 * sI + 8 * hi), rb = *(const LAS f32x4*)(RV + 16 * sI + 8 * hi + 4);
                const u32x4 wu = __builtin_bit_cast(u32x4, wf[sI]); u32x4 ws4;
                { const f32x2_t t0 = (f32x2_t){__uint_as_float(wu.x << 16), __uint_as_float(wu.x & 0xffff0000u)} * (f32x2_t){ra[0], ra[1]}, t1 = (f32x2_t){__uint_as_float(wu.y << 16), __uint_as_float(wu.y & 0xffff0000u)} * (f32x2_t){ra[2], ra[3]};
                  const f32x2_t t2 = (f32x2_t){__uint_as_float(wu.z << 16), __uint_as_float(wu.z & 0xffff0000u)} * (f32x2_t){rb[0], rb[1]}, t3 = (f32x2_t){__uint_as_float(wu.w << 16), __uint_as_float(wu.w & 0xffff0000u)} * (f32x2_t){rb[2], rb[3]};
                  ws4.x = cvtpk(t0.x, t0.y); ws4.y = cvtpk(t1.x, t1.y); ws4.z = cvtpk(t2.x, t2.y); ws4.w = cvtpk(t3.x, t3.y); }
                const bf16x8 bfr = __builtin_bit_cast(bf16x8, ws4);
#pragma unroll
                for (int dh = 0; dh < 2; ++dh) { const LAS unsigned char* vp = gb + (16 * sI) * 128 + gvoff[dh];
                    const s16x4 lo = trrd(vp), hi4 = trrd(vp + 4 * 128); const bf16x8 vf = {lo[0], lo[1], lo[2], lo[3], hi4[0], hi4[1], hi4[2], hi4[3]};
                    if (dh == 0) a0 = __builtin_amdgcn_mfma_f32_32x32x16_bf16(vf, bfr, a0, 0, 0, 0); else a1 = __builtin_amdgcn_mfma_f32_32x32x16_bf16(vf, bfr, a1, 0, 0, 0); }
            }
            const float bsv = PBS[hh * 128 + pbase];
            const LAS unsigned char* ub = lds + (hq < 2 ? L_UA + hq * 8192 : L_UB + (hq - 2) * 8192) + (32 * tb + r32) * 128 + 8 * hi;
#pragma unroll
            for (int dh = 0; dh < 2; ++dh)
#pragma unroll
                for (int gq = 0; gq < 4; ++gq) { const int col = 64 * hh + 32 * dh + 8 * gq + 4 * hi; const f32x4 vg = *(const LAS f32x4*)(PVG + col);
                    const u32x2 uu = *(const LAS u32x2*)(ub + (((4 * dh + gq) ^ ((r32 >> 1) & 7)) << 4));
                    const float u0 = __uint_as_float(uu.x << 16), u1 = __uint_as_float(uu.x & 0xffff0000u), u2 = __uint_as_float(uu.y << 16), u3 = __uint_as_float(uu.y & 0xffff0000u);
                    f32x16& acc = dh == 0 ? a0 : a1;
                    const f32x2_t e0 = (f32x2_t){u0, u1} * ((f32x2_t){vg[0], vg[1]} * (f32x2_t){acc[4 * gq], acc[4 * gq + 1]} + bsv), e1 = (f32x2_t){u2, u3} * ((f32x2_t){vg[2], vg[3]} * (f32x2_t){acc[4 * gq + 2], acc[4 * gq + 3]} + bsv);
                    acc[4 * gq] = e0.x; acc[4 * gq + 1] = e0.y; acc[4 * gq + 2] = e1.x; acc[4 * gq + 3] = e1.y; }
            og[rd][0] = a0; og[rd][1] = a1;
        }
        { float ss = 0.f;
#pragma unroll
          for (int rd = 0; rd < 2; ++rd)
#pragma unroll
              for (int dh = 0; dh < 2; ++dh)
#pragma unroll
                  for (int r = 0; r < 16; ++r) ss += og[rd][dh][r] * og[rd][dh][r];
          ss = xhalf_sum(ss); if (hi == 0) SS[256 + wave * 32 + r32] = ss; }
        __syncthreads();
        { const float tot = (SS[256 + tb * 32 + r32] + SS[256 + (2 + tb) * 32 + r32]) + (SS[256 + (4 + tb) * 32 + r32] + SS[256 + (6 + tb) * 32 + r32]);
          const float rg = rsqrtf(tot * (1.0f / 512.0f) + EPS);
#pragma unroll
          for (int rd = 0; rd < 2; ++rd)
#pragma unroll
              for (int dh = 0; dh < 2; ++dh)
                  { u32x2 w[4];
#pragma unroll
                    for (int gq = 0; gq < 4; ++gq) { const int col = 64 * (4 * rd + hq) + 32 * dh + 8 * gq + 4 * hi; const f32x4 gn = *(const LAS f32x4*)(PGG + col);
                      const f32x2_t s0 = ((f32x2_t){og[rd][dh][4 * gq], og[rd][dh][4 * gq + 1]} * rg) * (f32x2_t){gn[0], gn[1]}, s1 = ((f32x2_t){og[rd][dh][4 * gq + 2], og[rd][dh][4 * gq + 3]} * rg) * (f32x2_t){gn[2], gn[3]};
                      w[gq].x = cvtpk(s0.x, s0.y); w[gq].y = cvtpk(s1.x, s1.y); }
                    pack_pairs(gout[rd][dh], w); } }
        pend = true; prow = mrow;
    }
    if (pend) MIX_GOUT_STORES();
#undef MIX_GOUT_STORES
    __syncthreads();
}
}

constexpr int NWAVES = 8;
constexpr int N_PHASES = 6;
constexpr int RING_BYTES = 131072;
constexpr int LDSCTL_OFF = 163840 - 2048, MISC_OFF = LDSCTL_OFF + 320;
constexpr int LDS_BYTES = 163840;
static_assert(MISC_OFF + 128 <= LDS_BYTES && mix::L_END3 <= LDSCTL_OFF, "LDS map");
#if MK_MIXER_RING
static_assert(mixr::R_END <= LDSCTL_OFF, "LDS map (ring mixer)");
#endif
constexpr int CW_BAR = 4096;

#define GAS __attribute__((address_space(1)))

typedef GAS unsigned gu32;
#define RLX_AGENT __ATOMIC_RELAXED, __HIP_MEMORY_SCOPE_AGENT

#define XB_TMO      128
#define XB_XCNT(j)  (256  + 64 * (j))
#define XB_XSUB(j)  (1280 + 64 * (j))
#define XB_XGEN(j)  (2304 + 64 * (j))
#define XB_TOP      3328
#define XB_TOPGEN   3392
#define XCD_BAR_WORDS 3456
#define XB_SPIN_CAP (1u << 18)

__device__ __forceinline__ unsigned xb_ld(unsigned* p)              { return __hip_atomic_load(p, __ATOMIC_RELAXED, __HIP_MEMORY_SCOPE_AGENT); }
__device__ __forceinline__ unsigned xb_add(unsigned* p, unsigned v) { return __hip_atomic_fetch_add(p, v, __ATOMIC_RELAXED, __HIP_MEMORY_SCOPE_AGENT); }
__device__ __forceinline__ unsigned xb_xcc_id() { return (unsigned)__builtin_amdgcn_s_getreg((3 << 11) | 20) & 0xFu; }
#define XB_SPIN(cond, bar) do { unsigned _sp = 0; while (cond) { __builtin_amdgcn_s_sleep(1); \
    if ((++_sp & 255u) == 0u) { if (xb_ld(&(bar)[XB_TMO])) break; if (_sp > XB_SPIN_CAP) { atomicAdd(&(bar)[XB_TMO], 1u); break; } } } } while (0)

struct XcdBarrier { unsigned* bar; unsigned x; volatile LAS unsigned* st; };
__device__ __forceinline__ XcdBarrier xcd_barrier_post(unsigned* bar, volatile LAS unsigned* st) {
    XcdBarrier b; b.bar = bar; b.x = xb_xcc_id(); b.st = st;
    if (threadIdx.x == 0) (void)xb_add(&bar[XB_XCNT(b.x)], 1u);
    return b;
}
__device__ __forceinline__ void xcd_barrier_complete(unsigned* bar, unsigned x, unsigned& nloc, unsigned& nx) {
    const unsigned G = gridDim.x * gridDim.y * gridDim.z;
    unsigned sum, cnt, mine, sp = 0u;
    for (;;) {
        sum = 0u; cnt = 0u; mine = 0u;
#pragma unroll
        for (unsigned j = 0; j < 16; ++j) { const unsigned c = xb_ld(&bar[XB_XCNT(j)]); sum += c; cnt += (c > 0u) ? 1u : 0u; mine = (j == x) ? c : mine; }
        if (sum == G) break;
        __builtin_amdgcn_s_sleep(1);
        if ((++sp & 255u) == 0u) { if (xb_ld(&bar[XB_TMO])) break; if (sp > XB_SPIN_CAP) { atomicAdd(&bar[XB_TMO], 1u); break; } }
    }
    nloc = mine > 0u ? mine : 1u; nx = cnt > 0u ? cnt : 1u;
}
__device__ __forceinline__ void xcd_barrier(const XcdBarrier& b) {
    asm volatile("s_waitcnt vmcnt(0)" ::: "memory");
    __syncthreads();
    if (threadIdx.x == 0) {
        unsigned* bar = b.bar;
        __builtin_amdgcn_s_waitcnt(0);
        unsigned nloc = b.st[0], nx = b.st[1];
        if (nloc == 0u) { xcd_barrier_complete(bar, b.x, nloc, nx); b.st[0] = nloc; b.st[1] = nx; }
        const unsigned old = xb_add(&bar[XB_XSUB(b.x)], 1u);
        const unsigned gen = old / nloc;
        if (old + 1u == (gen + 1u) * nloc) {
            __builtin_amdgcn_fence(__ATOMIC_RELEASE, "agent");
            asm volatile("s_waitcnt vmcnt(0)" ::: "memory");
            const unsigned og = xb_add(&bar[XB_TOP], 1u);
            const unsigned tg = og / nx;
            if (og + 1u == (tg + 1u) * nx) xb_add(&bar[XB_TOPGEN], 1u);
            else XB_SPIN(xb_ld(&bar[XB_TOPGEN]) == tg, bar);
            __builtin_amdgcn_fence(__ATOMIC_ACQUIRE, "agent");
            xb_add(&bar[XB_XGEN(b.x)], 1u);
            asm volatile("s_waitcnt vmcnt(0)" ::: "memory");
        } else {
            XB_SPIN(xb_ld(&bar[XB_XGEN(b.x)]) == gen, bar);
            __builtin_amdgcn_fence(__ATOMIC_ACQUIRE, "agent");
            asm volatile("s_waitcnt vmcnt(0)" ::: "memory");
        }
    }
    __syncthreads();
}

struct Args { const float* in[18]; float* out; unsigned char* ws; int ph_lo, ph_hi; };

__global__ void __launch_bounds__(NWAVES * 64, 2) mk_fwd(Args args) {
    extern __shared__ __attribute__((aligned(16))) unsigned char lds_raw[];
    LAS unsigned char* lds = (LAS unsigned char*)lds_raw;
    volatile LAS unsigned* MISC = (volatile LAS unsigned*)(lds + MISC_OFF);
    const int tid = threadIdx.x, G = gridDim.x;
    unsigned char* ws = args.ws;
    gu32* ctl = (gu32*)(ws + WS_CTL);
    for (int u = tid; u < (LDS_BYTES - LDSCTL_OFF) / 4; u += NWAVES * 64) ((LAS unsigned*)(lds + LDSCTL_OFF))[u] = 0u;
    __syncthreads();
    const int lo = args.ph_lo, hi = args.ph_hi;
    const bool multi = hi - lo > 1;
    XcdBarrier bar; bar.bar = (unsigned*)(ctl + CW_BAR); bar.x = 0; bar.st = nullptr;
    if (multi) bar = xcd_barrier_post((unsigned*)(ctl + CW_BAR), MISC + 8);
#define STAMP(k) do {} while (0)
#define STAGGER_TICKS(ticks) do { const unsigned long long t0_ = __builtin_amdgcn_s_memrealtime(), dl_ = (unsigned long long)(ticks); while (__builtin_amdgcn_s_memrealtime() - t0_ < dl_) __builtin_amdgcn_s_sleep(4); } while (0)
#define IN(k) (lo <= (k) && (k) < hi)
#define BOTH(k) (IN(k) && IN((k) + 1))
    const float* xp = args.in[0]; const float* xs = args.in[1];
    bf16_t* WIN = (bf16_t*)(ws + WS_WIN); bf16_t* WO = (bf16_t*)(ws + WS_WO); bf16_t* WGU = (bf16_t*)(ws + WS_WGU); bf16_t* WDN = (bf16_t*)(ws + WS_WDN);
    float* VSSQ = (float*)(ws + WS_VSSQ); float* SSQ2 = (float*)(ws + WS_SSQ2);
    bf16_t* XN = (bf16_t*)(ws + WS_XN); bf16_t* PROJ = (bf16_t*)(ws + WS_PROJ); bf16_t* H = (bf16_t*)(ws + WS_H); bf16_t* MIX = (bf16_t*)(ws + WS_MIX); bf16_t* X1B = (bf16_t*)(ws + WS_X1B);

    for (int rep = 0; rep < 1 + ((MK_REPEAT_MASK >> 0) & 1); ++rep) if (IN(0)) {
#if MK_PROLOGUE_NAIVE
        p0_prologue_naive(args.in, ws, G);
#else
        p0_prologue(args.in, ws, lds, G);
#endif
        if (BOTH(0)) xcd_barrier(bar); STAMP(0); }
    for (int rep = 0; rep < 1 + ((MK_REPEAT_MASK >> 1) & 1); ++rep) if (IN(1)) {
        pg8::Gemm g{XN, WIN, M, INW, D}; pg8::StaticOrder S; S.init(M, INW, G, (int)blockIdx.x);
        LAS float* RSL = (LAS float*)(lds + RING_BYTES);
        { const float* RS1 = (const float*)(ws + WS_RS1);
          float rv[pg8::EpiIn::NS1 / 2];
#pragma unroll
          for (int k = 0; k < pg8::EpiIn::NS1 / 2; ++k) { pg8::Unit uu; rv[k] = S.next((tid >> 8) + 2 * k, uu) ? RS1[uu.pm * 256 + (tid & 255)] : 0.f; }
#pragma unroll
          for (int k = 0; k < pg8::EpiIn::NS1 / 2; ++k) RSL[((tid >> 8) + 2 * k) * 256 + (tid & 255)] = rv[k];
          __syncthreads(); }
        pg8::EpiIn E{PROJ, VSSQ, args.in[5], args.in[6], RSL, (const float*)(ws + WS_RS1)};
        pg8::gemm_phase<pg8::EpiIn, pg8::StaticOrder, true>(lds, g, S, E);
#if MK_LATE_WEIGHTS
        {
          const int rounds = (S.nwg + G - 1) / G, nbusy = S.nwg - (rounds - 1) * G, c = (int)blockIdx.x;
          const int wave = __builtin_amdgcn_readfirstlane(tid >> 6);
          if (nbusy == G) p0_weights(args.in, ws, lds, P0_I_IN, P0_NITEMS, c * 8 + wave, G * 8);
          else if (c >= nbusy) p0_weights(args.in, ws, lds, P0_I_IN, P0_NITEMS, (c - nbusy) * 8 + wave, (G - nbusy) * 8); }
#endif
        if (BOTH(1)) xcd_barrier(bar); STAMP(1);
    }
    for (int rep = 0; rep < 1 + ((MK_REPEAT_MASK >> 2) & 1); ++rep) if (IN(2) || (MK_EXTRA_PHASE >= 14 && MK_EXTRA_PHASE <= 17 && lo == MK_EXTRA_PHASE)) {
#if MK_MIXER_NAIVE
        p2_mixer_naive(args.in, ws, lds_raw, G);
#else
#if MK_MIXER_RING
        mixr::p2_mixer_ring(args.in, ws, lds, G);
#elif 1
        mix::p2_mixer(args.in, ws, lds, G, (MK_EXTRA_PHASE >= 14 && MK_EXTRA_PHASE <= 17 && lo == MK_EXTRA_PHASE) ? (MK_PFLAGS ? MK_PFLAGS : (1 << (MK_EXTRA_PHASE - 14))) : 0);
#endif
#endif
        if (BOTH(2)) xcd_barrier(bar); STAMP(2); }
    for (int rep = 0; rep < 1 + ((MK_REPEAT_MASK >> 3) & 1); ++rep) if (IN(3)) {
        pg8::Gemm g{MIX, WO, M, D, D}; pg8::StaticOrder S; S.init(M, D, G, (int)blockIdx.x);
        pg8::EpiOut E{XN, X1B, SSQ2};
        pg8::gemm_phase<pg8::EpiOut, pg8::StaticOrder, MK_ALIGN35>(lds, g, S, E);
        if (BOTH(3)) xcd_barrier(bar); STAMP(3);
    }
    for (int rep = 0; rep < 1 + ((MK_REPEAT_MASK >> 4) & 1); ++rep) if (IN(4)) {
        pg8::Gemm g{X1B, WGU, M, NGU, D}; pg8::StaticOrder S; S.init(M, NGU, G, (int)blockIdx.x); if (MK_REV5 == 2) S.reverse();
        LAS float* RS = (LAS float*)(lds + RING_BYTES);
        { pg8::Unit u0; S.next(0, u0); const int r8 = u0.pm & 7, g0 = ((u0.pm >> 3) / 3) * 3;
          for (int i = tid; i < 768; i += NWAVES * 64) { const int row = (8 * (g0 + (i >> 8)) + r8) * 256 + (i & 255); const pg8::f32x4* sp = (const pg8::f32x4*)(SSQ2 + (size_t)row * 16);
              const pg8::f32x4 sv = (sp[0] + sp[1]) + (sp[2] + sp[3]); RS[i] = rsqrtf(((sv[0] + sv[1]) + (sv[2] + sv[3])) * (1.0f / D) + EPS); }
          if (tid < 3) ((LAS int*)(RS + 768))[tid] = 8 * (g0 + tid) + r8;
          __syncthreads(); }
        pg8::EpiUp E{H, RS, SSQ2};
        pg8::gemm_phase<pg8::EpiUp, pg8::StaticOrder, MK_ALIGN4>(lds, g, S, E);
        if (BOTH(4)) xcd_barrier(bar); STAMP(4);
    }
    if (IN(5)) {
        if (MK_STAGGER_TICKS > 0 && (xb_xcc_id() & 1)) STAGGER_TICKS(MK_STAGGER_TICKS);
        pg8::Gemm g{H, WDN, M, D, DFF}; pg8::StaticOrder S; S.init(M, D, G, (int)blockIdx.x); if (MK_REV5 == 1) S.reverse();
        pg8::EpiDown E{X1B, args.out};
        pg8::gemm_phase<pg8::EpiDown, pg8::StaticOrder, MK_ALIGN35>(lds, g, S, E);
        STAMP(5);
    }

#if MK_EXTRA_PHASE >= 6
    if (lo == 6) { pg8::Gemm g{X1B, WGU, M, NGU, D}; pg8::StaticOrder S; S.init(M, NGU, G, (int)blockIdx.x); S.wgm = MK_PFLAGS ? MK_PFLAGS : 8; pg8::EpiNone E; pg8::gemm_phase<pg8::EpiNone, pg8::StaticOrder, true>(lds, g, S, E); }
    if (lo == 7) { pg8::Gemm g{H, WDN, M, D, DFF}; pg8::StaticOrder S; S.init(M, D, G, (int)blockIdx.x); pg8::EpiNone E; pg8::gemm_phase<pg8::EpiNone, pg8::StaticOrder, true>(lds, g, S, E); }
    if (lo == 8) { pg8::Gemm g{X1B, WGU, M, INW, D}; pg8::StaticOrder S; S.init(M, INW, G, (int)blockIdx.x); pg8::EpiNone E; pg8::gemm_phase<pg8::EpiNone, pg8::StaticOrder, true>(lds, g, S, E); }
#endif
#if MK_EXTRA_PHASE == 19
    if (lo == 19) { pg8::Gemm g{X1B, WGU, M, NGU, D}; pg8::StaticOrder S; S.init(M, NGU, G, (int)blockIdx.x);
        LAS float* RS = (LAS float*)(lds + RING_BYTES); for (int i = tid; i < 768; i += NWAVES * 64) RS[i] = 1.0f; __syncthreads();
        pg8::EpiUpFullLine E{H, RS}; pg8::gemm_phase<pg8::EpiUpFullLine, pg8::StaticOrder, true>(lds, g, S, E); }
#endif
#if MK_EXTRA_PHASE == 18
    if (lo == 18) { pg8::Gemm g{MIX, WO, M, D, D}; pg8::StaticOrder S; S.init(M, D, G, (int)blockIdx.x); pg8::EpiNone E; pg8::gemm_phase<pg8::EpiNone, pg8::StaticOrder, true>(lds, g, S, E); }
#endif
#if MK_EXTRA_PHASE >= 11
    if (lo == 20) { pg8::Gemm g{X1B, WGU, M, NGU, D}; pg8::StaticOrder S; S.init(M, NGU, G, (int)blockIdx.x); pg8::EpiNone E; pg8::gemm_phase<pg8::EpiNone, pg8::StaticOrder, true, 4>(lds, g, S, E); }
    if (lo == 11) { pg8::Gemm g{X1B, WGU, M, NGU, D}; pg8::StaticOrder S; S.init(M, NGU, G, (int)blockIdx.x); pg8::EpiNone E; pg8::gemm_phase<pg8::EpiNone, pg8::StaticOrder, true, 1>(lds, g, S, E); }
    if (lo == 12) { pg8::Gemm g{X1B, WGU, M, NGU, D}; pg8::StaticOrder S; S.init(M, NGU, G, (int)blockIdx.x); pg8::EpiNone E; pg8::gemm_phase<pg8::EpiNone, pg8::StaticOrder, true, 2>(lds, g, S, E); }
    if (lo == 13) { pg8::Gemm g{X1B, WGU, M, NGU, D}; pg8::StaticOrder S; S.init(M, NGU, G, (int)blockIdx.x); pg8::EpiNone E; pg8::gemm_phase<pg8::EpiNone, pg8::StaticOrder, true, 3>(lds, g, S, E); }
#endif
#if MK_EXTRA_PHASE >= 9
    if (lo == 9)  { pg8::Gemm g{H, WDN, M, D, DFF}; pg8::StaticOrder S; S.init(M, D, G, (int)blockIdx.x); pg8::EpiDownProbe<1> E{X1B, (float*)(ws + WS_MIX)}; pg8::gemm_phase<pg8::EpiDownProbe<1>, pg8::StaticOrder, true>(lds, g, S, E); }
    if (lo == 10) { pg8::Gemm g{H, WDN, M, D, DFF}; pg8::StaticOrder S; S.init(M, D, G, (int)blockIdx.x); pg8::EpiDownProbe<2> E{X1B, args.out}; pg8::gemm_phase<pg8::EpiDownProbe<2>, pg8::StaticOrder, true>(lds, g, S, E); }
#endif
#undef IN
#undef BOTH
}

extern "C" void kernel_launch(void* const* d_in, const int* in_sizes, int n_in, void* d_out, int out_size, void* d_ws, size_t ws_size, hipStream_t stream) {
    static int grid = 0;
    if (grid == 0) {
        if (n_in != 18 || in_sizes[0] != MP * D || in_sizes[1] != (M - MP) * D || out_size != M * D || ws_size < WS_END) {
            fprintf(stderr, "kernel_launch: unexpected shapes (n_in %d, in0 %d, in1 %d, out %d, ws %zu)\n", n_in, n_in > 0 ? in_sizes[0] : -1, n_in > 1 ? in_sizes[1] : -1, out_size, ws_size); grid = -1; return; }
        int dev = 0, cus = 0, per_cu = 0;
        if (hipGetDevice(&dev) != hipSuccess || hipDeviceGetAttribute(&cus, hipDeviceAttributeMultiprocessorCount, dev) != hipSuccess) { grid = -1; return; }
        if (hipFuncSetAttribute((const void*)mk_fwd, hipFuncAttributeMaxDynamicSharedMemorySize, LDS_BYTES) != hipSuccess) { fprintf(stderr, "kernel_launch: hipFuncSetAttribute failed\n"); grid = -1; return; }
        if (hipOccupancyMaxActiveBlocksPerMultiprocessor(&per_cu, (const void*)mk_fwd, NWAVES * 64, LDS_BYTES) != hipSuccess || per_cu < 1) { fprintf(stderr, "kernel_launch: occupancy query says %d blocks per CU\n", per_cu); grid = -1; return; }
        (void)hipGetLastError();
        grid = cus;
    }
    if (grid < 0) return;
    Args a{};
    for (int i = 0; i < 18; ++i) a.in[i] = (const float*)d_in[i];
    a.out = (float*)d_out; a.ws = (unsigned char*)d_ws;
    unsigned char* ws = (unsigned char*)d_ws;
    static_assert((CW_BAR + XCD_BAR_WORDS) * 4 <= 32768, "control words inside the per-call memset");
    (void)hipMemsetAsync(ws + WS_CTL, 0, 32768, stream);
#if MK_ONE_LAUNCH
#if 0 && MK_EXTRA_PHASE == 3
    a.ph_lo = 0; a.ph_hi = 4; hipLaunchKernelGGL(mk_fwd, dim3(grid), dim3(NWAVES * 64), LDS_BYTES, stream, a);
    (void)hipMemsetAsync(ws + WS_CTL, 0, 1 * MiB, stream);
    a.ph_lo = 3; a.ph_hi = 6; hipLaunchKernelGGL(mk_fwd, dim3(grid), dim3(NWAVES * 64), LDS_BYTES, stream, a);
#else
    a.ph_lo = 0; a.ph_hi = N_PHASES;
#if MK_PLAIN_LAUNCH
    hipLaunchKernelGGL(mk_fwd, dim3(grid), dim3(NWAVES * 64), LDS_BYTES, stream, a);
#else
    { void* kargs[] = {&a}; hipError_t e = hipLaunchCooperativeKernel((const void*)mk_fwd, dim3(grid), dim3(NWAVES * 64), kargs, LDS_BYTES, stream);
      if (e != hipSuccess) fprintf(stderr, "kernel_launch: cooperative launch failed: %s (grid %d)\n", hipGetErrorString(e), grid); }
#endif
#if MK_EXTRA_PHASE >= 0
    a.ph_lo = MK_EXTRA_PHASE; a.ph_hi = MK_EXTRA_PHASE + 1; hipLaunchKernelGGL(mk_fwd, dim3(grid), dim3(NWAVES * 64), LDS_BYTES, stream, a);
#endif
#endif
#else
    for (int p = 0; p < N_PHASES; ++p) {
        if (!(MK_PHASE_MASK & (1 << p))) { launch_naive_phase(p, d_in, (float*)d_out, ws, stream); continue; }
        a.ph_lo = p; a.ph_hi = p + 1;
        hipLaunchKernelGGL(mk_fwd, dim3(grid), dim3(NWAVES * 64), LDS_BYTES, stream, a);
    }
#endif
}
```

```cpp
#include <hip/hip_runtime.h>
#include <cstdio>
#include <cstdint>

typedef unsigned short bf16_t;
constexpr int D = 1024, SEQ = 4096, NSEQ = 12, M = NSEQ * SEQ, MP = 4 * SEQ;
constexpr int INW = 1792, DFF = 2816, NGU = 2 * DFF;
constexpr float EPS = 1e-6f, LOG2E = 1.4426950408889634f, QSCALE = 0.125f * LOG2E;

constexpr size_t MiB = 1u << 20;
constexpr size_t WS_CTL = 0;
constexpr size_t WS_WIN = 1 * MiB;
constexpr size_t WS_WO = 5 * MiB;
constexpr size_t WS_WGU = 7 * MiB;
constexpr size_t WS_WDN = 18 * MiB;
constexpr size_t WS_WS = 24 * MiB;
constexpr size_t WS_VSSQ = 25 * MiB;
constexpr size_t WS_SSQ2 = 27 * MiB;
constexpr size_t WS_RS1 = 30 * MiB;
constexpr size_t WS_XN = 32 * MiB;
constexpr size_t WS_PROJ = 128 * MiB;
constexpr size_t WS_H = 32 * MiB;
constexpr size_t WS_MIX = 296 * MiB;
constexpr size_t WS_X1B = 392 * MiB;
constexpr size_t WS_END = 488 * MiB;

__device__ __forceinline__ unsigned f2bf(float f) { unsigned u = __builtin_bit_cast(unsigned, f); return (u + 0x7fffu + ((u >> 16) & 1u)) >> 16; }
__device__ __forceinline__ float bf2f(bf16_t b) { return __builtin_bit_cast(float, (unsigned)b << 16); }
__device__ __forceinline__ float gelu_tanh(float x) { const float u = x * (-2.302208198f - 0.1029432397f * x * x); return x * __builtin_amdgcn_rcpf(1.0f + __builtin_amdgcn_exp2f(u)); }
__device__ __forceinline__ float silu(float x) { return x * __builtin_amdgcn_rcpf(1.0f + __builtin_amdgcn_exp2f(-LOG2E * x)); }
__device__ __forceinline__ int t5_bucket(int rel) { const int n = rel < 0 ? -rel : rel; int b = n < 8 ? n : (2 + (31 - __builtin_clz(n * n))); b = b > 15 ? 15 : b; return b + (rel > 0 ? 16 : 0); }

__device__ __forceinline__ void prep_w_elem(size_t i, const float* w_in, const float* w_o, const float* w_gate, const float* w_up, const float* w_down, const float* w_s, const float* norm2, unsigned char* ws) {
    const size_t N0 = (size_t)INW * D, N1 = (size_t)D * D, N2 = (size_t)NGU * D, N3 = (size_t)D * DFF, N4 = 8 * 128 * 128;
    if (i < N0) { const int n = i / D, k = i % D; ((bf16_t*)(ws + WS_WIN))[i] = f2bf(w_in[(size_t)k * INW + n]); return; } i -= N0;
    if (i < N1) { const int n = i / D, k = i % D; ((bf16_t*)(ws + WS_WO))[i] = f2bf(w_o[(size_t)k * D + n]); return; } i -= N1;
    if (i < N2) { const int r = i / D, k = i % D; const int pn = r >> 8, bj = (r >> 7) & 1, c = r & 127, col = 128 * pn + c;
        ((bf16_t*)(ws + WS_WGU))[i] = f2bf(norm2[k] * (bj ? w_up : w_gate)[(size_t)k * DFF + col]); return; } i -= N2;
    if (i < N3) { const int n = i / DFF, k = i % DFF; ((bf16_t*)(ws + WS_WDN))[i] = f2bf(w_down[(size_t)k * D + n]); return; } i -= N3;
    if (i < N4) { ((bf16_t*)(ws + WS_WS))[i] = f2bf(w_s[i]); }
}
constexpr size_t NPREP = (size_t)INW * D + (size_t)D * D + (size_t)NGU * D + (size_t)D * DFF + 8 * 128 * 128;
__global__ void __launch_bounds__(256) k_prep_w(const float* w_in, const float* w_o, const float* w_gate, const float* w_up, const float* w_down, const float* w_s, const float* norm2, unsigned char* ws) {
    prep_w_elem((size_t)blockIdx.x * 256 + threadIdx.x, w_in, w_o, w_gate, w_up, w_down, w_s, norm2, ws);
}
__device__ __forceinline__ void xn_row(int m, int lane, const float* xp, const float* xs, const float* norm1, bf16_t* XN) {
    const float* x = m < MP ? xp + (size_t)m * D : xs + (size_t)(m - MP) * D;
    float v[16]; float ss = 0.f;
#pragma unroll
    for (int j = 0; j < 16; ++j) { v[j] = x[lane + 64 * j]; ss += v[j] * v[j]; }
#pragma unroll
    for (int o = 1; o < 64; o <<= 1) ss += __shfl_xor(ss, o);
    const float r = rsqrtf(ss * (1.0f / D) + EPS);
#pragma unroll
    for (int j = 0; j < 16; ++j) XN[(size_t)m * D + lane + 64 * j] = f2bf(v[j] * r * norm1[lane + 64 * j]);
}
__global__ void __launch_bounds__(256) k_xn(const float* xp, const float* xs, const float* norm1, bf16_t* XN) { xn_row(blockIdx.x * 4 + (threadIdx.x >> 6), threadIdx.x & 63, xp, xs, norm1, XN); }

template <class Epi, bool DUAL>
__global__ void __launch_bounds__(256) k_gemm_naive(const bf16_t* A, const bf16_t* Bt, int K, Epi epi) {
    __shared__ float As[32][68], Bs[32][68], B2s[DUAL ? 32 : 1][68], Ct[64][65], C2t[DUAL ? 64 : 1][65];
    const int tid = threadIdx.x, ty = tid >> 4, tx = tid & 15, lr = tid >> 2, kc = (tid & 3) * 8;
    const int m0 = blockIdx.y * 64, n0 = blockIdx.x * 64;
    const bf16_t* ap = A + (size_t)(m0 + lr) * K + kc;
    const int br = epi.brow(n0 + lr);
    const bf16_t* bp = Bt + (size_t)br * K + kc;
    const bf16_t* bp2 = Bt + (size_t)(br + 128) * K + kc;
    float acc[4][4] = {}, acc2[4][4] = {};
    for (int k0 = 0; k0 < K; k0 += 32) {
        const uint4 av = *(const uint4*)(ap + k0), bv = *(const uint4*)(bp + k0);
        const unsigned aw[4] = {av.x, av.y, av.z, av.w}, bw[4] = {bv.x, bv.y, bv.z, bv.w};
#pragma unroll
        for (int j = 0; j < 4; ++j) { As[kc + 2 * j][lr] = __builtin_bit_cast(float, aw[j] << 16); As[kc + 2 * j + 1][lr] = __builtin_bit_cast(float, aw[j] & 0xffff0000u);
                                      Bs[kc + 2 * j][lr] = __builtin_bit_cast(float, bw[j] << 16); Bs[kc + 2 * j + 1][lr] = __builtin_bit_cast(float, bw[j] & 0xffff0000u); }
        if (DUAL) { const uint4 cv = *(const uint4*)(bp2 + k0); const unsigned cw[4] = {cv.x, cv.y, cv.z, cv.w};
#pragma unroll
            for (int j = 0; j < 4; ++j) { B2s[kc + 2 * j][lr] = __builtin_bit_cast(float, cw[j] << 16); B2s[kc + 2 * j + 1][lr] = __builtin_bit_cast(float, cw[j] & 0xffff0000u); } }
        __syncthreads();
#pragma unroll 8
        for (int k = 0; k < 32; ++k) {
            float a[4], b[4], b2[4];
#pragma unroll
            for (int i = 0; i < 4; ++i) { a[i] = As[k][4 * ty + i]; b[i] = Bs[k][4 * tx + i]; b2[i] = DUAL ? B2s[k][4 * tx + i] : 0.f; }
#pragma unroll
            for (int i = 0; i < 4; ++i)
#pragma unroll
                for (int j = 0; j < 4; ++j) { acc[i][j] += a[i] * b[j]; if (DUAL) acc2[i][j] += a[i] * b2[j]; }
        }
        __syncthreads();
    }
#pragma unroll
    for (int i = 0; i < 4; ++i)
#pragma unroll
        for (int j = 0; j < 4; ++j) { Ct[4 * ty + i][4 * tx + j] = acc[i][j]; if (DUAL) C2t[4 * ty + i][4 * tx + j] = acc2[i][j]; }
    __syncthreads();
    const int r = tid >> 2, part = tid & 3;
    epi(m0 + r, n0, part, &Ct[r][part * 16], DUAL ? &C2t[r][part * 16] : nullptr);
}
__device__ __forceinline__ float red4(float v) { v += __shfl_xor(v, 1); v += __shfl_xor(v, 2); return v; }
struct NEpiIn {
    bf16_t* PROJ; float* VSSQ; const float* qg; const float* kg;
    __device__ int brow(int n) const { return n; }
    __device__ void operator()(int row, int n0, int part, const float* c, const float*) const {
        const int ct = n0 >> 6; float v[16];
#pragma unroll
        for (int j = 0; j < 16; ++j) v[j] = c[j];
        if (ct < 10) { float ss = 0.f;
#pragma unroll
            for (int j = 0; j < 16; ++j) ss += v[j] * v[j];
            ss = red4(ss); const float r = rsqrtf(ss * (1.0f / 64.0f) + EPS); const float* g = ct < 8 ? qg : kg; const float sc = ct < 8 ? QSCALE : 1.0f;
#pragma unroll
            for (int j = 0; j < 16; ++j) v[j] = v[j] * r * g[part * 16 + j] * sc;
        } else if (ct >= 12) { float ss = 0.f;
#pragma unroll
            for (int j = 0; j < 16; ++j) { v[j] = gelu_tanh(v[j]); ss += v[j] * v[j]; }
            if (ct >= 20) { ss = red4(ss); if (part == 0) VSSQ[(size_t)row * 8 + (ct - 20)] = ss; }
        }
#pragma unroll
        for (int j = 0; j < 16; ++j) PROJ[(size_t)row * INW + n0 + part * 16 + j] = f2bf(v[j]);
    }
};
struct NEpiOut {
    const float* xp; const float* xs; float* out; bf16_t* X1B; float* SSQ2;
    __device__ int brow(int n) const { return n; }
    __device__ void operator()(int row, int n0, int part, const float* c, const float*) const {
        const float* x = row < MP ? xp + (size_t)row * D : xs + (size_t)(row - MP) * D; float ss = 0.f;
#pragma unroll
        for (int j = 0; j < 16; ++j) { const int col = n0 + part * 16 + j; const float v = x[col] + c[j]; out[(size_t)row * D + col] = v; X1B[(size_t)row * D + col] = f2bf(v); ss += v * v; }
        ss = red4(ss); if (part == 0) SSQ2[(size_t)row * 16 + (n0 >> 6)] = ss;
    }
};
struct NEpiUp {
    bf16_t* H; const float* SSQ2;
    __device__ int brow(int n) const { return 256 * (n >> 7) + (n & 127); }
    __device__ void operator()(int row, int n0, int part, const float* c, const float* c2) const {
        float ss = 0.f;
#pragma unroll
        for (int j = 0; j < 16; ++j) ss += SSQ2[(size_t)row * 16 + j];
        const float r = rsqrtf(ss * (1.0f / D) + EPS);
#pragma unroll
        for (int j = 0; j < 16; ++j) H[(size_t)row * DFF + n0 + part * 16 + j] = f2bf(silu(c[j] * r) * (c2[j] * r));
    }
};
struct NEpiDown {
    float* out;
    __device__ int brow(int n) const { return n; }
    __device__ void operator()(int row, int n0, int part, const float* c, const float*) const {
#pragma unroll
        for (int j = 0; j < 16; ++j) { const size_t o = (size_t)row * D + n0 + part * 16 + j; out[o] = out[o] + c[j]; }
    }
};

struct MixNaiveLds { float ps[4][320], qs[4][64], arow[512], grow[512], rv[128], red[4]; };
__device__ __forceinline__ void mix_naive_token(int m, int tid, MixNaiveLds& L, const bf16_t* PROJ, const float* VSSQ, const bf16_t* WSB, const float* rel_table, const float* sink, const float* v_gain,
                                                const float* b_s, const float* ag, const float* gg, bf16_t* MIX) {
    const int s = m / SEQ, t = m % SEQ, w = tid >> 6, lane = tid & 63;
    const bf16_t* prow = PROJ + (size_t)m * INW;
    const int jlo = t - 128 < 0 ? 0 : t - 128, jhi = t + 128 > SEQ - 1 ? SEQ - 1 : t + 128, nk = jhi - jlo + 1;
    for (int hh = 0; hh < 2; ++hh) {
        const int h = w * 2 + hh, g = h >> 2;
        L.qs[w][lane] = bf2f(prow[64 * h + lane]);
        __syncthreads();
        const float sink2 = sink[h] * LOG2E; float sc[5]; float mx = sink2;
#pragma unroll
        for (int i = 0; i < 5; ++i) { const int j = jlo + lane + 64 * i; sc[i] = -1e30f;
            if (j <= jhi) { const bf16_t* kr = PROJ + (size_t)(s * SEQ + j) * INW + 512 + 64 * g; float dot = 0.f;
                for (int d = 0; d < 64; ++d) dot += L.qs[w][d] * bf2f(kr[d]);
                dot += rel_table[t5_bucket(j - t) * 8 + h] * LOG2E; sc[i] = dot; mx = fmaxf(mx, dot); } }
#pragma unroll
        for (int o = 1; o < 64; o <<= 1) mx = fmaxf(mx, __shfl_xor(mx, o));
        float l = 0.f;
#pragma unroll
        for (int i = 0; i < 5; ++i) { const int j = jlo + lane + 64 * i; const float p = j <= jhi ? exp2f(sc[i] - mx) : 0.f; l += p; L.ps[w][lane + 64 * i] = p; }
#pragma unroll
        for (int o = 1; o < 64; o <<= 1) l += __shfl_xor(l, o);
        l += exp2f(sink2 - mx);
        __syncthreads();
        float o = 0.f;
        for (int jj = 0; jj < nk; ++jj) o += L.ps[w][jj] * bf2f(PROJ[(size_t)(s * SEQ + jlo + jj) * INW + 640 + 64 * g + lane]);
        L.arow[64 * h + lane] = o / l;
        __syncthreads();
    }
    const int mc = m - (t & 127), p = t & 127;
    if (tid < 128) { float ss = 0.f; for (int i = 0; i < 8; ++i) ss += VSSQ[(size_t)(mc + tid) * 8 + i]; L.rv[tid] = rsqrtf(ss * (1.0f / 512.0f) + EPS); }
    __syncthreads();
    for (int c = tid; c < 512; c += 256) { const int h = c >> 6; float a = 0.f; const float vg = v_gain[c];
        for (int q = 0; q < 128; ++q) a += bf2f(WSB[(h * 128 + p) * 128 + q]) * (bf2f(PROJ[(size_t)(mc + q) * INW + 1280 + c]) * L.rv[q] * vg);
        L.grow[c] = bf2f(prow[768 + c]) * (a + b_s[h * 128 + p]); }
    __syncthreads();
    float sa = L.arow[tid] * L.arow[tid] + L.arow[tid + 256] * L.arow[tid + 256], sg = L.grow[tid] * L.grow[tid] + L.grow[tid + 256] * L.grow[tid + 256];
#pragma unroll
    for (int o = 1; o < 64; o <<= 1) { sa += __shfl_xor(sa, o); sg += __shfl_xor(sg, o); }
    if (lane == 0) { L.red[w] = sa; } __syncthreads(); sa = L.red[0] + L.red[1] + L.red[2] + L.red[3]; __syncthreads();
    if (lane == 0) { L.red[w] = sg; } __syncthreads(); sg = L.red[0] + L.red[1] + L.red[2] + L.red[3];
    const float ra = rsqrtf(sa * (1.0f / 512.0f) + EPS), rg = rsqrtf(sg * (1.0f / 512.0f) + EPS);
    for (int c = tid; c < 512; c += 256) { MIX[(size_t)m * D + c] = f2bf(L.arow[c] * ra * ag[c]); MIX[(size_t)m * D + 512 + c] = f2bf(L.grow[c] * rg * gg[c]); }
    __syncthreads();
}
__global__ void __launch_bounds__(256) k_mix_naive(const bf16_t* PROJ, const float* VSSQ, const bf16_t* WSB, const float* rel_table, const float* sink, const float* v_gain,
                                                  const float* b_s, const float* ag, const float* gg, bf16_t* MIX) {
    __shared__ MixNaiveLds L;
    mix_naive_token(blockIdx.x, threadIdx.x, L, PROJ, VSSQ, WSB, rel_table, sink, v_gain, b_s, ag, gg, MIX);
}

#define MK_ONE_LAUNCH 1
#define MK_PHASE_MASK 0x3F
#define MK_MIXER_NAIVE 0
#define MK_PROLOGUE_NAIVE 0
#define MK_REPEAT_MASK 0
#define MK_EXTRA_PHASE -1
#define MK_STAGGER_TICKS 0
#define MK_PFLAGS 0
#define MK_MIXER_RING 0
#define MK_NST 0
#define MK_PLAIN_LAUNCH 0
#define MK_ALIGN35 true
#define MK_ALIGN4 true
#define MK_LATE_WEIGHTS 1
#define MK_REV5 2
#define MK_REV2 1
#define MK_LDSROW 1

namespace pg8 {
#define PG8_LAS __attribute__((address_space(3)))
typedef short bf16x8 __attribute__((ext_vector_type(8)));
typedef float f32x4 __attribute__((ext_vector_type(4)));
typedef unsigned u32x4 __attribute__((ext_vector_type(4)));
typedef unsigned u32x2 __attribute__((ext_vector_type(2)));
constexpr int BM = 256, BK = 64, HALF = 128, HTB = HALF * BK * 2  , STAGE_BYTES = 8 * HTB, NXCD = 8, WGM = 8;

__host__ __device__ __forceinline__ int lds_byte(int r, int c) { const int st = (r >> 4) * 2 + (c >> 5), rr = r & 15, cc = c & 31, ob = rr * 64 + cc * 2; return st * 1024 + (ob ^ (((ob >> 9) & 1) << 5)); }
__host__ __device__ __forceinline__ void stage_rc(int b, int& R, int& C) { const int st = b / 1024, sb = b % 1024, swz = sb ^ (((sb >> 9) & 1) << 5); R = (st >> 1) * 16 + swz / 64; C = (st & 1) * 32 + (swz % 64) / 2; }
__host__ __device__ __forceinline__ int perm32(int rho) { const int n = rho >> 4, i = rho & 15; return 8 * (i >> 2) + 4 * n + (i & 3); }

struct Unit { int pm, pn, ui; };
struct Gemm { const bf16_t* A; const bf16_t* Bt; int M, N, K; };

struct StaticOrder {
    int nM, nN, nwg, G, c, wgm, rev;
    __host__ __device__ __forceinline__ void init(int M_, int N_, int G_, int c_) { nM = M_ / BM; nN = N_ / BM; nwg = nM * nN; G = G_; c = c_; wgm = WGM; rev = 0; }
    __host__ __device__ __forceinline__ void reverse() { rev = c < nwg ? (nwg - c + G - 1) / G : 0; }
    __host__ __device__ __forceinline__ bool next(int i, Unit& u) const {
        if (rev > 0 && i >= rev) return false;
        const long L = (long)(rev > 0 ? rev - 1 - i : i) * G + c; if (L >= nwg) return false;
        int wgid = (int)L; { const int q = nwg / NXCD, r = nwg % NXCD, xcd = wgid % NXCD, off = wgid / NXCD; wgid = (xcd < r ? xcd * (q + 1) : r * (q + 1) + (xcd - r) * q) + off; }
        const int nig = wgm * nN, gid = wgid / nig, fm = gid * wgm, gsz = (nM - fm) < wgm ? (nM - fm) : wgm;
        u.pm = fm + ((wgid % nig) % gsz); u.pn = (wgid % nig) / gsz; u.ui = i; return true;
    }
};

__device__ __forceinline__ unsigned cvt_pk_bf16(float lo, float hi) { unsigned r; asm volatile("v_cvt_pk_bf16_f32 %0, %1, %2" : "=v"(r) : "v"(lo), "v"(hi)); return r; }
__device__ __forceinline__ float rsum_fq(float s) { s += __shfl_xor(s, 16); s += __shfl_xor(s, 32); return s; }

struct EpiIn {
    static constexpr int BMAP = 2, NS1 = 8;
    bf16_t* PROJ; float* VSSQ; const float* qg; const float* kg; const PG8_LAS float* RSL; const float* RS1;
    __device__ __forceinline__ void operator()(const f32x4 (&acc)[2][2][4][2], const Unit& u, int wr, int wc, int fr, int fq) const {
        const int ct = 4 * u.pn + wc;
        const int row0 = u.pm * BM + wr * 64 + fr, col0 = u.pn * BM + wc * 64 + 8 * fq;
        float r1[2][4];
        if (u.ui < NS1) { const PG8_LAS float* rp = RSL + u.ui * 256 + wr * 64 + fr;
#pragma unroll
            for (int ai = 0; ai < 2; ++ai)
#pragma unroll
                for (int m = 0; m < 4; ++m) r1[ai][m] = rp[ai * HALF + m * 16];
        } else {
#pragma unroll
            for (int ai = 0; ai < 2; ++ai)
#pragma unroll
                for (int m = 0; m < 4; ++m) r1[ai][m] = RS1[row0 + ai * HALF + m * 16];
        }
        if (ct < 10) {
            const float* g = (ct < 8 ? qg : kg) + 8 * fq; const float sc = ct < 8 ? QSCALE : 1.0f;
            f32x4 gv[2][2];
#pragma unroll
            for (int bj = 0; bj < 2; ++bj)
#pragma unroll
                for (int n = 0; n < 2; ++n) gv[bj][n] = *(const f32x4*)(g + 32 * bj + 4 * n) * sc;
#pragma unroll
            for (int ai = 0; ai < 2; ++ai)
#pragma unroll
                for (int m = 0; m < 4; ++m) {
                    float ss = 0.f;
#pragma unroll
                    for (int bj = 0; bj < 2; ++bj)
#pragma unroll
                        for (int n = 0; n < 2; ++n) { const f32x4 x = acc[ai][bj][m][n]; ss += (x[0] * x[0] + x[1] * x[1]) + (x[2] * x[2] + x[3] * x[3]); }
                    const float rr = r1[ai][m];
                    ss = rsum_fq(ss) * (rr * rr); const float r = rsqrtf(ss * (1.0f / 64.0f) + EPS) * rr;
                    bf16_t* rowp = PROJ + (size_t)(row0 + ai * HALF + m * 16) * INW + col0;
#pragma unroll
                    for (int bj = 0; bj < 2; ++bj) { const f32x4 v0 = acc[ai][bj][m][0] * r * gv[bj][0], v1 = acc[ai][bj][m][1] * r * gv[bj][1];
                        u32x4 w; w.x = cvt_pk_bf16(v0[0], v0[1]); w.y = cvt_pk_bf16(v0[2], v0[3]); w.z = cvt_pk_bf16(v1[0], v1[1]); w.w = cvt_pk_bf16(v1[2], v1[3]);
                        *(u32x4*)(rowp + 32 * bj) = w; }
                }
        } else if (ct < 12) {
#pragma unroll
            for (int ai = 0; ai < 2; ++ai)
#pragma unroll
                for (int m = 0; m < 4; ++m) { bf16_t* rowp = PROJ + (size_t)(row0 + ai * HALF + m * 16) * INW + col0; const float rr = r1[ai][m];
#pragma unroll
                    for (int bj = 0; bj < 2; ++bj) { const f32x4 v0 = acc[ai][bj][m][0] * rr, v1 = acc[ai][bj][m][1] * rr;
                        u32x4 w; w.x = cvt_pk_bf16(v0[0], v0[1]); w.y = cvt_pk_bf16(v0[2], v0[3]); w.z = cvt_pk_bf16(v1[0], v1[1]); w.w = cvt_pk_bf16(v1[2], v1[3]);
                        *(u32x4*)(rowp + 32 * bj) = w; } }
        } else {
#pragma unroll
            for (int ai = 0; ai < 2; ++ai)
#pragma unroll
                for (int m = 0; m < 4; ++m) { const int row = row0 + ai * HALF + m * 16; bf16_t* rowp = PROJ + (size_t)row * INW + col0; float ss = 0.f; const float rr = r1[ai][m];
#pragma unroll
                    for (int bj = 0; bj < 2; ++bj) { f32x4 v0 = acc[ai][bj][m][0] * rr, v1 = acc[ai][bj][m][1] * rr;
#pragma unroll
                        for (int e = 0; e < 4; e += 2) { typedef float f32x2v __attribute__((ext_vector_type(2)));
                            f32x2v x0 = {v0[e], v0[e + 1]}, x1 = {v1[e], v1[e + 1]};
                            const f32x2v u0 = x0 * ((x0 * x0) * (-0.1029432397f) + (-2.302208198f)), u1 = x1 * ((x1 * x1) * (-0.1029432397f) + (-2.302208198f));
                            f32x2v e0, e1; e0.x = __builtin_amdgcn_exp2f(u0.x); e0.y = __builtin_amdgcn_exp2f(u0.y); e1.x = __builtin_amdgcn_exp2f(u1.x); e1.y = __builtin_amdgcn_exp2f(u1.y);
                            const f32x2v d0 = e0 + 1.0f, d1 = e1 + 1.0f; f32x2v s0, s1; s0.x = __builtin_amdgcn_rcpf(d0.x); s0.y = __builtin_amdgcn_rcpf(d0.y); s1.x = __builtin_amdgcn_rcpf(d1.x); s1.y = __builtin_amdgcn_rcpf(d1.y);
                            x0 = x0 * s0; x1 = x1 * s1; v0[e] = x0.x; v0[e + 1] = x0.y; v1[e] = x1.x; v1[e + 1] = x1.y;
                            const f32x2v q = x0 * x0 + x1 * x1; ss += q.x + q.y; }
                        u32x4 w; w.x = cvt_pk_bf16(v0[0], v0[1]); w.y = cvt_pk_bf16(v0[2], v0[3]); w.z = cvt_pk_bf16(v1[0], v1[1]); w.w = cvt_pk_bf16(v1[2], v1[3]);
                        *(u32x4*)(rowp + 32 * bj) = w; }
                    if (ct >= 20) { ss = rsum_fq(ss); if (fq == 0) VSSQ[(size_t)row * 8 + (ct - 20)] = ss; }
                }
        }
    }
};
struct EpiOut {
    static constexpr int BMAP = 2;
    const bf16_t* XB; bf16_t* X1B; float* SSQ2;
    __device__ __forceinline__ void operator()(const f32x4 (&acc)[2][2][4][2], const Unit& u, int wr, int wc, int fr, int fq) const {
        const int row0 = u.pm * BM + wr * 64 + fr, col0 = u.pn * BM + wc * 64 + 8 * fq;
        u32x4 xv[2][4][2];
#pragma unroll
        for (int ai = 0; ai < 2; ++ai)
#pragma unroll
            for (int m = 0; m < 4; ++m)
#pragma unroll
                for (int bj = 0; bj < 2; ++bj) xv[ai][m][bj] = *(const u32x4*)(XB + (size_t)(row0 + ai * HALF + m * 16) * D + col0 + bj * 32);
#pragma unroll
        for (int ai = 0; ai < 2; ++ai)
#pragma unroll
            for (int m = 0; m < 4; ++m) { const int row = row0 + ai * HALF + m * 16; bf16_t* rowp = X1B + (size_t)row * D + col0; float ss = 0.f;
#pragma unroll
                for (int bj = 0; bj < 2; ++bj) { const u32x4 x = xv[ai][m][bj];
                    const f32x4 r0 = {__uint_as_float(x.x << 16), __uint_as_float(x.x & 0xffff0000u), __uint_as_float(x.y << 16), __uint_as_float(x.y & 0xffff0000u)};
                    const f32x4 r1 = {__uint_as_float(x.z << 16), __uint_as_float(x.z & 0xffff0000u), __uint_as_float(x.w << 16), __uint_as_float(x.w & 0xffff0000u)};
                    const f32x4 v0 = r0 + acc[ai][bj][m][0], v1 = r1 + acc[ai][bj][m][1];
                    u32x4 w; w.x = cvt_pk_bf16(v0[0], v0[1]); w.y = cvt_pk_bf16(v0[2], v0[3]); w.z = cvt_pk_bf16(v1[0], v1[1]); w.w = cvt_pk_bf16(v1[2], v1[3]);
                    *(u32x4*)(rowp + bj * 32) = w;
                    ss += ((v0[0] * v0[0] + v0[1] * v0[1]) + (v0[2] * v0[2] + v0[3] * v0[3])) + ((v1[0] * v1[0] + v1[1] * v1[1]) + (v1[2] * v1[2] + v1[3] * v1[3])); }
                ss = rsum_fq(ss); if (fq == 0) SSQ2[(size_t)row * 16 + 4 * u.pn + wc] = ss; }
    }
};
struct EpiUp {
    static constexpr int BMAP = 1;
    bf16_t* H; const PG8_LAS float* RS; const float* SSQ2;
    __device__ __forceinline__ void operator()(const f32x4 (&acc)[2][2][4][2], const Unit& u, int wr, int wc, int fr, int fq) const {
        const int row0 = u.pm * BM + wr * 64 + fr, col0 = u.pn * HALF + wc * 32 + 8 * fq;
        const int slot = (u.pm >> 3) % 3;
        float rs[2][4];
        if (((const PG8_LAS int*)(RS + 768))[slot] == u.pm) {
            const PG8_LAS float* rsp = RS + slot * 256 + wr * 64 + fr;
#pragma unroll
            for (int ai = 0; ai < 2; ++ai)
#pragma unroll
                for (int m = 0; m < 4; ++m) rs[ai][m] = rsp[ai * HALF + m * 16];
        } else {
#pragma unroll
            for (int ai = 0; ai < 2; ++ai)
#pragma unroll
                for (int m = 0; m < 4; ++m) { const f32x4 pl = *(const f32x4*)(SSQ2 + (size_t)(row0 + ai * HALF + m * 16) * 16 + 4 * fq);
                    rs[ai][m] = rsqrtf(rsum_fq((pl[0] + pl[1]) + (pl[2] + pl[3])) * (1.0f / D) + EPS); }
        }
#pragma unroll
        for (int ai = 0; ai < 2; ++ai)
#pragma unroll
            for (int m = 0; m < 4; ++m) { const int row = row0 + ai * HALF + m * 16; const float r = rs[ai][m], kk = __builtin_amdgcn_rcpf(r * r), c1 = -LOG2E * r;
                unsigned wq[4];
#pragma unroll
                for (int n = 0; n < 2; ++n)
#pragma unroll
                    for (int e = 0; e < 4; e += 2) { typedef float f32x2v __attribute__((ext_vector_type(2)));
                        const f32x2v gg2 = {acc[ai][0][m][n][e], acc[ai][0][m][n][e + 1]}, uu2 = {acc[ai][1][m][n][e], acc[ai][1][m][n][e + 1]};
                        const f32x2v cc = gg2 * c1; f32x2v ee; ee.x = __builtin_amdgcn_exp2f(cc.x); ee.y = __builtin_amdgcn_exp2f(cc.y);
                        const f32x2v dd = ee * kk + kk; f32x2v ss; ss.x = __builtin_amdgcn_rcpf(dd.x); ss.y = __builtin_amdgcn_rcpf(dd.y);
                        const f32x2v hh = (gg2 * uu2) * ss;
                        wq[2 * n + (e >> 1)] = cvt_pk_bf16(hh.x, hh.y); }
                const u32x4 w = {wq[0], wq[1], wq[2], wq[3]};
                *(u32x4*)(H + (size_t)row * DFF + col0) = w; }
    }
};
struct EpiUpFullLine {
    static constexpr int BMAP = 1;
    bf16_t* H; const PG8_LAS float* RS; const float* SSQ2;
    __device__ __forceinline__ void operator()(const f32x4 (&acc)[2][2][4][2], const Unit& u, int wr, int wc, int fr, int fq) const {
        const int row0 = u.pm * BM + wr * 64 + fr, col0 = u.pn * HALF + wc * 32 + 8 * fq;
        const int slot = (u.pm >> 3) % 3;
        float rs[2][4];
        if (((const PG8_LAS int*)(RS + 768))[slot] == u.pm) {
            const PG8_LAS float* rsp = RS + slot * 256 + wr * 64 + fr;
#pragma unroll
            for (int ai = 0; ai < 2; ++ai)
#pragma unroll
                for (int m = 0; m < 4; ++m) rs[ai][m] = rsp[ai * HALF + m * 16];
        } else {
#pragma unroll
            for (int ai = 0; ai < 2; ++ai)
#pragma unroll
                for (int m = 0; m < 4; ++m) { const f32x4 pl = *(const f32x4*)(SSQ2 + (size_t)(row0 + ai * HALF + m * 16) * 16 + 4 * fq);
                    rs[ai][m] = rsqrtf(rsum_fq((pl[0] + pl[1]) + (pl[2] + pl[3])) * (1.0f / D) + EPS); }
        }
#pragma unroll
        for (int ai = 0; ai < 2; ++ai)
#pragma unroll
            for (int m = 0; m < 4; ++m) { const int row = row0 + ai * HALF + m * 16; const float r = rs[ai][m], r2 = r * r, c1 = -LOG2E * r;
                f32x4 h0, h1;
#pragma unroll
                for (int n = 0; n < 2; ++n)
#pragma unroll
                    for (int e = 0; e < 4; e += 2) { typedef float f32x2v __attribute__((ext_vector_type(2)));
                        const f32x2v gg2 = {acc[ai][0][m][n][e], acc[ai][0][m][n][e + 1]}, uu2 = {acc[ai][1][m][n][e], acc[ai][1][m][n][e + 1]};
                        const f32x2v cc = gg2 * c1; f32x2v ee; ee.x = __builtin_amdgcn_exp2f(cc.x); ee.y = __builtin_amdgcn_exp2f(cc.y);
                        const f32x2v dd = ee + 1.0f; f32x2v ss; ss.x = __builtin_amdgcn_rcpf(dd.x); ss.y = __builtin_amdgcn_rcpf(dd.y);
                        const f32x2v hh = ((gg2 * uu2) * r2) * ss;
                        if (n == 0) { h0[e] = hh.x; h0[e + 1] = hh.y; } else { h1[e] = hh.x; h1[e + 1] = hh.y; } }
                u32x4 w; w.x = cvt_pk_bf16(h0[0], h0[1]); w.y = cvt_pk_bf16(h0[2], h0[3]); w.z = cvt_pk_bf16(h1[0], h1[1]); w.w = cvt_pk_bf16(h1[2], h1[3]);
                { const int l = fr + 16 * fq; *(u32x4*)(H + (size_t)(u.pm * BM + ai * HALF + wr * 64 + m * 16 + 8 * (wc & 1) + (l >> 3)) * DFF + u.pn * HALF + 64 * (wc >> 1) + (l & 7) * 8) = w; } }
    }
};
struct EpiDown {
    static constexpr int BMAP = 2;
    const bf16_t* X1B; float* out;
    __device__ __forceinline__ void operator()(const f32x4 (&acc)[2][2][4][2], const Unit& u, int wr, int wc, int fr, int fq) const {
        const int row0 = u.pm * BM + wr * 64 + fr, col0 = u.pn * BM + wc * 64 + 8 * fq;
        u32x4 xv[2][4][2];
#pragma unroll
        for (int ai = 0; ai < 2; ++ai)
#pragma unroll
            for (int m = 0; m < 4; ++m)
#pragma unroll
                for (int bj = 0; bj < 2; ++bj) xv[ai][m][bj] = *(const u32x4*)(X1B + (size_t)(row0 + ai * HALF + m * 16) * D + col0 + bj * 32);
#pragma unroll
        for (int ai = 0; ai < 2; ++ai)
#pragma unroll
            for (int m = 0; m < 4; ++m) { float* rowp = out + (size_t)(row0 + ai * HALF + m * 16) * D + col0;
#pragma unroll
                for (int bj = 0; bj < 2; ++bj) { const u32x4 x = xv[ai][m][bj];
                    const f32x4 r0 = {__uint_as_float(x.x << 16), __uint_as_float(x.x & 0xffff0000u), __uint_as_float(x.y << 16), __uint_as_float(x.y & 0xffff0000u)};
                    const f32x4 r1 = {__uint_as_float(x.z << 16), __uint_as_float(x.z & 0xffff0000u), __uint_as_float(x.w << 16), __uint_as_float(x.w & 0xffff0000u)};
                    *(f32x4*)(rowp + bj * 32) = r0 + acc[ai][bj][m][0]; *(f32x4*)(rowp + bj * 32 + 4) = r1 + acc[ai][bj][m][1]; } }
    }
};
struct EpiNone {
    static constexpr int BMAP = 1;
    __device__ __forceinline__ void operator()(const f32x4 (&acc)[2][2][4][2], const Unit& u, int wr, int wc, int fr, int fq) const {
#pragma unroll
        for (int ai = 0; ai < 2; ++ai)
#pragma unroll
            for (int bj = 0; bj < 2; ++bj)
#pragma unroll
                for (int m = 0; m < 4; ++m)
#pragma unroll
                    for (int n = 0; n < 2; ++n) asm volatile("" :: "v"(acc[ai][bj][m][n]));
    }
};


template <int MODE> struct EpiDownProbe {
    static constexpr int BMAP = 0;
    const bf16_t* X1B; float* out;
    __device__ __forceinline__ void operator()(const f32x4 (&acc)[2][2][4][2], const Unit& u, int wr, int wc, int fr, int fq) const {
        const int row0 = u.pm * BM + wr * 64 + fr, col0 = u.pn * BM + wc * 32 + 4 * fq;
        u32x2 xv[2][4][2][2];
#pragma unroll
        for (int ai = 0; ai < 2; ++ai)
#pragma unroll
            for (int m = 0; m < 4; ++m)
#pragma unroll
                for (int bj = 0; bj < 2; ++bj)
#pragma unroll
                    for (int n = 0; n < 2; ++n) { if (MODE == 2) xv[ai][m][bj][n] = *(const u32x2*)(X1B + (size_t)(row0 + ai * HALF + m * 16) * D + col0 + bj * HALF + n * 16); else xv[ai][m][bj][n] = (u32x2){0u, 0u}; }
#pragma unroll
        for (int ai = 0; ai < 2; ++ai)
#pragma unroll
            for (int m = 0; m < 4; ++m) { float* rowp = out + (size_t)(row0 + ai * HALF + m * 16) * D + col0;
#pragma unroll
                for (int bj = 0; bj < 2; ++bj)
#pragma unroll
                    for (int n = 0; n < 2; ++n) { const u32x2 x = xv[ai][m][bj][n];
                        const f32x4 r = {__uint_as_float(x.x << 16), __uint_as_float(x.x & 0xffff0000u), __uint_as_float(x.y << 16), __uint_as_float(x.y & 0xffff0000u)};
                        const f32x4 v = r + acc[ai][bj][m][n];
                        if (MODE == 1) __builtin_nontemporal_store(v, (f32x4*)(rowp + bj * HALF + n * 16)); else asm volatile("" :: "v"(v)); } }
    }
};

template <class Epi, class Sched, bool ALIGN_EPI, int KMODE = 0>
__device__ __forceinline__ void gemm_phase(PG8_LAS unsigned char* lds, const Gemm g, const Sched& S, const Epi& E) {
    int tid_ = threadIdx.x; asm volatile("" : "+v"(tid_));
    const int tid = tid_, wid = __builtin_amdgcn_readfirstlane(tid >> 6), lane = tid & 63, wr = wid >> 2, wc = wid & 3, fr = lane & 15, fq = lane >> 4;
    const int K = g.K, nt = K / BK;
    unsigned voffA, voffB;
    { int R, C;
#if MK_LDSROW
      R = 8 * wid + (lane >> 3); C = 8 * ((lane & 7) ^ ((R >> 1) & 7));
#else
      stage_rc(tid * 16, R, C);
#endif
      const int Rb = Epi::BMAP == 0 ? R : Epi::BMAP == 1 ? ((R & ~31) + perm32(R & 31)) : (64 * (R >> 5) + perm32(R & 31));
      voffA = (unsigned)(R * K + C) * 2u; voffB = (unsigned)(Rb * K + C) * 2u; }
    const size_t pstepA = (size_t)64 * K * 2, pstepB = (size_t)(Epi::BMAP == 2 ? 128 : 64) * K * 2;
    const size_t kstep = (size_t)(BK * 2);
    const size_t hstep = (size_t)HALF * K * 2;
    const size_t hstepB = Epi::BMAP == 2 ? (size_t)32 * K * 2 : hstep;
    const size_t tstep = 2 * hstep;
    const unsigned ldsw = (unsigned)wid * 1024u;
#if MK_LDSROW
    const int aoff = (wr * 64 + fr) * 128 + ((fq ^ (((wr * 64 + fr) >> 1) & 7)) << 4), boff = (wc * 32 + fr) * 128 + ((fq ^ (((wc * 32 + fr) >> 1) & 7)) << 4);
#define PG8_KOFF(off, k) ((off) ^ ((k) << 6))
#else
    const int aoff = lds_byte(wr * 64 + fr, fq * 8), boff = lds_byte(wc * 32 + fr, fq * 8);
#define PG8_KOFF(off, k) ((off) + (k) * 1024)
#endif
#define PG8_SA(b, h) (((b) * 2 + (h)) * HTB)
#define PG8_SB(b, h) ((4 + (b) * 2 + (h)) * HTB)
#define PG8_STAGE(bufoff, gbase, X) do { if (KMODE != 1) { _Pragma("unroll") for (int _i = 0; _i < 2; ++_i) \
        __builtin_amdgcn_global_load_lds((const unsigned*)((const char*)(KMODE == 2 ? (const void*)g.Bt : (const void*)(gbase)) + (size_t)_i * pstep##X + voff##X), (PG8_LAS unsigned*)(lds + (bufoff) + ldsw + _i * 8192), 16, 0, 0); } } while (0)
#define PG8_LDA(dst, b, h) do { if (KMODE != 3) { _Pragma("unroll") for (int m = 0; m < 4; ++m) _Pragma("unroll") for (int k = 0; k < 2; ++k) dst[m][k] = *(const PG8_LAS bf16x8*)(lds + PG8_SA(b, h) + PG8_KOFF(aoff, k) + m * 2048); } else { _Pragma("unroll") for (int m = 0; m < 4; ++m) _Pragma("unroll") for (int k = 0; k < 2; ++k) asm volatile("" : "+v"(dst[m][k])); } } while (0)
#define PG8_LDB(dst, b, h) do { if (KMODE != 3) { _Pragma("unroll") for (int n = 0; n < 2; ++n) _Pragma("unroll") for (int k = 0; k < 2; ++k) dst[n][k] = *(const PG8_LAS bf16x8*)(lds + PG8_SB(b, h) + PG8_KOFF(boff, k) + n * 2048); } else { _Pragma("unroll") for (int n = 0; n < 2; ++n) _Pragma("unroll") for (int k = 0; k < 2; ++k) asm volatile("" : "+v"(dst[n][k])); } } while (0)
#define PG8_MMA(ai, bj, At, Bt) do { __builtin_amdgcn_s_setprio(1); _Pragma("unroll") for (int m = 0; m < 4; ++m) _Pragma("unroll") for (int n = 0; n < 2; ++n) _Pragma("unroll") for (int k = 0; k < 2; ++k) \
        acc[ai][bj][m][n] = __builtin_amdgcn_mfma_f32_16x16x32_bf16(Bt[n][k], At[m][k], acc[ai][bj][m][n], 0, 0, 0); __builtin_amdgcn_s_setprio(0); } while (0)
#define PG8_WAIT_V(n) asm volatile("s_waitcnt vmcnt(" #n ")" ::: "memory")
#define PG8_WAIT_L(n) asm volatile("s_waitcnt lgkmcnt(" #n ")" ::: "memory")
#define PG8_BAR __builtin_amdgcn_s_barrier()
#define PG8_SCHED __builtin_amdgcn_sched_barrier(0)
    Unit cur, nxt; int ui = 0;
    if (!S.next(0, cur)) return;
    f32x4 acc[2][2][4][2];
#pragma unroll
    for (int a = 0; a < 2; ++a)
#pragma unroll
        for (int b = 0; b < 2; ++b)
#pragma unroll
            for (int m = 0; m < 4; ++m)
#pragma unroll
                for (int n = 0; n < 2; ++n) acc[a][b][m][n] = (f32x4){0.f, 0.f, 0.f, 0.f};
    bf16x8 At[4][2], B0[2][2], B1[2][2];
    if (KMODE == 3) { _Pragma("unroll") for (int m = 0; m < 4; ++m) _Pragma("unroll") for (int k = 0; k < 2; ++k) At[m][k] = (bf16x8){1, 2, 3, 4, 5, 6, 7, 8}; _Pragma("unroll") for (int n = 0; n < 2; ++n) _Pragma("unroll") for (int k = 0; k < 2; ++k) { B0[n][k] = (bf16x8){1, 2, 3, 4, 5, 6, 7, 8}; B1[n][k] = B0[n][k]; } }
    const char* cA = (const char*)g.A + (size_t)cur.pm * tstep; const char* cB = (const char*)g.Bt + (size_t)cur.pn * tstep;
    PG8_STAGE(PG8_SB(0, 0), cB, B); PG8_STAGE(PG8_SB(0, 1), cB + hstepB, B); PG8_STAGE(PG8_SA(0, 0), cA, A); PG8_STAGE(PG8_SA(0, 1), cA + hstep, A);
    if (wr == 1) PG8_BAR;
    PG8_WAIT_V(2); PG8_BAR;
    PG8_STAGE(PG8_SB(1, 0), cB + kstep, B); PG8_STAGE(PG8_SA(1, 0), cA + kstep, A); PG8_STAGE(PG8_SB(1, 1), cB + hstepB + kstep, B);
    PG8_WAIT_V(6); PG8_BAR;
    for (;;) {
        const bool has_next = S.next(ui + 1, nxt);
        const char* nA = has_next ? (const char*)g.A + (size_t)nxt.pm * tstep : cA; const char* nB = has_next ? (const char*)g.Bt + (size_t)nxt.pn * tstep : cB;
        for (int t = 0; t < nt; t += 2) {
            const bool last = (t == nt - 2);
            const char* a1 = cA + (size_t)(t + 1) * kstep;
            const char* a2 = last ? nA : cA + (size_t)(t + 2) * kstep; const char* b2 = last ? nB : cB + (size_t)(t + 2) * kstep;
            const char* a3 = a2 + kstep; const char* b3 = b2 + kstep;
            if constexpr (KMODE == 4) {
            PG8_LDB(B0, 0, 0); PG8_LDB(B1, 0, 1); PG8_SCHED; PG8_LDA(At, 0, 0);
            PG8_WAIT_V(6); PG8_WAIT_L(0); PG8_BAR; PG8_STAGE(PG8_SA(1, 1), a1 + hstep, A); PG8_MMA(0, 0, At, B0); PG8_MMA(0, 1, At, B1); PG8_BAR; PG8_SCHED;
            PG8_LDA(At, 0, 1);
            PG8_WAIT_V(2); PG8_WAIT_L(0); PG8_BAR; PG8_STAGE(PG8_SB(0, 0), b2, B); PG8_STAGE(PG8_SB(0, 1), b2 + hstepB, B); PG8_STAGE(PG8_SA(0, 0), a2, A); PG8_MMA(1, 0, At, B0); PG8_MMA(1, 1, At, B1); PG8_BAR; PG8_SCHED;
            PG8_LDB(B0, 1, 0); PG8_LDB(B1, 1, 1); PG8_SCHED; PG8_LDA(At, 1, 0);
            PG8_WAIT_V(6); PG8_WAIT_L(0); PG8_BAR; PG8_STAGE(PG8_SA(0, 1), a2 + hstep, A); PG8_MMA(0, 0, At, B0); PG8_MMA(0, 1, At, B1); PG8_BAR; PG8_SCHED;
            PG8_LDA(At, 1, 1);
            PG8_WAIT_V(2); PG8_WAIT_L(0); PG8_BAR; PG8_STAGE(PG8_SB(1, 0), b3, B); PG8_STAGE(PG8_SB(1, 1), b3 + hstepB, B); PG8_STAGE(PG8_SA(1, 0), a3, A); PG8_MMA(1, 0, At, B0); PG8_MMA(1, 1, At, B1); PG8_BAR; PG8_SCHED;
            } else {
            PG8_LDB(B0, 0, 0); PG8_LDB(B1, 0, 1); PG8_SCHED; PG8_LDA(At, 0, 0); PG8_STAGE(PG8_SA(1, 1), a1 + hstep, A);
            PG8_WAIT_V(8); PG8_WAIT_L(0); PG8_BAR; PG8_MMA(0, 0, At, B0); PG8_MMA(0, 1, At, B1); PG8_BAR; PG8_SCHED;
            PG8_LDA(At, 0, 1); PG8_STAGE(PG8_SB(0, 0), b2, B); PG8_STAGE(PG8_SB(0, 1), b2 + hstepB, B); PG8_STAGE(PG8_SA(0, 0), a2, A);
            PG8_WAIT_V(8); PG8_WAIT_L(0); PG8_BAR; PG8_MMA(1, 0, At, B0); PG8_MMA(1, 1, At, B1); PG8_BAR; PG8_SCHED;
            PG8_LDB(B0, 1, 0); PG8_LDB(B1, 1, 1); PG8_SCHED; PG8_LDA(At, 1, 0); PG8_STAGE(PG8_SA(0, 1), a2 + hstep, A);
            PG8_WAIT_V(8); PG8_WAIT_L(0); PG8_BAR; PG8_MMA(0, 0, At, B0); PG8_MMA(0, 1, At, B1); PG8_BAR; PG8_SCHED;
            PG8_LDA(At, 1, 1); PG8_STAGE(PG8_SB(1, 0), b3, B); PG8_STAGE(PG8_SB(1, 1), b3 + hstepB, B); PG8_STAGE(PG8_SA(1, 0), a3, A);
            PG8_WAIT_V(8); PG8_WAIT_L(0); PG8_BAR; PG8_MMA(1, 0, At, B0); PG8_MMA(1, 1, At, B1); PG8_BAR; PG8_SCHED;
                    }
        }
        if constexpr (ALIGN_EPI) { if (wr == 0) PG8_BAR; }
        E(acc, cur, wr, wc, fr, fq);
        if (!has_next) break;
        bf16x8 zfrag = {0, 0, 0, 0, 0, 0, 0, 0}; asm volatile("" : "+v"(zfrag));
#pragma unroll
        for (int a = 0; a < 2; ++a)
#pragma unroll
            for (int b = 0; b < 2; ++b)
#pragma unroll
                for (int m = 0; m < 4; ++m)
#pragma unroll
                    for (int n = 0; n < 2; ++n) acc[a][b][m][n] = __builtin_amdgcn_mfma_f32_16x16x32_bf16(zfrag, zfrag, (f32x4){0.f, 0.f, 0.f, 0.f}, 0, 0, 0);
        cur = nxt; cA = nA; cB = nB; ++ui;
        if constexpr (ALIGN_EPI) { if (wr == 1) PG8_BAR; }
    }
    PG8_WAIT_V(0);
    if constexpr (!ALIGN_EPI) { if (wr == 0) PG8_BAR; }
    PG8_BAR;
#undef PG8_SA
#undef PG8_KOFF
#undef PG8_SB
#undef PG8_STAGE
#undef PG8_LDA
#undef PG8_LDB
#undef PG8_MMA
#undef PG8_WAIT_V
#undef PG8_WAIT_L
#undef PG8_BAR
#undef PG8_SCHED
}
}
#define LAS __attribute__((address_space(3)))

struct Args;
__device__ __forceinline__ void p0_prologue_naive(const float* const* in, unsigned char* ws, int G) {
    const size_t gt = (size_t)blockIdx.x * 512 + threadIdx.x, GT = (size_t)G * 512;
    for (size_t i = gt; i < NPREP; i += GT) prep_w_elem(i, in[4], in[13], in[15], in[16], in[17], in[9], in[14], ws);
    const int wave = threadIdx.x >> 6, lane = threadIdx.x & 63;
    for (int m = blockIdx.x * 8 + wave; m < M; m += G * 8) xn_row(m, lane, in[0], in[1], in[3], (bf16_t*)(ws + WS_XN));
}


__device__ __forceinline__ unsigned pk2(float lo, float hi) { return f2bf(lo) | (f2bf(hi) << 16); }
__device__ __forceinline__ void p0_item(const float* W, int K, int N, bf16_t* WT, int orow0, const float* kscale, LAS float* scr, int k0, int n0, int lane) {
    typedef unsigned v4u __attribute__((ext_vector_type(4)));
    float wv[32];
#pragma unroll
    for (int i = 0; i < 32; ++i) wv[i] = W[(size_t)(k0 + 2 * i + (lane >> 5)) * N + n0 + (lane & 31)];
    if (kscale) {
#pragma unroll
        for (int i = 0; i < 32; ++i) wv[i] *= kscale[k0 + 2 * i + (lane >> 5)]; }
#pragma unroll
    for (int i = 0; i < 32; ++i) scr[(2 * i + (lane >> 5)) * 33 + (lane & 31)] = wv[i];
    asm volatile("s_waitcnt lgkmcnt(0)" ::: "memory");
    const int c = lane & 7;
#pragma unroll
    for (int j = 0; j < 4; ++j) { const int n = (lane >> 3) + 8 * j; const LAS float* s = scr + (8 * c) * 33 + n;
        v4u o; o.x = pk2(s[0 * 33], s[1 * 33]); o.y = pk2(s[2 * 33], s[3 * 33]); o.z = pk2(s[4 * 33], s[5 * 33]); o.w = pk2(s[6 * 33], s[7 * 33]);
        *(v4u*)(WT + (size_t)(orow0 + n) * K + k0 + 8 * c) = o; }
    asm volatile("s_waitcnt lgkmcnt(0)" ::: "memory");
}
__device__ __forceinline__ void p0_weights(const float* const* in, unsigned char* ws, LAS unsigned char* lds, int it_lo, int it_hi, int w, int nw) {
    const int wave = __builtin_amdgcn_readfirstlane(threadIdx.x >> 6), lane = threadIdx.x & 63;
    LAS float* scr = (LAS float*)(lds + wave * 16384);
    constexpr int I_IN = (D / 64) * (INW / 32), I_O = (D / 64) * (D / 32), I_G = (D / 64) * (DFF / 32);
    bf16_t* WIN = (bf16_t*)(ws + WS_WIN); bf16_t* WO = (bf16_t*)(ws + WS_WO); bf16_t* WGU = (bf16_t*)(ws + WS_WGU); bf16_t* WDN = (bf16_t*)(ws + WS_WDN);
    for (int it = it_lo + w; it < it_hi; it += nw) {
        int r = it;
        if (r < I_IN) { const int nb = r % (INW / 32), kb = r / (INW / 32); p0_item(in[4], D, INW, WIN, 32 * nb, in[3], scr, 64 * kb, 32 * nb, lane); continue; } r -= I_IN;
        if (r < I_O) { const int nb = r % (D / 32), kb = r / (D / 32); p0_item(in[13], D, D, WO, 32 * nb, nullptr, scr, 64 * kb, 32 * nb, lane); continue; } r -= I_O;
        if (r < 2 * I_G) { const int up = r >= I_G; if (up) r -= I_G; const int nb = r % (DFF / 32), kb = r / (DFF / 32), n0 = 32 * nb;
            p0_item(in[up ? 16 : 15], D, DFF, WGU, 256 * (n0 >> 7) + (n0 & 127) + 128 * up, in[14], scr, 64 * kb, n0, lane); continue; } r -= 2 * I_G;
        { const int nb = r % (D / 32), kb = r / (D / 32); p0_item(in[17], DFF, D, WDN, 32 * nb, nullptr, scr, 64 * kb, 32 * nb, lane); }
    }
}
constexpr int P0_I_IN = (D / 64) * (INW / 32), P0_NITEMS = P0_I_IN + (D / 64) * (D / 32) + 2 * (D / 64) * (DFF / 32) + (DFF / 64) * (D / 32);
__device__ __forceinline__ void p0_prologue(const float* const* in, unsigned char* ws, LAS unsigned char* lds, int G) {
    const int wave = __builtin_amdgcn_readfirstlane(threadIdx.x >> 6), lane = threadIdx.x & 63;
    const int gw = (int)blockIdx.x * 8 + wave, NGW = G * 8;
    p0_weights(in, ws, lds, 0, MK_LATE_WEIGHTS ? P0_I_IN : P0_NITEMS, gw, NGW);
    { const size_t gt = (size_t)blockIdx.x * 512 + threadIdx.x; bf16_t* WSB = (bf16_t*)(ws + WS_WS); for (size_t i = gt; i < 8 * 128 * 128; i += (size_t)G * 512) WSB[i] = f2bf(in[9][i]); }
    typedef float f32x4 __attribute__((ext_vector_type(4)));
    bf16_t* XB = (bf16_t*)(ws + WS_XN); float* RS1 = (float*)(ws + WS_RS1);
    for (int m4 = gw * 4; m4 < M; m4 += NGW * 4) {
        const f32x4* xr = (const f32x4*)(m4 < MP ? in[0] + (size_t)m4 * D : in[1] + (size_t)(m4 - MP) * D) + lane;
        f32x4 v[4][4]; float ss[4];
#pragma unroll
        for (int r = 0; r < 4; ++r)
#pragma unroll
            for (int j = 0; j < 4; ++j) v[r][j] = __builtin_nontemporal_load(xr + r * (D / 4) + 64 * j);
#pragma unroll
        for (int r = 0; r < 4; ++r) { ss[r] = 0.f;
            unsigned long long* b8 = (unsigned long long*)(XB + (size_t)(m4 + r) * D) + lane;
#pragma unroll
            for (int j = 0; j < 4; ++j) { ss[r] += (v[r][j][0] * v[r][j][0] + v[r][j][1] * v[r][j][1]) + (v[r][j][2] * v[r][j][2] + v[r][j][3] * v[r][j][3]);
                b8[64 * j] = (unsigned long long)pk2(v[r][j][0], v[r][j][1]) | ((unsigned long long)pk2(v[r][j][2], v[r][j][3]) << 32); } }
#pragma unroll
        for (int o = 1; o < 64; o <<= 1) {
#pragma unroll
            for (int r = 0; r < 4; ++r) ss[r] += __shfl_xor(ss[r], o); }
        if (lane < 4) RS1[m4 + lane] = rsqrtf((lane == 0 ? ss[0] : lane == 1 ? ss[1] : lane == 2 ? ss[2] : ss[3]) * (1.0f / D) + EPS);
    }
}

__device__ __forceinline__ void p2_mixer_naive(const float* const* in, unsigned char* ws, unsigned char* lds_generic, int G) {
    MixNaiveLds* L = (MixNaiveLds*)lds_generic + (threadIdx.x >> 8);
    for (int pr = blockIdx.x; pr < M / 2; pr += G)
        mix_naive_token(2 * pr + (threadIdx.x >> 8), threadIdx.x & 255, *L, (const bf16_t*)(ws + WS_PROJ), (const float*)(ws + WS_VSSQ), (const bf16_t*)(ws + WS_WS), in[2], in[7], in[8], in[10], in[11], in[12], (bf16_t*)(ws + WS_MIX));
}

static void launch_naive_phase(int p, void* const* d_in, float* out, unsigned char* ws, hipStream_t stream) {
    const float* xp = (const float*)d_in[0]; const float* xs = (const float*)d_in[1]; const float* rel = (const float*)d_in[2]; const float* norm1 = (const float*)d_in[3];
    const float* w_in = (const float*)d_in[4]; const float* qg = (const float*)d_in[5]; const float* kg = (const float*)d_in[6]; const float* sink = (const float*)d_in[7];
    const float* vg = (const float*)d_in[8]; const float* w_s = (const float*)d_in[9]; const float* b_s = (const float*)d_in[10]; const float* ag = (const float*)d_in[11];
    const float* gg = (const float*)d_in[12]; const float* w_o = (const float*)d_in[13]; const float* norm2 = (const float*)d_in[14]; const float* w_gate = (const float*)d_in[15];
    const float* w_up = (const float*)d_in[16]; const float* w_down = (const float*)d_in[17];
    bf16_t* WIN = (bf16_t*)(ws + WS_WIN); bf16_t* WO = (bf16_t*)(ws + WS_WO); bf16_t* WGU = (bf16_t*)(ws + WS_WGU); bf16_t* WDN = (bf16_t*)(ws + WS_WDN); bf16_t* WSB = (bf16_t*)(ws + WS_WS);
    float* VSSQ = (float*)(ws + WS_VSSQ); float* SSQ2 = (float*)(ws + WS_SSQ2);
    bf16_t* XN = (bf16_t*)(ws + WS_XN); bf16_t* PROJ = (bf16_t*)(ws + WS_PROJ); bf16_t* H = (bf16_t*)(ws + WS_H); bf16_t* MIX = (bf16_t*)(ws + WS_MIX); bf16_t* X1B = (bf16_t*)(ws + WS_X1B);
    switch (p) {
    case 0: k_prep_w<<<(unsigned)((NPREP + 255) / 256), 256, 0, stream>>>(w_in, w_o, w_gate, w_up, w_down, w_s, norm2, ws);
            k_xn<<<M / 4, 256, 0, stream>>>(xp, xs, norm1, XN); break;
    case 1: k_gemm_naive<NEpiIn, false><<<dim3(INW / 64, M / 64), 256, 0, stream>>>(XN, WIN, D, NEpiIn{PROJ, VSSQ, qg, kg}); break;
    case 2: k_mix_naive<<<M, 256, 0, stream>>>(PROJ, VSSQ, WSB, rel, sink, vg, b_s, ag, gg, MIX); break;
    case 3: k_gemm_naive<NEpiOut, false><<<dim3(D / 64, M / 64), 256, 0, stream>>>(MIX, WO, D, NEpiOut{xp, xs, out, X1B, SSQ2}); break;
    case 4: k_gemm_naive<NEpiUp, true><<<dim3(DFF / 64, M / 64), 256, 0, stream>>>(X1B, WGU, D, NEpiUp{H, SSQ2}); break;
    case 5: k_gemm_naive<NEpiDown, false><<<dim3(D / 64, M / 64), 256, 0, stream>>>(H, WDN, DFF, NEpiDown{out}); break;
    }
}

namespace mix {
typedef short bf16x8 __attribute__((ext_vector_type(8)));
typedef short s16x4 __attribute__((ext_vector_type(4)));
typedef float f32x16 __attribute__((ext_vector_type(16)));
typedef float f32x4 __attribute__((ext_vector_type(4)));
typedef unsigned u32x2 __attribute__((ext_vector_type(2)));
typedef unsigned u32x4 __attribute__((ext_vector_type(4)));
typedef float f32x2_t __attribute__((ext_vector_type(2))); typedef __bf16 bf16x2_t __attribute__((ext_vector_type(2)));
constexpr int L_K = 0, L_V = 40960, L_TAB = 81920, TABN = 392, L_RV = L_TAB + 8 * 4 * TABN * 4, L_SS = L_RV + 512, L_END = L_SS + 2048, L_UA = 65536, L_UB = L_END, L_END2 = L_UB + 16384, L_PAR = L_END2, L_END3 = L_PAR + 2560 * 4;
constexpr int NUNITS = NSEQ * (SEQ / 64);
__device__ __forceinline__ unsigned cvtpk(float lo, float hi) { f32x2_t v = {lo, hi}; bf16x2_t b = __builtin_convertvector(v, bf16x2_t); return __builtin_bit_cast(unsigned, b); }
__device__ __forceinline__ s16x4 trrd(const LAS unsigned char* p) { typedef short v4i16_t __attribute__((ext_vector_type(4))); return __builtin_bit_cast(s16x4, __builtin_amdgcn_ds_read_tr16_b64_v4i16((LAS v4i16_t*)p)); }
__device__ __forceinline__ float xhalf_sum(float v) { auto rr = __builtin_amdgcn_permlane32_swap(__float_as_uint(v), __float_as_uint(v), false, false); return __uint_as_float(rr[0]) + __uint_as_float(rr[1]); }
__device__ __forceinline__ float xhalf_max(float v) { auto rr = __builtin_amdgcn_permlane32_swap(__float_as_uint(v), __float_as_uint(v), false, false); return fmaxf(__uint_as_float(rr[0]), __uint_as_float(rr[1])); }


__device__ __forceinline__ void store_pairs(bf16_t* p, const u32x2 (&w)[4], int hi, bool skip = false) {
    if (skip) { asm volatile("" :: "v"(w[0].x), "v"(w[1].x), "v"(w[2].x), "v"(w[3].x)); return; }
#pragma unroll
    for (int k = 0; k < 4; k += 2) {
        auto rx = __builtin_amdgcn_permlane32_swap(w[k].x, w[k + 1].x, false, false); auto ry = __builtin_amdgcn_permlane32_swap(w[k].y, w[k + 1].y, false, false);
        const u32x4 v = {rx[0], ry[0], rx[1], ry[1]};
        *(u32x4*)(p + 8 * (k + hi)) = v;
    }
}

__device__ __forceinline__ void pack_pairs(u32x4 (&out)[2], const u32x2 (&w)[4]) {
#pragma unroll
    for (int k = 0; k < 4; k += 2) {
        auto rx = __builtin_amdgcn_permlane32_swap(w[k].x, w[k + 1].x, false, false); auto ry = __builtin_amdgcn_permlane32_swap(w[k].y, w[k + 1].y, false, false);
        out[k >> 1] = (u32x4){rx[0], ry[0], rx[1], ry[1]};
    }
}

template <int MODE> __device__ __forceinline__ void stage_rows(LAS unsigned char* img, const bf16_t* src, int row_lo, int row_hi, int wave, int lane, bool nodma) {
    if (nodma) return;
    for (int r8 = (row_lo >> 3) + wave; r8 < (row_hi >> 3); r8 += 8) {
        const int row = 8 * r8 + (lane >> 3), pc = lane & 7, c = MODE == 0 ? (pc ^ ((row >> 1) & 7)) : (pc ^ (((row >> 1) & 1) << 2));
        __builtin_amdgcn_global_load_lds((const unsigned*)(src + (size_t)row * INW + 8 * c), (LAS unsigned*)(img + r8 * 1024), 16, 0, 0);
    }
}


template <bool FAST> __device__ __forceinline__ void attn_tiles(LAS unsigned char* lds, const bf16x8 (&qf)[4], const LAS float* tbp, int kt_lo, int kt_hi, const int (&koff)[4], const int (&voff)[2], int hi, f32x16& o0r, f32x16& o1r) {
    float m = 0.0f, l = hi == 0 ? 1.0f : 0.0f;
    f32x16 o0 = {}, o1 = {};
    for (int kt = kt_lo; kt < kt_hi; ++kt) {
        f32x16 p0, p1;
        { const LAS float* tp = tbp + 64 * kt;
#pragma unroll
          for (int gq = 0; gq < 4; ++gq) { const f32x4 a = *(const LAS f32x4*)(tp + 8 * gq), b = *(const LAS f32x4*)(tp + 32 + 8 * gq);
#pragma unroll
              for (int e = 0; e < 4; ++e) { p0[4 * gq + e] = a[e]; p1[4 * gq + e] = b[e]; } } }
        const LAS unsigned char* kb = lds + L_K + kt * 8192;
#pragma unroll
        for (int d0 = 0; d0 < 4; ++d0) { const bf16x8 k0 = *(const LAS bf16x8*)(kb + koff[d0]), k1 = *(const LAS bf16x8*)(kb + 4096 + koff[d0]);
            p0 = __builtin_amdgcn_mfma_f32_32x32x16_bf16(k0, qf[d0], p0, 0, 0, 0); p1 = __builtin_amdgcn_mfma_f32_32x32x16_bf16(k1, qf[d0], p1, 0, 0, 0); }
        const LAS unsigned char* vb = lds + L_V + kt * 8192;
        bf16x8 vf0[2][2];
#pragma unroll
        for (int sI = 0; sI < 2; ++sI)
#pragma unroll
            for (int dh = 0; dh < 2; ++dh) { const LAS unsigned char* vp = vb + (16 * sI) * 128 + voff[dh];
                const s16x4 lo = trrd(vp), hi4 = trrd(vp + 8 * 128); vf0[sI][dh] = (bf16x8){lo[0], lo[1], lo[2], lo[3], hi4[0], hi4[1], hi4[2], hi4[3]}; }
        float ls = 0.f;
        if (FAST) {
#pragma unroll
            for (int r = 0; r < 16; ++r) { p0[r] = __builtin_amdgcn_exp2f(p0[r]); p1[r] = __builtin_amdgcn_exp2f(p1[r]); }
            { f32x2_t l2 = {0.f, 0.f};
#pragma unroll
              for (int r = 0; r < 16; r += 2) l2 += (f32x2_t){p0[r], p0[r + 1]} + (f32x2_t){p1[r], p1[r + 1]};
              ls = l2.x + l2.y; }
            l += ls;
        } else {
            float rm = fmaxf(p0[0], p1[0]);
#pragma unroll
            for (int r = 1; r < 16; ++r) rm = fmaxf(rm, fmaxf(p0[r], p1[r]));
            rm = xhalf_max(rm);
            const float mn = fmaxf(m, rm), alpha = __builtin_amdgcn_exp2f(m - mn); m = mn;
#pragma unroll
            for (int r = 0; r < 16; ++r) { p0[r] = __builtin_amdgcn_exp2f(p0[r] - m); p1[r] = __builtin_amdgcn_exp2f(p1[r] - m); ls += p0[r] + p1[r]; }
            l = l * alpha + ls;
#pragma unroll
            for (int r = 0; r < 16; ++r) { o0[r] *= alpha; o1[r] *= alpha; }
        }
        u32x4 pw[2][2];
#pragma unroll
        for (int sI = 0; sI < 2; ++sI) { pw[0][sI] = (u32x4){cvtpk(p0[8 * sI], p0[8 * sI + 1]), cvtpk(p0[8 * sI + 2], p0[8 * sI + 3]), cvtpk(p0[8 * sI + 4], p0[8 * sI + 5]), cvtpk(p0[8 * sI + 6], p0[8 * sI + 7])};
                                         pw[1][sI] = (u32x4){cvtpk(p1[8 * sI], p1[8 * sI + 1]), cvtpk(p1[8 * sI + 2], p1[8 * sI + 3]), cvtpk(p1[8 * sI + 4], p1[8 * sI + 5]), cvtpk(p1[8 * sI + 6], p1[8 * sI + 7])}; }
#pragma unroll
        for (int sI = 0; sI < 2; ++sI) { const bf16x8 pf = __builtin_bit_cast(bf16x8, pw[0][sI]);
            o0 = __builtin_amdgcn_mfma_f32_32x32x16_bf16(vf0[sI][0], pf, o0, 0, 0, 0); o1 = __builtin_amdgcn_mfma_f32_32x32x16_bf16(vf0[sI][1], pf, o1, 0, 0, 0); }
#pragma unroll
        for (int sI = 0; sI < 2; ++sI) { const bf16x8 pf = __builtin_bit_cast(bf16x8, pw[1][sI]);
#pragma unroll
            for (int dh = 0; dh < 2; ++dh) { const LAS unsigned char* vp = vb + (32 + 16 * sI) * 128 + voff[dh];
                const s16x4 lo = trrd(vp), hi4 = trrd(vp + 8 * 128); const bf16x8 vf = {lo[0], lo[1], lo[2], lo[3], hi4[0], hi4[1], hi4[2], hi4[3]};
                if (dh == 0) o0 = __builtin_amdgcn_mfma_f32_32x32x16_bf16(vf, pf, o0, 0, 0, 0); else o1 = __builtin_amdgcn_mfma_f32_32x32x16_bf16(vf, pf, o1, 0, 0, 0); } }
    }
    const float inv = 1.0f / xhalf_sum(l);
#pragma unroll
    for (int r = 0; r < 16; ++r) { o0[r] *= inv; o1[r] *= inv; }
    o0r = o0; o1r = o1;
}

__device__ __forceinline__ void p2_mixer(const float* const* in, unsigned char* ws, LAS unsigned char* lds, int G, int pflags) {
    const bool nodma = pflags & 1;
    const int tid = threadIdx.x, wave = __builtin_amdgcn_readfirstlane(tid >> 6), lane = tid & 63, r32 = lane & 31, hi = lane >> 5, hq = wave >> 1, tb = wave & 1;
    const bf16_t* PROJ = (const bf16_t*)(ws + WS_PROJ); const float* VSSQ = (const float*)(ws + WS_VSSQ); const bf16_t* WSB = (const bf16_t*)(ws + WS_WS); bf16_t* MIX = (bf16_t*)(ws + WS_MIX);
    const float* rel_table = in[2]; const float* sink = in[7]; const float* v_gain = in[8]; const float* b_s = in[10]; const float* ag = in[11]; const float* gg = in[12];
    LAS float* TAB = (LAS float*)(lds + L_TAB); LAS float* RV = (LAS float*)(lds + L_RV); LAS float* SS = (LAS float*)(lds + L_SS);
    { LAS float* RT = (LAS float*)(lds + L_K);
      if (tid < 256) RT[tid] = rel_table[tid]; else if (tid < 264) RT[tid] = sink[tid - 256];
      __syncthreads();
      { const int h = wave;
        const float sk = RT[256 + h];
#pragma unroll
        for (int k = 0; k < 7; ++k) { const int bi = lane + 64 * k - 64;
            const float v = (bi >= 0 && bi <= 256) ? (RT[t5_bucket(bi - 128) * 8 + h] - sk) * LOG2E : -1e30f;
#pragma unroll
            for (int s4 = 0; s4 < 4; ++s4) { const int e = bi + 64 - s4; if (e >= 0 && e < TABN) TAB[(h * 4 + s4) * TABN + e] = v; } } }
      LAS float* PAR = (LAS float*)(lds + L_PAR);
      PAR[tid] = ag[tid]; PAR[512 + tid] = gg[tid]; PAR[1024 + tid] = v_gain[tid]; PAR[1536 + tid] = b_s[tid]; PAR[2048 + tid] = b_s[512 + tid]; }
    const LAS float* PAG = (const LAS float*)(lds + L_PAR); const LAS float* PGG = PAG + 512; const LAS float* PVG = PAG + 1024; const LAS float* PBS = PAG + 1536;
    bool fast;
    { float mq = fabsf(in[5][lane]), mk = fabsf(in[6][lane]), mb = fmaxf(fmaxf(fabsf(rel_table[lane]), fabsf(rel_table[64 + lane])), fmaxf(fabsf(rel_table[128 + lane]), fabsf(rel_table[192 + lane]))), ms = fabsf(sink[lane & 7]);
#pragma unroll
      for (int o = 1; o < 64; o <<= 1) { mq = fmaxf(mq, __shfl_xor(mq, o)); mk = fmaxf(mk, __shfl_xor(mk, o)); mb = fmaxf(mb, __shfl_xor(mb, o)); ms = fmaxf(ms, __shfl_xor(ms, o)); }
      const float bound = (8.0f * mq * mk * 1.02f + mb + ms) * LOG2E;
      fast = __builtin_amdgcn_readfirstlane((int)(bound < 100.0f)) != 0; }
    int koff[4], voff[2], gvoff[2];
    { const int q = (lane & 15) >> 2, sw = (q >> 1) & 1;
#pragma unroll
      for (int d0 = 0; d0 < 4; ++d0) koff[d0] = r32 * 128 + (((2 * d0 + hi) ^ ((r32 >> 1) & 7)) << 4);
#pragma unroll
      for (int dh = 0; dh < 2; ++dh) { const int ch = 4 * (dh ^ sw) + 2 * ((lane >> 4) & 1) + ((lane & 3) >> 1);
          voff[dh] = (4 * hi + q) * 128 + ch * 16 + (lane & 1) * 8; gvoff[dh] = (8 * hi + q) * 128 + ch * 16 + (lane & 1) * 8; } }
    const int e0 = 64 - 32 * tb - r32 + 4 * hi, sh = e0 & 3;
    const int vcu = (G % 8 == 0) ? ((int)blockIdx.x % 8) * (G / 8) + (int)blockIdx.x / 8 : (int)blockIdx.x;

    u32x4 aout[2][2][2]; u32x4 gout[2][2][2]; bool pend = false; size_t prow = 0;
#define MIX_GOUT_STORES() do { if (!(pflags & 8)) { _Pragma("unroll") for (int rd_ = 0; rd_ < 2; ++rd_) _Pragma("unroll") for (int dh_ = 0; dh_ < 2; ++dh_) { bf16_t* pp_ = MIX + prow * D + 512 + 64 * (4 * rd_ + hq) + 32 * dh_; \
        *(u32x4*)(pp_ + 8 * hi) = gout[rd_][dh_][0]; *(u32x4*)(pp_ + 8 * (2 + hi)) = gout[rd_][dh_][1]; \
        bf16_t* pa_ = MIX + prow * D + 64 * (4 * rd_ + hq) + 32 * dh_; *(u32x4*)(pa_ + 8 * hi) = aout[rd_][dh_][0]; *(u32x4*)(pa_ + 8 * (2 + hi)) = aout[rd_][dh_][1]; } } } while (0)
    for (int ri = 0; ; ++ri) {
        int u;
        if (MK_REV2 && G == 256 && NUNITS == 768) { if (ri >= 3) break; u = 4 * (24 * (vcu >> 5) + 8 * (2 - ri) + ((vcu & 31) >> 2)) + (vcu & 3); }
        else { u = vcu + ri * G; if (u >= NUNITS) break; }
        const int s = u >> 6, t0 = (u & 63) * 64, m0 = s * SEQ + t0;
        const int kt_lo = t0 < 128 ? (128 - t0) >> 6 : 0, kt_hi = (pflags & 2) ? kt_lo : (t0 + 192 > SEQ ? (SEQ + 128 - t0) >> 6 : 5);
        const int mc = m0 - (t0 & 127), pbase = (t0 & 127) + 32 * tb + r32;
        const size_t mrow = (size_t)(m0 + 32 * tb + r32);
        f32x16 oa[2][2];
        __syncthreads();
        if (tid < 128) { const f32x4* vp = (const f32x4*)(VSSQ + (size_t)(mc + tid) * 8); const f32x4 a = vp[0] + vp[1]; RV[tid] = rsqrtf(((a[0] + a[1]) + (a[2] + a[3])) * (1.0f / 512.0f) + EPS); }
#pragma unroll
        for (int g = 0; g < 2; ++g) {
            const int h = 4 * g + hq;
            if (g == 1) __syncthreads();
            { const bf16_t* krow0 = PROJ + (long)(m0 - 128) * INW + 512 + 64 * g;
              stage_rows<0>(lds + L_K, krow0, 64 * kt_lo, 64 * kt_hi, wave, lane, nodma);
              stage_rows<1>(lds + L_V, krow0 + 128, 64 * kt_lo, 64 * kt_hi, wave, lane, nodma); }
            bf16x8 qf[4];
#pragma unroll
            for (int d0 = 0; d0 < 4; ++d0) qf[d0] = *(const bf16x8*)(PROJ + mrow * INW + 64 * h + 16 * d0 + 8 * hi);
            __syncthreads();
            if (g == 0 && pend) MIX_GOUT_STORES();
            f32x16 o0, o1;
            { const LAS float* tbp = TAB + (h * 4 + sh) * TABN + (e0 - sh);
              if (fast) attn_tiles<true>(lds, qf, tbp, kt_lo, kt_hi, koff, voff, hi, o0, o1); else attn_tiles<false>(lds, qf, tbp, kt_lo, kt_hi, koff, voff, hi, o0, o1); }
            oa[g][0] = o0; oa[g][1] = o1;
        }
        { float ss = 0.f;
#pragma unroll
          for (int g = 0; g < 2; ++g)
#pragma unroll
              for (int dh = 0; dh < 2; ++dh)
#pragma unroll
                  for (int r = 0; r < 16; ++r) ss += oa[g][dh][r] * oa[g][dh][r];
          ss = xhalf_sum(ss); if (hi == 0) SS[wave * 32 + r32] = ss; }
        __syncthreads();
        { const bf16_t* vrow0 = PROJ + (size_t)mc * INW + 1280;
#pragma unroll
          for (int hh = 0; hh < 4; ++hh) stage_rows<1>(lds + hh * 16384, vrow0 + 64 * hh, 0, 128, wave, lane, nodma);
          const bf16_t* urow0 = PROJ + (size_t)m0 * INW + 768;
#pragma unroll
          for (int hh = 0; hh < 4; ++hh) stage_rows<0>(lds + (hh < 2 ? L_UA + hh * 8192 : L_UB + (hh - 2) * 8192), urow0 + 64 * hh, 0, 64, wave, lane, nodma); }
        { const float tot = (SS[tb * 32 + r32] + SS[(2 + tb) * 32 + r32]) + (SS[(4 + tb) * 32 + r32] + SS[(6 + tb) * 32 + r32]);
          const float ra = rsqrtf(tot * (1.0f / 512.0f) + EPS);
#pragma unroll
          for (int g = 0; g < 2; ++g)
#pragma unroll
              for (int dh = 0; dh < 2; ++dh)
                  { u32x2 w[4];
#pragma unroll
                    for (int gq = 0; gq < 4; ++gq) { const int col = 64 * (4 * g + hq) + 32 * dh + 8 * gq + 4 * hi; const f32x4 gn = *(const LAS f32x4*)(PAG + col);
                      const f32x2_t s0 = ((f32x2_t){oa[g][dh][4 * gq], oa[g][dh][4 * gq + 1]} * ra) * (f32x2_t){gn[0], gn[1]}, s1 = ((f32x2_t){oa[g][dh][4 * gq + 2], oa[g][dh][4 * gq + 3]} * ra) * (f32x2_t){gn[2], gn[3]};
                      w[gq].x = cvtpk(s0.x, s0.y); w[gq].y = cvtpk(s1.x, s1.y); }
                    pack_pairs(aout[g][dh], w); } }
        f32x16 og[2][2];
#pragma unroll
        for (int rd = 0; rd < 2; ++rd) {
            const int hh = 4 * rd + hq;
            if (rd == 1) { __syncthreads();
                const bf16_t* vrow0 = PROJ + (size_t)mc * INW + 1280 + 256;
#pragma unroll
                for (int h4 = 0; h4 < 4; ++h4) stage_rows<1>(lds + h4 * 16384, vrow0 + 64 * h4, 0, 128, wave, lane, nodma);
                const bf16_t* urow0 = PROJ + (size_t)m0 * INW + 768 + 256;
#pragma unroll
                for (int h4 = 0; h4 < 4; ++h4) stage_rows<0>(lds + (h4 < 2 ? L_UA + h4 * 8192 : L_UB + (h4 - 2) * 8192), urow0 + 64 * h4, 0, 64, wave, lane, nodma); }
            bf16x8 wf[8];
            { const bf16_t* wrow = WSB + ((size_t)hh * 128 + pbase) * 128 + 8 * hi;
#pragma unroll
              for (int sI = 0; sI < 8; ++sI) wf[sI] = *(const bf16x8*)(wrow + 16 * sI); }
            __syncthreads();
            f32x16 a0 = {}, a1 = {};
            const LAS unsigned char* gb = lds + hq * 16384;
            if (!(pflags & 4))
#pragma unroll
            for (int sI = 0; sI < 8; ++sI) {
                const f32x4 ra = *(const LAS f32x4*)(RV + 16 * sI + 8 * hi), rb = *(const LAS f32x4*)(RV + 16 * sI + 8 * hi + 4);
                const u32x4 wu = __builtin_bit_cast(u32x4, wf[sI]); u32x4 ws4;
                { const f32x2_t t0 = (f32x2_t){__uint_as_float(wu.x << 16), __uint_as_float(wu.x & 0xffff0000u)} * (f32x2_t){ra[0], ra[1]}, t1 = (f32x2_t){__uint_as_float(wu.y << 16), __uint_as_float(wu.y & 0xffff0000u)} * (f32x2_t){ra[2], ra[3]};
                  const f32x2_t t2 = (f32x2_t){__uint_as_float(wu.z << 16), __uint_as_float(wu.z & 0xffff0000u)} * (f32x2_t){rb[0], rb[1]}, t3 = (f32x2_t){__uint_as_float(wu.w << 16), __uint_as_float(wu.w & 0xffff0000u)} * (f32x2_t){rb[2], rb[3]};
                  ws4.x = cvtpk(t0.x, t0.y); ws4.y = cvtpk(t1.x, t1.y); ws4.z = cvtpk(t2.x, t2.y); ws4.w = cvtpk(t3.x, t3.y); }
                const bf16x8 bfr = __builtin_bit_cast(bf16x8, ws4);
#pragma unroll
                for (int dh = 0; dh < 2; ++dh) { const LAS unsigned char* vp = gb + (16 * sI) * 128 + gvoff[dh];
                    const s16x4 lo = trrd(vp), hi4 = trrd(vp + 4 * 128); const bf16x8 vf = {lo[0], lo[1], lo[2], lo[3], hi4[0], hi4[1], hi4[2], hi4[3]};
                    if (dh == 0) a0 = __builtin_amdgcn_mfma_f32_32x32x16_bf16(vf, bfr, a0, 0, 0, 0); else a1 = __builtin_amdgcn_mfma_f32_32x32x16_bf16(vf, bfr, a1, 0, 0, 0); }
            }
            const float bsv = PBS[hh * 128 + pbase];
            const LAS unsigned char* ub = lds + (hq < 2 ? L_UA + hq * 8192 : L_UB + (hq - 2) * 8192) + (32 * tb + r32) * 128 + 8 * hi;
#pragma unroll
            for (int dh = 0; dh < 2; ++dh)
#pragma unroll
                for (int gq = 0; gq < 4; ++gq) { const int col = 64 * hh + 32 * dh + 8 * gq + 4 * hi; const f32x4 vg = *(const LAS f32x4*)(PVG + col);
                    const u32x2 uu = *(const LAS u32x2*)(ub + (((4 * dh + gq) ^ ((r32 >> 1) & 7)) << 4));
                    const float u0 = __uint_as_float(uu.x << 16), u1 = __uint_as_float(uu.x & 0xffff0000u), u2 = __uint_as_float(uu.y << 16), u3 = __uint_as_float(uu.y & 0xffff0000u);
                    f32x16& acc = dh == 0 ? a0 : a1;
                    const f32x2_t e0 = (f32x2_t){u0, u1} * ((f32x2_t){vg[0], vg[1]} * (f32x2_t){acc[4 * gq], acc[4 * gq + 1]} + bsv), e1 = (f32x2_t){u2, u3} * ((f32x2_t){vg[2], vg[3]} * (f32x2_t){acc[4 * gq + 2], acc[4 * gq + 3]} + bsv);
                    acc[4 * gq] = e0.x; acc[4 * gq + 1] = e0.y; acc[4 * gq + 2] = e1.x; acc[4 * gq + 3] = e1.y; }
            og[rd][0] = a0; og[rd][1] = a1;
        }
        { float ss = 0.f;
#pragma unroll
          for (int rd = 0; rd < 2; ++rd)
#pragma unroll
              for (int dh = 0; dh < 2; ++dh)
#pragma unroll
                  for (int r = 0; r < 16; ++r) ss += og[rd][dh][r] * og[rd][dh][r];
          ss = xhalf_sum(ss); if (hi == 0) SS[256 + wave * 32 + r32] = ss; }
        __syncthreads();
        { const float tot = (SS[256 + tb * 32 + r32] + SS[256 + (2 + tb) * 32 + r32]) + (SS[256 + (4 + tb) * 32 + r32] + SS[256 + (6 + tb) * 32 + r32]);
          const float rg = rsqrtf(tot * (1.0f / 512.0f) + EPS);
#pragma unroll
          for (int rd = 0; rd < 2; ++rd)
#pragma unroll
              for (int dh = 0; dh < 2; ++dh)
                  { u32x2 w[4];
#pragma unroll
                    for (int gq = 0; gq < 4; ++gq) { const int col = 64 * (4 * rd + hq) + 32 * dh + 8 * gq + 4 * hi; const f32x4 gn = *(const LAS f32x4*)(PGG + col);
                      const f32x2_t s0 = ((f32x2_t){og[rd][dh][4 * gq], og[rd][dh][4 * gq + 1]} * rg) * (f32x2_t){gn[0], gn[1]}, s1 = ((f32x2_t){og[rd][dh][4 * gq + 2], og[rd][dh][4 * gq + 3]} * rg) * (f32x2_t){gn[2], gn[3]};
                      w[gq].x = cvtpk(s0.x, s0.y); w[gq].y = cvtpk(s1.x, s1.y); }
                    pack_pairs(gout[rd][dh], w); } }
        pend = true; prow = mrow;
    }
    if (pend) MIX_GOUT_STORES();
#undef MIX_GOUT_STORES
    __syncthreads();
}
}

constexpr int NWAVES = 8;
constexpr int N_PHASES = 6;
constexpr int RING_BYTES = 131072;
constexpr int LDSCTL_OFF = 163840 - 2048, MISC_OFF = LDSCTL_OFF + 320;
constexpr int LDS_BYTES = 163840;
static_assert(MISC_OFF + 128 <= LDS_BYTES && mix::L_END3 <= LDSCTL_OFF, "LDS map");
#if MK_MIXER_RING
static_assert(mixr::R_END <= LDSCTL_OFF, "LDS map (ring mixer)");
#endif
constexpr int CW_BAR = 4096;

#define GAS __attribute__((address_space(1)))

typedef GAS unsigned gu32;
#define RLX_AGENT __ATOMIC_RELAXED, __HIP_MEMORY_SCOPE_AGENT

#define XB_TMO      128
#define XB_XCNT(j)  (256  + 64 * (j))
#define XB_XSUB(j)  (1280 + 64 * (j))
#define XB_XGEN(j)  (2304 + 64 * (j))
#define XB_TOP      3328
#define XB_TOPGEN   3392
#define XCD_BAR_WORDS 3456
#define XB_SPIN_CAP (1u << 18)

__device__ __forceinline__ unsigned xb_ld(unsigned* p)              { return __hip_atomic_load(p, __ATOMIC_RELAXED, __HIP_MEMORY_SCOPE_AGENT); }
__device__ __forceinline__ unsigned xb_add(unsigned* p, unsigned v) { return __hip_atomic_fetch_add(p, v, __ATOMIC_RELAXED, __HIP_MEMORY_SCOPE_AGENT); }
__device__ __forceinline__ unsigned xb_xcc_id() { return (unsigned)__builtin_amdgcn_s_getreg((3 << 11) | 20) & 0xFu; }
#define XB_SPIN(cond, bar) do { unsigned _sp = 0; while (cond) { __builtin_amdgcn_s_sleep(1); \
    if ((++_sp & 255u) == 0u) { if (xb_ld(&(bar)[XB_TMO])) break; if (_sp > XB_SPIN_CAP) { atomicAdd(&(bar)[XB_TMO], 1u); break; } } } } while (0)

struct XcdBarrier { unsigned* bar; unsigned x; volatile LAS unsigned* st; };
__device__ __forceinline__ XcdBarrier xcd_barrier_post(unsigned* bar, volatile LAS unsigned* st) {
    XcdBarrier b; b.bar = bar; b.x = xb_xcc_id(); b.st = st;
    if (threadIdx.x == 0) (void)xb_add(&bar[XB_XCNT(b.x)], 1u);
    return b;
}
__device__ __forceinline__ void xcd_barrier_complete(unsigned* bar, unsigned x, unsigned& nloc, unsigned& nx) {
    const unsigned G = gridDim.x * gridDim.y * gridDim.z;
    unsigned sum, cnt, mine, sp = 0u;
    for (;;) {
        sum = 0u; cnt = 0u; mine = 0u;
#pragma unroll
        for (unsigned j = 0; j < 16; ++j) { const unsigned c = xb_ld(&bar[XB_XCNT(j)]); sum += c; cnt += (c > 0u) ? 1u : 0u; mine = (j == x) ? c : mine; }
        if (sum == G) break;
        __builtin_amdgcn_s_sleep(1);
        if ((++sp & 255u) == 0u) { if (xb_ld(&bar[XB_TMO])) break; if (sp > XB_SPIN_CAP) { atomicAdd(&bar[XB_TMO], 1u); break; } }
    }
    nloc = mine > 0u ? mine : 1u; nx = cnt > 0u ? cnt : 1u;
}
__device__ __forceinline__ void xcd_barrier(const XcdBarrier& b) {
    asm volatile("s_waitcnt vmcnt(0)" ::: "memory");
    __syncthreads();
    if (threadIdx.x == 0) {
        unsigned* bar = b.bar;
        __builtin_amdgcn_s_waitcnt(0);
        unsigned nloc = b.st[0], nx = b.st[1];
        if (nloc == 0u) { xcd_barrier_complete(bar, b.x, nloc, nx); b.st[0] = nloc; b.st[1] = nx; }
        const unsigned old = xb_add(&bar[XB_XSUB(b.x)], 1u);
        const unsigned gen = old / nloc;
        if (old + 1u == (gen + 1u) * nloc) {
            __builtin_amdgcn_fence(__ATOMIC_RELEASE, "agent");
            asm volatile("s_waitcnt vmcnt(0)" ::: "memory");
            const unsigned og = xb_add(&bar[XB_TOP], 1u);
            const unsigned tg = og / nx;
            if (og + 1u == (tg + 1u) * nx) xb_add(&bar[XB_TOPGEN], 1u);
            else XB_SPIN(xb_ld(&bar[XB_TOPGEN]) == tg, bar);
            __builtin_amdgcn_fence(__ATOMIC_ACQUIRE, "agent");
            xb_add(&bar[XB_XGEN(b.x)], 1u);
            asm volatile("s_waitcnt vmcnt(0)" ::: "memory");
        } else {
            XB_SPIN(xb_ld(&bar[XB_XGEN(b.x)]) == gen, bar);
            __builtin_amdgcn_fence(__ATOMIC_ACQUIRE, "agent");
            asm volatile("s_waitcnt vmcnt(0)" ::: "memory");
        }
    }
    __syncthreads();
}

struct Args { const float* in[18]; float* out; unsigned char* ws; int ph_lo, ph_hi; };

__global__ void __launch_bounds__(NWAVES * 64, 2) mk_fwd(Args args) {
    extern __shared__ __attribute__((aligned(16))) unsigned char lds_raw[];
    LAS unsigned char* lds = (LAS unsigned char*)lds_raw;
    volatile LAS unsigned* MISC = (volatile LAS unsigned*)(lds + MISC_OFF);
    const int tid = threadIdx.x, G = gridDim.x;
    unsigned char* ws = args.ws;
    gu32* ctl = (gu32*)(ws + WS_CTL);
    for (int u = tid; u < (LDS_BYTES - LDSCTL_OFF) / 4; u += NWAVES * 64) ((LAS unsigned*)(lds + LDSCTL_OFF))[u] = 0u;
    __syncthreads();
    const int lo = args.ph_lo, hi = args.ph_hi;
    const bool multi = hi - lo > 1;
    XcdBarrier bar; bar.bar = (unsigned*)(ctl + CW_BAR); bar.x = 0; bar.st = nullptr;
    if (multi) bar = xcd_barrier_post((unsigned*)(ctl + CW_BAR), MISC + 8);
#define STAMP(k) do {} while (0)
#define STAGGER_TICKS(ticks) do { const unsigned long long t0_ = __builtin_amdgcn_s_memrealtime(), dl_ = (unsigned long long)(ticks); while (__builtin_amdgcn_s_memrealtime() - t0_ < dl_) __builtin_amdgcn_s_sleep(4); } while (0)
#define IN(k) (lo <= (k) && (k) < hi)
#define BOTH(k) (IN(k) && IN((k) + 1))
    const float* xp = args.in[0]; const float* xs = args.in[1];
    bf16_t* WIN = (bf16_t*)(ws + WS_WIN); bf16_t* WO = (bf16_t*)(ws + WS_WO); bf16_t* WGU = (bf16_t*)(ws + WS_WGU); bf16_t* WDN = (bf16_t*)(ws + WS_WDN);
    float* VSSQ = (float*)(ws + WS_VSSQ); float* SSQ2 = (float*)(ws + WS_SSQ2);
    bf16_t* XN = (bf16_t*)(ws + WS_XN); bf16_t* PROJ = (bf16_t*)(ws + WS_PROJ); bf16_t* H = (bf16_t*)(ws + WS_H); bf16_t* MIX = (bf16_t*)(ws + WS_MIX); bf16_t* X1B = (bf16_t*)(ws + WS_X1B);

    for (int rep = 0; rep < 1 + ((MK_REPEAT_MASK >> 0) & 1); ++rep) if (IN(0)) {
#if MK_PROLOGUE_NAIVE
        p0_prologue_naive(args.in, ws, G);
#else
        p0_prologue(args.in, ws, lds, G);
#endif
        if (BOTH(0)) xcd_barrier(bar); STAMP(0); }
    for (int rep = 0; rep < 1 + ((MK_REPEAT_MASK >> 1) & 1); ++rep) if (IN(1)) {
        pg8::Gemm g{XN, WIN, M, INW, D}; pg8::StaticOrder S; S.init(M, INW, G, (int)blockIdx.x);
        LAS float* RSL = (LAS float*)(lds + RING_BYTES);
        { const float* RS1 = (const float*)(ws + WS_RS1);
          float rv[pg8::EpiIn::NS1 / 2];
#pragma unroll
          for (int k = 0; k < pg8::EpiIn::NS1 / 2; ++k) { pg8::Unit uu; rv[k] = S.next((tid >> 8) + 2 * k, uu) ? RS1[uu.pm * 256 + (tid & 255)] : 0.f; }
#pragma unroll
          for (int k = 0; k < pg8::EpiIn::NS1 / 2; ++k) RSL[((tid >> 8) + 2 * k) * 256 + (tid & 255)] = rv[k];
          __syncthreads(); }
        pg8::EpiIn E{PROJ, VSSQ, args.in[5], args.in[6], RSL, (const float*)(ws + WS_RS1)};
        pg8::gemm_phase<pg8::EpiIn, pg8::StaticOrder, true>(lds, g, S, E);
#if MK_LATE_WEIGHTS
        {
          const int rounds = (S.nwg + G - 1) / G, nbusy = S.nwg - (rounds - 1) * G, c = (int)blockIdx.x;
          const int wave = __builtin_amdgcn_readfirstlane(tid >> 6);
          if (nbusy == G) p0_weights(args.in, ws, lds, P0_I_IN, P0_NITEMS, c * 8 + wave, G * 8);
          else if (c >= nbusy) p0_weights(args.in, ws, lds, P0_I_IN, P0_NITEMS, (c - nbusy) * 8 + wave, (G - nbusy) * 8); }
#endif
        if (BOTH(1)) xcd_barrier(bar); STAMP(1);
    }
    for (int rep = 0; rep < 1 + ((MK_REPEAT_MASK >> 2) & 1); ++rep) if (IN(2) || (MK_EXTRA_PHASE >= 14 && MK_EXTRA_PHASE <= 17 && lo == MK_EXTRA_PHASE)) {
#if MK_MIXER_NAIVE
        p2_mixer_naive(args.in, ws, lds_raw, G);
#else
#if MK_MIXER_RING
        mixr::p2_mixer_ring(args.in, ws, lds, G);
#elif 1
        mix::p2_mixer(args.in, ws, lds, G, (MK_EXTRA_PHASE >= 14 && MK_EXTRA_PHASE <= 17 && lo == MK_EXTRA_PHASE) ? (MK_PFLAGS ? MK_PFLAGS : (1 << (MK_EXTRA_PHASE - 14))) : 0);
#endif
#endif
        if (BOTH(2)) xcd_barrier(bar); STAMP(2); }
    for (int rep = 0; rep < 1 + ((MK_REPEAT_MASK >> 3) & 1); ++rep) if (IN(3)) {
        pg8::Gemm g{MIX, WO, M, D, D}; pg8::StaticOrder S; S.init(M, D, G, (int)blockIdx.x);
        pg8::EpiOut E{XN, X1B, SSQ2};
        pg8::gemm_phase<pg8::EpiOut, pg8::StaticOrder, MK_ALIGN35>(lds, g, S, E);
        if (BOTH(3)) xcd_barrier(bar); STAMP(3);
    }
    for (int rep = 0; rep < 1 + ((MK_REPEAT_MASK >> 4) & 1); ++rep) if (IN(4)) {
        pg8::Gemm g{X1B, WGU, M, NGU, D}; pg8::StaticOrder S; S.init(M, NGU, G, (int)blockIdx.x); if (MK_REV5 == 2) S.reverse();
        LAS float* RS = (LAS float*)(lds + RING_BYTES);
        { pg8::Unit u0; S.next(0, u0); const int r8 = u0.pm & 7, g0 = ((u0.pm >> 3) / 3) * 3;
          for (int i = tid; i < 768; i += NWAVES * 64) { const int row = (8 * (g0 + (i >> 8)) + r8) * 256 + (i & 255); const pg8::f32x4* sp = (const pg8::f32x4*)(SSQ2 + (size_t)row * 16);
              const pg8::f32x4 sv = (sp[0] + sp[1]) + (sp[2] + sp[3]); RS[i] = rsqrtf(((sv[0] + sv[1]) + (sv[2] + sv[3])) * (1.0f / D) + EPS); }
          if (tid < 3) ((LAS int*)(RS + 768))[tid] = 8 * (g0 + tid) + r8;
          __syncthreads(); }
        pg8::EpiUp E{H, RS, SSQ2};
        pg8::gemm_phase<pg8::EpiUp, pg8::StaticOrder, MK_ALIGN4>(lds, g, S, E);
        if (BOTH(4)) xcd_barrier(bar); STAMP(4);
    }
    if (IN(5)) {
        if (MK_STAGGER_TICKS > 0 && (xb_xcc_id() & 1)) STAGGER_TICKS(MK_STAGGER_TICKS);
        pg8::Gemm g{H, WDN, M, D, DFF}; pg8::StaticOrder S; S.init(M, D, G, (int)blockIdx.x); if (MK_REV5 == 1) S.reverse();
        pg8::EpiDown E{X1B, args.out};
        pg8::gemm_phase<pg8::EpiDown, pg8::StaticOrder, MK_ALIGN35>(lds, g, S, E);
        STAMP(5);
    }

#if MK_EXTRA_PHASE >= 6
    if (lo == 6) { pg8::Gemm g{X1B, WGU, M, NGU, D}; pg8::StaticOrder S; S.init(M, NGU, G, (int)blockIdx.x); S.wgm = MK_PFLAGS ? MK_PFLAGS : 8; pg8::EpiNone E; pg8::gemm_phase<pg8::EpiNone, pg8::StaticOrder, true>(lds, g, S, E); }
    if (lo == 7) { pg8::Gemm g{H, WDN, M, D, DFF}; pg8::StaticOrder S; S.init(M, D, G, (int)blockIdx.x); pg8::EpiNone E; pg8::gemm_phase<pg8::EpiNone, pg8::StaticOrder, true>(lds, g, S, E); }
    if (lo == 8) { pg8::Gemm g{X1B, WGU, M, INW, D}; pg8::StaticOrder S; S.init(M, INW, G, (int)blockIdx.x); pg8::EpiNone E; pg8::gemm_phase<pg8::EpiNone, pg8::StaticOrder, true>(lds, g, S, E); }
#endif
#if MK_EXTRA_PHASE == 19
    if (lo == 19) { pg8::Gemm g{X1B, WGU, M, NGU, D}; pg8::StaticOrder S; S.init(M, NGU, G, (int)blockIdx.x);
        LAS float* RS = (LAS float*)(lds + RING_BYTES); for (int i = tid; i < 768; i += NWAVES * 64) RS[i] = 1.0f; __syncthreads();
        pg8::EpiUpFullLine E{H, RS}; pg8::gemm_phase<pg8::EpiUpFullLine, pg8::StaticOrder, true>(lds, g, S, E); }
#endif
#if MK_EXTRA_PHASE == 18
    if (lo == 18) { pg8::Gemm g{MIX, WO, M, D, D}; pg8::StaticOrder S; S.init(M, D, G, (int)blockIdx.x); pg8::EpiNone E; pg8::gemm_phase<pg8::EpiNone, pg8::StaticOrder, true>(lds, g, S, E); }
#endif
#if MK_EXTRA_PHASE >= 11
    if (lo == 20) { pg8::Gemm g{X1B, WGU, M, NGU, D}; pg8::StaticOrder S; S.init(M, NGU, G, (int)blockIdx.x); pg8::EpiNone E; pg8::gemm_phase<pg8::EpiNone, pg8::StaticOrder, true, 4>(lds, g, S, E); }
    if (lo == 11) { pg8::Gemm g{X1B, WGU, M, NGU, D}; pg8::StaticOrder S; S.init(M, NGU, G, (int)blockIdx.x); pg8::EpiNone E; pg8::gemm_phase<pg8::EpiNone, pg8::StaticOrder, true, 1>(lds, g, S, E); }
    if (lo == 12) { pg8::Gemm g{X1B, WGU, M, NGU, D}; pg8::StaticOrder S; S.init(M, NGU, G, (int)blockIdx.x); pg8::EpiNone E; pg8::gemm_phase<pg8::EpiNone, pg8::StaticOrder, true, 2>(lds, g, S, E); }
    if (lo == 13) { pg8::Gemm g{X1B, WGU, M, NGU, D}; pg8::StaticOrder S; S.init(M, NGU, G, (int)blockIdx.x); pg8::EpiNone E; pg8::gemm_phase<pg8::EpiNone, pg8::StaticOrder, true, 3>(lds, g, S, E); }
#endif
#if MK_EXTRA_PHASE >= 9
    if (lo == 9)  { pg8::Gemm g{H, WDN, M, D, DFF}; pg8::StaticOrder S; S.init(M, D, G, (int)blockIdx.x); pg8::EpiDownProbe<1> E{X1B, (float*)(ws + WS_MIX)}; pg8::gemm_phase<pg8::EpiDownProbe<1>, pg8::StaticOrder, true>(lds, g, S, E); }
    if (lo == 10) { pg8::Gemm g{H, WDN, M, D, DFF}; pg8::StaticOrder S; S.init(M, D, G, (int)blockIdx.x); pg8::EpiDownProbe<2> E{X1B, args.out}; pg8::gemm_phase<pg8::EpiDownProbe<2>, pg8::StaticOrder, true>(lds, g, S, E); }
#endif
#undef IN
#undef BOTH
}

extern "C" void kernel_launch(void* const* d_in, const int* in_sizes, int n_in, void* d_out, int out_size, void* d_ws, size_t ws_size, hipStream_t stream) {
    static int grid = 0;
    if (grid == 0) {
        if (n_in != 18 || in_sizes[0] != MP * D || in_sizes[1] != (M - MP) * D || out_size != M * D || ws_size < WS_END) {
            fprintf(stderr, "kernel_launch: unexpected shapes (n_in %d, in0 %d, in1 %d, out %d, ws %zu)\n", n_in, n_in > 0 ? in_sizes[0] : -1, n_in > 1 ? in_sizes[1] : -1, out_size, ws_size); grid = -1; return; }
        int dev = 0, cus = 0, per_cu = 0;
        if (hipGetDevice(&dev) != hipSuccess || hipDeviceGetAttribute(&cus, hipDeviceAttributeMultiprocessorCount, dev) != hipSuccess) { grid = -1; return; }
        if (hipFuncSetAttribute((const void*)mk_fwd, hipFuncAttributeMaxDynamicSharedMemorySize, LDS_BYTES) != hipSuccess) { fprintf(stderr, "kernel_launch: hipFuncSetAttribute failed\n"); grid = -1; return; }
        if (hipOccupancyMaxActiveBlocksPerMultiprocessor(&per_cu, (const void*)mk_fwd, NWAVES * 64, LDS_BYTES) != hipSuccess || per_cu < 1) { fprintf(stderr, "kernel_launch: occupancy query says %d blocks per CU\n", per_cu); grid = -1; return; }
        (void)hipGetLastError();
        grid = cus;
    }
    if (grid < 0) return;
    Args a{};
    for (int i = 0; i < 18; ++i) a.in[i] = (const float*)d_in[i];
    a.out = (float*)d_out; a.ws = (unsigned char*)d_ws;
    unsigned char* ws = (unsigned char*)d_ws;
    static_assert((CW_BAR + XCD_BAR_WORDS) * 4 <= 32768, "control words inside the per-call memset");
    (void)hipMemsetAsync(ws + WS_CTL, 0, 32768, stream);
#if MK_ONE_LAUNCH
#if 0 && MK_EXTRA_PHASE == 3
    a.ph_lo = 0; a.ph_hi = 4; hipLaunchKernelGGL(mk_fwd, dim3(grid), dim3(NWAVES * 64), LDS_BYTES, stream, a);
    (void)hipMemsetAsync(ws + WS_CTL, 0, 1 * MiB, stream);
    a.ph_lo = 3; a.ph_hi = 6; hipLaunchKernelGGL(mk_fwd, dim3(grid), dim3(NWAVES * 64), LDS_BYTES, stream, a);
#else
    a.ph_lo = 0; a.ph_hi = N_PHASES;
#if MK_PLAIN_LAUNCH
    hipLaunchKernelGGL(mk_fwd, dim3(grid), dim3(NWAVES * 64), LDS_BYTES, stream, a);
#else
    { void* kargs[] = {&a}; hipError_t e = hipLaunchCooperativeKernel((const void*)mk_fwd, dim3(grid), dim3(NWAVES * 64), kargs, LDS_BYTES, stream);
      if (e != hipSuccess) fprintf(stderr, "kernel_launch: cooperative launch failed: %s (grid %d)\n", hipGetErrorString(e), grid); }
#endif
#if MK_EXTRA_PHASE >= 0
    a.ph_lo = MK_EXTRA_PHASE; a.ph_hi = MK_EXTRA_PHASE + 1; hipLaunchKernelGGL(mk_fwd, dim3(grid), dim3(NWAVES * 64), LDS_BYTES, stream, a);
#endif
#endif
#else
    for (int p = 0; p < N_PHASES; ++p) {
        if (!(MK_PHASE_MASK & (1 << p))) { launch_naive_phase(p, d_in, (float*)d_out, ws, stream); continue; }
        a.ph_lo = p; a.ph_hi = p + 1;
        hipLaunchKernelGGL(mk_fwd, dim3(grid), dim3(NWAVES * 64), LDS_BYTES, stream, a);
    }
#endif
}
```
